# Optimizing an MI355X kernel written in HIP

```python
import jax, jax.numpy as jnp
from jax import lax
import numpy as np

D_MODEL = 1024
BATCH = 2
SEQ = 8192
DEPTH = 2

NSA_HEADS = 8
NSA_GROUPS = 2
NSA_HPG = NSA_HEADS // NSA_GROUPS
NSA_DK = 64
NSA_DV = 64
CMP_BLOCK = 32
CMP_STRIDE = 16
SLC_BLOCK = 64
N_SELECT = 16
WINDOW = 512
MLA_HEADS = 8
MLA_NOPE = 64
MLA_ROPE = 32
MLA_V = 64
MLA_Q_RANK = 384
MLA_KV_RANK = 256
ROPE_THETA = 10000.0
D_FF = 2816
N_MOD = 9
Q_BLOCK = 128
NORM_EPS = 1e-6

IN_SPLITS = (
    NSA_HEADS * NSA_DK,
    NSA_GROUPS * NSA_DK,
    NSA_GROUPS * NSA_DV,
    NSA_GROUPS * NSA_DK,
    NSA_GROUPS * NSA_DV,
    NSA_GROUPS * NSA_DK,
    NSA_GROUPS * NSA_DV,
    3 * NSA_HEADS,
    MLA_Q_RANK,
    MLA_KV_RANK,
    MLA_ROPE,
    2 * D_MODEL,
)
IN_TOTAL = sum(IN_SPLITS)

kernel_name = "hybrid_nsa_mla_macaron_adaln"


def rms_norm(x):
    xf = x.astype(jnp.float32)
    return (xf * lax.rsqrt(jnp.mean(xf * xf, -1, keepdims=True) + NORM_EPS)).astype(x.dtype)


def modulate(x, shift, scale):
    return rms_norm(x) * (1 + scale[:, None, :]) + shift[:, None, :]


def swiglu(u, w_gate, w_up, w_down):
    return (jax.nn.silu(u @ w_gate) * (u @ w_up)) @ w_down


def masked_softmax(scores, mask):
    s = jnp.where(mask, scores.astype(jnp.float32), -jnp.inf)
    m = jnp.max(s, -1, keepdims=True)
    m = jnp.where(jnp.isfinite(m), m, 0.0)
    p = jnp.exp(s - m)
    return p / jnp.maximum(jnp.sum(p, -1, keepdims=True), 1.0)


def rope(x, cos, sin):
    half = x.shape[-1] // 2
    x1, x2 = x[..., :half], x[..., half:]
    return jnp.concatenate([x1 * cos - x2 * sin, x1 * sin + x2 * cos], -1).astype(x.dtype)


def alibi_slopes(n):
    return 2.0 ** (-8.0 * jnp.arange(1, n + 1, dtype=jnp.float32) / n)


def compress(k, w1, w2, pe):
    B, G, S, d = k.shape
    n_chunks = S // CMP_STRIDE
    r = CMP_BLOCK // CMP_STRIDE
    n_cmp = n_chunks - r + 1
    chunks = k.reshape(B, G, n_chunks, CMP_STRIDE, d)
    blocks = jnp.concatenate([chunks[:, :, j:j + n_cmp] for j in range(r)], axis=3)
    blocks = (blocks + pe).reshape(B, G, n_cmp, CMP_BLOCK * d)
    return jax.nn.gelu(blocks @ w1) @ w2


def nsa_attention(q, k_c, v_c, k_s, v_s, k_w, v_w, gates):
    B, G, HPG, S, dk = q.shape
    dv = v_c.shape[-1]
    nq = S // Q_BLOCK
    n_slc = S // SLC_BLOCK
    n_top = min(N_SELECT, n_slc)
    n_cmp = k_c.shape[2]
    ratio = SLC_BLOCK // CMP_STRIDE
    r = CMP_BLOCK // CMP_STRIDE
    cmp_end = jnp.arange(n_cmp) * CMP_STRIDE + CMP_BLOCK - 1
    ks_blocks = k_s.reshape(B, G, n_slc, SLC_BLOCK, dk)
    vs_blocks = v_s.reshape(B, G, n_slc, SLC_BLOCK, dv)
    kw_pad = jnp.pad(k_w, ((0, 0), (0, 0), (WINDOW, 0), (0, 0)))
    vw_pad = jnp.pad(v_w, ((0, 0), (0, 0), (WINDOW, 0), (0, 0)))
    slope = alibi_slopes(NSA_HEADS).reshape(1, G, HPG, 1, 1)
    scale = dk ** -0.5
    b_ix = jnp.arange(B)[:, None, None, None]
    g_ix = jnp.arange(G)[None, :, None, None]
    blk = jnp.arange(n_slc)

    def block(i):
        q0 = i * Q_BLOCK
        qb = lax.dynamic_slice_in_dim(q, q0, Q_BLOCK, axis=3)
        gb = lax.dynamic_slice_in_dim(gates, q0, Q_BLOCK, axis=3)
        t = q0 + jnp.arange(Q_BLOCK)
        d_c = (t[:, None] - cmp_end[None, :]).astype(jnp.float32)
        s_c = jnp.einsum('bghqd,bgnd->bghqn', qb, k_c).astype(jnp.float32) * scale - slope * d_c
        p_c = masked_softmax(s_c, cmp_end[None, :] <= t[:, None])
        o_c = jnp.einsum('bghqn,bgnd->bghqd', p_c.astype(v_c.dtype), v_c)
        imp = jnp.pad(p_c.sum(axis=2), ((0, 0), (0, 0), (0, 0), (r - 1, n_slc * ratio - n_cmp)))
        imp_s = imp[..., 0:ratio * n_slc:ratio]
        for j in range(1, ratio + r - 1):
            imp_s = imp_s + imp[..., j:j + ratio * n_slc:ratio]
        cur = t // SLC_BLOCK
        forced = (blk[None, :] == 0) | (blk[None, :] == cur[:, None]) | (blk[None, :] == cur[:, None] - 1)
        valid = blk[None, :] * SLC_BLOCK <= t[:, None]
        imp_s = jnp.where(forced, jnp.inf, jnp.where(valid, imp_s, -jnp.inf))
        _, idx = lax.top_k(imp_s, n_top)
        ks = ks_blocks[b_ix, g_ix, idx].reshape(B, G, Q_BLOCK, n_top * SLC_BLOCK, dk)
        vs = vs_blocks[b_ix, g_ix, idx].reshape(B, G, Q_BLOCK, n_top * SLC_BLOCK, dv)
        pos_s = (idx[..., None] * SLC_BLOCK + jnp.arange(SLC_BLOCK)).reshape(B, G, Q_BLOCK, n_top * SLC_BLOCK)
        d_s = (t[:, None] - pos_s).astype(jnp.float32)[:, :, None]
        s_s = jnp.einsum('bghqd,bgqkd->bghqk', qb, ks).astype(jnp.float32) * scale - slope * d_s
        p_s = masked_softmax(s_s, (pos_s <= t[:, None])[:, :, None])
        o_s = jnp.einsum('bghqk,bgqkd->bghqd', p_s.astype(vs.dtype), vs)
        kw = lax.dynamic_slice_in_dim(kw_pad, q0, WINDOW + Q_BLOCK, axis=2)
        vw = lax.dynamic_slice_in_dim(vw_pad, q0, WINDOW + Q_BLOCK, axis=2)
        pos_w = q0 - WINDOW + jnp.arange(WINDOW + Q_BLOCK)
        d_w = t[:, None] - pos_w[None, :]
        mask_w = (d_w >= 0) & (d_w < WINDOW) & (pos_w[None, :] >= 0)
        s_w = jnp.einsum('bghqd,bgkd->bghqk', qb, kw).astype(jnp.float32) * scale - slope * d_w.astype(jnp.float32)
        p_w = masked_softmax(s_w, mask_w)
        o_w = jnp.einsum('bghqk,bgkd->bghqd', p_w.astype(vw.dtype), vw)
        return gb[..., 0:1] * o_c + gb[..., 1:2] * o_s + gb[..., 2:3] * o_w

    out = lax.map(block, jnp.arange(nq))
    return out.transpose(1, 0, 4, 2, 3, 5).reshape(B, S, G * HPG * dv)


def mla_attention(q_nope, q_rope, k_nope, k_rope, v):
    B, H, S, _ = q_nope.shape
    dv = v.shape[-1]
    nq = S // Q_BLOCK
    scale = (MLA_NOPE + MLA_ROPE) ** -0.5
    kpos = jnp.arange(S)

    def block(i):
        q0 = i * Q_BLOCK
        qn = lax.dynamic_slice_in_dim(q_nope, q0, Q_BLOCK, axis=2)
        qr = lax.dynamic_slice_in_dim(q_rope, q0, Q_BLOCK, axis=2)
        s = (jnp.einsum('bhqd,bhkd->bhqk', qn, k_nope)
             + jnp.einsum('bhqd,bkd->bhqk', qr, k_rope)).astype(jnp.float32) * scale
        qpos = q0 + jnp.arange(Q_BLOCK)
        p = masked_softmax(s, kpos[None, :] <= qpos[:, None])
        return jnp.einsum('bhqk,bhkd->bhqd', p.astype(v.dtype), v)

    out = lax.map(block, jnp.arange(nq))
    return out.transpose(1, 0, 3, 2, 4).reshape(B, S, H * dv)


def token_mix(u, cos, sin, w_in, cmpk_w1, cmpk_w2, cmpk_pe, cmpv_w1, cmpv_w2, cmpv_pe,
              mla_q_norm, mla_w_uq, mla_kv_norm, mla_w_uk, mla_w_uv,
              w_branch_a, w_branch_b, w_out):
    B, S, _ = u.shape
    points = np.cumsum(IN_SPLITS)[:-1].tolist()
    (q_a, kc, vc, ks, vs, kw, vw, g_nsa, cq, ckv, kr, g_merge) = jnp.split(u @ w_in, points, axis=-1)
    q_a = q_a.reshape(B, S, NSA_GROUPS, NSA_HPG, NSA_DK).transpose(0, 2, 3, 1, 4)
    grp = lambda t: t.reshape(B, S, NSA_GROUPS, -1).transpose(0, 2, 1, 3)
    g_nsa = jax.nn.sigmoid(g_nsa).reshape(B, S, NSA_GROUPS, NSA_HPG, 3).transpose(0, 2, 3, 1, 4)
    k_c = compress(grp(kc), cmpk_w1, cmpk_w2, cmpk_pe)
    v_c = compress(grp(vc), cmpv_w1, cmpv_w2, cmpv_pe)
    o_a = nsa_attention(q_a, k_c, v_c, grp(ks), grp(vs), grp(kw), grp(vw), g_nsa)
    q = (rms_norm(cq) * mla_q_norm) @ mla_w_uq
    q = q.reshape(B, S, MLA_HEADS, MLA_NOPE + MLA_ROPE)
    q_nope = q[..., :MLA_NOPE].transpose(0, 2, 1, 3)
    q_rope = rope(q[..., MLA_NOPE:], cos[:, None, :], sin[:, None, :]).transpose(0, 2, 1, 3)
    ckv = rms_norm(ckv) * mla_kv_norm
    k_nope = (ckv @ mla_w_uk).reshape(B, S, MLA_HEADS, MLA_NOPE).transpose(0, 2, 1, 3)
    v = (ckv @ mla_w_uv).reshape(B, S, MLA_HEADS, MLA_V).transpose(0, 2, 1, 3)
    k_rope = rope(kr, cos, sin)
    o_b = mla_attention(q_nope, q_rope, k_nope, k_rope, v)
    g_a, g_b = jnp.split(g_merge, 2, axis=-1)
    y = jax.nn.sigmoid(g_a) * (o_a @ w_branch_a) + jax.nn.sigmoid(g_b) * (o_b @ w_branch_b)
    return y @ w_out


def setup_inputs(seed: int = 0) -> dict:
    key = jax.random.key(seed)
    keys = iter(jax.random.split(key, 40))
    nrm = lambda shape, s: jax.random.normal(next(keys), shape, jnp.float32) * s
    L, D = DEPTH, D_MODEL
    return {
        "x": nrm((BATCH, SEQ, D), 1.0),
        "c": nrm((BATCH, D), 1.0),
        "w_ada": nrm((L, D, N_MOD * D), D ** -0.5),
        "b_ada": nrm((L, N_MOD * D), 0.02),
        "ffn1_gate": nrm((L, D, D_FF), D ** -0.5),
        "ffn1_up": nrm((L, D, D_FF), D ** -0.5),
        "ffn1_down": nrm((L, D_FF, D), D_FF ** -0.5),
        "ffn2_gate": nrm((L, D, D_FF), D ** -0.5),
        "ffn2_up": nrm((L, D, D_FF), D ** -0.5),
        "ffn2_down": nrm((L, D_FF, D), D_FF ** -0.5),
        "w_in": nrm((L, D, IN_TOTAL), D ** -0.5),
        "cmpk_w1": nrm((L, CMP_BLOCK * NSA_DK, NSA_DK), (CMP_BLOCK * NSA_DK) ** -0.5),
        "cmpk_w2": nrm((L, NSA_DK, NSA_DK), NSA_DK ** -0.5),
        "cmpk_pe": nrm((L, CMP_BLOCK, NSA_DK), 0.5),
        "cmpv_w1": nrm((L, CMP_BLOCK * NSA_DV, NSA_DV), (CMP_BLOCK * NSA_DV) ** -0.5),
        "cmpv_w2": nrm((L, NSA_DV, NSA_DV), NSA_DV ** -0.5),
        "cmpv_pe": nrm((L, CMP_BLOCK, NSA_DV), 0.5),
        "mla_q_norm": 1.0 + nrm((L, MLA_Q_RANK), 0.02),
        "mla_w_uq": nrm((L, MLA_Q_RANK, MLA_HEADS * (MLA_NOPE + MLA_ROPE)), MLA_Q_RANK ** -0.5),
        "mla_kv_norm": 1.0 + nrm((L, MLA_KV_RANK), 0.02),
        "mla_w_uk": nrm((L, MLA_KV_RANK, MLA_HEADS * MLA_NOPE), MLA_KV_RANK ** -0.5),
        "mla_w_uv": nrm((L, MLA_KV_RANK, MLA_HEADS * MLA_V), MLA_KV_RANK ** -0.5),
        "w_branch_a": nrm((L, NSA_HEADS * NSA_DV, D), (NSA_HEADS * NSA_DV) ** -0.5),
        "w_branch_b": nrm((L, MLA_HEADS * MLA_V, D), (MLA_HEADS * MLA_V) ** -0.5),
        "w_out": nrm((L, D, D), D ** -0.5),
        "final_norm": 1.0 + nrm((D,), 0.02),
    }


def reference(x, c, w_ada, b_ada, ffn1_gate, ffn1_up, ffn1_down, ffn2_gate, ffn2_up, ffn2_down,
              w_in, cmpk_w1, cmpk_w2, cmpk_pe, cmpv_w1, cmpv_w2, cmpv_pe,
              mla_q_norm, mla_w_uq, mla_kv_norm, mla_w_uk, mla_w_uv,
              w_branch_a, w_branch_b, w_out, final_norm):
    S = x.shape[1]
    half = MLA_ROPE // 2
    inv_freq = ROPE_THETA ** (-jnp.arange(half, dtype=jnp.float32) / half)
    ang = jnp.arange(S, dtype=jnp.float32)[:, None] * inv_freq[None, :]
    cos, sin = jnp.cos(ang).astype(x.dtype), jnp.sin(ang).astype(x.dtype)
    c_act = jax.nn.silu(c)
    for l in range(DEPTH):
        mod = c_act @ w_ada[l] + b_ada[l]
        sh1, sc1, g1, sh2, sc2, g2, sh3, sc3, g3 = jnp.split(mod, N_MOD, axis=-1)
        x = x + 0.5 * g1[:, None, :] * swiglu(modulate(x, sh1, sc1), ffn1_gate[l], ffn1_up[l], ffn1_down[l])
        x = x + g2[:, None, :] * token_mix(
            modulate(x, sh2, sc2), cos, sin, w_in[l],
            cmpk_w1[l], cmpk_w2[l], cmpk_pe[l], cmpv_w1[l], cmpv_w2[l], cmpv_pe[l],
            mla_q_norm[l], mla_w_uq[l], mla_kv_norm[l], mla_w_uk[l], mla_w_uv[l],
            w_branch_a[l], w_branch_b[l], w_out[l])
        x = x + 0.5 * g3[:, None, :] * swiglu(modulate(x, sh3, sc3), ffn2_gate[l], ffn2_up[l], ffn2_down[l])
    return rms_norm(x) * final_norm
```

```cpp
#include <hip/hip_runtime.h>
#include <hip/hip_cooperative_groups.h>
#include <cstdio>
#include <cstdint>
namespace cg = cooperative_groups;

constexpr size_t MiB = 1u << 20;
constexpr size_t WS_MOD = 0;
constexpr size_t WS_CBIAS = 256 * 1024;
constexpr size_t WS_ERR = 384 * 1024;
constexpr size_t WS_SSQQ = 512 * 1024;
constexpr size_t WS_SSQKV = 640 * 1024;
constexpr size_t WS_GATES = 1 * MiB;
constexpr size_t WS_CS = 3 * MiB;
constexpr size_t WS_W = 4 * MiB;
constexpr size_t W_GU1 = WS_W, W_D1 = W_GU1 + (size_t)5632 * 1024 * 2, W_GU2 = W_D1 + (size_t)1024 * 2816 * 2, W_D2 = W_GU2 + (size_t)5632 * 1024 * 2;
constexpr size_t W_IN = W_D2 + (size_t)1024 * 2816 * 2, W_UQ = W_IN + (size_t)4096 * 1024 * 2, W_UKV = W_UQ + (size_t)768 * 384 * 2, W_BA = W_UKV + (size_t)1024 * 256 * 2;
constexpr size_t W_BB = W_BA + (size_t)1024 * 512 * 2, W_OUT = W_BB + (size_t)1024 * 512 * 2, W_1K = W_OUT + (size_t)1024 * 1024 * 2, W_1V = W_1K + (size_t)64 * 2048 * 2, W_END = W_1V + (size_t)64 * 2048 * 2;
static_assert(W_END <= 52 * MiB, "weights region");
constexpr size_t WS_XN = 52 * MiB;
constexpr size_t WS_OA = 52 * MiB, WS_OB = 68 * MiB;
constexpr size_t WS_C = 84 * MiB;
constexpr size_t WS_QN = 84 * MiB, WS_KCF = 100 * MiB, WS_VCF = 104 * MiB, WS_KSEL = 108 * MiB, WS_VSEL = 112 * MiB, WS_KWIN = 116 * MiB, WS_VWIN = 120 * MiB;
constexpr size_t WS_CQ = 124 * MiB, WS_CKV = 136 * MiB, WS_GM = 144 * MiB, WS_KC = 208 * MiB, WS_VC = 208 * MiB + 256 * 1024;
constexpr size_t WS_QM = 212 * MiB, WS_KM = 236 * MiB, WS_VM = 260 * MiB, WS_Y = 212 * MiB, WS_TOTAL = 276 * MiB;


__device__ __forceinline__ int opaque_lane() { unsigned z; asm volatile("v_mov_b32 %0, 0" : "=v"(z)); return (int)__builtin_amdgcn_mbcnt_hi(~0u, __builtin_amdgcn_mbcnt_lo(~0u, z)); }
template <int K> __device__ __forceinline__ float swz_xor(float v) { return __int_as_float(__builtin_amdgcn_ds_swizzle(__float_as_int(v), (K << 10) | 0x1f)); }
__device__ __forceinline__ float half_sum(float v) { auto rr = __builtin_amdgcn_permlane32_swap(__float_as_uint(v), __float_as_uint(v), false, false); return __uint_as_float(rr[0]) + __uint_as_float(rr[1]); }
__device__ __forceinline__ float wave_sum(float v) { v += swz_xor<1>(v); v += swz_xor<2>(v); v += swz_xor<4>(v); v += swz_xor<8>(v); v += swz_xor<16>(v); return half_sum(v); }
namespace pg8 {
#define PG8_LAS __attribute__((address_space(3)))
typedef unsigned short bf16_t;
typedef short bf16x8 __attribute__((ext_vector_type(8)));
typedef float f32x4 __attribute__((ext_vector_type(4)));
typedef unsigned u32x4 __attribute__((ext_vector_type(4)));
constexpr int BM = 256, BK = 64, HALF = 128, HTB = HALF * BK * 2  , STAGE_BYTES = 8 * HTB, NXCD = 8, WGM = 8;

__host__ __device__ __forceinline__ int lds_byte(int r, int c) { const int st = (r >> 4) * 2 + (c >> 5), rr = r & 15, cc = c & 31, ob = rr * 64 + cc * 2; return st * 1024 + (ob ^ (((ob >> 9) & 1) << 5)); }
__host__ __device__ __forceinline__ void stage_rc(int b, int& R, int& C) { const int st = b / 1024, sb = b % 1024, swz = sb ^ (((sb >> 9) & 1) << 5); R = (st >> 1) * 16 + swz / 64; C = (st & 1) * 32 + (swz % 64) / 2; }
__host__ __device__ __forceinline__ int perm32(int rho) { const int n = rho >> 4, i = rho & 15; return 8 * (i >> 2) + 4 * n + (i & 3); }

struct Unit { int pm, pn; };
struct Gemm { const bf16_t* A; const bf16_t* Bt; int M, N, K; };

struct StaticOrder {
    int nM, nN, nwg, G, c;
    __host__ __device__ void init(int M, int N, int G_, int c_) { nM = M / BM; nN = N / BM; nwg = nM * nN; G = G_; c = c_; }
    __host__ __device__ bool next(int i, Unit& u) const {
        const long L = (long)i * G + c; if (L >= nwg) return false;
        int wgid = (int)L; { const int q = nwg / NXCD, r = nwg % NXCD, xcd = wgid % NXCD, off = wgid / NXCD; wgid = (xcd < r ? xcd * (q + 1) : r * (q + 1) + (xcd - r) * q) + off; }
        const int nig = WGM * nN, gid = wgid / nig, fm = gid * WGM, gsz = (nM - fm) < WGM ? (nM - fm) : WGM;
        u.pm = fm + ((wgid % nig) % gsz); u.pn = (wgid % nig) / gsz; return true;
    }
    __device__ __forceinline__ void a_ready(const Unit&) const {}
    __device__ __forceinline__ void done(const Unit&) const {}
};

typedef float cvt_f32x2_t __attribute__((ext_vector_type(2))); typedef __bf16 cvt_bf16x2_t __attribute__((ext_vector_type(2)));
__device__ __forceinline__ unsigned cvt_pk_bf16(float lo, float hi) { cvt_f32x2_t v = {lo, hi}; cvt_bf16x2_t b = __builtin_convertvector(v, cvt_bf16x2_t); return __builtin_bit_cast(unsigned, b); }
typedef float f32x2 __attribute__((ext_vector_type(2)));
constexpr int SEQL = 8192, DMODEL = 1024, DFFN = 2816;
constexpr float LOG2E = 1.4426950408889634f;
constexpr float QSC_NSA = 0.125f * LOG2E;
constexpr float QSC_MLA = 0.10206207261596577f * LOG2E;
constexpr float NEPS = 1e-6f;
__device__ __forceinline__ float sigm(float x) { return __builtin_amdgcn_rcpf(1.0f + __builtin_amdgcn_exp2f(-LOG2E * x)); }
__device__ __forceinline__ void st8(bf16_t* p, f32x4 a0, f32x4 a1) {
    u32x4 w; w.x = cvt_pk_bf16(a0[0], a0[1]); w.y = cvt_pk_bf16(a0[2], a0[3]); w.z = cvt_pk_bf16(a1[0], a1[1]); w.w = cvt_pk_bf16(a1[2], a1[3]); *(u32x4*)p = w; }
__device__ __forceinline__ float bf2f(unsigned short h) { return __uint_as_float(((unsigned)h) << 16); }

struct EpiSwiGLU { static constexpr bool PERM = true, AFTER_DRAIN = false; unsigned char* ws;
    __device__ __forceinline__ void operator()(const f32x4 (&acc)[2][2][4][2], const Unit& u, int wr, int wc, int fr, int fq) const {
        { const int ln_ = opaque_lane(); fr = ln_ & 15; fq = ln_ >> 4; }
        const int row0 = u.pm * BM + wr * 64 + fr, col0 = u.pn * 128 + wc * 32 + 8 * fq;
#pragma unroll
        for (int ai = 0; ai < 2; ++ai)
#pragma unroll
            for (int m = 0; m < 4; ++m) { bf16_t* rowp = (bf16_t*)(ws + WS_C) + (size_t)(row0 + ai * HALF + m * 16) * DFFN + col0;
                f32x4 h0, h1;
#pragma unroll
                for (int j = 0; j < 4; ++j) { const float g0 = acc[ai][0][m][0][j], g1 = acc[ai][0][m][1][j];
                    h0[j] = g0 * sigm(g0) * acc[ai][1][m][0][j]; h1[j] = g1 * sigm(g1) * acc[ai][1][m][1][j]; }
                st8(rowp, h0, h1); }
    }
};
struct EpiResid { static constexpr bool PERM = false, AFTER_DRAIN = false; const float* xin; float* xout; const float* gate; float gs;
    __device__ __forceinline__ void operator()(const f32x4 (&acc)[2][2][4][2], const Unit& u, int wr, int wc, int fr, int fq) const {
        { const int ln_ = opaque_lane(); fr = ln_ & 15; fq = ln_ >> 4; }
        const int col0 = u.pn * BM + wc * 32 + 4 * fq; const int b = (u.pm * BM) >> 13;
        f32x4 gv[2][2];
#pragma unroll
        for (int bj = 0; bj < 2; ++bj)
#pragma unroll
            for (int n = 0; n < 2; ++n) gv[bj][n] = *(const f32x4*)(gate + (size_t)b * 9216 + col0 + bj * HALF + n * 16) * gs;
#pragma unroll
        for (int ai = 0; ai < 2; ++ai)
#pragma unroll
            for (int m = 0; m < 4; ++m) { const size_t off = (size_t)(u.pm * BM + ai * HALF + wr * 64 + m * 16 + fr) * DMODEL + col0;
#pragma unroll
                for (int bj = 0; bj < 2; ++bj)
#pragma unroll
                    for (int n = 0; n < 2; ++n) { const f32x4 xv = *(const f32x4*)(xin + off + bj * HALF + n * 16);
                        *(f32x4*)(xout + off + bj * HALF + n * 16) = xv + gv[bj][n] * acc[ai][bj][m][n]; }
                if (m & 1) asm volatile("" ::: "memory"); }
    }
};
struct EpiWin { static constexpr bool PERM = true, AFTER_DRAIN = false;
    unsigned char* ws;
    __device__ __forceinline__ void operator()(const f32x4 (&acc)[2][2][4][2], const Unit& u, int wr, int wc, int fr, int fq) const {
        { const int ln_ = opaque_lane(); fr = ln_ & 15; fq = ln_ >> 4; }
        bf16_t* const Qn = (bf16_t*)(ws + WS_QN); bf16_t* const kcf = (bf16_t*)(ws + WS_KCF); bf16_t* const vcf = (bf16_t*)(ws + WS_VCF); bf16_t* const Ksel = (bf16_t*)(ws + WS_KSEL); bf16_t* const Vsel = (bf16_t*)(ws + WS_VSEL);
        bf16_t* const Kwin = (bf16_t*)(ws + WS_KWIN); bf16_t* const Vwin = (bf16_t*)(ws + WS_VWIN); bf16_t* const cq = (bf16_t*)(ws + WS_CQ); bf16_t* const ckv = (bf16_t*)(ws + WS_CKV); bf16_t* const Km = (bf16_t*)(ws + WS_KM); bf16_t* const gm = (bf16_t*)(ws + WS_GM);
        float* const gates = (float*)(ws + WS_GATES); const float* const cs = (const float*)(ws + WS_CS);
        const int pn = u.pn;
#pragma unroll
        for (int ai = 0; ai < 2; ++ai)
#pragma unroll
            for (int m = 0; m < 4; ++m) {
                const int row = u.pm * BM + ai * HALF + wr * 64 + m * 16 + fr, b = row >> 13, t = row & (SEQL - 1);
                const int d = wc * 32 + 8 * fq;
                if (pn < 2) {
#pragma unroll
                    for (int bj = 0; bj < 2; ++bj) st8(Qn + (size_t)row * 512 + pn * 256 + bj * HALF + d, acc[ai][bj][m][0] * QSC_NSA, acc[ai][bj][m][1] * QSC_NSA);
                } else if (pn == 2) {
                    const int g = d >> 6, dd = d & 63; const size_t o = ((size_t)(b * 2 + g) * SEQL + t) * 64 + dd;
                    st8(kcf + o, acc[ai][0][m][0], acc[ai][0][m][1]); st8(vcf + o, acc[ai][1][m][0], acc[ai][1][m][1]);
                } else if (pn == 3 || pn == 4) {
                    bf16_t* Kd = pn == 3 ? Ksel : Kwin; bf16_t* Vd = pn == 3 ? Vsel : Vwin;
                    const int g = d >> 6, dd = d & 63; const size_t tb = (size_t)(b * 2 + g) * 128 + (t >> 6);
                    st8(Kd + (tb * 8 + (dd >> 3)) * 512 + (t & 63) * 8, acc[ai][0][m][0], acc[ai][0][m][1]);
                    st8(Vd + tb * 4096 + (dd >> 5) * 2048 + (t & 63) * 32 + (dd & 31), acc[ai][1][m][0], acc[ai][1][m][1]);
                } else if (pn == 5 || pn == 6) {
#pragma unroll
                    for (int bj = 0; bj < 2; ++bj) { const f32x4 a0 = acc[ai][bj][m][0], a1 = acc[ai][bj][m][1];
                        if (pn == 5) st8(ckv + (size_t)row * 256 + bj * HALF + d, a0, a1); else st8(cq + (size_t)row * 384 + bj * HALF + d, a0, a1); }
                } else if (pn == 7) {
                    st8(cq + (size_t)row * 384 + 256 + d, acc[ai][0][m][0], acc[ai][0][m][1]);
                    const f32x4 a0 = acc[ai][1][m][0], a1 = acc[ai][1][m][1];
                    if (wc == 0) {
                        const f32x4 c4 = *(const f32x4*)(cs + (size_t)t * 32 + 4 * fq), s4 = *(const f32x4*)(cs + (size_t)t * 32 + 16 + 4 * fq);
                        f32x4 o0, o1;
                        o0[0] = a0[0] * c4[0] - a0[1] * s4[0]; o0[1] = a0[0] * s4[0] + a0[1] * c4[0];
                        o0[2] = a0[2] * c4[1] - a0[3] * s4[1]; o0[3] = a0[2] * s4[1] + a0[3] * c4[1];
                        o1[0] = a1[0] * c4[2] - a1[1] * s4[2]; o1[1] = a1[0] * s4[2] + a1[1] * c4[2];
                        o1[2] = a1[2] * c4[3] - a1[3] * s4[3]; o1[3] = a1[2] * s4[3] + a1[3] * c4[3];
#pragma unroll
                        for (int h = 0; h < 8; ++h) st8(Km + (((size_t)(b * 8 + h) * 128 + (t >> 6)) * 12 + 8 + fq) * 512 + (t & 63) * 8, o0, o1);
                    } else if (wc == 1 && fq < 3) {
                        float* gp = gates + (size_t)row * 24 + 8 * fq; f32x4 g0, g1;
#pragma unroll
                        for (int j = 0; j < 4; ++j) { g0[j] = sigm(a0[j]); g1[j] = sigm(a1[j]); }
                        *(f32x4*)gp = g0; *(f32x4*)(gp + 4) = g1;
                    }
                } else {
#pragma unroll
                    for (int bj = 0; bj < 2; ++bj) { f32x4 g0, g1;
#pragma unroll
                        for (int j = 0; j < 4; ++j) { g0[j] = sigm(acc[ai][bj][m][0][j]); g1[j] = sigm(acc[ai][bj][m][1][j]); }
                        st8(gm + (size_t)row * 2048 + (pn - 8) * 256 + bj * HALF + d, g0, g1); }
                }
                asm volatile("" ::: "memory");
            }
    }
};
struct EpiQproj { static constexpr bool PERM = true, AFTER_DRAIN = false; unsigned char* ws; const PG8_LAS float* tab;
    __device__ __forceinline__ void operator()(const f32x4 (&acc)[2][2][4][2], const Unit& u, int wr, int wc, int fr, int fq) const {
        { const int ln_ = opaque_lane(); fr = ln_ & 15; fq = ln_ >> 4; }
        bf16_t* const Qm = (bf16_t*)(ws + WS_QM); const float* const cs = (const float*)(ws + WS_CS);
#pragma unroll
        for (int ai = 0; ai < 2; ++ai)
#pragma unroll
            for (int m = 0; m < 4; ++m) {
                const int row = u.pm * BM + ai * HALF + wr * 64 + m * 16 + fr, t = row & (SEQL - 1);
                const float rs = tab[ai * HALF + wr * 64 + m * 16 + fr];
#pragma unroll
                for (int bj = 0; bj < 2; ++bj) { const int n = u.pn * BM + bj * HALF + wc * 32 + 8 * fq; const int p = n % 96;
                    f32x4 a0 = acc[ai][bj][m][0] * rs, a1 = acc[ai][bj][m][1] * rs;
                    if (p >= 64) { const int i0 = (p - 64) >> 1;
                        const f32x4 c4 = *(const f32x4*)(cs + (size_t)t * 32 + i0), s4 = *(const f32x4*)(cs + (size_t)t * 32 + 16 + i0);
                        f32x4 o0, o1;
                        o0[0] = a0[0] * c4[0] - a0[1] * s4[0]; o0[1] = a0[0] * s4[0] + a0[1] * c4[0];
                        o0[2] = a0[2] * c4[1] - a0[3] * s4[1]; o0[3] = a0[2] * s4[1] + a0[3] * c4[1];
                        o1[0] = a1[0] * c4[2] - a1[1] * s4[2]; o1[1] = a1[0] * s4[2] + a1[1] * c4[2];
                        o1[2] = a1[2] * c4[3] - a1[3] * s4[3]; o1[3] = a1[2] * s4[3] + a1[3] * c4[3];
                        a0 = o0; a1 = o1; }
                    st8(Qm + (size_t)row * 768 + n, a0, a1); }
                asm volatile("" ::: "memory");
            }
    }
};
struct EpiKVproj { static constexpr bool PERM = true, AFTER_DRAIN = false; unsigned char* ws; const PG8_LAS float* tab;
    __device__ __forceinline__ void operator()(const f32x4 (&acc)[2][2][4][2], const Unit& u, int wr, int wc, int fr, int fq) const {
        { const int ln_ = opaque_lane(); fr = ln_ & 15; fq = ln_ >> 4; }
        bf16_t* const Km = (bf16_t*)(ws + WS_KM); bf16_t* const Vm = (bf16_t*)(ws + WS_VM);
#pragma unroll
        for (int ai = 0; ai < 2; ++ai)
#pragma unroll
            for (int m = 0; m < 4; ++m) {
                const int row = u.pm * BM + ai * HALF + wr * 64 + m * 16 + fr, b = row >> 13, t = row & (SEQL - 1);
                const float rs = tab[ai * HALF + wr * 64 + m * 16 + fr];
#pragma unroll
                for (int bj = 0; bj < 2; ++bj) { const int n = (u.pn & 1) * BM + bj * HALF + wc * 32 + 8 * fq; const int h = n >> 6, dd = n & 63;
                    const f32x4 a0 = acc[ai][bj][m][0] * rs, a1 = acc[ai][bj][m][1] * rs; const size_t tb = (size_t)(b * 8 + h) * 128 + (t >> 6);
                    if (u.pn < 2) st8(Km + (tb * 12 + (dd >> 3)) * 512 + (t & 63) * 8, a0, a1);
                    else st8(Vm + tb * 4096 + (dd >> 5) * 2048 + (t & 63) * 32 + (dd & 31), a0, a1); }
                asm volatile("" ::: "memory");
            }
    }
};
template <int PASS> struct EpiBranch { static constexpr bool PERM = true, AFTER_DRAIN = false; unsigned char* ws;
    __device__ __forceinline__ void operator()(const f32x4 (&acc)[2][2][4][2], const Unit& u, int wr, int wc, int fr, int fq) const {
        { const int ln_ = opaque_lane(); fr = ln_ & 15; fq = ln_ >> 4; }
        bf16_t* const Y = (bf16_t*)(ws + WS_Y); const bf16_t* const gm = (const bf16_t*)(ws + WS_GM);
#pragma unroll
        for (int ai = 0; ai < 2; ++ai)
#pragma unroll
            for (int m = 0; m < 4; ++m) { const int row = u.pm * BM + ai * HALF + wr * 64 + m * 16 + fr;
#pragma unroll
                for (int bj = 0; bj < 2; ++bj) { const int n = u.pn * BM + bj * HALF + wc * 32 + 8 * fq;
                    const u32x4 gw = *(const u32x4*)(gm + (size_t)row * 2048 + PASS * 1024 + n);
                    f32x4 a0 = acc[ai][bj][m][0], a1 = acc[ai][bj][m][1];
                    a0[0] *= __uint_as_float(gw.x << 16); a0[1] *= __uint_as_float(gw.x & 0xffff0000u); a0[2] *= __uint_as_float(gw.y << 16); a0[3] *= __uint_as_float(gw.y & 0xffff0000u);
                    a1[0] *= __uint_as_float(gw.z << 16); a1[1] *= __uint_as_float(gw.z & 0xffff0000u); a1[2] *= __uint_as_float(gw.w << 16); a1[3] *= __uint_as_float(gw.w & 0xffff0000u);
                    bf16_t* yp = Y + (size_t)row * DMODEL + n;
                    if (PASS == 1) { const u32x4 yw = *(const u32x4*)yp;
                        a0[0] += __uint_as_float(yw.x << 16); a0[1] += __uint_as_float(yw.x & 0xffff0000u); a0[2] += __uint_as_float(yw.y << 16); a0[3] += __uint_as_float(yw.y & 0xffff0000u);
                        a1[0] += __uint_as_float(yw.z << 16); a1[1] += __uint_as_float(yw.z & 0xffff0000u); a1[2] += __uint_as_float(yw.w << 16); a1[3] += __uint_as_float(yw.w & 0xffff0000u); }
                    st8(yp, a0, a1); }
            }
    }
};
template <class Epi, class Sched, bool ALIGN_EPI = false, bool SP2 = false>
__device__ __forceinline__ void gemm_phase(PG8_LAS unsigned char* lds, const Gemm g, const Sched& S, const Epi& E, int wave_id) {
    int tid_ = wave_id * 64 + opaque_lane();
    const int tid = tid_, wid = __builtin_amdgcn_readfirstlane(tid >> 6), lane = tid & 63, wr = wid >> 2, wc = wid & 3, fr = lane & 15, fq = lane >> 4;
    const int K = g.K, nt = K / BK;
    unsigned voffA[2], voffB[2];
#pragma unroll
    for (int i = 0; i < 2; ++i) { int R, C; stage_rc(tid * 16 + i * 8192, R, C); const int Rb = Epi::PERM ? ((R & ~31) + perm32(R & 31)) : R;
        voffA[i] = (unsigned)(R * K + C) * 2u; voffB[i] = (unsigned)(Rb * K + C) * 2u; }
    const size_t kstep = (size_t)(BK * 2);
    const size_t hstep = (size_t)HALF * K * 2;
    const size_t tstep = 2 * hstep;
    const unsigned ldsw = (unsigned)wid * 1024u;
    const int aoff = lds_byte(wr * 64 + fr, fq * 8), boff = lds_byte(wc * 32 + fr, fq * 8);
#define PG8_SA(b, h) (((b) * 2 + (h)) * HTB)
#define PG8_SB(b, h) ((4 + (b) * 2 + (h)) * HTB)
#define PG8_STAGE(bufoff, gbase, voff) do { _Pragma("unroll") for (int _i = 0; _i < 2; ++_i) \
        __builtin_amdgcn_global_load_lds((const unsigned*)((const char*)(gbase) + (voff)[_i]), (PG8_LAS unsigned*)(lds + (bufoff) + ldsw + _i * 8192), 16, 0, 0); } while (0)
#define PG8_LDA(dst, b, h) do { _Pragma("unroll") for (int m = 0; m < 4; ++m) _Pragma("unroll") for (int k = 0; k < 2; ++k) dst[m][k] = *(const PG8_LAS bf16x8*)(lds + PG8_SA(b, h) + aoff + m * 2048 + k * 1024); } while (0)
#define PG8_LDB(dst, b, h) do { _Pragma("unroll") for (int n = 0; n < 2; ++n) _Pragma("unroll") for (int k = 0; k < 2; ++k) dst[n][k] = *(const PG8_LAS bf16x8*)(lds + PG8_SB(b, h) + boff + n * 2048 + k * 1024); } while (0)
#define PG8_MMA(ai, bj, At, Bt) do { __builtin_amdgcn_s_setprio(1); _Pragma("unroll") for (int m = 0; m < 4; ++m) _Pragma("unroll") for (int n = 0; n < 2; ++n) _Pragma("unroll") for (int k = 0; k < 2; ++k) \
        acc[ai][bj][m][n] = __builtin_amdgcn_mfma_f32_16x16x32_bf16(Bt[n][k], At[m][k], acc[ai][bj][m][n], 0, 0, 0); __builtin_amdgcn_s_setprio(0); } while (0)
#define PG8_WAIT_V(n) asm volatile("s_waitcnt vmcnt(" #n ")" ::: "memory")
#define PG8_WAIT_L(n) asm volatile("s_waitcnt lgkmcnt(" #n ")" ::: "memory")
#define PG8_BAR __builtin_amdgcn_s_barrier()
#define PG8_SCHED __builtin_amdgcn_sched_barrier(0)
    Unit cur, nxt; int ui = 0;
    if (!S.next(0, cur)) return;
    f32x4 acc[2][2][4][2];
#pragma unroll
    for (int a = 0; a < 2; ++a)
#pragma unroll
        for (int b = 0; b < 2; ++b)
#pragma unroll
            for (int m = 0; m < 4; ++m)
#pragma unroll
                for (int n = 0; n < 2; ++n) acc[a][b][m][n] = (f32x4){0.f, 0.f, 0.f, 0.f};
    bf16x8 At[4][2], B0[2][2], B1[2][2];
    const char* cA = (const char*)g.A + (size_t)cur.pm * tstep; const char* cB = (const char*)g.Bt + (size_t)cur.pn * tstep;
    S.a_ready(cur);
    if constexpr (SP2) {
        PG8_STAGE(PG8_SB(0, 0), cB, voffB); PG8_STAGE(PG8_SB(0, 1), cB + hstep, voffB); PG8_STAGE(PG8_SA(0, 0), cA, voffA); PG8_STAGE(PG8_SA(0, 1), cA + hstep, voffA);
        if (wr == 1) PG8_BAR;
        PG8_WAIT_V(2); PG8_BAR;
        PG8_STAGE(PG8_SB(1, 0), cB + kstep, voffB); PG8_STAGE(PG8_SA(1, 0), cA + kstep, voffA); PG8_STAGE(PG8_SB(1, 1), cB + hstep + kstep, voffB);
        PG8_WAIT_V(6); PG8_BAR;
    } else {
        PG8_STAGE(PG8_SB(0, 0), cB, voffB); PG8_STAGE(PG8_SA(0, 0), cA, voffA); PG8_STAGE(PG8_SB(0, 1), cB + hstep, voffB); PG8_STAGE(PG8_SA(0, 1), cA + hstep, voffA);
        if (wr == 1) PG8_BAR;
        PG8_WAIT_V(4); PG8_BAR;
        PG8_STAGE(PG8_SB(1, 0), cB + kstep, voffB); PG8_STAGE(PG8_SA(1, 0), cA + kstep, voffA); PG8_STAGE(PG8_SB(1, 1), cB + hstep + kstep, voffB);
        PG8_WAIT_V(6); PG8_BAR;
    }
    for (;;) {
        const bool has_next = S.next(ui + 1, nxt);
        const char* nA = has_next ? (const char*)g.A + (size_t)nxt.pm * tstep : cA; const char* nB = has_next ? (const char*)g.Bt + (size_t)nxt.pn * tstep : cB;
        for (int t = 0; t < nt; t += 2) {
            const bool last = (t == nt - 2);
            const char* a1 = cA + (size_t)(t + 1) * kstep;
            const char* a2 = last ? nA : cA + (size_t)(t + 2) * kstep; const char* b2 = last ? nB : cB + (size_t)(t + 2) * kstep;
            const char* a3 = a2 + kstep; const char* b3 = b2 + kstep;
            if (last && has_next) S.a_ready(nxt);
            if constexpr (SP2) {
            PG8_LDB(B0, 0, 0); PG8_LDB(B1, 0, 1); PG8_SCHED; PG8_LDA(At, 0, 0); PG8_STAGE(PG8_SA(1, 1), a1 + hstep, voffA);
            PG8_WAIT_V(8); PG8_WAIT_L(0); PG8_BAR; PG8_MMA(0, 0, At, B0); PG8_MMA(0, 1, At, B1); PG8_BAR; PG8_SCHED;
            PG8_LDA(At, 0, 1); PG8_STAGE(PG8_SB(0, 0), b2, voffB); PG8_STAGE(PG8_SB(0, 1), b2 + hstep, voffB); PG8_STAGE(PG8_SA(0, 0), a2, voffA);
            PG8_WAIT_V(8); PG8_WAIT_L(0); PG8_BAR; PG8_MMA(1, 0, At, B0); PG8_MMA(1, 1, At, B1); PG8_BAR; PG8_SCHED;
            PG8_LDB(B0, 1, 0); PG8_LDB(B1, 1, 1); PG8_SCHED; PG8_LDA(At, 1, 0); PG8_STAGE(PG8_SA(0, 1), a2 + hstep, voffA);
            PG8_WAIT_V(8); PG8_WAIT_L(0); PG8_BAR; PG8_MMA(0, 0, At, B0); PG8_MMA(0, 1, At, B1); PG8_BAR; PG8_SCHED;
            PG8_LDA(At, 1, 1); PG8_STAGE(PG8_SB(1, 0), b3, voffB); PG8_STAGE(PG8_SB(1, 1), b3 + hstep, voffB); PG8_STAGE(PG8_SA(1, 0), a3, voffA);
            PG8_WAIT_V(8); PG8_WAIT_L(0); PG8_BAR; PG8_MMA(1, 0, At, B0); PG8_MMA(1, 1, At, B1); PG8_BAR; PG8_SCHED;
            } else {
            PG8_LDB(B0, 0, 0); PG8_SCHED; PG8_LDA(At, 0, 0); PG8_STAGE(PG8_SA(1, 1), a1 + hstep, voffA);
            PG8_WAIT_L(8); PG8_BAR; PG8_WAIT_L(0); PG8_MMA(0, 0, At, B0); PG8_BAR; PG8_SCHED;
            PG8_LDB(B1, 0, 1); PG8_STAGE(PG8_SB(0, 0), b2, voffB);
            PG8_BAR; PG8_WAIT_L(0); PG8_MMA(0, 1, At, B1); PG8_BAR;
            PG8_LDA(At, 0, 1); PG8_STAGE(PG8_SA(0, 0), a2, voffA);
            PG8_BAR; PG8_WAIT_L(0); PG8_MMA(1, 0, At, B0); PG8_BAR; PG8_SCHED;
            PG8_STAGE(PG8_SB(0, 1), b2 + hstep, voffB);
            PG8_WAIT_V(6); PG8_BAR; PG8_MMA(1, 1, At, B1); PG8_BAR;
            PG8_LDB(B0, 1, 0); PG8_SCHED; PG8_LDA(At, 1, 0); PG8_STAGE(PG8_SA(0, 1), a2 + hstep, voffA);
            PG8_WAIT_L(8); PG8_BAR; PG8_WAIT_L(0); PG8_MMA(0, 0, At, B0); PG8_BAR; PG8_SCHED;
            PG8_LDB(B1, 1, 1); PG8_STAGE(PG8_SB(1, 0), b3, voffB);
            PG8_BAR; PG8_WAIT_L(0); PG8_MMA(0, 1, At, B1); PG8_BAR;
            PG8_LDA(At, 1, 1); PG8_STAGE(PG8_SA(1, 0), a3, voffA);
            PG8_BAR; PG8_WAIT_L(0); PG8_MMA(1, 0, At, B0); PG8_BAR; PG8_SCHED;
            PG8_STAGE(PG8_SB(1, 1), b3 + hstep, voffB);
            PG8_WAIT_V(6); PG8_BAR; PG8_MMA(1, 1, At, B1); PG8_BAR;
            }
        }
        if constexpr (ALIGN_EPI) { if (wr == 0) PG8_BAR; }
        if constexpr (!Epi::AFTER_DRAIN) { E(acc, cur, wr, wc, fr, fq); S.done(cur); }
        if (!has_next) break;
#pragma unroll
        for (int a = 0; a < 2; ++a)
#pragma unroll
            for (int b = 0; b < 2; ++b)
#pragma unroll
                for (int m = 0; m < 4; ++m)
#pragma unroll
                    for (int n = 0; n < 2; ++n) acc[a][b][m][n] = (f32x4){0.f, 0.f, 0.f, 0.f};
        cur = nxt; cA = nA; cB = nB; ++ui;
        if constexpr (ALIGN_EPI) { if (wr == 1) PG8_BAR; }
    }
    PG8_WAIT_V(0);
    if constexpr (!ALIGN_EPI) { if (wr == 0) PG8_BAR; }
    PG8_BAR;
    if constexpr (Epi::AFTER_DRAIN) { E.fused(acc, cur, wr, wc, fr, fq, lds, wid, lane); S.done(cur); }
#undef PG8_SA
#undef PG8_SB
#undef PG8_STAGE
#undef PG8_LDA
#undef PG8_LDB
#undef PG8_MMA
#undef PG8_WAIT_V
#undef PG8_WAIT_L
#undef PG8_BAR
#undef PG8_SCHED
}
}
namespace att {
#define LAS __attribute__((address_space(3)))
typedef unsigned short bf16;
typedef short bf16x8 __attribute__((ext_vector_type(8)));
typedef short s16x4 __attribute__((ext_vector_type(4)));
typedef float f32x16 __attribute__((ext_vector_type(16)));
typedef float f32x4 __attribute__((ext_vector_type(4)));
typedef unsigned u32x4 __attribute__((ext_vector_type(4)));
typedef unsigned u32x2 __attribute__((ext_vector_type(2)));
typedef const LAS char* lcp;
constexpr float LOG2E = 1.4426950408889634f;
__device__ __forceinline__ int crow(int r, int hi) { return (r & 3) + 8 * (r >> 2) + 4 * hi; }
typedef float f32x2_t __attribute__((ext_vector_type(2))); typedef __bf16 bf16x2_t __attribute__((ext_vector_type(2)));
__device__ __forceinline__ unsigned cvtpk(float lo, float hi) { f32x2_t v = {lo, hi}; bf16x2_t b = __builtin_convertvector(v, bf16x2_t); return __builtin_bit_cast(unsigned, b); }
__device__ __forceinline__ unsigned short f2bf(float f) { return (unsigned short)(cvtpk(f, 0.f) & 0xffffu); }
__device__ __forceinline__ float xmax(float v) { auto rr = __builtin_amdgcn_permlane32_swap(__float_as_uint(v), __float_as_uint(v), false, false); return fmaxf(__uint_as_float(rr[0]), __uint_as_float(rr[1])); }
__device__ __forceinline__ float xsum(float v) { auto rr = __builtin_amdgcn_permlane32_swap(__float_as_uint(v), __float_as_uint(v), false, false); return __uint_as_float(rr[0]) + __uint_as_float(rr[1]); }
typedef short v4i16_t __attribute__((ext_vector_type(4)));
__device__ __forceinline__ s16x4 vtr(lcp p) { return __builtin_bit_cast(s16x4, __builtin_amdgcn_ds_read_tr16_b64_v4i16((LAS v4i16_t*)p)); }

template <int ND0> __device__ __forceinline__ void qk_tile(f32x16& p0, f32x16& p1, lcp kslot, const bf16x8* qr, int r32, int hi) {
    lcp kb = kslot + hi * 1024 + r32 * 16;
    p0 = f32x16{}; p1 = f32x16{};
#pragma unroll
    for (int d0 = 0; d0 < ND0; ++d0) {
        const bf16x8 b0 = *(const LAS bf16x8*)(kb + d0 * 2048), b1 = *(const LAS bf16x8*)(kb + d0 * 2048 + 512);
        p0 = __builtin_amdgcn_mfma_f32_32x32x16_bf16(b0, qr[d0], p0, 0, 0, 0);
        p1 = __builtin_amdgcn_mfma_f32_32x32x16_bf16(b1, qr[d0], p1, 0, 0, 0); }
}
__device__ __forceinline__ void pv_tile(f32x16& o0, f32x16& o1, lcp vp, const u32x4 (&pa)[4]) {
#pragma unroll
    for (int ks = 0; ks < 4; ++ks) {
        const s16x4 l0 = vtr(vp + ks * 1024), h0 = vtr(vp + ks * 1024 + 512), l1 = vtr(vp + 4096 + ks * 1024), h1 = vtr(vp + 4096 + ks * 1024 + 512);
        const bf16x8 v0 = (bf16x8){l0[0], l0[1], l0[2], l0[3], h0[0], h0[1], h0[2], h0[3]}, v1 = (bf16x8){l1[0], l1[1], l1[2], l1[3], h1[0], h1[1], h1[2], h1[3]};
        const bf16x8 a = __builtin_bit_cast(bf16x8, pa[ks]);
        o0 = __builtin_amdgcn_mfma_f32_32x32x16_bf16(a, v0, o0, 0, 0, 0);
        o1 = __builtin_amdgcn_mfma_f32_32x32x16_bf16(a, v1, o1, 0, 0, 0); }
}
__device__ __forceinline__ void pack_p(u32x4 (&pa)[4], const f32x16& p0, const f32x16& p1) {
    pa[0] = (u32x4){cvtpk(p0[0], p0[1]), cvtpk(p0[2], p0[3]), cvtpk(p0[4], p0[5]), cvtpk(p0[6], p0[7])};
    pa[1] = (u32x4){cvtpk(p0[8], p0[9]), cvtpk(p0[10], p0[11]), cvtpk(p0[12], p0[13]), cvtpk(p0[14], p0[15])};
    pa[2] = (u32x4){cvtpk(p1[0], p1[1]), cvtpk(p1[2], p1[3]), cvtpk(p1[4], p1[5]), cvtpk(p1[6], p1[7])};
    pa[3] = (u32x4){cvtpk(p1[8], p1[9]), cvtpk(p1[10], p1[11]), cvtpk(p1[12], p1[13]), cvtpk(p1[14], p1[15])};
}
__device__ __forceinline__ float max32(const f32x16& p0, const f32x16& p1) {
    float a = fmaxf(p0[0], p1[0]);
#pragma unroll
    for (int r = 1; r < 16; ++r) a = fmaxf(a, fmaxf(p0[r], p1[r]));
    return a;
}
__device__ __forceinline__ void softmax_pv(f32x16& p0, f32x16& p1, float& m, float& l, f32x16& o0, f32x16& o1, lcp vp, LAS float* wsf, int r32, int hi) {
    const float rm = xmax(max32(p0, p1));
    const float mn = fmaxf(m, rm); const float f = __builtin_amdgcn_exp2f(m - mn); m = mn;
    float s = 0.f;
#pragma unroll
    for (int r = 0; r < 16; ++r) { p0[r] = __builtin_amdgcn_exp2f(p0[r] - mn); p1[r] = __builtin_amdgcn_exp2f(p1[r] - mn); s += p0[r] + p1[r]; }
    l = l * f + s;
    if (__any(f != 1.0f)) {
        if (hi == 0) wsf[r32] = f;
#pragma unroll
        for (int r = 0; r < 16; ++r) { const float fr = wsf[crow(r, hi)]; o0[r] *= fr; o1[r] *= fr; }
    }
    u32x4 pa[4]; pack_p(pa, p0, p1);
    pv_tile(o0, o1, vp, pa);
}
__device__ __forceinline__ void add_scaled(f32x16& a0, f32x16& a1, const f32x16& o0, const f32x16& o1, float fac, LAS float* wsf, int r32, int hi) {
    if (hi == 0) wsf[32 + r32] = fac;
#pragma unroll
    for (int r = 0; r < 16; ++r) { const float fr = wsf[32 + crow(r, hi)]; a0[r] += fr * o0[r]; a1[r] += fr * o1[r]; }
}
template <bool FIRST> __device__ __forceinline__ void acc_lds(LAS float* accL, const f32x16& o0, const f32x16& o1, float fac, LAS float* wsf, int r32, int hi) {
    if (hi == 0) wsf[32 + r32] = fac;
#pragma unroll
    for (int r = 0; r < 16; ++r) { const int row = crow(r, hi); const float fr = wsf[32 + row]; LAS float* p = accL + row * 64 + r32;
        if (FIRST) { p[0] = fr * o0[r]; p[32] = fr * o1[r]; } else { p[0] += fr * o0[r]; p[32] += fr * o1[r]; } }
}
__device__ __forceinline__ void store_acc(const LAS float* accL, bf16* gdst, int pitch, int lane) {
#pragma unroll
    for (int i = 0; i < 4; ++i) { const int row = i * 8 + (lane >> 3), ch = lane & 7; const f32x4 a = *(const LAS f32x4*)(accL + row * 64 + ch * 8), b = *(const LAS f32x4*)(accL + row * 64 + ch * 8 + 4);
        const u32x4 v = (u32x4){cvtpk(a[0], a[1]), cvtpk(a[2], a[3]), cvtpk(b[0], b[1]), cvtpk(b[2], b[3])}; *(u32x4*)(gdst + (size_t)row * pitch + ch * 8) = v; }
}
__device__ __forceinline__ void store_o(const f32x16& o0, const f32x16& o1, LAS bf16* stg, bf16* gdst, int pitch, int lane, int r32, int hi) {
#pragma unroll
    for (int r = 0; r < 16; ++r) { const int orow = crow(r, hi); stg[orow * 64 + r32] = f2bf(o0[r]); stg[orow * 64 + 32 + r32] = f2bf(o1[r]); }
#pragma unroll
    for (int i = 0; i < 4; ++i) { const int row = i * 8 + (lane >> 3), ch = lane & 7; const u32x4 v = *(const LAS u32x4*)(stg + row * 64 + ch * 8); *(u32x4*)(gdst + (size_t)row * pitch + ch * 8) = v; }
}

constexpr int M_KS = 0, M_VS = 24576, M_WSF = 40960, M_OST = 43008;
__device__ __forceinline__ void mla_unit(int b, int h, int qb, const bf16* Qm, const bf16* Km, const bf16* Vm, bf16* Ob, LAS char* lds, int wave_id) {
    int tid_ = wave_id * 64 + opaque_lane();
    const int tid = tid_, lane = tid & 63, r32 = lane & 31, hi = lane >> 5, wid = __builtin_amdgcn_readfirstlane(tid >> 6);
    const int q0 = qb * 256, NT = (q0 + 256) / 64;
    const int qmin = q0 + wid * 32, qpos = qmin + r32;
    bf16x8 qr[6];
    { const bf16* qp = Qm + ((size_t)b * 8192 + qpos) * 768 + h * 96 + hi * 8;
#pragma unroll
      for (int d0 = 0; d0 < 6; ++d0) qr[d0] = *(const bf16x8*)(qp + d0 * 16); }
    const char* Kg = (const char*)(Km + (size_t)(b * 8 + h) * 128 * 6144);
    const char* Vg = (const char*)(Vm + (size_t)(b * 8 + h) * 128 * 4096);
    LAS float* wsf = (LAS float*)(lds + M_WSF) + wid * 64;
    const int vlane = ((lane >> 4) & 1) * 32 + (lane & 3) * 8 + (4 * hi + ((lane & 15) >> 2)) * 64;
    float m = -1e30f, l = 0.f; f32x16 o0 = f32x16{}, o1 = f32x16{};
    u32x4 kr0, kr1 = u32x4{}, vr0;
    kr0 = *(const u32x4*)(Kg + tid * 16); if (tid < 256) kr1 = *(const u32x4*)(Kg + 8192 + tid * 16); vr0 = *(const u32x4*)(Vg + tid * 16);
    *(LAS u32x4*)(lds + M_KS + tid * 16) = kr0; if (tid < 256) *(LAS u32x4*)(lds + M_KS + 8192 + tid * 16) = kr1; *(LAS u32x4*)(lds + M_VS + tid * 16) = vr0;
    __syncthreads();
    for (int kt = 0; kt < NT; ++kt) {
        const int sl = kt & 1;
        if (kt + 1 < NT) { const char* kg = Kg + (size_t)(kt + 1) * 12288; const char* vg = Vg + (size_t)(kt + 1) * 8192;
            kr0 = *(const u32x4*)(kg + tid * 16); if (tid < 256) kr1 = *(const u32x4*)(kg + 8192 + tid * 16); vr0 = *(const u32x4*)(vg + tid * 16); }
        if (64 * kt <= qmin + 31) {
            f32x16 p0, p1; qk_tile<6>(p0, p1, (lcp)(lds + M_KS + sl * 12288), qr, r32, hi);
            if (64 * kt + 63 > qmin) {
                const int kb = 64 * kt + 4 * hi;
#pragma unroll
                for (int r = 0; r < 16; ++r) { const int kv = kb + (r & 3) + 8 * (r >> 2); if (kv > qpos) p0[r] = -INFINITY; if (kv + 32 > qpos) p1[r] = -INFINITY; }
            }
            softmax_pv(p0, p1, m, l, o0, o1, (lcp)(lds + M_VS + sl * 8192 + vlane), wsf, r32, hi);
        }
        if (kt + 1 < NT) { const int sn = sl ^ 1;
            *(LAS u32x4*)(lds + M_KS + sn * 12288 + tid * 16) = kr0; if (tid < 256) *(LAS u32x4*)(lds + M_KS + sn * 12288 + 8192 + tid * 16) = kr1; *(LAS u32x4*)(lds + M_VS + sn * 8192 + tid * 16) = vr0; }
        __syncthreads();
    }
    const float lt = xsum(l); const float inv = lt > 0.f ? 1.0f / lt : 0.f;
    f32x16 a0 = f32x16{}, a1 = f32x16{};
    add_scaled(a0, a1, o0, o1, inv, wsf, r32, hi);
    store_o(a0, a1, (LAS bf16*)(lds + M_OST + wid * 4096), Ob + ((size_t)b * 8192 + qmin) * 512 + h * 64, 512, lane, r32, hi);
    __syncthreads();
}

constexpr int N_KS = 0, N_VS = 16384, N_WSF = 32768, N_ACC = 34816, N_IMP = 100352, N_SEL = 133376, N_UNI = 134400, N_BL = 134464, IMPS = 129;
struct NsaT { const bf16 *Qn, *Kc, *Vc, *Ksel, *Vsel, *Kwin, *Vwin; const float* gates; bf16* Oa; };
__device__ __forceinline__ void setbit(unsigned (&w)[4], int j) { const int wi = j >> 5; const unsigned bv = 1u << (j & 31); w[0] |= wi == 0 ? bv : 0u; w[1] |= wi == 1 ? bv : 0u; w[2] |= wi == 2 ? bv : 0u; w[3] |= wi == 3 ? bv : 0u; }
__device__ __forceinline__ void nsa_unit(int b, int g, int ti, const NsaT& T, LAS char* lds, int wave_id) {
    int tid_ = wave_id * 64 + opaque_lane();
    const int tid = tid_, lane = tid & 63, r32 = lane & 31, hi = lane >> 5, wid = __builtin_amdgcn_readfirstlane(tid >> 6);
    const int hh = wid & 3, qh = wid >> 2, H = g * 4 + hh, bg = b * 2 + g;
    const int t0 = ti * 64, qrow = qh * 32 + r32, t = t0 + qrow;
    const float slope2 = __builtin_amdgcn_exp2f(-(float)(H + 1)) * LOG2E;
    bf16x8 qr[4];
    { const bf16* qp = T.Qn + ((size_t)b * 8192 + t) * 512 + H * 64 + hi * 8;
#pragma unroll
      for (int d0 = 0; d0 < 4; ++d0) qr[d0] = *(const bf16x8*)(qp + d0 * 16); }
    LAS float* wsf = (LAS float*)(lds + N_WSF) + wid * 64;
    LAS float* imp = (LAS float*)(lds + N_IMP);
    LAS unsigned* selw = (LAS unsigned*)(lds + N_SEL);
    LAS unsigned* uni = (LAS unsigned*)(lds + N_UNI);
    LAS unsigned* blist = (LAS unsigned*)(lds + N_BL);
    const int vlane = ((lane >> 4) & 1) * 32 + (lane & 3) * 8 + (4 * hi + ((lane & 15) >> 2)) * 64;
    for (int i = tid; i < 64 * IMPS; i += 512) imp[i] = 0.f;
    if (tid < 256) selw[tid] = 0u;
    if (tid < 8) uni[tid] = 0u;
    const float* gp = T.gates + ((size_t)b * 8192 + t) * 24 + H * 3;
    const float gc = gp[0], gs = gp[1], gw = gp[2];
    LAS float* accL = (LAS float*)(lds + N_ACC) + wid * 2048;
    u32x4 kr0, vr0;
    const int ntc = (4 * ti + 3 + 63) >> 6;
    const char* Kcg = (const char*)(T.Kc + (size_t)bg * 8 * 4096); const char* Vcg = (const char*)(T.Vc + (size_t)bg * 8 * 4096);
    float m = -1e30f, l = 0.f;
#ifndef NSA_SKIP_P1
    kr0 = *(const u32x4*)(Kcg + tid * 16); *(LAS u32x4*)(lds + N_KS + tid * 16) = kr0;
    __syncthreads();
    for (int kt = 0; kt < ntc; ++kt) {
        const int sl = kt & 1;
        if (kt + 1 < ntc) kr0 = *(const u32x4*)(Kcg + (size_t)(kt + 1) * 8192 + tid * 16);
        { f32x16 p0, p1; qk_tile<4>(p0, p1, (lcp)(lds + N_KS + sl * 8192), qr, r32, hi);
          const int nb = 64 * kt + 4 * hi;
#pragma unroll
          for (int r = 0; r < 16; ++r) { const int n = nb + (r & 3) + 8 * (r >> 2); const int e0 = 16 * n + 31 - t, e1 = e0 + 512;
              p0[r] = e0 <= 0 ? p0[r] + slope2 * (float)e0 : -INFINITY; p1[r] = e1 <= 0 ? p1[r] + slope2 * (float)e1 : -INFINITY; }
          const float rm = max32(p0, p1); const float mn = fmaxf(m, rm); float s = 0.f;
#pragma unroll
          for (int r = 0; r < 16; ++r) s += __builtin_amdgcn_exp2f(p0[r] - mn) + __builtin_amdgcn_exp2f(p1[r] - mn);
          l = l * __builtin_amdgcn_exp2f(m - mn) + s; m = mn; }
        if (kt + 1 < ntc) *(LAS u32x4*)(lds + N_KS + (sl ^ 1) * 8192 + tid * 16) = kr0;
        __syncthreads();
    }
    {
      auto rm_ = __builtin_amdgcn_permlane32_swap(__float_as_uint(m), __float_as_uint(m), false, false); auto rl_ = __builtin_amdgcn_permlane32_swap(__float_as_uint(l), __float_as_uint(l), false, false);
      const float mo = __uint_as_float(hi ? rm_[0] : rm_[1]), lo = __uint_as_float(hi ? rl_[0] : rl_[1]); const float mn = fmaxf(m, mo);
      l = l * __builtin_amdgcn_exp2f(m - mn) + lo * __builtin_amdgcn_exp2f(mo - mn); m = mn; }
#endif
    const float invl = l > 0.f ? 1.0f / l : 0.f;
    f32x16 o0 = f32x16{}, o1 = f32x16{};
#ifndef NSA_SKIP_P2
    kr0 = *(const u32x4*)(Kcg + tid * 16); vr0 = *(const u32x4*)(Vcg + tid * 16);
    *(LAS u32x4*)(lds + N_KS + tid * 16) = kr0; *(LAS u32x4*)(lds + N_VS + tid * 16) = vr0;
    __syncthreads();
    for (int kt = 0; kt < ntc; ++kt) {
        const int sl = kt & 1;
        if (kt + 1 < ntc) { kr0 = *(const u32x4*)(Kcg + (size_t)(kt + 1) * 8192 + tid * 16); vr0 = *(const u32x4*)(Vcg + (size_t)(kt + 1) * 8192 + tid * 16); }
        { f32x16 p0, p1; qk_tile<4>(p0, p1, (lcp)(lds + N_KS + sl * 8192), qr, r32, hi);
          const int nb = 64 * kt + 4 * hi;
#pragma unroll
          for (int r = 0; r < 16; ++r) { const int n = nb + (r & 3) + 8 * (r >> 2); const int e0 = 16 * n + 31 - t, e1 = e0 + 512;
              p0[r] = e0 <= 0 ? __builtin_amdgcn_exp2f(p0[r] + slope2 * (float)e0 - m) * invl : 0.f; p1[r] = e1 <= 0 ? __builtin_amdgcn_exp2f(p1[r] + slope2 * (float)e1 - m) * invl : 0.f; }
          LAS float* ir = imp + qrow * IMPS + 16 * kt + hi;
#pragma unroll
          for (int rg = 0; rg < 4; ++rg) {
              const float A0 = (p0[4 * rg] + p0[4 * rg + 1]) + (p0[4 * rg + 2] + p0[4 * rg + 3]), A1 = (p1[4 * rg] + p1[4 * rg + 1]) + (p1[4 * rg + 2] + p1[4 * rg + 3]);
              __hip_atomic_fetch_add(ir + 2 * rg, A0, __ATOMIC_RELAXED, __HIP_MEMORY_SCOPE_WORKGROUP); __hip_atomic_fetch_add(ir + 2 * rg + 1, p0[4 * rg + 3], __ATOMIC_RELAXED, __HIP_MEMORY_SCOPE_WORKGROUP);
              __hip_atomic_fetch_add(ir + 8 + 2 * rg, A1, __ATOMIC_RELAXED, __HIP_MEMORY_SCOPE_WORKGROUP); __hip_atomic_fetch_add(ir + 8 + 2 * rg + 1, p1[4 * rg + 3], __ATOMIC_RELAXED, __HIP_MEMORY_SCOPE_WORKGROUP); }
          u32x4 pa[4]; pack_p(pa, p0, p1);
          pv_tile(o0, o1, (lcp)(lds + N_VS + sl * 8192 + vlane), pa); }
        if (kt + 1 < ntc) { *(LAS u32x4*)(lds + N_KS + (sl ^ 1) * 8192 + tid * 16) = kr0; *(LAS u32x4*)(lds + N_VS + (sl ^ 1) * 8192 + tid * 16) = vr0; }
        __syncthreads();
    }
    acc_lds<true>(accL, o0, o1, gc, wsf, r32, hi);
#endif
#ifndef NSA_SKIP_TOPK
    {
        const int q = tid >> 3, sub = tid & 7;
        unsigned w[4] = {0u, 0u, 0u, 0u};
        if (ti <= 15) { if (sub == 0) w[0] = (2u << ti) - 1u; }
        else {
            const LAS float* row = imp + q * IMPS;
#pragma unroll 1
            for (int half = 0; half < 2; ++half) {
                float v[8]; int cnt[8];
#pragma unroll
                for (int k = 0; k < 8; ++k) { const int j = 1 + sub + 8 * (k + 8 * half); v[k] = (j <= ti - 2) ? row[j] : -1.0f; cnt[k] = 0; }
#pragma unroll 1
                for (int jp = 1; jp <= ti - 2; ++jp) { const float vp = row[jp];
#pragma unroll
                    for (int k = 0; k < 8; ++k) { const int j = 1 + sub + 8 * (k + 8 * half); cnt[k] += (vp > v[k] || (vp == v[k] && jp < j)) ? 1 : 0; } }
#pragma unroll
                for (int k = 0; k < 8; ++k) { const int j = 1 + sub + 8 * (k + 8 * half); if (j <= ti - 2 && cnt[k] < 13) setbit(w, j); }
            }
            if (sub == 0) { w[0] |= 1u; setbit(w, ti); setbit(w, ti - 1); }
        }
#pragma unroll
        for (int k = 0; k < 4; ++k) if (w[k]) { __hip_atomic_fetch_or(selw + q * 4 + k, w[k], __ATOMIC_RELAXED, __HIP_MEMORY_SCOPE_WORKGROUP); __hip_atomic_fetch_or(uni + k, w[k], __ATOMIC_RELAXED, __HIP_MEMORY_SCOPE_WORKGROUP); }
    }
#endif
    __syncthreads();
    if (tid == 0) { int nb = 0;
        for (int k = 0; k < 4; ++k) { unsigned u = uni[k]; while (u) { const int bit = __builtin_ctz(u); u &= u - 1u; blist[nb++] = (unsigned)(32 * k + bit); } }
        uni[4] = (unsigned)nb; }
    __syncthreads();
    const int nsel = (int)uni[4];
    unsigned sw[4];
#pragma unroll
    for (int k = 0; k < 4; ++k) sw[k] = selw[qrow * 4 + k];
#ifndef NSA_SKIP_SEL
    {
        const char* Kg = (const char*)(T.Ksel + (size_t)bg * 128 * 4096); const char* Vg = (const char*)(T.Vsel + (size_t)bg * 128 * 4096);
        m = -1e30f; l = 0.f; o0 = f32x16{}; o1 = f32x16{};
        int j = (int)blist[0];
        kr0 = *(const u32x4*)(Kg + (size_t)j * 8192 + tid * 16); vr0 = *(const u32x4*)(Vg + (size_t)j * 8192 + tid * 16);
        *(LAS u32x4*)(lds + N_KS + tid * 16) = kr0; *(LAS u32x4*)(lds + N_VS + tid * 16) = vr0;
        __syncthreads();
        for (int k = 0; k < nsel; ++k) {
            const int sl = k & 1; int jn = 0;
            if (k + 1 < nsel) { jn = (int)blist[k + 1]; kr0 = *(const u32x4*)(Kg + (size_t)jn * 8192 + tid * 16); vr0 = *(const u32x4*)(Vg + (size_t)jn * 8192 + tid * 16); }
            { f32x16 p0, p1; qk_tile<4>(p0, p1, (lcp)(lds + N_KS + sl * 8192), qr, r32, hi);
              const int jw = j >> 5; const unsigned swj = jw == 0 ? sw[0] : jw == 1 ? sw[1] : jw == 2 ? sw[2] : sw[3]; const bool mine = (swj >> (j & 31)) & 1u; const int pb = 64 * j + 4 * hi - t;
#pragma unroll
              for (int r = 0; r < 16; ++r) { const int e0 = pb + (r & 3) + 8 * (r >> 2), e1 = e0 + 32;
                  p0[r] = (mine && e0 <= 0) ? p0[r] + slope2 * (float)e0 : -INFINITY; p1[r] = (mine && e1 <= 0) ? p1[r] + slope2 * (float)e1 : -INFINITY; }
              softmax_pv(p0, p1, m, l, o0, o1, (lcp)(lds + N_VS + sl * 8192 + vlane), wsf, r32, hi); }
            if (k + 1 < nsel) { *(LAS u32x4*)(lds + N_KS + (sl ^ 1) * 8192 + tid * 16) = kr0; *(LAS u32x4*)(lds + N_VS + (sl ^ 1) * 8192 + tid * 16) = vr0; }
            j = jn;
            __syncthreads();
        }
        const float lt = xsum(l); acc_lds<false>(accL, o0, o1, lt > 0.f ? gs / lt : 0.f, wsf, r32, hi);
    }
#endif
#ifndef NSA_SKIP_WIN
    {
        const char* Kg = (const char*)(T.Kwin + (size_t)bg * 128 * 4096); const char* Vg = (const char*)(T.Vwin + (size_t)bg * 128 * 4096);
        m = -1e30f; l = 0.f; o0 = f32x16{}; o1 = f32x16{};
        const int j0 = ti >= 8 ? ti - 8 : 0, nw = ti - j0 + 1;
        kr0 = *(const u32x4*)(Kg + (size_t)j0 * 8192 + tid * 16); vr0 = *(const u32x4*)(Vg + (size_t)j0 * 8192 + tid * 16);
        *(LAS u32x4*)(lds + N_KS + tid * 16) = kr0; *(LAS u32x4*)(lds + N_VS + tid * 16) = vr0;
        __syncthreads();
        for (int k = 0; k < nw; ++k) {
            const int sl = k & 1, j = j0 + k;
            if (k + 1 < nw) { kr0 = *(const u32x4*)(Kg + (size_t)(j + 1) * 8192 + tid * 16); vr0 = *(const u32x4*)(Vg + (size_t)(j + 1) * 8192 + tid * 16); }
            { f32x16 p0, p1; qk_tile<4>(p0, p1, (lcp)(lds + N_KS + sl * 8192), qr, r32, hi);
              const int pb = 64 * j + 4 * hi - t;
#pragma unroll
              for (int r = 0; r < 16; ++r) { const int e0 = pb + (r & 3) + 8 * (r >> 2), e1 = e0 + 32;
                  p0[r] = (e0 <= 0 && e0 > -512) ? p0[r] + slope2 * (float)e0 : -INFINITY; p1[r] = (e1 <= 0 && e1 > -512) ? p1[r] + slope2 * (float)e1 : -INFINITY; }
              softmax_pv(p0, p1, m, l, o0, o1, (lcp)(lds + N_VS + sl * 8192 + vlane), wsf, r32, hi); }
            if (k + 1 < nw) { *(LAS u32x4*)(lds + N_KS + (sl ^ 1) * 8192 + tid * 16) = kr0; *(LAS u32x4*)(lds + N_VS + (sl ^ 1) * 8192 + tid * 16) = vr0; }
            __syncthreads();
        }
        const float lt = xsum(l); acc_lds<false>(accL, o0, o1, lt > 0.f ? gw / lt : 0.f, wsf, r32, hi);
    }
#endif
    store_acc(accL, T.Oa + ((size_t)b * 8192 + t0 + qh * 32) * 512 + H * 64, 512, lane);
    __syncthreads();
}
}
#define GLAS __attribute__((address_space(3)))
typedef unsigned short bf16_t;
typedef float f32x4 __attribute__((ext_vector_type(4)));
typedef unsigned u32x4 __attribute__((ext_vector_type(4)));
constexpr int NT_TOK = 16384, SEQ = 8192, DM = 1024, DFF = 2816, NTHREADS = 512, NWAVES = 8;
struct KArgs { const float* in[26]; float* out; unsigned char* ws; };
struct ArgRef { unsigned char* ws;
    __device__ __forceinline__ const float* in_(int i) const { const __attribute__((address_space(4))) KArgs* p = (const __attribute__((address_space(4))) KArgs*)__builtin_amdgcn_kernarg_segment_ptr(); asm volatile("" : "+s"(p)); return p->in[i]; }
};

__device__ __forceinline__ unsigned f2bf_rne(float f) { unsigned u = __builtin_bit_cast(unsigned, f); return (u + 0x7fffu + ((u >> 16) & 1u)) >> 16; }
__device__ __forceinline__ unsigned pk2(float lo, float hi) { return f2bf_rne(lo) | (f2bf_rne(hi) << 16); }

struct WSrc { const float* p; int ld; };
template <class Map> __device__ __forceinline__ void conv_weight(GLAS float* scr, int lane, int gw, int ngw, int K, int N, bf16_t* WT, const float* kscale, Map map) {
    asm volatile("" : "+v"(lane));
    const int nblk = N / 32, nitems = (K / 64) * nblk;
    for (int it = gw; it < nitems; it += ngw) {
        const int kb = it / nblk, nb = it % nblk, k0 = 64 * kb, n0 = 32 * nb;
        const WSrc s = map(n0 + (lane & 31));
#pragma unroll 8
        for (int i = 0; i < 32; ++i) { const int kk = 2 * i + (lane >> 5); float v = s.p ? s.p[(size_t)(k0 + kk) * s.ld] : 0.f; if (kscale) v *= kscale[k0 + kk]; scr[kk * 33 + (lane & 31)] = v; }
        asm volatile("s_waitcnt lgkmcnt(0)" ::: "memory");
        const int c = lane & 7;
#pragma unroll
        for (int j = 0; j < 4; ++j) { const int n = (lane >> 3) + 8 * j; const GLAS float* sp = scr + (8 * c) * 33 + n;
            u32x4 o; o.x = pk2(sp[0 * 33], sp[1 * 33]); o.y = pk2(sp[2 * 33], sp[3 * 33]); o.z = pk2(sp[4 * 33], sp[5 * 33]); o.w = pk2(sp[6 * 33], sp[7 * 33]);
            *(u32x4*)(WT + (size_t)(n0 + n) * K + k0 + 8 * c) = o; }
        asm volatile("s_waitcnt lgkmcnt(0)" ::: "memory");
    }
}
__device__ __forceinline__ void convert_layer(const ArgRef& A, int l, GLAS unsigned char* lds, int lane, int wave, int gw, int ngw) {
    GLAS float* scr = (GLAS float*)(lds + wave * 8448);
    unsigned char* ws = A.ws;
    { const float* G = A.in_(4) + (size_t)l * 1024 * 2816; const float* U = A.in_(5) + (size_t)l * 1024 * 2816;
      conv_weight(scr, lane, gw, ngw, 1024, 5632, (bf16_t*)(ws + W_GU1), nullptr, [=](int n) { const int tl = n >> 8, r = n & 255; const uintptr_t gp = (uintptr_t)G, up = (uintptr_t)U; return WSrc{(const float*)(gp + (up - gp) * (uintptr_t)(r >> 7)) + tl * 128 + (r & 127), 2816}; }); }
    { const float* Dn = A.in_(6) + (size_t)l * 2816 * 1024; conv_weight(scr, lane, gw, ngw, 2816, 1024, (bf16_t*)(ws + W_D1), nullptr, [=](int n) { return WSrc{Dn + n, 1024}; }); }
    { const float* G = A.in_(7) + (size_t)l * 1024 * 2816; const float* U = A.in_(8) + (size_t)l * 1024 * 2816;
      conv_weight(scr, lane, gw, ngw, 1024, 5632, (bf16_t*)(ws + W_GU2), nullptr, [=](int n) { const int tl = n >> 8, r = n & 255; const uintptr_t gp = (uintptr_t)G, up = (uintptr_t)U; return WSrc{(const float*)(gp + (up - gp) * (uintptr_t)(r >> 7)) + tl * 128 + (r & 127), 2816}; }); }
    { const float* Dn = A.in_(9) + (size_t)l * 2816 * 1024; conv_weight(scr, lane, gw, ngw, 2816, 1024, (bf16_t*)(ws + W_D2), nullptr, [=](int n) { return WSrc{Dn + n, 1024}; }); }
    { const float* Wi = A.in_(10) + (size_t)l * 1024 * 4024;
      conv_weight(scr, lane, gw, ngw, 1024, 4096, (bf16_t*)(ws + W_IN), nullptr, [=](int n) {
          int src;
          if (n < 1280) src = n;
          else if (n < 1536) src = 1688 + (n - 1280);
          else if (n < 1792) src = 1304 + (n - 1536);
          else if (n < 2048) { const int r = n - 1792;
              if (r < 128) src = 1304 + 256 + r;
              else if (r < 160) { const int p = r - 128; src = 1944 + ((p & 1) ? 16 + (p >> 1) : (p >> 1)); }
              else if (r < 184) src = 1280 + (r - 160);
              else src = -1; }
          else src = 1976 + (n - 2048);
          return WSrc{src >= 0 ? Wi + src : nullptr, 4024}; }); }
    { const float* Wq = A.in_(18) + (size_t)l * 384 * 768;
      conv_weight(scr, lane, gw, ngw, 384, 768, (bf16_t*)(ws + W_UQ), A.in_(17) + (size_t)l * 384, [=](int n) { const int h = n / 96, p = n % 96; int src = h * 96 + p;
          if (p >= 64) { const int pp = p - 64; src = h * 96 + 64 + ((pp & 1) ? 16 + (pp >> 1) : (pp >> 1)); }
          return WSrc{Wq + src, 768}; }); }
    { const float* Wk = A.in_(20) + (size_t)l * 256 * 512; const float* Wv = A.in_(21) + (size_t)l * 256 * 512;
      conv_weight(scr, lane, gw, ngw, 256, 1024, (bf16_t*)(ws + W_UKV), A.in_(19) + (size_t)l * 256, [=](int n) { const uintptr_t kp = (uintptr_t)Wk, vp = (uintptr_t)Wv; return WSrc{(const float*)(kp + (vp - kp) * (uintptr_t)(n >> 9)) + (n & 511), 512}; }); }
    { const float* Wa = A.in_(22) + (size_t)l * 512 * 1024; conv_weight(scr, lane, gw, ngw, 512, 1024, (bf16_t*)(ws + W_BA), nullptr, [=](int n) { return WSrc{Wa + n, 1024}; }); }
    { const float* Wb = A.in_(23) + (size_t)l * 512 * 1024; conv_weight(scr, lane, gw, ngw, 512, 1024, (bf16_t*)(ws + W_BB), nullptr, [=](int n) { return WSrc{Wb + n, 1024}; }); }
    { const float* Wo = A.in_(24) + (size_t)l * 1024 * 1024; conv_weight(scr, lane, gw, ngw, 1024, 1024, (bf16_t*)(ws + W_OUT), nullptr, [=](int n) { return WSrc{Wo + n, 1024}; }); }
    { const float* W1 = A.in_(11) + (size_t)l * 2048 * 64; conv_weight(scr, lane, gw, ngw, 2048, 64, (bf16_t*)(ws + W_1K), nullptr, [=](int n) { return WSrc{W1 + n, 64}; }); }
    { const float* W1 = A.in_(14) + (size_t)l * 2048 * 64; conv_weight(scr, lane, gw, ngw, 2048, 64, (bf16_t*)(ws + W_1V), nullptr, [=](int n) { return WSrc{W1 + n, 64}; }); }
}
__device__ __forceinline__ void norm_phase(const float* x, bf16_t* xn, const float* sh, const float* sc, int lane, int gw, int ngw) {
    asm volatile("" : "+v"(lane));
    for (int row = gw; row < NT_TOK; row += ngw) {
        const f32x4* xr = (const f32x4*)(x + (size_t)row * DM) + lane; const int b = row >> 13;
        f32x4 v[4]; float s = 0.f;
#pragma unroll
        for (int j = 0; j < 4; ++j) { v[j] = xr[64 * j]; s += (v[j].x * v[j].x + v[j].y * v[j].y) + (v[j].z * v[j].z + v[j].w * v[j].w); }
        const float rstd = 1.0f / sqrtf(wave_sum(s) * (1.0f / DM) + 1e-6f);
        unsigned long long* o8 = (unsigned long long*)(xn + (size_t)row * DM) + lane;
#pragma unroll
        for (int j = 0; j < 4; ++j) { const f32x4 a = *((const f32x4*)(sc + (size_t)b * 9216) + lane + 64 * j), c = *((const f32x4*)(sh + (size_t)b * 9216) + lane + 64 * j);
            const f32x4 y = v[j] * rstd * (a + 1.0f) + c;
            o8[64 * j] = (unsigned long long)pk2(y.x, y.y) | ((unsigned long long)pk2(y.z, y.w) << 32); }
    }
}
__device__ __forceinline__ void final_norm_phase(float* x, const float* wn, int lane, int gw, int ngw) {
    asm volatile("" : "+v"(lane));
    for (int row = gw; row < NT_TOK; row += ngw) {
        f32x4* xr = (f32x4*)(x + (size_t)row * DM) + lane;
        f32x4 v[4]; float s = 0.f;
#pragma unroll
        for (int j = 0; j < 4; ++j) { v[j] = xr[64 * j]; s += (v[j].x * v[j].x + v[j].y * v[j].y) + (v[j].z * v[j].z + v[j].w * v[j].w); }
        const float rstd = 1.0f / sqrtf(wave_sum(s) * (1.0f / DM) + 1e-6f);
#pragma unroll
        for (int j = 0; j < 4; ++j) { const f32x4 w = *((const f32x4*)wn + lane + 64 * j); xr[64 * j] = v[j] * rstd * w; }
    }
}
__device__ __forceinline__ void adaln_phase(const ArgRef& A, GLAS unsigned char* lds, int tid, int lane, int wave, int blk, int nblk) {
    asm volatile("" : "+v"(tid), "+v"(lane));
    GLAS float* ca = (GLAS float*)lds;
    GLAS float* red = (GLAS float*)(lds + 8192);
    for (int i = tid; i < 2048; i += NTHREADS) { const float c = A.in_(1)[i]; ca[i] = c / (1.0f + __expf(-c)); }
    __syncthreads();
    float* mod = (float*)(A.ws + WS_MOD);
    for (int u = blk; u < 288; u += nblk) {
        const int l = u / 144, n0 = (u % 144) * 64;
        const float* W = A.in_(2) + (size_t)l * 1024 * 9216 + n0 + lane;
        float a0 = 0.f, a1 = 0.f;
        const int kb = wave * 128;
#pragma unroll 8
        for (int k = 0; k < 128; ++k) { const float w = W[(size_t)(kb + k) * 9216]; a0 += ca[kb + k] * w; a1 += ca[1024 + kb + k] * w; }
        red[(wave * 2 + 0) * 64 + lane] = a0; red[(wave * 2 + 1) * 64 + lane] = a1;
        __syncthreads();
        if (tid < 128) { const int b = tid >> 6, n = tid & 63; float s = A.in_(3)[(size_t)l * 9216 + n0 + n];
#pragma unroll
            for (int w = 0; w < 8; ++w) s += red[(w * 2 + b) * 64 + n];
            mod[((size_t)l * 2 + b) * 9216 + n0 + n] = s; }
        __syncthreads();
    }
}
__device__ __forceinline__ void rope_table_phase(float* cs, int gtid, int ngt) {
    for (int e = gtid; e < SEQ * 16; e += ngt) { const int t = e >> 4, i = e & 15;
        const float inv = powf(10000.0f, -(float)i / 16.0f); const float ang = (float)t * inv;
        const double rev = (double)ang * 0.15915494309189535; const double fr = rev - __builtin_rint(rev);
        cs[t * 32 + i] = __builtin_amdgcn_cosf((float)fr); cs[t * 32 + 16 + i] = __builtin_amdgcn_sinf((float)fr); }
}
__device__ __forceinline__ void cbias_phase(const ArgRef& A, GLAS unsigned char* lds, int tid, int blk) {
    GLAS float* red = (GLAS float*)(lds + 16384);
    if (blk < 4) { const int l = blk >> 1, kv = blk & 1; const float* pe = A.in_(kv ? 16 : 13) + (size_t)l * 2048; const float* w1 = A.in_(kv ? 14 : 11) + (size_t)l * 2048 * 64;
        const int n = tid & 63, part = tid >> 6; float s = 0.f;
        for (int j = part * 256; j < part * 256 + 256; ++j) s += pe[j] * w1[(size_t)j * 64 + n];
        red[part * 64 + n] = s;
        __syncthreads();
        if (tid < 64) { float t = 0.f;
#pragma unroll
            for (int p = 0; p < 8; ++p) t += red[p * 64 + tid];
            ((float*)(A.ws + WS_CBIAS))[(l * 2 + kv) * 64 + tid] = t; }
        __syncthreads();
    }
}
__device__ __forceinline__ void compress_phase(const ArgRef& A, int l, GLAS unsigned char* lds, int tid, int lane, int wave, int ubeg, int ustep) {
    asm volatile("" : "+v"(tid), "+v"(lane));
    typedef short bf16x8 __attribute__((ext_vector_type(8))); typedef float f32x16 __attribute__((ext_vector_type(16)));
    GLAS float* red = (GLAS float*)lds;
    GLAS float* c1 = (GLAS float*)(lds + 65536);
    const int r32 = lane & 31, hi = lane >> 5;
    for (int u = ubeg; u < 128; u += ustep) {
        const int kv = u >> 6, bg = (u >> 4) & 3, rb = u & 15, i0 = rb * 32;
        const bf16_t* src = (const bf16_t*)(A.ws + (kv ? WS_VCF : WS_KCF)) + (size_t)bg * SEQ * 64;
        const bf16_t* w1t = (const bf16_t*)(A.ws + (kv ? W_1V : W_1K));
        const float* w2 = A.in_(kv ? 15 : 12) + (size_t)l * 4096;
        const float* cb = (const float*)(A.ws + WS_CBIAS) + (l * 2 + kv) * 64;
        f32x16 a0 = f32x16{}, a1 = f32x16{};
        const bf16_t* ap = src + (size_t)(i0 + r32) * 1024 + wave * 256 + hi * 8;
        const bf16_t* bp = w1t + (size_t)r32 * 2048 + wave * 256 + hi * 8;
#pragma unroll 4
        for (int ks = 0; ks < 16; ++ks) {
            const bf16x8 af = *(const bf16x8*)(ap + ks * 16), b0 = *(const bf16x8*)(bp + ks * 16), b1 = *(const bf16x8*)(bp + 32 * 2048 + ks * 16);
            a0 = __builtin_amdgcn_mfma_f32_32x32x16_bf16(af, b0, a0, 0, 0, 0);
            a1 = __builtin_amdgcn_mfma_f32_32x32x16_bf16(af, b1, a1, 0, 0, 0); }
#pragma unroll
        for (int r = 0; r < 16; ++r) { red[wave * 2048 + r * 64 + lane] = a0[r]; red[wave * 2048 + (16 + r) * 64 + lane] = a1[r]; }
        __syncthreads();
#pragma unroll
        for (int j = 0; j < 4; ++j) { const int e = tid + 512 * j; float s = 0.f;
#pragma unroll
            for (int w = 0; w < 8; ++w) s += red[w * 2048 + e];
            const int nt = e >> 10, r = (e >> 6) & 15, ln = e & 63; const int i = (r & 3) + 8 * (r >> 2) + 4 * (ln >> 5), n = 32 * nt + (ln & 31);
            const float xv = s + cb[n]; const float z = 0.7978845608028654f * (xv + 0.044715f * xv * xv * xv);
            const float th = 1.0f - 2.0f * __builtin_amdgcn_rcpf(__builtin_amdgcn_exp2f(2.885390081777927f * z) + 1.0f);
            c1[i * 65 + n] = 0.5f * xv * (1.0f + th); }
        __syncthreads();
        { const int i = tid >> 4, n2 = (tid & 15) * 4; f32x4 o = (f32x4){0.f, 0.f, 0.f, 0.f};
#pragma unroll 8
          for (int k = 0; k < 64; ++k) { const float c = c1[i * 65 + k]; const f32x4 w = *(const f32x4*)(w2 + k * 64 + n2); o += w * c; }
          const int nc = i0 + i; if (nc == 511) o = (f32x4){0.f, 0.f, 0.f, 0.f};
          const size_t tb = (size_t)bg * 8 + (nc >> 6); const int key = nc & 63;
          const unsigned long long pk = (unsigned long long)pk2(o.x, o.y) | ((unsigned long long)pk2(o.z, o.w) << 32);
          if (kv == 0) *(unsigned long long*)((bf16_t*)(A.ws + WS_KC) + (tb * 8 + (n2 >> 3)) * 512 + key * 8 + (n2 & 7)) = pk;
          else *(unsigned long long*)((bf16_t*)(A.ws + WS_VC) + tb * 4096 + (n2 >> 5) * 2048 + key * 32 + (n2 & 31)) = pk; }
        __syncthreads();
    }
}

template <int NC> __device__ __forceinline__ void rstd_table(const bf16_t* X, int row0, GLAS float* tab, float scale, int lane, int wave) {
    for (int r = 0; r < 32; ++r) { const int row = wave * 32 + r; float s = 0.f;
        if (lane < NC / 8) { const u32x4 v = *(const u32x4*)(X + (size_t)(row0 + row) * NC + lane * 8);
            const unsigned w4[4] = {v.x, v.y, v.z, v.w};
#pragma unroll
            for (int i = 0; i < 4; ++i) { const float a = __uint_as_float(w4[i] << 16), b = __uint_as_float(w4[i] & 0xffff0000u); s += a * a + b * b; } }
        s = wave_sum(s);
        if (lane == 0) tab[row] = scale * __builtin_amdgcn_rsqf(s * (1.0f / NC) + 1e-6f); }
}
__device__ __forceinline__ void dump_bf16(float* out, const bf16_t* src, int nslab, int gtid, int ngt) {
    for (int i = gtid; i < NT_TOK * DM; i += ngt) { float s = 0.f; for (int k = 0; k < nslab; ++k) if (k < 3 || i < 14 * 1024 * 1024) s += __uint_as_float(((unsigned)src[(size_t)k * NT_TOK * DM + i]) << 16); out[i] = s; }
}
#ifndef WIN_ALIGN
#define WIN_ALIGN true
#define WIN_SP2 true
#endif
#ifndef STOPAT
#define STOPAT 99
#endif
#ifndef PHMASK
#define PHMASK 0xffffffffu
#endif
#define PH(k) ((PHMASK >> (k)) & 1u)
constexpr int LDS_BYTES = 147456;
__global__ void __launch_bounds__(NTHREADS, 2) hybrid_fwd(KArgs KA) {
    extern __shared__ __attribute__((aligned(16))) unsigned char lds_raw[];
    GLAS unsigned char* lds = (GLAS unsigned char*)lds_raw;
    cg::grid_group grid = cg::this_grid();
    const int wave = __builtin_amdgcn_readfirstlane(threadIdx.x >> 6);
#define MYTID() (wave * 64 + opaque_lane())
    int tid = MYTID(), lane = tid & 63; asm volatile("" : "+v"(tid), "+v"(lane));
    const int G = gridDim.x, blk0 = blockIdx.x; int blk = blk0;
    const int vcu = (G % 8 == 0) ? (blk % 8) * (G / 8) + blk / 8 : blk;
    const int gw = blk * NWAVES + wave, ngw = G * NWAVES;
    ArgRef A; A.ws = KA.ws; unsigned char* const ws0 = KA.ws; unsigned char* ws = ws0;
#define PHASE_BEGIN() do { ws = ws0; blk = blk0; asm volatile("" : "+s"(ws), "+s"(blk)); A.ws = ws; tid = MYTID(); lane = tid & 63; asm volatile("" : "+v"(tid), "+v"(lane)); } while (0)
    float* mod = (float*)(ws + WS_MOD);
    float* xres = KA.out;

    if (PH(0)) adaln_phase(A, lds, tid, lane, wave, blk, G);
    if (PH(1)) rope_table_phase((float*)(ws + WS_CS), blk * NTHREADS + tid, G * NTHREADS);
    if (PH(2)) convert_layer(A, 0, lds, lane, wave, gw, ngw);
    __syncthreads();
    if (PH(3)) cbias_phase(A, lds, tid, blk);
    grid.sync();

    for (int l = 0; l < 2; ++l) {
        PHASE_BEGIN();
        const float* ml = mod + (size_t)l * 2 * 9216;
        const float* xin = (l == 0) ? A.in_(0) : xres;
        if (PH(2) && l == 1) { convert_layer(A, 1, lds, lane, wave, gw, ngw); }
        if (PH(4)) norm_phase(xin, (bf16_t*)(ws + WS_XN), ml + 0 * 1024, ml + 1 * 1024, lane, gw, ngw);
        grid.sync();
        PHASE_BEGIN();
        if (PH(5)) { pg8::Gemm g{(const bf16_t*)(ws + WS_XN), (const bf16_t*)(ws + W_GU1), NT_TOK, 5632, 1024}; pg8::StaticOrder S; S.init(NT_TOK, 5632, G, blk);
          pg8::EpiSwiGLU E{ws};
          pg8::gemm_phase<pg8::EpiSwiGLU, pg8::StaticOrder, true, true>(lds, g, S, E, wave); }
        grid.sync();
        PHASE_BEGIN();
        if (STOPAT == 2) { dump_bf16(xres, (const bf16_t*)(ws + WS_C), 4, blk * NTHREADS + tid, G * NTHREADS); return; }
        if (PH(6)) { pg8::Gemm g{(const bf16_t*)(ws + WS_C), (const bf16_t*)(ws + W_D1), NT_TOK, 1024, 2816}; pg8::StaticOrder S; S.init(NT_TOK, 1024, G, blk);
          pg8::EpiResid E{xin, xres, ml + 2 * 1024, 0.5f};
          pg8::gemm_phase<pg8::EpiResid, pg8::StaticOrder, true, true>(lds, g, S, E, wave); }
        grid.sync();
        PHASE_BEGIN();
        if (STOPAT == 3) {  return; }
        if (PH(4)) norm_phase(xres, (bf16_t*)(ws + WS_XN), ml + 3 * 1024, ml + 4 * 1024, lane, gw, ngw);
#ifdef SENTINEL
        { unsigned* gp = (unsigned*)(ws + WS_GM); for (int i = blk * NTHREADS + tid; i < 16 * 1024 * 1024; i += G * NTHREADS) gp[i] = 0x447a447au; }
#endif
        grid.sync();
        PHASE_BEGIN();
        if (PH(7)) { pg8::Gemm g{(const bf16_t*)(ws + WS_XN), (const bf16_t*)(ws + W_IN), NT_TOK, 4096, 1024}; pg8::StaticOrder S; S.init(NT_TOK, 4096, G, blk);
          pg8::EpiWin E{ws};
          pg8::gemm_phase<pg8::EpiWin, pg8::StaticOrder, WIN_ALIGN, WIN_SP2>(lds, g, S, E, wave); }
        grid.sync();
        PHASE_BEGIN();
#ifndef DUMP_OFF
#define DUMP_OFF 84
#define DUMP_SLABS 4
#endif
        if (STOPAT == 5) { dump_bf16(xres, (const bf16_t*)(ws + (size_t)DUMP_OFF * MiB), DUMP_SLABS, blk * NTHREADS + tid, G * NTHREADS); return; }
        if (PH(8)) { pg8::Gemm g{(const bf16_t*)(ws + WS_CQ), (const bf16_t*)(ws + W_UQ), NT_TOK, 768, 384}; pg8::StaticOrder S; S.init(NT_TOK, 768, G, blk);
          { pg8::Unit u0; if (S.next(0, u0)) rstd_table<384>((const bf16_t*)(ws + WS_CQ), u0.pm * 256, (GLAS float*)(lds + 131072), 0.10206207261596577f * 1.4426950408889634f, lane, wave); }
          __syncthreads();
          pg8::EpiQproj E{ws, (const GLAS float*)(lds + 131072)};
          pg8::gemm_phase<pg8::EpiQproj, pg8::StaticOrder, true, true>(lds, g, S, E, wave); }
        if (PH(9)) { pg8::Gemm g{(const bf16_t*)(ws + WS_CKV), (const bf16_t*)(ws + W_UKV), NT_TOK, 1024, 256}; pg8::StaticOrder S; S.init(NT_TOK, 1024, G, blk);
          PHASE_BEGIN();
          { pg8::Unit u0; if (S.next(0, u0)) rstd_table<256>((const bf16_t*)(ws + WS_CKV), u0.pm * 256, (GLAS float*)(lds + 131072 + 1024), 1.0f, lane, wave); }
          __syncthreads();
          pg8::EpiKVproj E{ws, (const GLAS float*)(lds + 131072 + 1024)};
          pg8::gemm_phase<pg8::EpiKVproj, pg8::StaticOrder, true, true>(lds, g, S, E, wave); }
        __syncthreads();
        PHASE_BEGIN();
        if (PH(10)) compress_phase(A, l, lds, tid, lane, wave, (G - 1 - blk), G);
        grid.sync();
        PHASE_BEGIN();
        if (STOPAT == 6) { dump_bf16(xres, (const bf16_t*)(ws + WS_QM), 2, blk * NTHREADS + tid, G * NTHREADS); return; }
        { att::NsaT NT{(const bf16_t*)(ws + WS_QN), (const bf16_t*)(ws + WS_KC), (const bf16_t*)(ws + WS_VC), (const bf16_t*)(ws + WS_KSEL), (const bf16_t*)(ws + WS_VSEL),
                       (const bf16_t*)(ws + WS_KWIN), (const bf16_t*)(ws + WS_VWIN), (const float*)(ws + WS_GATES), (bf16_t*)(ws + WS_OA)};
          for (int v = vcu; v < 256; v += G) {
              if (PH(11)) { const int bh = v >> 4, s = v & 15;
                att::mla_unit(bh >> 3, bh & 7, 31 - s, (const bf16_t*)(ws + WS_QM), (const bf16_t*)(ws + WS_KM), (const bf16_t*)(ws + WS_VM), (bf16_t*)(ws + WS_OB), (GLAS char*)lds, wave);
                att::mla_unit(bh >> 3, bh & 7, s, (const bf16_t*)(ws + WS_QM), (const bf16_t*)(ws + WS_KM), (const bf16_t*)(ws + WS_VM), (bf16_t*)(ws + WS_OB), (GLAS char*)lds, wave); }
              if (PH(12)) { const int bg = v >> 6, s = v & 63;
                att::nsa_unit(bg >> 1, bg & 1, 127 - s, NT, (GLAS char*)lds, wave);
                att::nsa_unit(bg >> 1, bg & 1, s, NT, (GLAS char*)lds, wave); }
          } }
        grid.sync();
        PHASE_BEGIN();
        if (STOPAT == 7) { dump_bf16(xres, (const bf16_t*)(ws + WS_OA), 1, blk * NTHREADS + tid, G * NTHREADS); return; }
        if (PH(13)) { pg8::Gemm g{(const bf16_t*)(ws + WS_OA), (const bf16_t*)(ws + W_BA), NT_TOK, 1024, 512}; pg8::StaticOrder S; S.init(NT_TOK, 1024, G, blk);
          pg8::EpiBranch<0> E{ws};
          pg8::gemm_phase<pg8::EpiBranch<0>, pg8::StaticOrder, true, true>(lds, g, S, E, wave); }
        if (PH(14)) { pg8::Gemm g{(const bf16_t*)(ws + WS_OB), (const bf16_t*)(ws + W_BB), NT_TOK, 1024, 512}; pg8::StaticOrder S; S.init(NT_TOK, 1024, G, blk);
          pg8::EpiBranch<1> E{ws};
          pg8::gemm_phase<pg8::EpiBranch<1>, pg8::StaticOrder, true, true>(lds, g, S, E, wave); }
        grid.sync();
        PHASE_BEGIN();
        if (STOPAT == 8) { dump_bf16(xres, (const bf16_t*)(ws + WS_Y), 1, blk * NTHREADS + tid, G * NTHREADS); return; }
        if (PH(15)) { pg8::Gemm g{(const bf16_t*)(ws + WS_Y), (const bf16_t*)(ws + W_OUT), NT_TOK, 1024, 1024}; pg8::StaticOrder S; S.init(NT_TOK, 1024, G, blk);
          pg8::EpiResid E{xres, xres, ml + 5 * 1024, 1.0f};
          pg8::gemm_phase<pg8::EpiResid, pg8::StaticOrder, true, true>(lds, g, S, E, wave); }
        grid.sync();
        PHASE_BEGIN();
        if (PH(4)) norm_phase(xres, (bf16_t*)(ws + WS_XN), ml + 6 * 1024, ml + 7 * 1024, lane, gw, ngw);
        grid.sync();
        PHASE_BEGIN();
        if (PH(16)) { pg8::Gemm g{(const bf16_t*)(ws + WS_XN), (const bf16_t*)(ws + W_GU2), NT_TOK, 5632, 1024}; pg8::StaticOrder S; S.init(NT_TOK, 5632, G, blk);
          pg8::EpiSwiGLU E{ws};
          pg8::gemm_phase<pg8::EpiSwiGLU, pg8::StaticOrder, true, true>(lds, g, S, E, wave); }
        grid.sync();
        PHASE_BEGIN();
        if (PH(17)) { pg8::Gemm g{(const bf16_t*)(ws + WS_C), (const bf16_t*)(ws + W_D2), NT_TOK, 1024, 2816}; pg8::StaticOrder S; S.init(NT_TOK, 1024, G, blk);
          pg8::EpiResid E{xres, xres, ml + 8 * 1024, 0.5f};
          pg8::gemm_phase<pg8::EpiResid, pg8::StaticOrder, true, true>(lds, g, S, E, wave); }
        grid.sync();
        PHASE_BEGIN();
    }
    tid = MYTID(); lane = tid & 63; asm volatile("" : "+v"(tid), "+v"(lane));
    if (PH(18)) final_norm_phase(xres, A.in_(25), lane, gw, ngw);
}

extern "C" void kernel_launch(void* const* d_in, const int* in_sizes, int n_in, void* d_out, int out_size, void* d_ws, size_t ws_size, hipStream_t stream) {
    static int grid_blocks = 0;
    if (grid_blocks == 0) {
        if (n_in != 26 || out_size != NT_TOK * DM || ws_size < WS_TOTAL) { fprintf(stderr, "kernel_launch: unexpected problem (n_in %d out %d ws %zu)\n", n_in, out_size, ws_size); grid_blocks = -1; return; }
        int dev = 0, cus = 0, per_cu = 0;
        hipGetDevice(&dev);
        hipDeviceGetAttribute(&cus, hipDeviceAttributeMultiprocessorCount, dev);
        hipFuncSetAttribute((const void*)hybrid_fwd, hipFuncAttributeMaxDynamicSharedMemorySize, LDS_BYTES);
        hipOccupancyMaxActiveBlocksPerMultiprocessor(&per_cu, (const void*)hybrid_fwd, NTHREADS, LDS_BYTES);
        if (per_cu < 1) { fprintf(stderr, "kernel_launch: occupancy query says %d blocks per CU\n", per_cu); per_cu = 1; }
        if (per_cu > 1) per_cu = 1;
        grid_blocks = cus * per_cu;
        (void)hipGetLastError();
    }
    if (grid_blocks < 0) return;
    KArgs a{};
    for (int i = 0; i < 26; ++i) a.in[i] = (const float*)d_in[i];
    a.out = (float*)d_out; a.ws = (unsigned char*)d_ws;
    void* args[] = {&a};
    hipError_t e = hipLaunchCooperativeKernel((const void*)hybrid_fwd, dim3(grid_blocks), dim3(NTHREADS), args, LDS_BYTES, stream);
    if (e != hipSuccess) fprintf(stderr, "cooperative launch failed: %s (grid %d)\n", hipGetErrorString(e), grid_blocks);
}
```

```cpp
#include <hip/hip_runtime.h>
#include <hip/hip_cooperative_groups.h>
#include <cstdio>
#include <cstdint>
namespace cg = cooperative_groups;

constexpr size_t MiB = 1u << 20;
constexpr size_t WS_MOD = 0;
constexpr size_t WS_CBIAS = 256 * 1024;
constexpr size_t WS_ERR = 384 * 1024;
constexpr size_t WS_SSQQ = 512 * 1024;
constexpr size_t WS_SSQKV = 640 * 1024;
constexpr size_t WS_GATES = 1 * MiB;
constexpr size_t WS_CS = 3 * MiB;
constexpr size_t WS_W = 4 * MiB;
constexpr size_t W_GU1 = WS_W, W_D1 = W_GU1 + (size_t)5632 * 1024 * 2, W_GU2 = W_D1 + (size_t)1024 * 2816 * 2, W_D2 = W_GU2 + (size_t)5632 * 1024 * 2;
constexpr size_t W_IN = W_D2 + (size_t)1024 * 2816 * 2, W_UQ = W_IN + (size_t)4096 * 1024 * 2, W_UKV = W_UQ + (size_t)768 * 384 * 2, W_BA = W_UKV + (size_t)1024 * 256 * 2;
constexpr size_t W_BB = W_BA + (size_t)1024 * 512 * 2, W_OUT = W_BB + (size_t)1024 * 512 * 2, W_1K = W_OUT + (size_t)1024 * 1024 * 2, W_1V = W_1K + (size_t)64 * 2048 * 2, W_END = W_1V + (size_t)64 * 2048 * 2;
static_assert(W_END <= 52 * MiB, "weights region");
constexpr size_t WS_XN = 52 * MiB;
constexpr size_t WS_OA = 52 * MiB, WS_OB = 68 * MiB;
constexpr size_t WS_C = 84 * MiB;
constexpr size_t WS_QN = 84 * MiB, WS_KCF = 100 * MiB, WS_VCF = 104 * MiB, WS_KSEL = 108 * MiB, WS_VSEL = 112 * MiB, WS_KWIN = 116 * MiB, WS_VWIN = 120 * MiB;
constexpr size_t WS_CQ = 124 * MiB, WS_CKV = 136 * MiB, WS_GM = 144 * MiB, WS_KC = 208 * MiB, WS_VC = 208 * MiB + 256 * 1024;
constexpr size_t WS_QM = 212 * MiB, WS_KM = 236 * MiB, WS_VM = 260 * MiB, WS_Y = 212 * MiB, WS_TOTAL = 276 * MiB;


__device__ __forceinline__ int opaque_lane() { unsigned z; asm volatile("v_mov_b32 %0, 0" : "=v"(z)); return (int)__builtin_amdgcn_mbcnt_hi(~0u, __builtin_amdgcn_mbcnt_lo(~0u, z)); }
template <int K> __device__ __forceinline__ float swz_xor(float v) { return __int_as_float(__builtin_amdgcn_ds_swizzle(__float_as_int(v), (K << 10) | 0x1f)); }
__device__ __forceinline__ float half_sum(float v) { auto rr = __builtin_amdgcn_permlane32_swap(__float_as_uint(v), __float_as_uint(v), false, false); return __uint_as_float(rr[0]) + __uint_as_float(rr[1]); }
__device__ __forceinline__ float wave_sum(float v) { v += swz_xor<1>(v); v += swz_xor<2>(v); v += swz_xor<4>(v); v += swz_xor<8>(v); v += swz_xor<16>(v); return half_sum(v); }
namespace pg8 {
#define PG8_LAS __attribute__((address_space(3)))
typedef unsigned short bf16_t;
typedef short bf16x8 __attribute__((ext_vector_type(8)));
typedef float f32x4 __attribute__((ext_vector_type(4)));
typedef unsigned u32x4 __attribute__((ext_vector_type(4)));
constexpr int BM = 256, BK = 64, HALF = 128, HTB = HALF * BK * 2  , STAGE_BYTES = 8 * HTB, NXCD = 8, WGM = 8;

__host__ __device__ __forceinline__ int lds_byte(int r, int c) { const int st = (r >> 4) * 2 + (c >> 5), rr = r & 15, cc = c & 31, ob = rr * 64 + cc * 2; return st * 1024 + (ob ^ (((ob >> 9) & 1) << 5)); }
__host__ __device__ __forceinline__ void stage_rc(int b, int& R, int& C) { const int st = b / 1024, sb = b % 1024, swz = sb ^ (((sb >> 9) & 1) << 5); R = (st >> 1) * 16 + swz / 64; C = (st & 1) * 32 + (swz % 64) / 2; }
__host__ __device__ __forceinline__ int perm32(int rho) { const int n = rho >> 4, i = rho & 15; return 8 * (i >> 2) + 4 * n + (i & 3); }

struct Unit { int pm, pn; };
struct Gemm { const bf16_t* A; const bf16_t* Bt; int M, N, K; };

struct StaticOrder {
    int nM, nN, nwg, G, c;
    __host__ __device__ __forceinline__ void init(int M, int N, int G_, int c_) { nM = M / BM; nN = N / BM; nwg = nM * nN; G = G_; c = c_; }
    __host__ __device__ __forceinline__ bool next(int i, Unit& u) const {
        const long L = (long)i * G + c; if (L >= nwg) return false;
        int wgid = (int)L; { const int q = nwg / NXCD, r = nwg % NXCD, xcd = wgid % NXCD, off = wgid / NXCD; wgid = (xcd < r ? xcd * (q + 1) : r * (q + 1) + (xcd - r) * q) + off; }
        const int nig = WGM * nN, gid = wgid / nig, fm = gid * WGM, gsz = (nM - fm) < WGM ? (nM - fm) : WGM;
        u.pm = fm + ((wgid % nig) % gsz); u.pn = (wgid % nig) / gsz; return true;
    }
    __device__ __forceinline__ void a_ready(const Unit&) const {}
    __device__ __forceinline__ void done(const Unit&) const {}
};

typedef float cvt_f32x2_t __attribute__((ext_vector_type(2))); typedef __bf16 cvt_bf16x2_t __attribute__((ext_vector_type(2)));
__device__ __forceinline__ unsigned cvt_pk_bf16(float lo, float hi) { cvt_f32x2_t v = {lo, hi}; cvt_bf16x2_t b = __builtin_convertvector(v, cvt_bf16x2_t); return __builtin_bit_cast(unsigned, b); }
typedef float f32x2 __attribute__((ext_vector_type(2)));
constexpr int SEQL = 8192, DMODEL = 1024, DFFN = 2816;
constexpr float LOG2E = 1.4426950408889634f;
constexpr float QSC_NSA = 0.125f * LOG2E;
constexpr float QSC_MLA = 0.10206207261596577f * LOG2E;
constexpr float NEPS = 1e-6f;
__device__ __forceinline__ float sigm(float x) { return __builtin_amdgcn_rcpf(1.0f + __builtin_amdgcn_exp2f(-LOG2E * x)); }
__device__ __forceinline__ void st8(bf16_t* p, f32x4 a0, f32x4 a1) {
    u32x4 w; w.x = cvt_pk_bf16(a0[0], a0[1]); w.y = cvt_pk_bf16(a0[2], a0[3]); w.z = cvt_pk_bf16(a1[0], a1[1]); w.w = cvt_pk_bf16(a1[2], a1[3]); *(u32x4*)p = w; }
__device__ __forceinline__ float bf2f(unsigned short h) { return __uint_as_float(((unsigned)h) << 16); }

struct EpiSwiGLU { static constexpr bool PERM = true, AFTER_DRAIN = false; unsigned char* ws;
    __device__ __forceinline__ void operator()(const f32x4 (&acc)[2][2][4][2], const Unit& u, int wr, int wc, int fr, int fq) const {
        { const int ln_ = opaque_lane(); fr = ln_ & 15; fq = ln_ >> 4; }
        const int row0 = u.pm * BM + wr * 64 + fr, col0 = u.pn * 128 + wc * 32 + 8 * fq;
#pragma unroll
        for (int ai = 0; ai < 2; ++ai)
#pragma unroll
            for (int m = 0; m < 4; ++m) { bf16_t* rowp = (bf16_t*)(ws + WS_C) + (size_t)(row0 + ai * HALF + m * 16) * DFFN + col0;
                f32x4 h0, h1;
#pragma unroll
                for (int j = 0; j < 4; ++j) { const float g0 = acc[ai][0][m][0][j], g1 = acc[ai][0][m][1][j];
                    h0[j] = g0 * sigm(g0) * acc[ai][1][m][0][j]; h1[j] = g1 * sigm(g1) * acc[ai][1][m][1][j]; }
                st8(rowp, h0, h1); }
    }
};
struct EpiResid { static constexpr bool PERM = false, AFTER_DRAIN = false; const float* xin; float* xout; const float* gate; float gs;
    __device__ __forceinline__ void operator()(const f32x4 (&acc)[2][2][4][2], const Unit& u, int wr, int wc, int fr, int fq) const {
        { const int ln_ = opaque_lane(); fr = ln_ & 15; fq = ln_ >> 4; }
        const int col0 = u.pn * BM + wc * 32 + 4 * fq; const int b = (u.pm * BM) >> 13;
        f32x4 gv[2][2];
#pragma unroll
        for (int bj = 0; bj < 2; ++bj)
#pragma unroll
            for (int n = 0; n < 2; ++n) gv[bj][n] = *(const f32x4*)(gate + (size_t)b * 9216 + col0 + bj * HALF + n * 16) * gs;
#pragma unroll
        for (int ai = 0; ai < 2; ++ai)
#pragma unroll
            for (int m = 0; m < 4; ++m) { const size_t off = (size_t)(u.pm * BM + ai * HALF + wr * 64 + m * 16 + fr) * DMODEL + col0;
#pragma unroll
                for (int bj = 0; bj < 2; ++bj)
#pragma unroll
                    for (int n = 0; n < 2; ++n) { const f32x4 xv = *(const f32x4*)(xin + off + bj * HALF + n * 16);
                        *(f32x4*)(xout + off + bj * HALF + n * 16) = xv + gv[bj][n] * acc[ai][bj][m][n]; }
                if (m & 1) asm volatile("" ::: "memory"); }
    }
};
struct EpiWin { static constexpr bool PERM = true, AFTER_DRAIN = false;
    unsigned char* ws;
    __device__ __forceinline__ void operator()(const f32x4 (&acc)[2][2][4][2], const Unit& u, int wr, int wc, int fr, int fq) const {
        { const int ln_ = opaque_lane(); fr = ln_ & 15; fq = ln_ >> 4; }
        bf16_t* const Qn = (bf16_t*)(ws + WS_QN); bf16_t* const kcf = (bf16_t*)(ws + WS_KCF); bf16_t* const vcf = (bf16_t*)(ws + WS_VCF); bf16_t* const Ksel = (bf16_t*)(ws + WS_KSEL); bf16_t* const Vsel = (bf16_t*)(ws + WS_VSEL);
        bf16_t* const Kwin = (bf16_t*)(ws + WS_KWIN); bf16_t* const Vwin = (bf16_t*)(ws + WS_VWIN); bf16_t* const cq = (bf16_t*)(ws + WS_CQ); bf16_t* const ckv = (bf16_t*)(ws + WS_CKV); bf16_t* const Km = (bf16_t*)(ws + WS_KM); bf16_t* const gm = (bf16_t*)(ws + WS_GM);
        float* const gates = (float*)(ws + WS_GATES); const float* const cs = (const float*)(ws + WS_CS);
        const int pn = u.pn;
#pragma unroll
        for (int ai = 0; ai < 2; ++ai)
#pragma unroll
            for (int m = 0; m < 4; ++m) {
                const int row = u.pm * BM + ai * HALF + wr * 64 + m * 16 + fr, b = row >> 13, t = row & (SEQL - 1);
                const int d = wc * 32 + 8 * fq;
                if (pn < 2) {
#pragma unroll
                    for (int bj = 0; bj < 2; ++bj) st8(Qn + (size_t)row * 512 + pn * 256 + bj * HALF + d, acc[ai][bj][m][0] * QSC_NSA, acc[ai][bj][m][1] * QSC_NSA);
                } else if (pn == 2) {
                    const int g = d >> 6, dd = d & 63; const size_t o = ((size_t)(b * 2 + g) * SEQL + t) * 64 + dd;
                    st8(kcf + o, acc[ai][0][m][0], acc[ai][0][m][1]); st8(vcf + o, acc[ai][1][m][0], acc[ai][1][m][1]);
                } else if (pn == 3 || pn == 4) {
                    bf16_t* Kd = pn == 3 ? Ksel : Kwin; bf16_t* Vd = pn == 3 ? Vsel : Vwin;
                    const int g = d >> 6, dd = d & 63; const size_t tb = (size_t)(b * 2 + g) * 128 + (t >> 6);
                    st8(Kd + (tb * 8 + (dd >> 3)) * 512 + (t & 63) * 8, acc[ai][0][m][0], acc[ai][0][m][1]);
                    st8(Vd + tb * 4096 + (dd >> 5) * 2048 + (t & 63) * 32 + (dd & 31), acc[ai][1][m][0], acc[ai][1][m][1]);
                } else if (pn == 5 || pn == 6) {
#pragma unroll
                    for (int bj = 0; bj < 2; ++bj) { const f32x4 a0 = acc[ai][bj][m][0], a1 = acc[ai][bj][m][1];
                        if (pn == 5) st8(ckv + (size_t)row * 256 + bj * HALF + d, a0, a1); else st8(cq + (size_t)row * 384 + bj * HALF + d, a0, a1); }
                } else if (pn == 7) {
                    st8(cq + (size_t)row * 384 + 256 + d, acc[ai][0][m][0], acc[ai][0][m][1]);
                    const f32x4 a0 = acc[ai][1][m][0], a1 = acc[ai][1][m][1];
                    if (wc == 0) {
                        const f32x4 c4 = *(const f32x4*)(cs + (size_t)t * 32 + 4 * fq), s4 = *(const f32x4*)(cs + (size_t)t * 32 + 16 + 4 * fq);
                        f32x4 o0, o1;
                        o0[0] = a0[0] * c4[0] - a0[1] * s4[0]; o0[1] = a0[0] * s4[0] + a0[1] * c4[0];
                        o0[2] = a0[2] * c4[1] - a0[3] * s4[1]; o0[3] = a0[2] * s4[1] + a0[3] * c4[1];
                        o1[0] = a1[0] * c4[2] - a1[1] * s4[2]; o1[1] = a1[0] * s4[2] + a1[1] * c4[2];
                        o1[2] = a1[2] * c4[3] - a1[3] * s4[3]; o1[3] = a1[2] * s4[3] + a1[3] * c4[3];
#pragma unroll
                        for (int h = 0; h < 8; ++h) st8(Km + (((size_t)(b * 8 + h) * 128 + (t >> 6)) * 12 + 8 + fq) * 512 + (t & 63) * 8, o0, o1);
                    } else if (wc == 1 && fq < 3) {
                        float* gp = gates + (size_t)row * 24 + 8 * fq; f32x4 g0, g1;
#pragma unroll
                        for (int j = 0; j < 4; ++j) { g0[j] = sigm(a0[j]); g1[j] = sigm(a1[j]); }
                        *(f32x4*)gp = g0; *(f32x4*)(gp + 4) = g1;
                    }
                } else {
#pragma unroll
                    for (int bj = 0; bj < 2; ++bj) { f32x4 g0, g1;
#pragma unroll
                        for (int j = 0; j < 4; ++j) { g0[j] = sigm(acc[ai][bj][m][0][j]); g1[j] = sigm(acc[ai][bj][m][1][j]); }
                        st8(gm + (size_t)row * 2048 + (pn - 8) * 256 + bj * HALF + d, g0, g1); }
                }
                asm volatile("" ::: "memory");
            }
    }
};
struct EpiQproj { static constexpr bool PERM = true, AFTER_DRAIN = false; unsigned char* ws; const PG8_LAS float* tab;
    __device__ __forceinline__ void operator()(const f32x4 (&acc)[2][2][4][2], const Unit& u, int wr, int wc, int fr, int fq) const {
        { const int ln_ = opaque_lane(); fr = ln_ & 15; fq = ln_ >> 4; }
        bf16_t* const Qm = (bf16_t*)(ws + WS_QM); const float* const cs = (const float*)(ws + WS_CS);
#pragma unroll
        for (int ai = 0; ai < 2; ++ai)
#pragma unroll
            for (int m = 0; m < 4; ++m) {
                const int row = u.pm * BM + ai * HALF + wr * 64 + m * 16 + fr, t = row & (SEQL - 1);
                const float rs = tab[ai * HALF + wr * 64 + m * 16 + fr];
#pragma unroll
                for (int bj = 0; bj < 2; ++bj) { const int n = u.pn * BM + bj * HALF + wc * 32 + 8 * fq; const int p = n % 96;
                    f32x4 a0 = acc[ai][bj][m][0] * rs, a1 = acc[ai][bj][m][1] * rs;
                    if (p >= 64) { const int i0 = (p - 64) >> 1;
                        const f32x4 c4 = *(const f32x4*)(cs + (size_t)t * 32 + i0), s4 = *(const f32x4*)(cs + (size_t)t * 32 + 16 + i0);
                        f32x4 o0, o1;
                        o0[0] = a0[0] * c4[0] - a0[1] * s4[0]; o0[1] = a0[0] * s4[0] + a0[1] * c4[0];
                        o0[2] = a0[2] * c4[1] - a0[3] * s4[1]; o0[3] = a0[2] * s4[1] + a0[3] * c4[1];
                        o1[0] = a1[0] * c4[2] - a1[1] * s4[2]; o1[1] = a1[0] * s4[2] + a1[1] * c4[2];
                        o1[2] = a1[2] * c4[3] - a1[3] * s4[3]; o1[3] = a1[2] * s4[3] + a1[3] * c4[3];
                        a0 = o0; a1 = o1; }
                    st8(Qm + (size_t)row * 768 + n, a0, a1); }
                asm volatile("" ::: "memory");
            }
    }
};
struct EpiKVproj { static constexpr bool PERM = true, AFTER_DRAIN = false; unsigned char* ws; const PG8_LAS float* tab;
    __device__ __forceinline__ void operator()(const f32x4 (&acc)[2][2][4][2], const Unit& u, int wr, int wc, int fr, int fq) const {
        { const int ln_ = opaque_lane(); fr = ln_ & 15; fq = ln_ >> 4; }
        bf16_t* const Km = (bf16_t*)(ws + WS_KM); bf16_t* const Vm = (bf16_t*)(ws + WS_VM);
#pragma unroll
        for (int ai = 0; ai < 2; ++ai)
#pragma unroll
            for (int m = 0; m < 4; ++m) {
                const int row = u.pm * BM + ai * HALF + wr * 64 + m * 16 + fr, b = row >> 13, t = row & (SEQL - 1);
                const float rs = tab[ai * HALF + wr * 64 + m * 16 + fr];
#pragma unroll
                for (int bj = 0; bj < 2; ++bj) { const int n = (u.pn & 1) * BM + bj * HALF + wc * 32 + 8 * fq; const int h = n >> 6, dd = n & 63;
                    const f32x4 a0 = acc[ai][bj][m][0] * rs, a1 = acc[ai][bj][m][1] * rs; const size_t tb = (size_t)(b * 8 + h) * 128 + (t >> 6);
                    if (u.pn < 2) st8(Km + (tb * 12 + (dd >> 3)) * 512 + (t & 63) * 8, a0, a1);
                    else st8(Vm + tb * 4096 + (dd >> 5) * 2048 + (t & 63) * 32 + (dd & 31), a0, a1); }
                asm volatile("" ::: "memory");
            }
    }
};
template <int PASS> struct EpiBranch { static constexpr bool PERM = true, AFTER_DRAIN = false; unsigned char* ws;
    __device__ __forceinline__ void operator()(const f32x4 (&acc)[2][2][4][2], const Unit& u, int wr, int wc, int fr, int fq) const {
        { const int ln_ = opaque_lane(); fr = ln_ & 15; fq = ln_ >> 4; }
        bf16_t* const Y = (bf16_t*)(ws + WS_Y); const bf16_t* const gm = (const bf16_t*)(ws + WS_GM);
#pragma unroll
        for (int ai = 0; ai < 2; ++ai)
#pragma unroll
            for (int m = 0; m < 4; ++m) { const int row = u.pm * BM + ai * HALF + wr * 64 + m * 16 + fr;
#pragma unroll
                for (int bj = 0; bj < 2; ++bj) { const int n = u.pn * BM + bj * HALF + wc * 32 + 8 * fq;
                    const u32x4 gw = *(const u32x4*)(gm + (size_t)row * 2048 + PASS * 1024 + n);
                    f32x4 a0 = acc[ai][bj][m][0], a1 = acc[ai][bj][m][1];
                    a0[0] *= __uint_as_float(gw.x << 16); a0[1] *= __uint_as_float(gw.x & 0xffff0000u); a0[2] *= __uint_as_float(gw.y << 16); a0[3] *= __uint_as_float(gw.y & 0xffff0000u);
                    a1[0] *= __uint_as_float(gw.z << 16); a1[1] *= __uint_as_float(gw.z & 0xffff0000u); a1[2] *= __uint_as_float(gw.w << 16); a1[3] *= __uint_as_float(gw.w & 0xffff0000u);
                    bf16_t* yp = Y + (size_t)row * DMODEL + n;
                    if (PASS == 1) { const u32x4 yw = *(const u32x4*)yp;
                        a0[0] += __uint_as_float(yw.x << 16); a0[1] += __uint_as_float(yw.x & 0xffff0000u); a0[2] += __uint_as_float(yw.y << 16); a0[3] += __uint_as_float(yw.y & 0xffff0000u);
                        a1[0] += __uint_as_float(yw.z << 16); a1[1] += __uint_as_float(yw.z & 0xffff0000u); a1[2] += __uint_as_float(yw.w << 16); a1[3] += __uint_as_float(yw.w & 0xffff0000u); }
                    st8(yp, a0, a1); }
            }
    }
};
template <class Epi, class Sched, bool ALIGN_EPI = false, bool SP2 = false>
__device__ __forceinline__ void gemm_phase(PG8_LAS unsigned char* lds, const Gemm g, const Sched& S, const Epi& E, int wave_id) {
    int tid_ = wave_id * 64 + opaque_lane();
    const int tid = tid_, wid = __builtin_amdgcn_readfirstlane(tid >> 6), lane = tid & 63, wr = wid >> 2, wc = wid & 3, fr = lane & 15, fq = lane >> 4;
    const int K = g.K, nt = K / BK;
    unsigned voffA[2], voffB[2];
#pragma unroll
    for (int i = 0; i < 2; ++i) { int R, C; stage_rc(tid * 16 + i * 8192, R, C); const int Rb = Epi::PERM ? ((R & ~31) + perm32(R & 31)) : R;
        voffA[i] = (unsigned)(R * K + C) * 2u; voffB[i] = (unsigned)(Rb * K + C) * 2u; }
    const size_t kstep = (size_t)(BK * 2);
    const size_t hstep = (size_t)HALF * K * 2;
    const size_t tstep = 2 * hstep;
    const unsigned ldsw = (unsigned)wid * 1024u;
    const int aoff = lds_byte(wr * 64 + fr, fq * 8), boff = lds_byte(wc * 32 + fr, fq * 8);
#define PG8_SA(b, h) (((b) * 2 + (h)) * HTB)
#define PG8_SB(b, h) ((4 + (b) * 2 + (h)) * HTB)
#define PG8_STAGE(bufoff, gbase, voff) do { _Pragma("unroll") for (int _i = 0; _i < 2; ++_i) \
        __builtin_amdgcn_global_load_lds((const unsigned*)((const char*)(gbase) + (voff)[_i]), (PG8_LAS unsigned*)(lds + (bufoff) + ldsw + _i * 8192), 16, 0, 0); } while (0)
#define PG8_LDA(dst, b, h) do { _Pragma("unroll") for (int m = 0; m < 4; ++m) _Pragma("unroll") for (int k = 0; k < 2; ++k) dst[m][k] = *(const PG8_LAS bf16x8*)(lds + PG8_SA(b, h) + aoff + m * 2048 + k * 1024); } while (0)
#define PG8_LDB(dst, b, h) do { _Pragma("unroll") for (int n = 0; n < 2; ++n) _Pragma("unroll") for (int k = 0; k < 2; ++k) dst[n][k] = *(const PG8_LAS bf16x8*)(lds + PG8_SB(b, h) + boff + n * 2048 + k * 1024); } while (0)
#define PG8_MMA(ai, bj, At, Bt) do { __builtin_amdgcn_s_setprio(1); _Pragma("unroll") for (int m = 0; m < 4; ++m) _Pragma("unroll") for (int n = 0; n < 2; ++n) _Pragma("unroll") for (int k = 0; k < 2; ++k) \
        acc[ai][bj][m][n] = __builtin_amdgcn_mfma_f32_16x16x32_bf16(Bt[n][k], At[m][k], acc[ai][bj][m][n], 0, 0, 0); __builtin_amdgcn_s_setprio(0); } while (0)
#define PG8_WAIT_V(n) asm volatile("s_waitcnt vmcnt(" #n ")" ::: "memory")
#define PG8_WAIT_L(n) asm volatile("s_waitcnt lgkmcnt(" #n ")" ::: "memory")
#define PG8_BAR __builtin_amdgcn_s_barrier()
#define PG8_SCHED __builtin_amdgcn_sched_barrier(0)
    Unit cur, nxt; int ui = 0;
    if (!S.next(0, cur)) return;
    f32x4 acc[2][2][4][2];
#pragma unroll
    for (int a = 0; a < 2; ++a)
#pragma unroll
        for (int b = 0; b < 2; ++b)
#pragma unroll
            for (int m = 0; m < 4; ++m)
#pragma unroll
                for (int n = 0; n < 2; ++n) acc[a][b][m][n] = (f32x4){0.f, 0.f, 0.f, 0.f};
    bf16x8 At[4][2], B0[2][2], B1[2][2];
    const char* cA = (const char*)g.A + (size_t)cur.pm * tstep; const char* cB = (const char*)g.Bt + (size_t)cur.pn * tstep;
    S.a_ready(cur);
    if constexpr (SP2) {
        PG8_STAGE(PG8_SB(0, 0), cB, voffB); PG8_STAGE(PG8_SB(0, 1), cB + hstep, voffB); PG8_STAGE(PG8_SA(0, 0), cA, voffA); PG8_STAGE(PG8_SA(0, 1), cA + hstep, voffA);
        if (wr == 1) PG8_BAR;
        PG8_WAIT_V(2); PG8_BAR;
        PG8_STAGE(PG8_SB(1, 0), cB + kstep, voffB); PG8_STAGE(PG8_SA(1, 0), cA + kstep, voffA); PG8_STAGE(PG8_SB(1, 1), cB + hstep + kstep, voffB);
        PG8_WAIT_V(6); PG8_BAR;
    } else {
        PG8_STAGE(PG8_SB(0, 0), cB, voffB); PG8_STAGE(PG8_SA(0, 0), cA, voffA); PG8_STAGE(PG8_SB(0, 1), cB + hstep, voffB); PG8_STAGE(PG8_SA(0, 1), cA + hstep, voffA);
        if (wr == 1) PG8_BAR;
        PG8_WAIT_V(4); PG8_BAR;
        PG8_STAGE(PG8_SB(1, 0), cB + kstep, voffB); PG8_STAGE(PG8_SA(1, 0), cA + kstep, voffA); PG8_STAGE(PG8_SB(1, 1), cB + hstep + kstep, voffB);
        PG8_WAIT_V(6); PG8_BAR;
    }
    for (;;) {
        const bool has_next = S.next(ui + 1, nxt);
        const char* nA = has_next ? (const char*)g.A + (size_t)nxt.pm * tstep : cA; const char* nB = has_next ? (const char*)g.Bt + (size_t)nxt.pn * tstep : cB;
        for (int t = 0; t < nt; t += 2) {
            const bool last = (t == nt - 2);
            const char* a1 = cA + (size_t)(t + 1) * kstep;
            const char* a2 = last ? nA : cA + (size_t)(t + 2) * kstep; const char* b2 = last ? nB : cB + (size_t)(t + 2) * kstep;
            const char* a3 = a2 + kstep; const char* b3 = b2 + kstep;
            if (last && has_next) S.a_ready(nxt);
            if constexpr (SP2) {
            PG8_LDB(B0, 0, 0); PG8_LDB(B1, 0, 1); PG8_SCHED; PG8_LDA(At, 0, 0); PG8_STAGE(PG8_SA(1, 1), a1 + hstep, voffA);
            PG8_WAIT_V(8); PG8_WAIT_L(0); PG8_BAR; PG8_MMA(0, 0, At, B0); PG8_MMA(0, 1, At, B1); PG8_BAR; PG8_SCHED;
            PG8_LDA(At, 0, 1); PG8_STAGE(PG8_SB(0, 0), b2, voffB); PG8_STAGE(PG8_SB(0, 1), b2 + hstep, voffB); PG8_STAGE(PG8_SA(0, 0), a2, voffA);
            PG8_WAIT_V(8); PG8_WAIT_L(0); PG8_BAR; PG8_MMA(1, 0, At, B0); PG8_MMA(1, 1, At, B1); PG8_BAR; PG8_SCHED;
            PG8_LDB(B0, 1, 0); PG8_LDB(B1, 1, 1); PG8_SCHED; PG8_LDA(At, 1, 0); PG8_STAGE(PG8_SA(0, 1), a2 + hstep, voffA);
            PG8_WAIT_V(8); PG8_WAIT_L(0); PG8_BAR; PG8_MMA(0, 0, At, B0); PG8_MMA(0, 1, At, B1); PG8_BAR; PG8_SCHED;
            PG8_LDA(At, 1, 1); PG8_STAGE(PG8_SB(1, 0), b3, voffB); PG8_STAGE(PG8_SB(1, 1), b3 + hstep, voffB); PG8_STAGE(PG8_SA(1, 0), a3, voffA);
            PG8_WAIT_V(8); PG8_WAIT_L(0); PG8_BAR; PG8_MMA(1, 0, At, B0); PG8_MMA(1, 1, At, B1); PG8_BAR; PG8_SCHED;
            } else {
            PG8_LDB(B0, 0, 0); PG8_SCHED; PG8_LDA(At, 0, 0); PG8_STAGE(PG8_SA(1, 1), a1 + hstep, voffA);
            PG8_WAIT_L(8); PG8_BAR; PG8_WAIT_L(0); PG8_MMA(0, 0, At, B0); PG8_BAR; PG8_SCHED;
            PG8_LDB(B1, 0, 1); PG8_STAGE(PG8_SB(0, 0), b2, voffB);
            PG8_BAR; PG8_WAIT_L(0); PG8_MMA(0, 1, At, B1); PG8_BAR;
            PG8_LDA(At, 0, 1); PG8_STAGE(PG8_SA(0, 0), a2, voffA);
            PG8_BAR; PG8_WAIT_L(0); PG8_MMA(1, 0, At, B0); PG8_BAR; PG8_SCHED;
            PG8_STAGE(PG8_SB(0, 1), b2 + hstep, voffB);
            PG8_WAIT_V(6); PG8_BAR; PG8_MMA(1, 1, At, B1); PG8_BAR;
            PG8_LDB(B0, 1, 0); PG8_SCHED; PG8_LDA(At, 1, 0); PG8_STAGE(PG8_SA(0, 1), a2 + hstep, voffA);
            PG8_WAIT_L(8); PG8_BAR; PG8_WAIT_L(0); PG8_MMA(0, 0, At, B0); PG8_BAR; PG8_SCHED;
            PG8_LDB(B1, 1, 1); PG8_STAGE(PG8_SB(1, 0), b3, voffB);
            PG8_BAR; PG8_WAIT_L(0); PG8_MMA(0, 1, At, B1); PG8_BAR;
            PG8_LDA(At, 1, 1); PG8_STAGE(PG8_SA(1, 0), a3, voffA);
            PG8_BAR; PG8_WAIT_L(0); PG8_MMA(1, 0, At, B0); PG8_BAR; PG8_SCHED;
            PG8_STAGE(PG8_SB(1, 1), b3 + hstep, voffB);
            PG8_WAIT_V(6); PG8_BAR; PG8_MMA(1, 1, At, B1); PG8_BAR;
            }
        }
        if constexpr (ALIGN_EPI) { if (wr == 0) PG8_BAR; }
        if constexpr (!Epi::AFTER_DRAIN) { E(acc, cur, wr, wc, fr, fq); S.done(cur); }
        if (!has_next) break;
#pragma unroll
        for (int a = 0; a < 2; ++a)
#pragma unroll
            for (int b = 0; b < 2; ++b)
#pragma unroll
                for (int m = 0; m < 4; ++m)
#pragma unroll
                    for (int n = 0; n < 2; ++n) acc[a][b][m][n] = (f32x4){0.f, 0.f, 0.f, 0.f};
        cur = nxt; cA = nA; cB = nB; ++ui;
        if constexpr (ALIGN_EPI) { if (wr == 1) PG8_BAR; }
    }
    PG8_WAIT_V(0);
    if constexpr (!ALIGN_EPI) { if (wr == 0) PG8_BAR; }
    PG8_BAR;
    if constexpr (Epi::AFTER_DRAIN) { E.fused(acc, cur, wr, wc, fr, fq, lds, wid, lane); S.done(cur); }
#undef PG8_SA
#undef PG8_SB
#undef PG8_STAGE
#undef PG8_LDA
#undef PG8_LDB
#undef PG8_MMA
#undef PG8_WAIT_V
#undef PG8_WAIT_L
#undef PG8_BAR
#undef PG8_SCHED
}
}
namespace att {
#define LAS __attribute__((address_space(3)))
typedef unsigned short bf16;
typedef short bf16x8 __attribute__((ext_vector_type(8)));
typedef short s16x4 __attribute__((ext_vector_type(4)));
typedef float f32x16 __attribute__((ext_vector_type(16)));
typedef float f32x4 __attribute__((ext_vector_type(4)));
typedef unsigned u32x4 __attribute__((ext_vector_type(4)));
typedef unsigned u32x2 __attribute__((ext_vector_type(2)));
typedef const LAS char* lcp;
constexpr float LOG2E = 1.4426950408889634f;
__device__ __forceinline__ int crow(int r, int hi) { return (r & 3) + 8 * (r >> 2) + 4 * hi; }
typedef float f32x2_t __attribute__((ext_vector_type(2))); typedef __bf16 bf16x2_t __attribute__((ext_vector_type(2)));
__device__ __forceinline__ unsigned cvtpk(float lo, float hi) { f32x2_t v = {lo, hi}; bf16x2_t b = __builtin_convertvector(v, bf16x2_t); return __builtin_bit_cast(unsigned, b); }
__device__ __forceinline__ unsigned short f2bf(float f) { return (unsigned short)(cvtpk(f, 0.f) & 0xffffu); }
__device__ __forceinline__ float xmax(float v) { auto rr = __builtin_amdgcn_permlane32_swap(__float_as_uint(v), __float_as_uint(v), false, false); return fmaxf(__uint_as_float(rr[0]), __uint_as_float(rr[1])); }
__device__ __forceinline__ float xsum(float v) { auto rr = __builtin_amdgcn_permlane32_swap(__float_as_uint(v), __float_as_uint(v), false, false); return __uint_as_float(rr[0]) + __uint_as_float(rr[1]); }
typedef short v4i16_t __attribute__((ext_vector_type(4)));
__device__ __forceinline__ s16x4 vtr(lcp p) { return __builtin_bit_cast(s16x4, __builtin_amdgcn_ds_read_tr16_b64_v4i16((LAS v4i16_t*)p)); }

template <int ND0> __device__ __forceinline__ void qk_tile(f32x16& p0, f32x16& p1, lcp kslot, const bf16x8* qr, int r32, int hi) {
    lcp kb = kslot + hi * 1024 + r32 * 16;
    p0 = f32x16{}; p1 = f32x16{};
#pragma unroll
    for (int d0 = 0; d0 < ND0; ++d0) {
        const bf16x8 b0 = *(const LAS bf16x8*)(kb + d0 * 2048), b1 = *(const LAS bf16x8*)(kb + d0 * 2048 + 512);
        p0 = __builtin_amdgcn_mfma_f32_32x32x16_bf16(b0, qr[d0], p0, 0, 0, 0);
        p1 = __builtin_amdgcn_mfma_f32_32x32x16_bf16(b1, qr[d0], p1, 0, 0, 0); }
}
__device__ __forceinline__ void pv_tile(f32x16& o0, f32x16& o1, lcp vp, const u32x4 (&pa)[4]) {
#pragma unroll
    for (int ks = 0; ks < 4; ++ks) {
        const s16x4 l0 = vtr(vp + ks * 1024), h0 = vtr(vp + ks * 1024 + 512), l1 = vtr(vp + 4096 + ks * 1024), h1 = vtr(vp + 4096 + ks * 1024 + 512);
        const bf16x8 v0 = (bf16x8){l0[0], l0[1], l0[2], l0[3], h0[0], h0[1], h0[2], h0[3]}, v1 = (bf16x8){l1[0], l1[1], l1[2], l1[3], h1[0], h1[1], h1[2], h1[3]};
        const bf16x8 a = __builtin_bit_cast(bf16x8, pa[ks]);
        o0 = __builtin_amdgcn_mfma_f32_32x32x16_bf16(a, v0, o0, 0, 0, 0);
        o1 = __builtin_amdgcn_mfma_f32_32x32x16_bf16(a, v1, o1, 0, 0, 0); }
}
__device__ __forceinline__ void pack_p(u32x4 (&pa)[4], const f32x16& p0, const f32x16& p1) {
    pa[0] = (u32x4){cvtpk(p0[0], p0[1]), cvtpk(p0[2], p0[3]), cvtpk(p0[4], p0[5]), cvtpk(p0[6], p0[7])};
    pa[1] = (u32x4){cvtpk(p0[8], p0[9]), cvtpk(p0[10], p0[11]), cvtpk(p0[12], p0[13]), cvtpk(p0[14], p0[15])};
    pa[2] = (u32x4){cvtpk(p1[0], p1[1]), cvtpk(p1[2], p1[3]), cvtpk(p1[4], p1[5]), cvtpk(p1[6], p1[7])};
    pa[3] = (u32x4){cvtpk(p1[8], p1[9]), cvtpk(p1[10], p1[11]), cvtpk(p1[12], p1[13]), cvtpk(p1[14], p1[15])};
}
__device__ __forceinline__ float max32(const f32x16& p0, const f32x16& p1) {
    float a = fmaxf(p0[0], p1[0]);
#pragma unroll
    for (int r = 1; r < 16; ++r) a = fmaxf(a, fmaxf(p0[r], p1[r]));
    return a;
}
__device__ __forceinline__ void softmax_pv(f32x16& p0, f32x16& p1, float& m, float& l, f32x16& o0, f32x16& o1, lcp vp, LAS float* wsf, int r32, int hi) {
    const float rm = xmax(max32(p0, p1));
    const float mn = fmaxf(m, rm); const float f = __builtin_amdgcn_exp2f(m - mn); m = mn;
    float s = 0.f;
#pragma unroll
    for (int r = 0; r < 16; ++r) { p0[r] = __builtin_amdgcn_exp2f(p0[r] - mn); p1[r] = __builtin_amdgcn_exp2f(p1[r] - mn); s += p0[r] + p1[r]; }
    l = l * f + s;
    if (__any(f != 1.0f)) {
        if (hi == 0) wsf[r32] = f;
#pragma unroll
        for (int r = 0; r < 16; ++r) { const float fr = wsf[crow(r, hi)]; o0[r] *= fr; o1[r] *= fr; }
    }
    u32x4 pa[4]; pack_p(pa, p0, p1);
    pv_tile(o0, o1, vp, pa);
}
__device__ __forceinline__ void add_scaled(f32x16& a0, f32x16& a1, const f32x16& o0, const f32x16& o1, float fac, LAS float* wsf, int r32, int hi) {
    if (hi == 0) wsf[32 + r32] = fac;
#pragma unroll
    for (int r = 0; r < 16; ++r) { const float fr = wsf[32 + crow(r, hi)]; a0[r] += fr * o0[r]; a1[r] += fr * o1[r]; }
}
template <bool FIRST> __device__ __forceinline__ void acc_lds(LAS float* accL, const f32x16& o0, const f32x16& o1, float fac, LAS float* wsf, int r32, int hi) {
    if (hi == 0) wsf[32 + r32] = fac;
#pragma unroll
    for (int r = 0; r < 16; ++r) { const int row = crow(r, hi); const float fr = wsf[32 + row]; LAS float* p = accL + row * 64 + r32;
        if (FIRST) { p[0] = fr * o0[r]; p[32] = fr * o1[r]; } else { p[0] += fr * o0[r]; p[32] += fr * o1[r]; } }
}
__device__ __forceinline__ void store_acc(const LAS float* accL, bf16* gdst, int pitch, int lane) {
#pragma unroll
    for (int i = 0; i < 4; ++i) { const int row = i * 8 + (lane >> 3), ch = lane & 7; const f32x4 a = *(const LAS f32x4*)(accL + row * 64 + ch * 8), b = *(const LAS f32x4*)(accL + row * 64 + ch * 8 + 4);
        const u32x4 v = (u32x4){cvtpk(a[0], a[1]), cvtpk(a[2], a[3]), cvtpk(b[0], b[1]), cvtpk(b[2], b[3])}; *(u32x4*)(gdst + (size_t)row * pitch + ch * 8) = v; }
}
__device__ __forceinline__ void store_o(const f32x16& o0, const f32x16& o1, LAS bf16* stg, bf16* gdst, int pitch, int lane, int r32, int hi) {
#pragma unroll
    for (int r = 0; r < 16; ++r) { const int orow = crow(r, hi); stg[orow * 64 + r32] = f2bf(o0[r]); stg[orow * 64 + 32 + r32] = f2bf(o1[r]); }
#pragma unroll
    for (int i = 0; i < 4; ++i) { const int row = i * 8 + (lane >> 3), ch = lane & 7; const u32x4 v = *(const LAS u32x4*)(stg + row * 64 + ch * 8); *(u32x4*)(gdst + (size_t)row * pitch + ch * 8) = v; }
}

constexpr int M_KS = 0, M_VS = 24576, M_WSF = 40960, M_OST = 43008;
__device__ __forceinline__ void mla_unit(int b, int h, int qb, const bf16* Qm, const bf16* Km, const bf16* Vm, bf16* Ob, LAS char* lds, int wave_id) {
    int tid_ = wave_id * 64 + opaque_lane();
    const int tid = tid_, lane = tid & 63, r32 = lane & 31, hi = lane >> 5, wid = __builtin_amdgcn_readfirstlane(tid >> 6);
    const int q0 = qb * 256, NT = (q0 + 256) / 64;
    const int qmin = q0 + wid * 32, qpos = qmin + r32;
    bf16x8 qr[6];
    { const bf16* qp = Qm + ((size_t)b * 8192 + qpos) * 768 + h * 96 + hi * 8;
#pragma unroll
      for (int d0 = 0; d0 < 6; ++d0) qr[d0] = *(const bf16x8*)(qp + d0 * 16); }
    const char* Kg = (const char*)(Km + (size_t)(b * 8 + h) * 128 * 6144);
    const char* Vg = (const char*)(Vm + (size_t)(b * 8 + h) * 128 * 4096);
    LAS float* wsf = (LAS float*)(lds + M_WSF) + wid * 64;
    const int vlane = ((lane >> 4) & 1) * 32 + (lane & 3) * 8 + (4 * hi + ((lane & 15) >> 2)) * 64;
    float m = -1e30f, l = 0.f; f32x16 o0 = f32x16{}, o1 = f32x16{};
    u32x4 kr0, kr1 = u32x4{}, vr0;
    kr0 = *(const u32x4*)(Kg + tid * 16); if (tid < 256) kr1 = *(const u32x4*)(Kg + 8192 + tid * 16); vr0 = *(const u32x4*)(Vg + tid * 16);
    *(LAS u32x4*)(lds + M_KS + tid * 16) = kr0; if (tid < 256) *(LAS u32x4*)(lds + M_KS + 8192 + tid * 16) = kr1; *(LAS u32x4*)(lds + M_VS + tid * 16) = vr0;
    __syncthreads();
    for (int kt = 0; kt < NT; ++kt) {
        const int sl = kt & 1;
        if (kt + 1 < NT) { const char* kg = Kg + (size_t)(kt + 1) * 12288; const char* vg = Vg + (size_t)(kt + 1) * 8192;
            kr0 = *(const u32x4*)(kg + tid * 16); if (tid < 256) kr1 = *(const u32x4*)(kg + 8192 + tid * 16); vr0 = *(const u32x4*)(vg + tid * 16); }
        if (64 * kt <= qmin + 31) {
            f32x16 p0, p1; qk_tile<6>(p0, p1, (lcp)(lds + M_KS + sl * 12288), qr, r32, hi);
            if (64 * kt + 63 > qmin) {
                const int kb = 64 * kt + 4 * hi;
#pragma unroll
                for (int r = 0; r < 16; ++r) { const int kv = kb + (r & 3) + 8 * (r >> 2); if (kv > qpos) p0[r] = -INFINITY; if (kv + 32 > qpos) p1[r] = -INFINITY; }
            }
            softmax_pv(p0, p1, m, l, o0, o1, (lcp)(lds + M_VS + sl * 8192 + vlane), wsf, r32, hi);
        }
        if (kt + 1 < NT) { const int sn = sl ^ 1;
            *(LAS u32x4*)(lds + M_KS + sn * 12288 + tid * 16) = kr0; if (tid < 256) *(LAS u32x4*)(lds + M_KS + sn * 12288 + 8192 + tid * 16) = kr1; *(LAS u32x4*)(lds + M_VS + sn * 8192 + tid * 16) = vr0; }
        __syncthreads();
    }
    const float lt = xsum(l); const float inv = lt > 0.f ? 1.0f / lt : 0.f;
    f32x16 a0 = f32x16{}, a1 = f32x16{};
    add_scaled(a0, a1, o0, o1, inv, wsf, r32, hi);
    store_o(a0, a1, (LAS bf16*)(lds + M_OST + wid * 4096), Ob + ((size_t)b * 8192 + qmin) * 512 + h * 64, 512, lane, r32, hi);
    __syncthreads();
}

constexpr int N_KS = 0, N_VS = 16384, N_WSF = 32768, N_ACC = 34816, N_IMP = 100352, N_SEL = 133376, N_UNI = 134400, N_BL = 134464, IMPS = 129;
struct NsaT { const bf16 *Qn, *Kc, *Vc, *Ksel, *Vsel, *Kwin, *Vwin; const float* gates; bf16* Oa; };
__device__ __forceinline__ void setbit(unsigned (&w)[4], int j) { const int wi = j >> 5; const unsigned bv = 1u << (j & 31); w[0] |= wi == 0 ? bv : 0u; w[1] |= wi == 1 ? bv : 0u; w[2] |= wi == 2 ? bv : 0u; w[3] |= wi == 3 ? bv : 0u; }
__device__ __forceinline__ void nsa_unit(int b, int g, int ti, const NsaT& T, LAS char* lds, int wave_id) {
    int tid_ = wave_id * 64 + opaque_lane();
    const int tid = tid_, lane = tid & 63, r32 = lane & 31, hi = lane >> 5, wid = __builtin_amdgcn_readfirstlane(tid >> 6);
    const int hh = wid & 3, qh = wid >> 2, H = g * 4 + hh, bg = b * 2 + g;
    const int t0 = ti * 64, qrow = qh * 32 + r32, t = t0 + qrow;
    const float slope2 = __builtin_amdgcn_exp2f(-(float)(H + 1)) * LOG2E;
    bf16x8 qr[4];
    { const bf16* qp = T.Qn + ((size_t)b * 8192 + t) * 512 + H * 64 + hi * 8;
#pragma unroll
      for (int d0 = 0; d0 < 4; ++d0) qr[d0] = *(const bf16x8*)(qp + d0 * 16); }
    LAS float* wsf = (LAS float*)(lds + N_WSF) + wid * 64;
    LAS float* imp = (LAS float*)(lds + N_IMP);
    LAS unsigned* selw = (LAS unsigned*)(lds + N_SEL);
    LAS unsigned* uni = (LAS unsigned*)(lds + N_UNI);
    LAS unsigned* blist = (LAS unsigned*)(lds + N_BL);
    const int vlane = ((lane >> 4) & 1) * 32 + (lane & 3) * 8 + (4 * hi + ((lane & 15) >> 2)) * 64;
    for (int i = tid; i < 64 * IMPS; i += 512) imp[i] = 0.f;
    if (tid < 256) selw[tid] = 0u;
    if (tid < 8) uni[tid] = 0u;
    const float* gp = T.gates + ((size_t)b * 8192 + t) * 24 + H * 3;
    const float gc = gp[0], gs = gp[1], gw = gp[2];
    LAS float* accL = (LAS float*)(lds + N_ACC) + wid * 2048;
    u32x4 kr0, vr0;
    const int ntc = (4 * ti + 3 + 63) >> 6;
    const char* Kcg = (const char*)(T.Kc + (size_t)bg * 8 * 4096); const char* Vcg = (const char*)(T.Vc + (size_t)bg * 8 * 4096);
    float m = -1e30f, l = 0.f;
#ifndef NSA_SKIP_P1
    kr0 = *(const u32x4*)(Kcg + tid * 16); *(LAS u32x4*)(lds + N_KS + tid * 16) = kr0;
    __syncthreads();
    for (int kt = 0; kt < ntc; ++kt) {
        const int sl = kt & 1;
        if (kt + 1 < ntc) kr0 = *(const u32x4*)(Kcg + (size_t)(kt + 1) * 8192 + tid * 16);
        { f32x16 p0, p1; qk_tile<4>(p0, p1, (lcp)(lds + N_KS + sl * 8192), qr, r32, hi);
          const int nb = 64 * kt + 4 * hi;
#pragma unroll
          for (int r = 0; r < 16; ++r) { const int n = nb + (r & 3) + 8 * (r >> 2); const int e0 = 16 * n + 31 - t, e1 = e0 + 512;
              p0[r] = e0 <= 0 ? p0[r] + slope2 * (float)e0 : -INFINITY; p1[r] = e1 <= 0 ? p1[r] + slope2 * (float)e1 : -INFINITY; }
          const float rm = max32(p0, p1); const float mn = fmaxf(m, rm); float s = 0.f;
#pragma unroll
          for (int r = 0; r < 16; ++r) s += __builtin_amdgcn_exp2f(p0[r] - mn) + __builtin_amdgcn_exp2f(p1[r] - mn);
          l = l * __builtin_amdgcn_exp2f(m - mn) + s; m = mn; }
        if (kt + 1 < ntc) *(LAS u32x4*)(lds + N_KS + (sl ^ 1) * 8192 + tid * 16) = kr0;
        __syncthreads();
    }
    {
      auto rm_ = __builtin_amdgcn_permlane32_swap(__float_as_uint(m), __float_as_uint(m), false, false); auto rl_ = __builtin_amdgcn_permlane32_swap(__float_as_uint(l), __float_as_uint(l), false, false);
      const float mo = __uint_as_float(hi ? rm_[0] : rm_[1]), lo = __uint_as_float(hi ? rl_[0] : rl_[1]); const float mn = fmaxf(m, mo);
      l = l * __builtin_amdgcn_exp2f(m - mn) + lo * __builtin_amdgcn_exp2f(mo - mn); m = mn; }
#endif
    const float invl = l > 0.f ? 1.0f / l : 0.f;
    f32x16 o0 = f32x16{}, o1 = f32x16{};
#ifndef NSA_SKIP_P2
    kr0 = *(const u32x4*)(Kcg + tid * 16); vr0 = *(const u32x4*)(Vcg + tid * 16);
    *(LAS u32x4*)(lds + N_KS + tid * 16) = kr0; *(LAS u32x4*)(lds + N_VS + tid * 16) = vr0;
    __syncthreads();
    for (int kt = 0; kt < ntc; ++kt) {
        const int sl = kt & 1;
        if (kt + 1 < ntc) { kr0 = *(const u32x4*)(Kcg + (size_t)(kt + 1) * 8192 + tid * 16); vr0 = *(const u32x4*)(Vcg + (size_t)(kt + 1) * 8192 + tid * 16); }
        { f32x16 p0, p1; qk_tile<4>(p0, p1, (lcp)(lds + N_KS + sl * 8192), qr, r32, hi);
          const int nb = 64 * kt + 4 * hi;
#pragma unroll
          for (int r = 0; r < 16; ++r) { const int n = nb + (r & 3) + 8 * (r >> 2); const int e0 = 16 * n + 31 - t, e1 = e0 + 512;
              p0[r] = e0 <= 0 ? __builtin_amdgcn_exp2f(p0[r] + slope2 * (float)e0 - m) * invl : 0.f; p1[r] = e1 <= 0 ? __builtin_amdgcn_exp2f(p1[r] + slope2 * (float)e1 - m) * invl : 0.f; }
          LAS float* ir = imp + qrow * IMPS + 16 * kt + hi;
#pragma unroll
          for (int rg = 0; rg < 4; ++rg) {
              const float A0 = (p0[4 * rg] + p0[4 * rg + 1]) + (p0[4 * rg + 2] + p0[4 * rg + 3]), A1 = (p1[4 * rg] + p1[4 * rg + 1]) + (p1[4 * rg + 2] + p1[4 * rg + 3]);
              __hip_atomic_fetch_add(ir + 2 * rg, A0, __ATOMIC_RELAXED, __HIP_MEMORY_SCOPE_WORKGROUP); __hip_atomic_fetch_add(ir + 2 * rg + 1, p0[4 * rg + 3], __ATOMIC_RELAXED, __HIP_MEMORY_SCOPE_WORKGROUP);
              __hip_atomic_fetch_add(ir + 8 + 2 * rg, A1, __ATOMIC_RELAXED, __HIP_MEMORY_SCOPE_WORKGROUP); __hip_atomic_fetch_add(ir + 8 + 2 * rg + 1, p1[4 * rg + 3], __ATOMIC_RELAXED, __HIP_MEMORY_SCOPE_WORKGROUP); }
          u32x4 pa[4]; pack_p(pa, p0, p1);
          pv_tile(o0, o1, (lcp)(lds + N_VS + sl * 8192 + vlane), pa); }
        if (kt + 1 < ntc) { *(LAS u32x4*)(lds + N_KS + (sl ^ 1) * 8192 + tid * 16) = kr0; *(LAS u32x4*)(lds + N_VS + (sl ^ 1) * 8192 + tid * 16) = vr0; }
        __syncthreads();
    }
    acc_lds<true>(accL, o0, o1, gc, wsf, r32, hi);
#endif
#ifndef NSA_SKIP_TOPK
    {
        const int q = tid >> 3, sub = tid & 7;
        unsigned w[4] = {0u, 0u, 0u, 0u};
        if (ti <= 15) { if (sub == 0) w[0] = (2u << ti) - 1u; }
        else {
            const LAS float* row = imp + q * IMPS;
#pragma unroll 1
            for (int half = 0; half < 2; ++half) {
                float v[8]; int cnt[8];
#pragma unroll
                for (int k = 0; k < 8; ++k) { const int j = 1 + sub + 8 * (k + 8 * half); v[k] = (j <= ti - 2) ? row[j] : -1.0f; cnt[k] = 0; }
#pragma unroll 1
                for (int jp = 1; jp <= ti - 2; ++jp) { const float vp = row[jp];
#pragma unroll
                    for (int k = 0; k < 8; ++k) { const int j = 1 + sub + 8 * (k + 8 * half); cnt[k] += (vp > v[k] || (vp == v[k] && jp < j)) ? 1 : 0; } }
#pragma unroll
                for (int k = 0; k < 8; ++k) { const int j = 1 + sub + 8 * (k + 8 * half); if (j <= ti - 2 && cnt[k] < 13) setbit(w, j); }
            }
            if (sub == 0) { w[0] |= 1u; setbit(w, ti); setbit(w, ti - 1); }
        }
#pragma unroll
        for (int k = 0; k < 4; ++k) if (w[k]) { __hip_atomic_fetch_or(selw + q * 4 + k, w[k], __ATOMIC_RELAXED, __HIP_MEMORY_SCOPE_WORKGROUP); __hip_atomic_fetch_or(uni + k, w[k], __ATOMIC_RELAXED, __HIP_MEMORY_SCOPE_WORKGROUP); }
    }
#endif
    __syncthreads();
    if (tid == 0) { int nb = 0;
        for (int k = 0; k < 4; ++k) { unsigned u = uni[k]; while (u) { const int bit = __builtin_ctz(u); u &= u - 1u; blist[nb++] = (unsigned)(32 * k + bit); } }
        uni[4] = (unsigned)nb; }
    __syncthreads();
    const int nsel = (int)uni[4];
    unsigned sw[4];
#pragma unroll
    for (int k = 0; k < 4; ++k) sw[k] = selw[qrow * 4 + k];
#ifndef NSA_SKIP_SEL
    {
        const char* Kg = (const char*)(T.Ksel + (size_t)bg * 128 * 4096); const char* Vg = (const char*)(T.Vsel + (size_t)bg * 128 * 4096);
        m = -1e30f; l = 0.f; o0 = f32x16{}; o1 = f32x16{};
        int j = (int)blist[0];
        kr0 = *(const u32x4*)(Kg + (size_t)j * 8192 + tid * 16); vr0 = *(const u32x4*)(Vg + (size_t)j * 8192 + tid * 16);
        *(LAS u32x4*)(lds + N_KS + tid * 16) = kr0; *(LAS u32x4*)(lds + N_VS + tid * 16) = vr0;
        __syncthreads();
        for (int k = 0; k < nsel; ++k) {
            const int sl = k & 1; int jn = 0;
            if (k + 1 < nsel) { jn = (int)blist[k + 1]; kr0 = *(const u32x4*)(Kg + (size_t)jn * 8192 + tid * 16); vr0 = *(const u32x4*)(Vg + (size_t)jn * 8192 + tid * 16); }
            { f32x16 p0, p1; qk_tile<4>(p0, p1, (lcp)(lds + N_KS + sl * 8192), qr, r32, hi);
              const int jw = j >> 5; const unsigned swj = jw == 0 ? sw[0] : jw == 1 ? sw[1] : jw == 2 ? sw[2] : sw[3]; const bool mine = (swj >> (j & 31)) & 1u; const int pb = 64 * j + 4 * hi - t;
#pragma unroll
              for (int r = 0; r < 16; ++r) { const int e0 = pb + (r & 3) + 8 * (r >> 2), e1 = e0 + 32;
                  p0[r] = (mine && e0 <= 0) ? p0[r] + slope2 * (float)e0 : -INFINITY; p1[r] = (mine && e1 <= 0) ? p1[r] + slope2 * (float)e1 : -INFINITY; }
              softmax_pv(p0, p1, m, l, o0, o1, (lcp)(lds + N_VS + sl * 8192 + vlane), wsf, r32, hi); }
            if (k + 1 < nsel) { *(LAS u32x4*)(lds + N_KS + (sl ^ 1) * 8192 + tid * 16) = kr0; *(LAS u32x4*)(lds + N_VS + (sl ^ 1) * 8192 + tid * 16) = vr0; }
            j = jn;
            __syncthreads();
        }
        const float lt = xsum(l); acc_lds<false>(accL, o0, o1, lt > 0.f ? gs / lt : 0.f, wsf, r32, hi);
    }
#endif
#ifndef NSA_SKIP_WIN
    {
        const char* Kg = (const char*)(T.Kwin + (size_t)bg * 128 * 4096); const char* Vg = (const char*)(T.Vwin + (size_t)bg * 128 * 4096);
        m = -1e30f; l = 0.f; o0 = f32x16{}; o1 = f32x16{};
        const int j0 = ti >= 8 ? ti - 8 : 0, nw = ti - j0 + 1;
        kr0 = *(const u32x4*)(Kg + (size_t)j0 * 8192 + tid * 16); vr0 = *(const u32x4*)(Vg + (size_t)j0 * 8192 + tid * 16);
        *(LAS u32x4*)(lds + N_KS + tid * 16) = kr0; *(LAS u32x4*)(lds + N_VS + tid * 16) = vr0;
        __syncthreads();
        for (int k = 0; k < nw; ++k) {
            const int sl = k & 1, j = j0 + k;
            if (k + 1 < nw) { kr0 = *(const u32x4*)(Kg + (size_t)(j + 1) * 8192 + tid * 16); vr0 = *(const u32x4*)(Vg + (size_t)(j + 1) * 8192 + tid * 16); }
            { f32x16 p0, p1; qk_tile<4>(p0, p1, (lcp)(lds + N_KS + sl * 8192), qr, r32, hi);
              const int pb = 64 * j + 4 * hi - t;
#pragma unroll
              for (int r = 0; r < 16; ++r) { const int e0 = pb + (r & 3) + 8 * (r >> 2), e1 = e0 + 32;
                  p0[r] = (e0 <= 0 && e0 > -512) ? p0[r] + slope2 * (float)e0 : -INFINITY; p1[r] = (e1 <= 0 && e1 > -512) ? p1[r] + slope2 * (float)e1 : -INFINITY; }
              softmax_pv(p0, p1, m, l, o0, o1, (lcp)(lds + N_VS + sl * 8192 + vlane), wsf, r32, hi); }
            if (k + 1 < nw) { *(LAS u32x4*)(lds + N_KS + (sl ^ 1) * 8192 + tid * 16) = kr0; *(LAS u32x4*)(lds + N_VS + (sl ^ 1) * 8192 + tid * 16) = vr0; }
            __syncthreads();
        }
        const float lt = xsum(l); acc_lds<false>(accL, o0, o1, lt > 0.f ? gw / lt : 0.f, wsf, r32, hi);
    }
#endif
    store_acc(accL, T.Oa + ((size_t)b * 8192 + t0 + qh * 32) * 512 + H * 64, 512, lane);
    __syncthreads();
}
}
#define XLAS __attribute__((address_space(3)))
#define XB_TMO      128
#define XB_XCNT(j)  (256  + 64 * (j))
#define XB_XSUB(j)  (1280 + 64 * (j))
#define XB_XGEN(j)  (2304 + 64 * (j))
#define XB_TOP      3328
#define XB_TOPGEN   3392
#define XCD_BAR_WORDS 3456
#define XB_SPIN_CAP (1u << 18)

__device__ __forceinline__ unsigned xb_ld(unsigned* p)              { return __hip_atomic_load(p, __ATOMIC_RELAXED, __HIP_MEMORY_SCOPE_AGENT); }
__device__ __forceinline__ unsigned xb_add(unsigned* p, unsigned v) { return __hip_atomic_fetch_add(p, v, __ATOMIC_RELAXED, __HIP_MEMORY_SCOPE_AGENT); }
__device__ __forceinline__ unsigned xb_xcc_id() { return (unsigned)__builtin_amdgcn_s_getreg((3 << 11) | 20) & 0xFu; }
#define XB_SPIN(cond, bar) do { unsigned _sp = 0; while (cond) { __builtin_amdgcn_s_sleep(1); \
    if ((++_sp & 255u) == 0u) { if (xb_ld(&(bar)[XB_TMO])) break; if (_sp > XB_SPIN_CAP) { atomicAdd(&(bar)[XB_TMO], 1u); break; } } } } while (0)

struct XcdBarrier {
    unsigned* bar; unsigned x;
    volatile XLAS unsigned* st;
};

__device__ __forceinline__ XcdBarrier xcd_barrier_post(unsigned* bar, volatile XLAS unsigned* st) {
    XcdBarrier b; b.bar = bar; b.x = xb_xcc_id(); b.st = st;
    if (threadIdx.x == 0) (void)xb_add(&bar[XB_XCNT(b.x)], 1u);
    return b;
}
__device__ __forceinline__ void xcd_barrier_complete(unsigned* bar, unsigned x, unsigned& nloc, unsigned& nx) {
    const unsigned G = gridDim.x * gridDim.y * gridDim.z;
    unsigned sum, cnt, mine, sp = 0u;
    for (;;) {
        sum = 0u; cnt = 0u; mine = 0u;
#pragma unroll
        for (unsigned j = 0; j < 16; ++j) { const unsigned c = xb_ld(&bar[XB_XCNT(j)]); sum += c; cnt += (c > 0u) ? 1u : 0u; mine = (j == x) ? c : mine; }
        if (sum == G) break;
        __builtin_amdgcn_s_sleep(1);
        if ((++sp & 255u) == 0u) { if (xb_ld(&bar[XB_TMO])) break; if (sp > XB_SPIN_CAP) { atomicAdd(&bar[XB_TMO], 1u); break; } }
    }
    nloc = mine > 0u ? mine : 1u; nx = cnt > 0u ? cnt : 1u;
}

__device__ __forceinline__ void xcd_barrier(const XcdBarrier& b) {
    asm volatile("s_waitcnt vmcnt(0)" ::: "memory");
    __syncthreads();
    if (threadIdx.x == 0) {
        unsigned* bar = b.bar;
        __builtin_amdgcn_s_waitcnt(0);
        unsigned nloc = b.st[0], nx = b.st[1];
        if (nloc == 0u) { xcd_barrier_complete(bar, b.x, nloc, nx); b.st[0] = nloc; b.st[1] = nx; }
        const unsigned old = xb_add(&bar[XB_XSUB(b.x)], 1u);
        const unsigned gen = old / nloc;
        if (old + 1u == (gen + 1u) * nloc) {
            __builtin_amdgcn_fence(__ATOMIC_RELEASE, "agent");
            asm volatile("s_waitcnt vmcnt(0)" ::: "memory");
            const unsigned og = xb_add(&bar[XB_TOP], 1u);
            const unsigned tg = og / nx;
            if (og + 1u == (tg + 1u) * nx) xb_add(&bar[XB_TOPGEN], 1u);
            else XB_SPIN(xb_ld(&bar[XB_TOPGEN]) == tg, bar);
            __builtin_amdgcn_fence(__ATOMIC_ACQUIRE, "agent");
            xb_add(&bar[XB_XGEN(b.x)], 1u);
            asm volatile("s_waitcnt vmcnt(0)" ::: "memory");
        } else {
            XB_SPIN(xb_ld(&bar[XB_XGEN(b.x)]) == gen, bar);
            __builtin_amdgcn_fence(__ATOMIC_ACQUIRE, "agent");
            asm volatile("s_waitcnt vmcnt(0)" ::: "memory");
        }
    }
    __syncthreads();
}
#define GLAS __attribute__((address_space(3)))
typedef unsigned short bf16_t;
typedef float f32x4 __attribute__((ext_vector_type(4)));
typedef unsigned u32x4 __attribute__((ext_vector_type(4)));
constexpr int NT_TOK = 16384, SEQ = 8192, DM = 1024, DFF = 2816, NTHREADS = 512, NWAVES = 8;
struct KArgs { const float* in[26]; float* out; unsigned char* ws; };
struct ArgRef { unsigned char* ws;
    __device__ __forceinline__ const float* in_(int i) const { const __attribute__((address_space(4))) KArgs* p = (const __attribute__((address_space(4))) KArgs*)__builtin_amdgcn_kernarg_segment_ptr(); asm volatile("" : "+s"(p)); return p->in[i]; }
};

__device__ __forceinline__ unsigned f2bf_rne(float f) { unsigned u = __builtin_bit_cast(unsigned, f); return (u + 0x7fffu + ((u >> 16) & 1u)) >> 16; }
__device__ __forceinline__ unsigned pk2(float lo, float hi) { return f2bf_rne(lo) | (f2bf_rne(hi) << 16); }

struct WSrc { const float* p; int ld; };
template <class Map> __device__ __forceinline__ void conv_weight(GLAS float* scr, int lane, int gw, int ngw, int K, int N, bf16_t* WT, const float* kscale, Map map) {
    asm volatile("" : "+v"(lane));
    const int nblk = N / 32, nitems = (K / 64) * nblk;
    for (int it = gw; it < nitems; it += ngw) {
        const int kb = it / nblk, nb = it % nblk, k0 = 64 * kb, n0 = 32 * nb;
        const WSrc s = map(n0 + (lane & 31));
#pragma unroll 8
        for (int i = 0; i < 32; ++i) { const int kk = 2 * i + (lane >> 5); float v = s.p ? s.p[(size_t)(k0 + kk) * s.ld] : 0.f; if (kscale) v *= kscale[k0 + kk]; scr[kk * 33 + (lane & 31)] = v; }
        asm volatile("s_waitcnt lgkmcnt(0)" ::: "memory");
        const int c = lane & 7;
#pragma unroll
        for (int j = 0; j < 4; ++j) { const int n = (lane >> 3) + 8 * j; const GLAS float* sp = scr + (8 * c) * 33 + n;
            u32x4 o; o.x = pk2(sp[0 * 33], sp[1 * 33]); o.y = pk2(sp[2 * 33], sp[3 * 33]); o.z = pk2(sp[4 * 33], sp[5 * 33]); o.w = pk2(sp[6 * 33], sp[7 * 33]);
            *(u32x4*)(WT + (size_t)(n0 + n) * K + k0 + 8 * c) = o; }
        asm volatile("s_waitcnt lgkmcnt(0)" ::: "memory");
    }
}
__device__ __forceinline__ void convert_layer(const ArgRef& A, int l, GLAS unsigned char* lds, int lane, int wave, int gw, int ngw) {
    GLAS float* scr = (GLAS float*)(lds + wave * 8448);
    unsigned char* ws = A.ws;
    { const float* G = A.in_(4) + (size_t)l * 1024 * 2816; const float* U = A.in_(5) + (size_t)l * 1024 * 2816;
      conv_weight(scr, lane, gw, ngw, 1024, 5632, (bf16_t*)(ws + W_GU1), nullptr, [=](int n) { const int tl = n >> 8, r = n & 255; const uintptr_t gp = (uintptr_t)G, up = (uintptr_t)U; return WSrc{(const float*)(gp + (up - gp) * (uintptr_t)(r >> 7)) + tl * 128 + (r & 127), 2816}; }); }
    { const float* Dn = A.in_(6) + (size_t)l * 2816 * 1024; conv_weight(scr, lane, gw, ngw, 2816, 1024, (bf16_t*)(ws + W_D1), nullptr, [=](int n) { return WSrc{Dn + n, 1024}; }); }
    { const float* G = A.in_(7) + (size_t)l * 1024 * 2816; const float* U = A.in_(8) + (size_t)l * 1024 * 2816;
      conv_weight(scr, lane, gw, ngw, 1024, 5632, (bf16_t*)(ws + W_GU2), nullptr, [=](int n) { const int tl = n >> 8, r = n & 255; const uintptr_t gp = (uintptr_t)G, up = (uintptr_t)U; return WSrc{(const float*)(gp + (up - gp) * (uintptr_t)(r >> 7)) + tl * 128 + (r & 127), 2816}; }); }
    { const float* Dn = A.in_(9) + (size_t)l * 2816 * 1024; conv_weight(scr, lane, gw, ngw, 2816, 1024, (bf16_t*)(ws + W_D2), nullptr, [=](int n) { return WSrc{Dn + n, 1024}; }); }
    { const float* Wi = A.in_(10) + (size_t)l * 1024 * 4024;
      conv_weight(scr, lane, gw, ngw, 1024, 4096, (bf16_t*)(ws + W_IN), nullptr, [=](int n) {
          int src;
          if (n < 1280) src = n;
          else if (n < 1536) src = 1688 + (n - 1280);
          else if (n < 1792) src = 1304 + (n - 1536);
          else if (n < 2048) { const int r = n - 1792;
              if (r < 128) src = 1304 + 256 + r;
              else if (r < 160) { const int p = r - 128; src = 1944 + ((p & 1) ? 16 + (p >> 1) : (p >> 1)); }
              else if (r < 184) src = 1280 + (r - 160);
              else src = -1; }
          else src = 1976 + (n - 2048);
          return WSrc{src >= 0 ? Wi + src : nullptr, 4024}; }); }
    { const float* Wq = A.in_(18) + (size_t)l * 384 * 768;
      conv_weight(scr, lane, gw, ngw, 384, 768, (bf16_t*)(ws + W_UQ), A.in_(17) + (size_t)l * 384, [=](int n) { const int h = n / 96, p = n % 96; int src = h * 96 + p;
          if (p >= 64) { const int pp = p - 64; src = h * 96 + 64 + ((pp & 1) ? 16 + (pp >> 1) : (pp >> 1)); }
          return WSrc{Wq + src, 768}; }); }
    { const float* Wk = A.in_(20) + (size_t)l * 256 * 512; const float* Wv = A.in_(21) + (size_t)l * 256 * 512;
      conv_weight(scr, lane, gw, ngw, 256, 1024, (bf16_t*)(ws + W_UKV), A.in_(19) + (size_t)l * 256, [=](int n) { const uintptr_t kp = (uintptr_t)Wk, vp = (uintptr_t)Wv; return WSrc{(const float*)(kp + (vp - kp) * (uintptr_t)(n >> 9)) + (n & 511), 512}; }); }
    { const float* Wa = A.in_(22) + (size_t)l * 512 * 1024; conv_weight(scr, lane, gw, ngw, 512, 1024, (bf16_t*)(ws + W_BA), nullptr, [=](int n) { return WSrc{Wa + n, 1024}; }); }
    { const float* Wb = A.in_(23) + (size_t)l * 512 * 1024; conv_weight(scr, lane, gw, ngw, 512, 1024, (bf16_t*)(ws + W_BB), nullptr, [=](int n) { return WSrc{Wb + n, 1024}; }); }
    { const float* Wo = A.in_(24) + (size_t)l * 1024 * 1024; conv_weight(scr, lane, gw, ngw, 1024, 1024, (bf16_t*)(ws + W_OUT), nullptr, [=](int n) { return WSrc{Wo + n, 1024}; }); }
    { const float* W1 = A.in_(11) + (size_t)l * 2048 * 64; conv_weight(scr, lane, gw, ngw, 2048, 64, (bf16_t*)(ws + W_1K), nullptr, [=](int n) { return WSrc{W1 + n, 64}; }); }
    { const float* W1 = A.in_(14) + (size_t)l * 2048 * 64; conv_weight(scr, lane, gw, ngw, 2048, 64, (bf16_t*)(ws + W_1V), nullptr, [=](int n) { return WSrc{W1 + n, 64}; }); }
}
__device__ __forceinline__ void norm_phase(const float* x, bf16_t* xn, const float* sh, const float* sc, int lane, int gw, int ngw) {
    asm volatile("" : "+v"(lane));
    for (int row = gw; row < NT_TOK; row += ngw) {
        const f32x4* xr = (const f32x4*)(x + (size_t)row * DM) + lane; const int b = row >> 13;
        f32x4 v[4]; float s = 0.f;
#pragma unroll
        for (int j = 0; j < 4; ++j) { v[j] = xr[64 * j]; s += (v[j].x * v[j].x + v[j].y * v[j].y) + (v[j].z * v[j].z + v[j].w * v[j].w); }
        const float rstd = 1.0f / sqrtf(wave_sum(s) * (1.0f / DM) + 1e-6f);
        unsigned long long* o8 = (unsigned long long*)(xn + (size_t)row * DM) + lane;
#pragma unroll
        for (int j = 0; j < 4; ++j) { const f32x4 a = *((const f32x4*)(sc + (size_t)b * 9216) + lane + 64 * j), c = *((const f32x4*)(sh + (size_t)b * 9216) + lane + 64 * j);
            const f32x4 y = v[j] * rstd * (a + 1.0f) + c;
            o8[64 * j] = (unsigned long long)pk2(y.x, y.y) | ((unsigned long long)pk2(y.z, y.w) << 32); }
    }
}
__device__ __forceinline__ void final_norm_phase(float* x, const float* wn, int lane, int gw, int ngw) {
    asm volatile("" : "+v"(lane));
    for (int row = gw; row < NT_TOK; row += ngw) {
        f32x4* xr = (f32x4*)(x + (size_t)row * DM) + lane;
        f32x4 v[4]; float s = 0.f;
#pragma unroll
        for (int j = 0; j < 4; ++j) { v[j] = xr[64 * j]; s += (v[j].x * v[j].x + v[j].y * v[j].y) + (v[j].z * v[j].z + v[j].w * v[j].w); }
        const float rstd = 1.0f / sqrtf(wave_sum(s) * (1.0f / DM) + 1e-6f);
#pragma unroll
        for (int j = 0; j < 4; ++j) { const f32x4 w = *((const f32x4*)wn + lane + 64 * j); xr[64 * j] = v[j] * rstd * w; }
    }
}
__device__ __forceinline__ void adaln_phase(const ArgRef& A, GLAS unsigned char* lds, int tid, int lane, int wave, int blk, int nblk) {
    asm volatile("" : "+v"(tid), "+v"(lane));
    GLAS float* ca = (GLAS float*)lds;
    GLAS float* red = (GLAS float*)(lds + 8192);
    for (int i = tid; i < 2048; i += NTHREADS) { const float c = A.in_(1)[i]; ca[i] = c / (1.0f + __expf(-c)); }
    __syncthreads();
    float* mod = (float*)(A.ws + WS_MOD);
    for (int u = blk; u < 288; u += nblk) {
        const int l = u / 144, n0 = (u % 144) * 64;
        const float* W = A.in_(2) + (size_t)l * 1024 * 9216 + n0 + lane;
        float a0 = 0.f, a1 = 0.f;
        const int kb = wave * 128;
#pragma unroll 8
        for (int k = 0; k < 128; ++k) { const float w = W[(size_t)(kb + k) * 9216]; a0 += ca[kb + k] * w; a1 += ca[1024 + kb + k] * w; }
        red[(wave * 2 + 0) * 64 + lane] = a0; red[(wave * 2 + 1) * 64 + lane] = a1;
        __syncthreads();
        if (tid < 128) { const int b = tid >> 6, n = tid & 63; float s = A.in_(3)[(size_t)l * 9216 + n0 + n];
#pragma unroll
            for (int w = 0; w < 8; ++w) s += red[(w * 2 + b) * 64 + n];
            mod[((size_t)l * 2 + b) * 9216 + n0 + n] = s; }
        __syncthreads();
    }
}
__device__ __forceinline__ void rope_table_phase(float* cs, int gtid, int ngt) {
    for (int e = gtid; e < SEQ * 16; e += ngt) { const int t = e >> 4, i = e & 15;
        const float inv = powf(10000.0f, -(float)i / 16.0f); const float ang = (float)t * inv;
        const double rev = (double)ang * 0.15915494309189535; const double fr = rev - __builtin_rint(rev);
        cs[t * 32 + i] = __builtin_amdgcn_cosf((float)fr); cs[t * 32 + 16 + i] = __builtin_amdgcn_sinf((float)fr); }
}
__device__ __forceinline__ void cbias_phase(const ArgRef& A, GLAS unsigned char* lds, int tid, int blk) {
    GLAS float* red = (GLAS float*)(lds + 16384);
    if (blk < 4) { const int l = blk >> 1, kv = blk & 1; const float* pe = A.in_(kv ? 16 : 13) + (size_t)l * 2048; const float* w1 = A.in_(kv ? 14 : 11) + (size_t)l * 2048 * 64;
        const int n = tid & 63, part = tid >> 6; float s = 0.f;
        for (int j = part * 256; j < part * 256 + 256; ++j) s += pe[j] * w1[(size_t)j * 64 + n];
        red[part * 64 + n] = s;
        __syncthreads();
        if (tid < 64) { float t = 0.f;
#pragma unroll
            for (int p = 0; p < 8; ++p) t += red[p * 64 + tid];
            ((float*)(A.ws + WS_CBIAS))[(l * 2 + kv) * 64 + tid] = t; }
        __syncthreads();
    }
}
__device__ __forceinline__ void compress_phase(const ArgRef& A, int l, GLAS unsigned char* lds, int tid, int lane, int wave, int ubeg, int ustep) {
    asm volatile("" : "+v"(tid), "+v"(lane));
    typedef short bf16x8 __attribute__((ext_vector_type(8))); typedef float f32x16 __attribute__((ext_vector_type(16)));
    GLAS float* red = (GLAS float*)lds;
    GLAS float* c1 = (GLAS float*)(lds + 65536);
    const int r32 = lane & 31, hi = lane >> 5;
    for (int u = ubeg; u < 128; u += ustep) {
        const int kv = u >> 6, bg = (u >> 4) & 3, rb = u & 15, i0 = rb * 32;
        const bf16_t* src = (const bf16_t*)(A.ws + (kv ? WS_VCF : WS_KCF)) + (size_t)bg * SEQ * 64;
        const bf16_t* w1t = (const bf16_t*)(A.ws + (kv ? W_1V : W_1K));
        const float* w2 = A.in_(kv ? 15 : 12) + (size_t)l * 4096;
        const float* cb = (const float*)(A.ws + WS_CBIAS) + (l * 2 + kv) * 64;
        f32x16 a0 = f32x16{}, a1 = f32x16{};
        const bf16_t* ap = src + (size_t)(i0 + r32) * 1024 + wave * 256 + hi * 8;
        const bf16_t* bp = w1t + (size_t)r32 * 2048 + wave * 256 + hi * 8;
#pragma unroll 4
        for (int ks = 0; ks < 16; ++ks) {
            const bf16x8 af = *(const bf16x8*)(ap + ks * 16), b0 = *(const bf16x8*)(bp + ks * 16), b1 = *(const bf16x8*)(bp + 32 * 2048 + ks * 16);
            a0 = __builtin_amdgcn_mfma_f32_32x32x16_bf16(af, b0, a0, 0, 0, 0);
            a1 = __builtin_amdgcn_mfma_f32_32x32x16_bf16(af, b1, a1, 0, 0, 0); }
#pragma unroll
        for (int r = 0; r < 16; ++r) { red[wave * 2048 + r * 64 + lane] = a0[r]; red[wave * 2048 + (16 + r) * 64 + lane] = a1[r]; }
        __syncthreads();
#pragma unroll
        for (int j = 0; j < 4; ++j) { const int e = tid + 512 * j; float s = 0.f;
#pragma unroll
            for (int w = 0; w < 8; ++w) s += red[w * 2048 + e];
            const int nt = e >> 10, r = (e >> 6) & 15, ln = e & 63; const int i = (r & 3) + 8 * (r >> 2) + 4 * (ln >> 5), n = 32 * nt + (ln & 31);
            const float xv = s + cb[n]; const float z = 0.7978845608028654f * (xv + 0.044715f * xv * xv * xv);
            const float th = 1.0f - 2.0f * __builtin_amdgcn_rcpf(__builtin_amdgcn_exp2f(2.885390081777927f * z) + 1.0f);
            c1[i * 65 + n] = 0.5f * xv * (1.0f + th); }
        __syncthreads();
        { const int i = tid >> 4, n2 = (tid & 15) * 4; f32x4 o = (f32x4){0.f, 0.f, 0.f, 0.f};
#pragma unroll 8
          for (int k = 0; k < 64; ++k) { const float c = c1[i * 65 + k]; const f32x4 w = *(const f32x4*)(w2 + k * 64 + n2); o += w * c; }
          const int nc = i0 + i; if (nc == 511) o = (f32x4){0.f, 0.f, 0.f, 0.f};
          const size_t tb = (size_t)bg * 8 + (nc >> 6); const int key = nc & 63;
          const unsigned long long pk = (unsigned long long)pk2(o.x, o.y) | ((unsigned long long)pk2(o.z, o.w) << 32);
          if (kv == 0) *(unsigned long long*)((bf16_t*)(A.ws + WS_KC) + (tb * 8 + (n2 >> 3)) * 512 + key * 8 + (n2 & 7)) = pk;
          else *(unsigned long long*)((bf16_t*)(A.ws + WS_VC) + tb * 4096 + (n2 >> 5) * 2048 + key * 32 + (n2 & 31)) = pk; }
        __syncthreads();
    }
}

template <int NC> __device__ __forceinline__ void rstd_table(const bf16_t* X, int row0, GLAS float* tab, float scale, int lane, int wave) {
    for (int r = 0; r < 32; ++r) { const int row = wave * 32 + r; float s = 0.f;
        if (lane < NC / 8) { const u32x4 v = *(const u32x4*)(X + (size_t)(row0 + row) * NC + lane * 8);
            const unsigned w4[4] = {v.x, v.y, v.z, v.w};
#pragma unroll
            for (int i = 0; i < 4; ++i) { const float a = __uint_as_float(w4[i] << 16), b = __uint_as_float(w4[i] & 0xffff0000u); s += a * a + b * b; } }
        s = wave_sum(s);
        if (lane == 0) tab[row] = scale * __builtin_amdgcn_rsqf(s * (1.0f / NC) + 1e-6f); }
}
__device__ __forceinline__ void dump_bf16(float* out, const bf16_t* src, int nslab, int gtid, int ngt) {
    for (int i = gtid; i < NT_TOK * DM; i += ngt) { float s = 0.f; for (int k = 0; k < nslab; ++k) if (k < 3 || i < 14 * 1024 * 1024) s += __uint_as_float(((unsigned)src[(size_t)k * NT_TOK * DM + i]) << 16); out[i] = s; }
}
#ifndef WIN_ALIGN
#define WIN_ALIGN true
#define WIN_SP2 true
#endif
#ifndef STOPAT
#define STOPAT 99
#endif
#ifndef PHMASK
#define PHMASK 0xffffffffu
#endif
#define PH(k) ((PHMASK >> (k)) & 1u)
#ifndef USE_CG
#define GRIDBAR() xcd_barrier(xbar)
#else
#define GRIDBAR() grid.sync()
#endif
constexpr int LDS_BYTES = 147456;
constexpr size_t WS_BAR = 384 * 1024, BAR_BYTES = 16384;
constexpr int LDS_BARST = 131072 + 4096;
__global__ void __launch_bounds__(NTHREADS, 2) hybrid_fwd(KArgs KA) {
    extern __shared__ __attribute__((aligned(16))) unsigned char lds_raw[];
    GLAS unsigned char* lds = (GLAS unsigned char*)lds_raw;
    cg::grid_group grid = cg::this_grid();
    if (threadIdx.x < 8) ((GLAS unsigned*)(lds + LDS_BARST))[threadIdx.x] = 0u;
    __syncthreads();
    XcdBarrier xbar = xcd_barrier_post((unsigned*)(KA.ws + WS_BAR), (volatile GLAS unsigned*)(lds + LDS_BARST));
    const int wave = __builtin_amdgcn_readfirstlane(threadIdx.x >> 6);
#define MYTID() (wave * 64 + opaque_lane())
    int tid = MYTID(), lane = tid & 63; asm volatile("" : "+v"(tid), "+v"(lane));
    const int G = gridDim.x, blk0 = blockIdx.x; int blk = blk0;
    const int vcu = (G % 8 == 0) ? (blk % 8) * (G / 8) + blk / 8 : blk;
    const int gw = blk * NWAVES + wave, ngw = G * NWAVES;
    ArgRef A; A.ws = KA.ws; unsigned char* const ws0 = KA.ws; unsigned char* ws = ws0;
#define PHASE_BEGIN() do { ws = ws0; blk = blk0; asm volatile("" : "+s"(ws), "+s"(blk)); A.ws = ws; tid = MYTID(); lane = tid & 63; asm volatile("" : "+v"(tid), "+v"(lane)); } while (0)
    float* mod = (float*)(ws + WS_MOD);
    float* xres = KA.out;

    if (PH(0)) adaln_phase(A, lds, tid, lane, wave, blk, G);
    if (PH(1)) rope_table_phase((float*)(ws + WS_CS), blk * NTHREADS + tid, G * NTHREADS);
    if (PH(2)) convert_layer(A, 0, lds, lane, wave, gw, ngw);
    __syncthreads();
    if (PH(3)) cbias_phase(A, lds, tid, blk);
    grid.sync();

    for (int l = 0; l < 2; ++l) {
        PHASE_BEGIN();
        const float* ml = mod + (size_t)l * 2 * 9216;
        const float* xin = (l == 0) ? A.in_(0) : xres;
        if (PH(2) && l == 1) { convert_layer(A, 1, lds, lane, wave, gw, ngw); }
        if (PH(4)) norm_phase(xin, (bf16_t*)(ws + WS_XN), ml + 0 * 1024, ml + 1 * 1024, lane, gw, ngw);
        GRIDBAR();
        PHASE_BEGIN();
        if (PH(5)) { pg8::Gemm g{(const bf16_t*)(ws + WS_XN), (const bf16_t*)(ws + W_GU1), NT_TOK, 5632, 1024}; pg8::StaticOrder S; S.init(NT_TOK, 5632, G, blk);
          pg8::EpiSwiGLU E{ws};
          pg8::gemm_phase<pg8::EpiSwiGLU, pg8::StaticOrder, true, true>(lds, g, S, E, wave); }
        GRIDBAR();
        PHASE_BEGIN();
        if (STOPAT == 2) { dump_bf16(xres, (const bf16_t*)(ws + WS_C), 4, blk * NTHREADS + tid, G * NTHREADS); return; }
        if (PH(6)) { pg8::Gemm g{(const bf16_t*)(ws + WS_C), (const bf16_t*)(ws + W_D1), NT_TOK, 1024, 2816}; pg8::StaticOrder S; S.init(NT_TOK, 1024, G, blk);
          pg8::EpiResid E{xin, xres, ml + 2 * 1024, 0.5f};
          pg8::gemm_phase<pg8::EpiResid, pg8::StaticOrder, true, true>(lds, g, S, E, wave); }
        GRIDBAR();
        PHASE_BEGIN();
        if (STOPAT == 3) {  return; }
        if (PH(4)) norm_phase(xres, (bf16_t*)(ws + WS_XN), ml + 3 * 1024, ml + 4 * 1024, lane, gw, ngw);
#ifdef SENTINEL
        { unsigned* gp = (unsigned*)(ws + WS_GM); for (int i = blk * NTHREADS + tid; i < 16 * 1024 * 1024; i += G * NTHREADS) gp[i] = 0x447a447au; }
#endif
        GRIDBAR();
        PHASE_BEGIN();
        if (PH(7)) { pg8::Gemm g{(const bf16_t*)(ws + WS_XN), (const bf16_t*)(ws + W_IN), NT_TOK, 4096, 1024}; pg8::StaticOrder S; S.init(NT_TOK, 4096, G, blk);
          pg8::EpiWin E{ws};
          pg8::gemm_phase<pg8::EpiWin, pg8::StaticOrder, WIN_ALIGN, WIN_SP2>(lds, g, S, E, wave); }
        GRIDBAR();
        PHASE_BEGIN();
#ifndef DUMP_OFF
#define DUMP_OFF 84
#define DUMP_SLABS 4
#endif
        if (STOPAT == 5) { dump_bf16(xres, (const bf16_t*)(ws + (size_t)DUMP_OFF * MiB), DUMP_SLABS, blk * NTHREADS + tid, G * NTHREADS); return; }
        if (PH(8)) { pg8::Gemm g{(const bf16_t*)(ws + WS_CQ), (const bf16_t*)(ws + W_UQ), NT_TOK, 768, 384}; pg8::StaticOrder S; S.init(NT_TOK, 768, G, blk);
          { pg8::Unit u0; if (S.next(0, u0)) rstd_table<384>((const bf16_t*)(ws + WS_CQ), u0.pm * 256, (GLAS float*)(lds + 131072), 0.10206207261596577f * 1.4426950408889634f, lane, wave); }
          __syncthreads();
          pg8::EpiQproj E{ws, (const GLAS float*)(lds + 131072)};
          pg8::gemm_phase<pg8::EpiQproj, pg8::StaticOrder, true, true>(lds, g, S, E, wave); }
        if (PH(9)) { pg8::Gemm g{(const bf16_t*)(ws + WS_CKV), (const bf16_t*)(ws + W_UKV), NT_TOK, 1024, 256}; pg8::StaticOrder S; S.init(NT_TOK, 1024, G, blk);
          PHASE_BEGIN();
          { pg8::Unit u0; if (S.next(0, u0)) rstd_table<256>((const bf16_t*)(ws + WS_CKV), u0.pm * 256, (GLAS float*)(lds + 131072 + 1024), 1.0f, lane, wave); }
          __syncthreads();
          pg8::EpiKVproj E{ws, (const GLAS float*)(lds + 131072 + 1024)};
          pg8::gemm_phase<pg8::EpiKVproj, pg8::StaticOrder, true, true>(lds, g, S, E, wave); }
        __syncthreads();
        PHASE_BEGIN();
        if (PH(10)) compress_phase(A, l, lds, tid, lane, wave, (G - 1 - blk), G);
        GRIDBAR();
        PHASE_BEGIN();
        if (STOPAT == 6) { dump_bf16(xres, (const bf16_t*)(ws + WS_QM), 2, blk * NTHREADS + tid, G * NTHREADS); return; }
        { att::NsaT NT{(const bf16_t*)(ws + WS_QN), (const bf16_t*)(ws + WS_KC), (const bf16_t*)(ws + WS_VC), (const bf16_t*)(ws + WS_KSEL), (const bf16_t*)(ws + WS_VSEL),
                       (const bf16_t*)(ws + WS_KWIN), (const bf16_t*)(ws + WS_VWIN), (const float*)(ws + WS_GATES), (bf16_t*)(ws + WS_OA)};
          for (int v = vcu; v < 256; v += G) {
              if (PH(11)) { const int bh = v >> 4, s = v & 15;
                att::mla_unit(bh >> 3, bh & 7, 31 - s, (const bf16_t*)(ws + WS_QM), (const bf16_t*)(ws + WS_KM), (const bf16_t*)(ws + WS_VM), (bf16_t*)(ws + WS_OB), (GLAS char*)lds, wave);
                att::mla_unit(bh >> 3, bh & 7, s, (const bf16_t*)(ws + WS_QM), (const bf16_t*)(ws + WS_KM), (const bf16_t*)(ws + WS_VM), (bf16_t*)(ws + WS_OB), (GLAS char*)lds, wave); }
              if (PH(12)) { const int bg = v >> 6, s = v & 63;
                att::nsa_unit(bg >> 1, bg & 1, 127 - s, NT, (GLAS char*)lds, wave);
                att::nsa_unit(bg >> 1, bg & 1, s, NT, (GLAS char*)lds, wave); }
          } }
        GRIDBAR();
        PHASE_BEGIN();
        if (STOPAT == 7) { dump_bf16(xres, (const bf16_t*)(ws + WS_OA), 1, blk * NTHREADS + tid, G * NTHREADS); return; }
        if (PH(13)) { pg8::Gemm g{(const bf16_t*)(ws + WS_OA), (const bf16_t*)(ws + W_BA), NT_TOK, 1024, 512}; pg8::StaticOrder S; S.init(NT_TOK, 1024, G, blk);
          pg8::EpiBranch<0> E{ws};
          pg8::gemm_phase<pg8::EpiBranch<0>, pg8::StaticOrder, true, true>(lds, g, S, E, wave); }
        if (PH(14)) { pg8::Gemm g{(const bf16_t*)(ws + WS_OB), (const bf16_t*)(ws + W_BB), NT_TOK, 1024, 512}; pg8::StaticOrder S; S.init(NT_TOK, 1024, G, blk);
          pg8::EpiBranch<1> E{ws};
          pg8::gemm_phase<pg8::EpiBranch<1>, pg8::StaticOrder, true, true>(lds, g, S, E, wave); }
        GRIDBAR();
        PHASE_BEGIN();
        if (STOPAT == 8) { dump_bf16(xres, (const bf16_t*)(ws + WS_Y), 1, blk * NTHREADS + tid, G * NTHREADS); return; }
        if (PH(15)) { pg8::Gemm g{(const bf16_t*)(ws + WS_Y), (const bf16_t*)(ws + W_OUT), NT_TOK, 1024, 1024}; pg8::StaticOrder S; S.init(NT_TOK, 1024, G, blk);
          pg8::EpiResid E{xres, xres, ml + 5 * 1024, 1.0f};
          pg8::gemm_phase<pg8::EpiResid, pg8::StaticOrder, true, true>(lds, g, S, E, wave); }
        GRIDBAR();
        PHASE_BEGIN();
        if (PH(4)) norm_phase(xres, (bf16_t*)(ws + WS_XN), ml + 6 * 1024, ml + 7 * 1024, lane, gw, ngw);
        GRIDBAR();
        PHASE_BEGIN();
        if (PH(16)) { pg8::Gemm g{(const bf16_t*)(ws + WS_XN), (const bf16_t*)(ws + W_GU2), NT_TOK, 5632, 1024}; pg8::StaticOrder S; S.init(NT_TOK, 5632, G, blk);
          pg8::EpiSwiGLU E{ws};
          pg8::gemm_phase<pg8::EpiSwiGLU, pg8::StaticOrder, true, true>(lds, g, S, E, wave); }
        GRIDBAR();
        PHASE_BEGIN();
        if (PH(17)) { pg8::Gemm g{(const bf16_t*)(ws + WS_C), (const bf16_t*)(ws + W_D2), NT_TOK, 1024, 2816}; pg8::StaticOrder S; S.init(NT_TOK, 1024, G, blk);
          pg8::EpiResid E{xres, xres, ml + 8 * 1024, 0.5f};
          pg8::gemm_phase<pg8::EpiResid, pg8::StaticOrder, true, true>(lds, g, S, E, wave); }
        GRIDBAR();
        PHASE_BEGIN();
    }
    tid = MYTID(); lane = tid & 63; asm volatile("" : "+v"(tid), "+v"(lane));
    if (PH(18)) final_norm_phase(xres, A.in_(25), lane, gw, ngw);
}

extern "C" void kernel_launch(void* const* d_in, const int* in_sizes, int n_in, void* d_out, int out_size, void* d_ws, size_t ws_size, hipStream_t stream) {
    static int grid_blocks = 0;
    if (grid_blocks == 0) {
        if (n_in != 26 || out_size != NT_TOK * DM || ws_size < WS_TOTAL) { fprintf(stderr, "kernel_launch: unexpected problem (n_in %d out %d ws %zu)\n", n_in, out_size, ws_size); grid_blocks = -1; return; }
        int dev = 0, cus = 0, per_cu = 0;
        hipGetDevice(&dev);
        hipDeviceGetAttribute(&cus, hipDeviceAttributeMultiprocessorCount, dev);
        hipFuncSetAttribute((const void*)hybrid_fwd, hipFuncAttributeMaxDynamicSharedMemorySize, LDS_BYTES);
        hipOccupancyMaxActiveBlocksPerMultiprocessor(&per_cu, (const void*)hybrid_fwd, NTHREADS, LDS_BYTES);
        if (per_cu < 1) { fprintf(stderr, "kernel_launch: occupancy query says %d blocks per CU\n", per_cu); per_cu = 1; }
        if (per_cu > 1) per_cu = 1;
        grid_blocks = cus * per_cu;
        (void)hipGetLastError();
    }
    if (grid_blocks < 0) return;
    if (hipMemsetAsync((char*)d_ws + WS_BAR, 0, BAR_BYTES, stream) != hipSuccess) { fprintf(stderr, "kernel_launch: memset failed\n"); return; }
    KArgs a{};
    for (int i = 0; i < 26; ++i) a.in[i] = (const float*)d_in[i];
    a.out = (float*)d_out; a.ws = (unsigned char*)d_ws;
    void* args[] = {&a};
    hipError_t e = hipLaunchCooperativeKernel((const void*)hybrid_fwd, dim3(grid_blocks), dim3(NTHREADS), args, LDS_BYTES, stream);
    if (e != hipSuccess) fprintf(stderr, "cooperative launch failed: %s (grid %d)\n", hipGetErrorString(e), grid_blocks);
}
```

```cpp
#include <hip/hip_runtime.h>
#include <hip/hip_cooperative_groups.h>
#include <cstdio>
#include <cstdint>
namespace cg = cooperative_groups;

constexpr size_t MiB = 1u << 20;
constexpr size_t WS_MOD = 0;
constexpr size_t WS_CBIAS = 256 * 1024;
constexpr size_t WS_ERR = 384 * 1024;
constexpr size_t WS_SSQQ = 512 * 1024;
constexpr size_t WS_SSQKV = 640 * 1024;
constexpr size_t WS_GATES = 1 * MiB;
constexpr size_t WS_CS = 3 * MiB;
constexpr size_t WS_W = 4 * MiB;
constexpr size_t W_GU1 = WS_W, W_D1 = W_GU1 + (size_t)5632 * 1024 * 2, W_GU2 = W_D1 + (size_t)1024 * 2816 * 2, W_D2 = W_GU2 + (size_t)5632 * 1024 * 2;
constexpr size_t W_IN = W_D2 + (size_t)1024 * 2816 * 2, W_UQ = W_IN + (size_t)4096 * 1024 * 2, W_UKV = W_UQ + (size_t)768 * 384 * 2, W_BA = W_UKV + (size_t)1024 * 256 * 2;
constexpr size_t W_BB = W_BA + (size_t)1024 * 512 * 2, W_OUT = W_BB + (size_t)1024 * 512 * 2, W_1K = W_OUT + (size_t)1024 * 1024 * 2, W_1V = W_1K + (size_t)64 * 2048 * 2, W_END = W_1V + (size_t)64 * 2048 * 2;
static_assert(W_END <= 52 * MiB, "weights region");
constexpr size_t WS_XN = 52 * MiB;
constexpr size_t WS_OA = 52 * MiB, WS_OB = 68 * MiB;
constexpr size_t WS_C = 84 * MiB;
constexpr size_t WS_QN = 84 * MiB, WS_KCF = 100 * MiB, WS_VCF = 104 * MiB, WS_KSEL = 108 * MiB, WS_VSEL = 112 * MiB, WS_KWIN = 116 * MiB, WS_VWIN = 120 * MiB;
constexpr size_t WS_CQ = 124 * MiB, WS_CKV = 136 * MiB, WS_GM = 144 * MiB, WS_KC = 208 * MiB, WS_VC = 208 * MiB + 256 * 1024;
constexpr size_t WS_QM = 212 * MiB, WS_KM = 236 * MiB, WS_VM = 260 * MiB, WS_Y = 212 * MiB, WS_TOTAL = 276 * MiB;


__device__ __forceinline__ int opaque_lane() { unsigned z; asm volatile("v_mov_b32 %0, 0" : "=v"(z)); return (int)__builtin_amdgcn_mbcnt_hi(~0u, __builtin_amdgcn_mbcnt_lo(~0u, z)); }
template <int K> __device__ __forceinline__ float swz_xor(float v) { return __int_as_float(__builtin_amdgcn_ds_swizzle(__float_as_int(v), (K << 10) | 0x1f)); }
__device__ __forceinline__ float half_sum(float v) { auto rr = __builtin_amdgcn_permlane32_swap(__float_as_uint(v), __float_as_uint(v), false, false); return __uint_as_float(rr[0]) + __uint_as_float(rr[1]); }
__device__ __forceinline__ float wave_sum(float v) { v += swz_xor<1>(v); v += swz_xor<2>(v); v += swz_xor<4>(v); v += swz_xor<8>(v); v += swz_xor<16>(v); return half_sum(v); }
namespace pg8 {
#define PG8_LAS __attribute__((address_space(3)))
typedef unsigned short bf16_t;
typedef short bf16x8 __attribute__((ext_vector_type(8)));
typedef float f32x4 __attribute__((ext_vector_type(4)));
typedef unsigned u32x4 __attribute__((ext_vector_type(4)));
constexpr int BM = 256, BK = 64, HALF = 128, HTB = HALF * BK * 2  , STAGE_BYTES = 8 * HTB, NXCD = 8, WGM = 8;

__host__ __device__ __forceinline__ int lds_byte(int r, int c) { const int st = (r >> 4) * 2 + (c >> 5), rr = r & 15, cc = c & 31, ob = rr * 64 + cc * 2; return st * 1024 + (ob ^ (((ob >> 9) & 1) << 5)); }
__host__ __device__ __forceinline__ void stage_rc(int b, int& R, int& C) { const int st = b / 1024, sb = b % 1024, swz = sb ^ (((sb >> 9) & 1) << 5); R = (st >> 1) * 16 + swz / 64; C = (st & 1) * 32 + (swz % 64) / 2; }
__host__ __device__ __forceinline__ int perm32(int rho) { const int n = rho >> 4, i = rho & 15; return 8 * (i >> 2) + 4 * n + (i & 3); }

struct Unit { int pm, pn; };
struct Gemm { const bf16_t* A; const bf16_t* Bt; int M, N, K; };

struct StaticOrder {
    int nM, nN, nwg, G, c;
    __host__ __device__ __forceinline__ void init(int M, int N, int G_, int c_) { nM = M / BM; nN = N / BM; nwg = nM * nN; G = G_; c = c_; }
    __host__ __device__ __forceinline__ bool next(int i, Unit& u) const {
        const long L = (long)i * G + c; if (L >= nwg) return false;
        int wgid = (int)L; { const int q = nwg / NXCD, r = nwg % NXCD, xcd = wgid % NXCD, off = wgid / NXCD; wgid = (xcd < r ? xcd * (q + 1) : r * (q + 1) + (xcd - r) * q) + off; }
        const int nig = WGM * nN, gid = wgid / nig, fm = gid * WGM, gsz = (nM - fm) < WGM ? (nM - fm) : WGM;
        u.pm = fm + ((wgid % nig) % gsz); u.pn = (wgid % nig) / gsz; return true;
    }
    __device__ __forceinline__ void a_ready(const Unit&) const {}
    __device__ __forceinline__ void done(const Unit&) const {}
};

typedef float cvt_f32x2_t __attribute__((ext_vector_type(2))); typedef __bf16 cvt_bf16x2_t __attribute__((ext_vector_type(2)));
__device__ __forceinline__ unsigned cvt_pk_bf16(float lo, float hi) { cvt_f32x2_t v = {lo, hi}; cvt_bf16x2_t b = __builtin_convertvector(v, cvt_bf16x2_t); return __builtin_bit_cast(unsigned, b); }
typedef float f32x2 __attribute__((ext_vector_type(2)));
constexpr int SEQL = 8192, DMODEL = 1024, DFFN = 2816;
constexpr float LOG2E = 1.4426950408889634f;
constexpr float QSC_NSA = 0.125f * LOG2E;
constexpr float QSC_MLA = 0.10206207261596577f * LOG2E;
constexpr float NEPS = 1e-6f;
__device__ __forceinline__ float sigm(float x) { return __builtin_amdgcn_rcpf(1.0f + __builtin_amdgcn_exp2f(-LOG2E * x)); }
__device__ __forceinline__ void st8(bf16_t* p, f32x4 a0, f32x4 a1) {
    u32x4 w; w.x = cvt_pk_bf16(a0[0], a0[1]); w.y = cvt_pk_bf16(a0[2], a0[3]); w.z = cvt_pk_bf16(a1[0], a1[1]); w.w = cvt_pk_bf16(a1[2], a1[3]); *(u32x4*)p = w; }
__device__ __forceinline__ float bf2f(unsigned short h) { return __uint_as_float(((unsigned)h) << 16); }

struct EpiSwiGLU { static constexpr bool PERM = true, AFTER_DRAIN = false; unsigned char* ws;
    __device__ __forceinline__ void operator()(const f32x4 (&acc)[2][2][4][2], const Unit& u, int wr, int wc, int fr, int fq) const {
        { const int ln_ = opaque_lane(); fr = ln_ & 15; fq = ln_ >> 4; }
        const int row0 = u.pm * BM + wr * 64 + fr, col0 = u.pn * 128 + wc * 32 + 8 * fq;
#pragma unroll
        for (int ai = 0; ai < 2; ++ai)
#pragma unroll
            for (int m = 0; m < 4; ++m) { bf16_t* rowp = (bf16_t*)(ws + WS_C) + (size_t)(row0 + ai * HALF + m * 16) * DFFN + col0;
                f32x4 h0, h1;
#pragma unroll
                for (int j = 0; j < 4; ++j) { const float g0 = acc[ai][0][m][0][j], g1 = acc[ai][0][m][1][j];
                    h0[j] = g0 * sigm(g0) * acc[ai][1][m][0][j]; h1[j] = g1 * sigm(g1) * acc[ai][1][m][1][j]; }
                st8(rowp, h0, h1); }
    }
};
struct EpiResid { static constexpr bool PERM = false, AFTER_DRAIN = false; const float* xin; float* xout; const float* gate; float gs;
    __device__ __forceinline__ void operator()(const f32x4 (&acc)[2][2][4][2], const Unit& u, int wr, int wc, int fr, int fq) const {
        { const int ln_ = opaque_lane(); fr = ln_ & 15; fq = ln_ >> 4; }
        const int col0 = u.pn * BM + wc * 32 + 4 * fq; const int b = (u.pm * BM) >> 13;
        f32x4 gv[2][2];
#pragma unroll
        for (int bj = 0; bj < 2; ++bj)
#pragma unroll
            for (int n = 0; n < 2; ++n) gv[bj][n] = *(const f32x4*)(gate + (size_t)b * 9216 + col0 + bj * HALF + n * 16) * gs;
#pragma unroll
        for (int ai = 0; ai < 2; ++ai)
#pragma unroll
            for (int m = 0; m < 4; ++m) { const size_t off = (size_t)(u.pm * BM + ai * HALF + wr * 64 + m * 16 + fr) * DMODEL + col0;
#pragma unroll
                for (int bj = 0; bj < 2; ++bj)
#pragma unroll
                    for (int n = 0; n < 2; ++n) { const f32x4 xv = *(const f32x4*)(xin + off + bj * HALF + n * 16);
                        *(f32x4*)(xout + off + bj * HALF + n * 16) = xv + gv[bj][n] * acc[ai][bj][m][n]; }
                if (m & 1) asm volatile("" ::: "memory"); }
    }
};
struct EpiWin { static constexpr bool PERM = true, AFTER_DRAIN = false;
    unsigned char* ws;
    __device__ __forceinline__ void operator()(const f32x4 (&acc)[2][2][4][2], const Unit& u, int wr, int wc, int fr, int fq) const {
        { const int ln_ = opaque_lane(); fr = ln_ & 15; fq = ln_ >> 4; }
        bf16_t* const Qn = (bf16_t*)(ws + WS_QN); bf16_t* const kcf = (bf16_t*)(ws + WS_KCF); bf16_t* const vcf = (bf16_t*)(ws + WS_VCF); bf16_t* const Ksel = (bf16_t*)(ws + WS_KSEL); bf16_t* const Vsel = (bf16_t*)(ws + WS_VSEL);
        bf16_t* const Kwin = (bf16_t*)(ws + WS_KWIN); bf16_t* const Vwin = (bf16_t*)(ws + WS_VWIN); bf16_t* const cq = (bf16_t*)(ws + WS_CQ); bf16_t* const ckv = (bf16_t*)(ws + WS_CKV); bf16_t* const Km = (bf16_t*)(ws + WS_KM); bf16_t* const gm = (bf16_t*)(ws + WS_GM);
        float* const gates = (float*)(ws + WS_GATES); const float* const cs = (const float*)(ws + WS_CS);
        const int pn = u.pn;
#pragma unroll
        for (int ai = 0; ai < 2; ++ai)
#pragma unroll
            for (int m = 0; m < 4; ++m) {
                const int row = u.pm * BM + ai * HALF + wr * 64 + m * 16 + fr, b = row >> 13, t = row & (SEQL - 1);
                const int d = wc * 32 + 8 * fq;
                if (pn < 2) {
#pragma unroll
                    for (int bj = 0; bj < 2; ++bj) st8(Qn + (size_t)row * 512 + pn * 256 + bj * HALF + d, acc[ai][bj][m][0] * QSC_NSA, acc[ai][bj][m][1] * QSC_NSA);
                } else if (pn == 2) {
                    const int g = d >> 6, dd = d & 63; const size_t o = ((size_t)(b * 2 + g) * SEQL + t) * 64 + dd;
                    st8(kcf + o, acc[ai][0][m][0], acc[ai][0][m][1]); st8(vcf + o, acc[ai][1][m][0], acc[ai][1][m][1]);
                } else if (pn == 3 || pn == 4) {
                    bf16_t* Kd = pn == 3 ? Ksel : Kwin; bf16_t* Vd = pn == 3 ? Vsel : Vwin;
                    const int g = d >> 6, dd = d & 63; const size_t tb = (size_t)(b * 2 + g) * 128 + (t >> 6);
                    st8(Kd + (tb * 8 + (dd >> 3)) * 512 + (t & 63) * 8, acc[ai][0][m][0], acc[ai][0][m][1]);
                    st8(Vd + tb * 4096 + (dd >> 5) * 2048 + (t & 63) * 32 + (dd & 31), acc[ai][1][m][0], acc[ai][1][m][1]);
                } else if (pn == 5 || pn == 6) {
#pragma unroll
                    for (int bj = 0; bj < 2; ++bj) { const f32x4 a0 = acc[ai][bj][m][0], a1 = acc[ai][bj][m][1];
                        if (pn == 5) st8(ckv + (size_t)row * 256 + bj * HALF + d, a0, a1); else st8(cq + (size_t)row * 384 + bj * HALF + d, a0, a1); }
                } else if (pn == 7) {
                    st8(cq + (size_t)row * 384 + 256 + d, acc[ai][0][m][0], acc[ai][0][m][1]);
                    const f32x4 a0 = acc[ai][1][m][0], a1 = acc[ai][1][m][1];
                    if (wc == 0) {
                        const f32x4 c4 = *(const f32x4*)(cs + (size_t)t * 32 + 4 * fq), s4 = *(const f32x4*)(cs + (size_t)t * 32 + 16 + 4 * fq);
                        f32x4 o0, o1;
                        o0[0] = a0[0] * c4[0] - a0[1] * s4[0]; o0[1] = a0[0] * s4[0] + a0[1] * c4[0];
                        o0[2] = a0[2] * c4[1] - a0[3] * s4[1]; o0[3] = a0[2] * s4[1] + a0[3] * c4[1];
                        o1[0] = a1[0] * c4[2] - a1[1] * s4[2]; o1[1] = a1[0] * s4[2] + a1[1] * c4[2];
                        o1[2] = a1[2] * c4[3] - a1[3] * s4[3]; o1[3] = a1[2] * s4[3] + a1[3] * c4[3];
#pragma unroll
                        for (int h = 0; h < 8; ++h) st8(Km + (((size_t)(b * 8 + h) * 128 + (t >> 6)) * 12 + 8 + fq) * 512 + (t & 63) * 8, o0, o1);
                    } else if (wc == 1 && fq < 3) {
                        float* gp = gates + (size_t)row * 24 + 8 * fq; f32x4 g0, g1;
#pragma unroll
                        for (int j = 0; j < 4; ++j) { g0[j] = sigm(a0[j]); g1[j] = sigm(a1[j]); }
                        *(f32x4*)gp = g0; *(f32x4*)(gp + 4) = g1;
                    }
                } else {
#pragma unroll
                    for (int bj = 0; bj < 2; ++bj) { f32x4 g0, g1;
#pragma unroll
                        for (int j = 0; j < 4; ++j) { g0[j] = sigm(acc[ai][bj][m][0][j]); g1[j] = sigm(acc[ai][bj][m][1][j]); }
                        st8(gm + (size_t)row * 2048 + (pn - 8) * 256 + bj * HALF + d, g0, g1); }
                }
                asm volatile("" ::: "memory");
            }
    }
};
struct EpiQproj { static constexpr bool PERM = true, AFTER_DRAIN = false; unsigned char* ws; const PG8_LAS float* tab;
    __device__ __forceinline__ void operator()(const f32x4 (&acc)[2][2][4][2], const Unit& u, int wr, int wc, int fr, int fq) const {
        { const int ln_ = opaque_lane(); fr = ln_ & 15; fq = ln_ >> 4; }
        bf16_t* const Qm = (bf16_t*)(ws + WS_QM); const float* const cs = (const float*)(ws + WS_CS);
#pragma unroll
        for (int ai = 0; ai < 2; ++ai)
#pragma unroll
            for (int m = 0; m < 4; ++m) {
                const int row = u.pm * BM + ai * HALF + wr * 64 + m * 16 + fr, t = row & (SEQL - 1);
                const float rs = tab[ai * HALF + wr * 64 + m * 16 + fr];
#pragma unroll
                for (int bj = 0; bj < 2; ++bj) { const int n = u.pn * BM + bj * HALF + wc * 32 + 8 * fq; const int p = n % 96;
                    f32x4 a0 = acc[ai][bj][m][0] * rs, a1 = acc[ai][bj][m][1] * rs;
                    if (p >= 64) { const int i0 = (p - 64) >> 1;
                        const f32x4 c4 = *(const f32x4*)(cs + (size_t)t * 32 + i0), s4 = *(const f32x4*)(cs + (size_t)t * 32 + 16 + i0);
                        f32x4 o0, o1;
                        o0[0] = a0[0] * c4[0] - a0[1] * s4[0]; o0[1] = a0[0] * s4[0] + a0[1] * c4[0];
                        o0[2] = a0[2] * c4[1] - a0[3] * s4[1]; o0[3] = a0[2] * s4[1] + a0[3] * c4[1];
                        o1[0] = a1[0] * c4[2] - a1[1] * s4[2]; o1[1] = a1[0] * s4[2] + a1[1] * c4[2];
                        o1[2] = a1[2] * c4[3] - a1[3] * s4[3]; o1[3] = a1[2] * s4[3] + a1[3] * c4[3];
                        a0 = o0; a1 = o1; }
                    st8(Qm + (size_t)row * 768 + n, a0, a1); }
                asm volatile("" ::: "memory");
            }
    }
};
struct EpiKVproj { static constexpr bool PERM = true, AFTER_DRAIN = false; unsigned char* ws; const PG8_LAS float* tab;
    __device__ __forceinline__ void operator()(const f32x4 (&acc)[2][2][4][2], const Unit& u, int wr, int wc, int fr, int fq) const {
        { const int ln_ = opaque_lane(); fr = ln_ & 15; fq = ln_ >> 4; }
        bf16_t* const Km = (bf16_t*)(ws + WS_KM); bf16_t* const Vm = (bf16_t*)(ws + WS_VM);
#pragma unroll
        for (int ai = 0; ai < 2; ++ai)
#pragma unroll
            for (int m = 0; m < 4; ++m) {
                const int row = u.pm * BM + ai * HALF + wr * 64 + m * 16 + fr, b = row >> 13, t = row & (SEQL - 1);
                const float rs = tab[ai * HALF + wr * 64 + m * 16 + fr];
#pragma unroll
                for (int bj = 0; bj < 2; ++bj) { const int n = (u.pn & 1) * BM + bj * HALF + wc * 32 + 8 * fq; const int h = n >> 6, dd = n & 63;
                    const f32x4 a0 = acc[ai][bj][m][0] * rs, a1 = acc[ai][bj][m][1] * rs; const size_t tb = (size_t)(b * 8 + h) * 128 + (t >> 6);
                    if (u.pn < 2) st8(Km + (tb * 12 + (dd >> 3)) * 512 + (t & 63) * 8, a0, a1);
                    else st8(Vm + tb * 4096 + (dd >> 5) * 2048 + (t & 63) * 32 + (dd & 31), a0, a1); }
                asm volatile("" ::: "memory");
            }
    }
};
template <int PASS> struct EpiBranch { static constexpr bool PERM = true, AFTER_DRAIN = false; unsigned char* ws;
    __device__ __forceinline__ void operator()(const f32x4 (&acc)[2][2][4][2], const Unit& u, int wr, int wc, int fr, int fq) const {
        { const int ln_ = opaque_lane(); fr = ln_ & 15; fq = ln_ >> 4; }
        bf16_t* const Y = (bf16_t*)(ws + WS_Y); const bf16_t* const gm = (const bf16_t*)(ws + WS_GM);
#pragma unroll
        for (int ai = 0; ai < 2; ++ai)
#pragma unroll
            for (int m = 0; m < 4; ++m) { const int row = u.pm * BM + ai * HALF + wr * 64 + m * 16 + fr;
#pragma unroll
                for (int bj = 0; bj < 2; ++bj) { const int n = u.pn * BM + bj * HALF + wc * 32 + 8 * fq;
                    const u32x4 gw = *(const u32x4*)(gm + (size_t)row * 2048 + PASS * 1024 + n);
                    f32x4 a0 = acc[ai][bj][m][0], a1 = acc[ai][bj][m][1];
                    a0[0] *= __uint_as_float(gw.x << 16); a0[1] *= __uint_as_float(gw.x & 0xffff0000u); a0[2] *= __uint_as_float(gw.y << 16); a0[3] *= __uint_as_float(gw.y & 0xffff0000u);
                    a1[0] *= __uint_as_float(gw.z << 16); a1[1] *= __uint_as_float(gw.z & 0xffff0000u); a1[2] *= __uint_as_float(gw.w << 16); a1[3] *= __uint_as_float(gw.w & 0xffff0000u);
                    bf16_t* yp = Y + (size_t)row * DMODEL + n;
                    if (PASS == 1) { const u32x4 yw = *(const u32x4*)yp;
                        a0[0] += __uint_as_float(yw.x << 16); a0[1] += __uint_as_float(yw.x & 0xffff0000u); a0[2] += __uint_as_float(yw.y << 16); a0[3] += __uint_as_float(yw.y & 0xffff0000u);
                        a1[0] += __uint_as_float(yw.z << 16); a1[1] += __uint_as_float(yw.z & 0xffff0000u); a1[2] += __uint_as_float(yw.w << 16); a1[3] += __uint_as_float(yw.w & 0xffff0000u); }
                    st8(yp, a0, a1); }
            }
    }
};
template <class Epi, class Sched, bool ALIGN_EPI = false, bool SP2 = false>
__device__ __forceinline__ void gemm_phase(PG8_LAS unsigned char* lds, const Gemm g, const Sched& S, const Epi& E, int wave_id) {
    int tid_ = wave_id * 64 + opaque_lane();
    const int tid = tid_, wid = __builtin_amdgcn_readfirstlane(tid >> 6), lane = tid & 63, wr = wid >> 2, wc = wid & 3, fr = lane & 15, fq = lane >> 4;
    const int K = g.K, nt = K / BK;
    unsigned voffA[2], voffB[2];
#pragma unroll
    for (int i = 0; i < 2; ++i) { int R, C; stage_rc(tid * 16 + i * 8192, R, C); const int Rb = Epi::PERM ? ((R & ~31) + perm32(R & 31)) : R;
        voffA[i] = (unsigned)(R * K + C) * 2u; voffB[i] = (unsigned)(Rb * K + C) * 2u; }
    const size_t kstep = (size_t)(BK * 2);
    const size_t hstep = (size_t)HALF * K * 2;
    const size_t tstep = 2 * hstep;
    const unsigned ldsw = (unsigned)wid * 1024u;
    const int aoff = lds_byte(wr * 64 + fr, fq * 8), boff = lds_byte(wc * 32 + fr, fq * 8);
#define PG8_SA(b, h) (((b) * 2 + (h)) * HTB)
#define PG8_SB(b, h) ((4 + (b) * 2 + (h)) * HTB)
#define PG8_STAGE(bufoff, gbase, voff) do { _Pragma("unroll") for (int _i = 0; _i < 2; ++_i) \
        __builtin_amdgcn_global_load_lds((const unsigned*)((const char*)(gbase) + (voff)[_i]), (PG8_LAS unsigned*)(lds + (bufoff) + ldsw + _i * 8192), 16, 0, 0); } while (0)
#define PG8_LDA(dst, b, h) do { _Pragma("unroll") for (int m = 0; m < 4; ++m) _Pragma("unroll") for (int k = 0; k < 2; ++k) dst[m][k] = *(const PG8_LAS bf16x8*)(lds + PG8_SA(b, h) + aoff + m * 2048 + k * 1024); } while (0)
#define PG8_LDB(dst, b, h) do { _Pragma("unroll") for (int n = 0; n < 2; ++n) _Pragma("unroll") for (int k = 0; k < 2; ++k) dst[n][k] = *(const PG8_LAS bf16x8*)(lds + PG8_SB(b, h) + boff + n * 2048 + k * 1024); } while (0)
#define PG8_MMA(ai, bj, At, Bt) do { __builtin_amdgcn_s_setprio(1); _Pragma("unroll") for (int m = 0; m < 4; ++m) _Pragma("unroll") for (int n = 0; n < 2; ++n) _Pragma("unroll") for (int k = 0; k < 2; ++k) \
        acc[ai][bj][m][n] = __builtin_amdgcn_mfma_f32_16x16x32_bf16(Bt[n][k], At[m][k], acc[ai][bj][m][n], 0, 0, 0); __builtin_amdgcn_s_setprio(0); } while (0)
#define PG8_WAIT_V(n) asm volatile("s_waitcnt vmcnt(" #n ")" ::: "memory")
#define PG8_WAIT_L(n) asm volatile("s_waitcnt lgkmcnt(" #n ")" ::: "memory")
#define PG8_BAR __builtin_amdgcn_s_barrier()
#define PG8_SCHED __builtin_amdgcn_sched_barrier(0)
    Unit cur, nxt; int ui = 0;
    if (!S.next(0, cur)) return;
    f32x4 acc[2][2][4][2];
#pragma unroll
    for (int a = 0; a < 2; ++a)
#pragma unroll
        for (int b = 0; b < 2; ++b)
#pragma unroll
            for (int m = 0; m < 4; ++m)
#pragma unroll
                for (int n = 0; n < 2; ++n) acc[a][b][m][n] = (f32x4){0.f, 0.f, 0.f, 0.f};
    bf16x8 At[4][2], B0[2][2], B1[2][2];
    const char* cA = (const char*)g.A + (size_t)cur.pm * tstep; const char* cB = (const char*)g.Bt + (size_t)cur.pn * tstep;
    S.a_ready(cur);
    if constexpr (SP2) {
        PG8_STAGE(PG8_SB(0, 0), cB, voffB); PG8_STAGE(PG8_SB(0, 1), cB + hstep, voffB); PG8_STAGE(PG8_SA(0, 0), cA, voffA); PG8_STAGE(PG8_SA(0, 1), cA + hstep, voffA);
        if (wr == 1) PG8_BAR;
        PG8_WAIT_V(2); PG8_BAR;
        PG8_STAGE(PG8_SB(1, 0), cB + kstep, voffB); PG8_STAGE(PG8_SA(1, 0), cA + kstep, voffA); PG8_STAGE(PG8_SB(1, 1), cB + hstep + kstep, voffB);
        PG8_WAIT_V(6); PG8_BAR;
    } else {
        PG8_STAGE(PG8_SB(0, 0), cB, voffB); PG8_STAGE(PG8_SA(0, 0), cA, voffA); PG8_STAGE(PG8_SB(0, 1), cB + hstep, voffB); PG8_STAGE(PG8_SA(0, 1), cA + hstep, voffA);
        if (wr == 1) PG8_BAR;
        PG8_WAIT_V(4); PG8_BAR;
        PG8_STAGE(PG8_SB(1, 0), cB + kstep, voffB); PG8_STAGE(PG8_SA(1, 0), cA + kstep, voffA); PG8_STAGE(PG8_SB(1, 1), cB + hstep + kstep, voffB);
        PG8_WAIT_V(6); PG8_BAR;
    }
    for (;;) {
        const bool has_next = S.next(ui + 1, nxt);
        const char* nA = has_next ? (const char*)g.A + (size_t)nxt.pm * tstep : cA; const char* nB = has_next ? (const char*)g.Bt + (size_t)nxt.pn * tstep : cB;
        for (int t = 0; t < nt; t += 2) {
            const bool last = (t == nt - 2);
            const char* a1 = cA + (size_t)(t + 1) * kstep;
            const char* a2 = last ? nA : cA + (size_t)(t + 2) * kstep; const char* b2 = last ? nB : cB + (size_t)(t + 2) * kstep;
            const char* a3 = a2 + kstep; const char* b3 = b2 + kstep;
            if (last && has_next) S.a_ready(nxt);
            if constexpr (SP2) {
            PG8_LDB(B0, 0, 0); PG8_LDB(B1, 0, 1); PG8_SCHED; PG8_LDA(At, 0, 0); PG8_STAGE(PG8_SA(1, 1), a1 + hstep, voffA);
            PG8_WAIT_V(8); PG8_WAIT_L(0); PG8_BAR; PG8_MMA(0, 0, At, B0); PG8_MMA(0, 1, At, B1); PG8_BAR; PG8_SCHED;
            PG8_LDA(At, 0, 1); PG8_STAGE(PG8_SB(0, 0), b2, voffB); PG8_STAGE(PG8_SB(0, 1), b2 + hstep, voffB); PG8_STAGE(PG8_SA(0, 0), a2, voffA);
            PG8_WAIT_V(8); PG8_WAIT_L(0); PG8_BAR; PG8_MMA(1, 0, At, B0); PG8_MMA(1, 1, At, B1); PG8_BAR; PG8_SCHED;
            PG8_LDB(B0, 1, 0); PG8_LDB(B1, 1, 1); PG8_SCHED; PG8_LDA(At, 1, 0); PG8_STAGE(PG8_SA(0, 1), a2 + hstep, voffA);
            PG8_WAIT_V(8); PG8_WAIT_L(0); PG8_BAR; PG8_MMA(0, 0, At, B0); PG8_MMA(0, 1, At, B1); PG8_BAR; PG8_SCHED;
            PG8_LDA(At, 1, 1); PG8_STAGE(PG8_SB(1, 0), b3, voffB); PG8_STAGE(PG8_SB(1, 1), b3 + hstep, voffB); PG8_STAGE(PG8_SA(1, 0), a3, voffA);
            PG8_WAIT_V(8); PG8_WAIT_L(0); PG8_BAR; PG8_MMA(1, 0, At, B0); PG8_MMA(1, 1, At, B1); PG8_BAR; PG8_SCHED;
            } else {
            PG8_LDB(B0, 0, 0); PG8_SCHED; PG8_LDA(At, 0, 0); PG8_STAGE(PG8_SA(1, 1), a1 + hstep, voffA);
            PG8_WAIT_L(8); PG8_BAR; PG8_WAIT_L(0); PG8_MMA(0, 0, At, B0); PG8_BAR; PG8_SCHED;
            PG8_LDB(B1, 0, 1); PG8_STAGE(PG8_SB(0, 0), b2, voffB);
            PG8_BAR; PG8_WAIT_L(0); PG8_MMA(0, 1, At, B1); PG8_BAR;
            PG8_LDA(At, 0, 1); PG8_STAGE(PG8_SA(0, 0), a2, voffA);
            PG8_BAR; PG8_WAIT_L(0); PG8_MMA(1, 0, At, B0); PG8_BAR; PG8_SCHED;
            PG8_STAGE(PG8_SB(0, 1), b2 + hstep, voffB);
            PG8_WAIT_V(6); PG8_BAR; PG8_MMA(1, 1, At, B1); PG8_BAR;
            PG8_LDB(B0, 1, 0); PG8_SCHED; PG8_LDA(At, 1, 0); PG8_STAGE(PG8_SA(0, 1), a2 + hstep, voffA);
            PG8_WAIT_L(8); PG8_BAR; PG8_WAIT_L(0); PG8_MMA(0, 0, At, B0); PG8_BAR; PG8_SCHED;
            PG8_LDB(B1, 1, 1); PG8_STAGE(PG8_SB(1, 0), b3, voffB);
            PG8_BAR; PG8_WAIT_L(0); PG8_MMA(0, 1, At, B1); PG8_BAR;
            PG8_LDA(At, 1, 1); PG8_STAGE(PG8_SA(1, 0), a3, voffA);
            PG8_BAR; PG8_WAIT_L(0); PG8_MMA(1, 0, At, B0); PG8_BAR; PG8_SCHED;
            PG8_STAGE(PG8_SB(1, 1), b3 + hstep, voffB);
            PG8_WAIT_V(6); PG8_BAR; PG8_MMA(1, 1, At, B1); PG8_BAR;
            }
        }
        if constexpr (ALIGN_EPI) { if (wr == 0) PG8_BAR; }
        if constexpr (!Epi::AFTER_DRAIN) { E(acc, cur, wr, wc, fr, fq); S.done(cur); }
        if (!has_next) break;
#pragma unroll
        for (int a = 0; a < 2; ++a)
#pragma unroll
            for (int b = 0; b < 2; ++b)
#pragma unroll
                for (int m = 0; m < 4; ++m)
#pragma unroll
                    for (int n = 0; n < 2; ++n) acc[a][b][m][n] = (f32x4){0.f, 0.f, 0.f, 0.f};
        cur = nxt; cA = nA; cB = nB; ++ui;
        if constexpr (ALIGN_EPI) { if (wr == 1) PG8_BAR; }
    }
    PG8_WAIT_V(0);
    if constexpr (!ALIGN_EPI) { if (wr == 0) PG8_BAR; }
    PG8_BAR;
    if constexpr (Epi::AFTER_DRAIN) { E.fused(acc, cur, wr, wc, fr, fq, lds, wid, lane); S.done(cur); }
#undef PG8_SA
#undef PG8_SB
#undef PG8_STAGE
#undef PG8_LDA
#undef PG8_LDB
#undef PG8_MMA
#undef PG8_WAIT_V
#undef PG8_WAIT_L
#undef PG8_BAR
#undef PG8_SCHED
}
}
namespace att {
#define LAS __attribute__((address_space(3)))
typedef unsigned short bf16;
typedef short bf16x8 __attribute__((ext_vector_type(8)));
typedef short s16x4 __attribute__((ext_vector_type(4)));
typedef float f32x16 __attribute__((ext_vector_type(16)));
typedef float f32x4 __attribute__((ext_vector_type(4)));
typedef unsigned u32x4 __attribute__((ext_vector_type(4)));
typedef unsigned u32x2 __attribute__((ext_vector_type(2)));
typedef const LAS char* lcp;
constexpr float LOG2E = 1.4426950408889634f;
__device__ __forceinline__ int crow(int r, int hi) { return (r & 3) + 8 * (r >> 2) + 4 * hi; }
typedef float f32x2_t __attribute__((ext_vector_type(2))); typedef __bf16 bf16x2_t __attribute__((ext_vector_type(2)));
__device__ __forceinline__ unsigned cvtpk(float lo, float hi) { f32x2_t v = {lo, hi}; bf16x2_t b = __builtin_convertvector(v, bf16x2_t); return __builtin_bit_cast(unsigned, b); }
__device__ __forceinline__ unsigned short f2bf(float f) { return (unsigned short)(cvtpk(f, 0.f) & 0xffffu); }
__device__ __forceinline__ float xmax(float v) { auto rr = __builtin_amdgcn_permlane32_swap(__float_as_uint(v), __float_as_uint(v), false, false); return fmaxf(__uint_as_float(rr[0]), __uint_as_float(rr[1])); }
__device__ __forceinline__ float xsum(float v) { auto rr = __builtin_amdgcn_permlane32_swap(__float_as_uint(v), __float_as_uint(v), false, false); return __uint_as_float(rr[0]) + __uint_as_float(rr[1]); }
typedef short v4i16_t __attribute__((ext_vector_type(4)));
__device__ __forceinline__ s16x4 vtr(lcp p) { return __builtin_bit_cast(s16x4, __builtin_amdgcn_ds_read_tr16_b64_v4i16((LAS v4i16_t*)p)); }

template <int ND0> __device__ __forceinline__ void qk_tile(f32x16& p0, f32x16& p1, lcp kslot, const bf16x8* qr, int r32, int hi) {
    lcp kb = kslot + hi * 1024 + r32 * 16;
    p0 = f32x16{}; p1 = f32x16{};
#pragma unroll
    for (int d0 = 0; d0 < ND0; ++d0) {
        const bf16x8 b0 = *(const LAS bf16x8*)(kb + d0 * 2048), b1 = *(const LAS bf16x8*)(kb + d0 * 2048 + 512);
        p0 = __builtin_amdgcn_mfma_f32_32x32x16_bf16(b0, qr[d0], p0, 0, 0, 0);
        p1 = __builtin_amdgcn_mfma_f32_32x32x16_bf16(b1, qr[d0], p1, 0, 0, 0); }
}
__device__ __forceinline__ void pv_tile(f32x16& o0, f32x16& o1, lcp vp, const u32x4 (&pa)[4]) {
#pragma unroll
    for (int ks = 0; ks < 4; ++ks) {
        const s16x4 l0 = vtr(vp + ks * 1024), h0 = vtr(vp + ks * 1024 + 512), l1 = vtr(vp + 4096 + ks * 1024), h1 = vtr(vp + 4096 + ks * 1024 + 512);
        const bf16x8 v0 = (bf16x8){l0[0], l0[1], l0[2], l0[3], h0[0], h0[1], h0[2], h0[3]}, v1 = (bf16x8){l1[0], l1[1], l1[2], l1[3], h1[0], h1[1], h1[2], h1[3]};
        const bf16x8 a = __builtin_bit_cast(bf16x8, pa[ks]);
        o0 = __builtin_amdgcn_mfma_f32_32x32x16_bf16(a, v0, o0, 0, 0, 0);
        o1 = __builtin_amdgcn_mfma_f32_32x32x16_bf16(a, v1, o1, 0, 0, 0); }
}
__device__ __forceinline__ void pack_p(u32x4 (&pa)[4], const f32x16& p0, const f32x16& p1) {
    pa[0] = (u32x4){cvtpk(p0[0], p0[1]), cvtpk(p0[2], p0[3]), cvtpk(p0[4], p0[5]), cvtpk(p0[6], p0[7])};
    pa[1] = (u32x4){cvtpk(p0[8], p0[9]), cvtpk(p0[10], p0[11]), cvtpk(p0[12], p0[13]), cvtpk(p0[14], p0[15])};
    pa[2] = (u32x4){cvtpk(p1[0], p1[1]), cvtpk(p1[2], p1[3]), cvtpk(p1[4], p1[5]), cvtpk(p1[6], p1[7])};
    pa[3] = (u32x4){cvtpk(p1[8], p1[9]), cvtpk(p1[10], p1[11]), cvtpk(p1[12], p1[13]), cvtpk(p1[14], p1[15])};
}
__device__ __forceinline__ float max32(const f32x16& p0, const f32x16& p1) {
    float a = fmaxf(p0[0], p1[0]);
#pragma unroll
    for (int r = 1; r < 16; ++r) a = fmaxf(a, fmaxf(p0[r], p1[r]));
    return a;
}
__device__ __forceinline__ void softmax_pv(f32x16& p0, f32x16& p1, float& m, float& l, f32x16& o0, f32x16& o1, lcp vp, LAS float* wsf, int r32, int hi) {
    const float rm = xmax(max32(p0, p1));
    const float mn = fmaxf(m, rm); const float f = __builtin_amdgcn_exp2f(m - mn); m = mn;
    float s = 0.f;
#pragma unroll
    for (int r = 0; r < 16; ++r) { p0[r] = __builtin_amdgcn_exp2f(p0[r] - mn); p1[r] = __builtin_amdgcn_exp2f(p1[r] - mn); s += p0[r] + p1[r]; }
    l = l * f + s;
    if (__any(f != 1.0f)) {
        if (hi == 0) wsf[r32] = f;
#pragma unroll
        for (int r = 0; r < 16; ++r) { const float fr = wsf[crow(r, hi)]; o0[r] *= fr; o1[r] *= fr; }
    }
    u32x4 pa[4]; pack_p(pa, p0, p1);
    pv_tile(o0, o1, vp, pa);
}
__device__ __forceinline__ void add_scaled(f32x16& a0, f32x16& a1, const f32x16& o0, const f32x16& o1, float fac, LAS float* wsf, int r32, int hi) {
    if (hi == 0) wsf[32 + r32] = fac;
#pragma unroll
    for (int r = 0; r < 16; ++r) { const float fr = wsf[32 + crow(r, hi)]; a0[r] += fr * o0[r]; a1[r] += fr * o1[r]; }
}
template <bool FIRST> __device__ __forceinline__ void acc_lds(LAS float* accL, const f32x16& o0, const f32x16& o1, float fac, LAS float* wsf, int r32, int hi) {
    if (hi == 0) wsf[32 + r32] = fac;
#pragma unroll
    for (int r = 0; r < 16; ++r) { const int row = crow(r, hi); const float fr = wsf[32 + row]; LAS float* p = accL + row * 64 + r32;
        if (FIRST) { p[0] = fr * o0[r]; p[32] = fr * o1[r]; } else { p[0] += fr * o0[r]; p[32] += fr * o1[r]; } }
}
__device__ __forceinline__ void store_acc(const LAS float* accL, bf16* gdst, int pitch, int lane) {
#pragma unroll
    for (int i = 0; i < 4; ++i) { const int row = i * 8 + (lane >> 3), ch = lane & 7; const f32x4 a = *(const LAS f32x4*)(accL + row * 64 + ch * 8), b = *(const LAS f32x4*)(accL + row * 64 + ch * 8 + 4);
        const u32x4 v = (u32x4){cvtpk(a[0], a[1]), cvtpk(a[2], a[3]), cvtpk(b[0], b[1]), cvtpk(b[2], b[3])}; *(u32x4*)(gdst + (size_t)row * pitch + ch * 8) = v; }
}
__device__ __forceinline__ void store_o(const f32x16& o0, const f32x16& o1, LAS bf16* stg, bf16* gdst, int pitch, int lane, int r32, int hi) {
#pragma unroll
    for (int r = 0; r < 16; ++r) { const int orow = crow(r, hi); stg[orow * 64 + r32] = f2bf(o0[r]); stg[orow * 64 + 32 + r32] = f2bf(o1[r]); }
#pragma unroll
    for (int i = 0; i < 4; ++i) { const int row = i * 8 + (lane >> 3), ch = lane & 7; const u32x4 v = *(const LAS u32x4*)(stg + row * 64 + ch * 8); *(u32x4*)(gdst + (size_t)row * pitch + ch * 8) = v; }
}


template <int ND0> __device__ __forceinline__ void qk_tile_c(f32x16& p0, f32x16& p1, lcp kslot, const bf16x8* qr, const f32x16& c0, const f32x16& c1, int r32, int hi) {
    lcp kb = kslot + hi * 1024 + r32 * 16;
#pragma unroll
    for (int d0 = 0; d0 < ND0; ++d0) {
        const bf16x8 b0 = *(const LAS bf16x8*)(kb + d0 * 2048), b1 = *(const LAS bf16x8*)(kb + d0 * 2048 + 512);
        p0 = __builtin_amdgcn_mfma_f32_32x32x16_bf16(b0, qr[d0], d0 == 0 ? c0 : p0, 0, 0, 0);
        p1 = __builtin_amdgcn_mfma_f32_32x32x16_bf16(b1, qr[d0], d0 == 0 ? c1 : p1, 0, 0, 0); }
}
__device__ __forceinline__ void dma1k(const char* gsrc, LAS char* dst) { __builtin_amdgcn_global_load_lds((const unsigned*)gsrc, (LAS unsigned*)dst, 16, 0, 0); }
__device__ __forceinline__ void mask_causal(f32x16& p0, f32x16& p1, int e0) {
#pragma unroll
    for (int r = 0; r < 16; ++r) { const int e = e0 + (r & 3) + 8 * (r >> 2); if (e > 0) p0[r] = -INFINITY; if (e + 32 > 0) p1[r] = -INFINITY; }
}
__device__ __forceinline__ void mask_winlow(f32x16& p0, f32x16& p1, int e0) {
#pragma unroll
    for (int r = 0; r < 16; ++r) { const int e = e0 + (r & 3) + 8 * (r >> 2); if (e <= -512) p0[r] = -INFINITY; if (e + 32 <= -512) p1[r] = -INFINITY; }
}
__device__ __forceinline__ void softmax_pv2(f32x16& p0, f32x16& p1, f32x16& p2, f32x16& p3, float offa, float offb, float& m, float& l, f32x16& o0, f32x16& o1, lcp va, lcp vb, LAS float* wsf, int r32, int hi) {
    const float rm = xmax(fmaxf(max32(p0, p1) + offa, max32(p2, p3) + offb));
    const float mn = fmaxf(m, rm); const float f = __builtin_amdgcn_exp2f(m - mn); m = mn;
    const float ca = mn - offa, cb = mn - offb;
    float s = 0.f;
#pragma unroll
    for (int r = 0; r < 16; ++r) { p0[r] = __builtin_amdgcn_exp2f(p0[r] - ca); p1[r] = __builtin_amdgcn_exp2f(p1[r] - ca); s += p0[r] + p1[r]; }
#pragma unroll
    for (int r = 0; r < 16; ++r) { p2[r] = __builtin_amdgcn_exp2f(p2[r] - cb); p3[r] = __builtin_amdgcn_exp2f(p3[r] - cb); s += p2[r] + p3[r]; }
    l = l * f + s;
    if (__any(f != 1.0f)) {
        if (hi == 0) wsf[r32] = f;
#pragma unroll
        for (int r = 0; r < 16; ++r) { const float fr = wsf[crow(r, hi)]; o0[r] *= fr; o1[r] *= fr; }
    }
    { u32x4 pa[4]; pack_p(pa, p0, p1); pv_tile(o0, o1, va, pa); }
    { u32x4 pa[4]; pack_p(pa, p2, p3); pv_tile(o0, o1, vb, pa); }
}

#ifdef ATT_V1
constexpr int M_KS = 0, M_VS = 24576, M_WSF = 40960, M_OST = 43008;
__device__ __forceinline__ void mla_unit(int b, int h, int qb, const bf16* Qm, const bf16* Km, const bf16* Vm, bf16* Ob, LAS char* lds, int wave_id) {
    int tid_ = wave_id * 64 + opaque_lane();
    const int tid = tid_, lane = tid & 63, r32 = lane & 31, hi = lane >> 5, wid = __builtin_amdgcn_readfirstlane(tid >> 6);
    const int q0 = qb * 256, NT = (q0 + 256) / 64;
    const int qmin = q0 + wid * 32, qpos = qmin + r32;
    bf16x8 qr[6];
    { const bf16* qp = Qm + ((size_t)b * 8192 + qpos) * 768 + h * 96 + hi * 8;
#pragma unroll
      for (int d0 = 0; d0 < 6; ++d0) qr[d0] = *(const bf16x8*)(qp + d0 * 16); }
    const char* Kg = (const char*)(Km + (size_t)(b * 8 + h) * 128 * 6144);
    const char* Vg = (const char*)(Vm + (size_t)(b * 8 + h) * 128 * 4096);
    LAS float* wsf = (LAS float*)(lds + M_WSF) + wid * 64;
    const int vlane = ((lane >> 4) & 1) * 32 + (lane & 3) * 8 + (4 * hi + ((lane & 15) >> 2)) * 64;
    float m = -1e30f, l = 0.f; f32x16 o0 = f32x16{}, o1 = f32x16{};
    u32x4 kr0, kr1 = u32x4{}, vr0;
    kr0 = *(const u32x4*)(Kg + tid * 16); if (tid < 256) kr1 = *(const u32x4*)(Kg + 8192 + tid * 16); vr0 = *(const u32x4*)(Vg + tid * 16);
    *(LAS u32x4*)(lds + M_KS + tid * 16) = kr0; if (tid < 256) *(LAS u32x4*)(lds + M_KS + 8192 + tid * 16) = kr1; *(LAS u32x4*)(lds + M_VS + tid * 16) = vr0;
    __syncthreads();
    for (int kt = 0; kt < NT; ++kt) {
        const int sl = kt & 1;
        if (kt + 1 < NT) { const char* kg = Kg + (size_t)(kt + 1) * 12288; const char* vg = Vg + (size_t)(kt + 1) * 8192;
            kr0 = *(const u32x4*)(kg + tid * 16); if (tid < 256) kr1 = *(const u32x4*)(kg + 8192 + tid * 16); vr0 = *(const u32x4*)(vg + tid * 16); }
        if (64 * kt <= qmin + 31) {
            f32x16 p0, p1; qk_tile<6>(p0, p1, (lcp)(lds + M_KS + sl * 12288), qr, r32, hi);
            if (64 * kt + 63 > qmin) {
                const int kb = 64 * kt + 4 * hi;
#pragma unroll
                for (int r = 0; r < 16; ++r) { const int kv = kb + (r & 3) + 8 * (r >> 2); if (kv > qpos) p0[r] = -INFINITY; if (kv + 32 > qpos) p1[r] = -INFINITY; }
            }
            softmax_pv(p0, p1, m, l, o0, o1, (lcp)(lds + M_VS + sl * 8192 + vlane), wsf, r32, hi);
        }
        if (kt + 1 < NT) { const int sn = sl ^ 1;
            *(LAS u32x4*)(lds + M_KS + sn * 12288 + tid * 16) = kr0; if (tid < 256) *(LAS u32x4*)(lds + M_KS + sn * 12288 + 8192 + tid * 16) = kr1; *(LAS u32x4*)(lds + M_VS + sn * 8192 + tid * 16) = vr0; }
        __syncthreads();
    }
    const float lt = xsum(l); const float inv = lt > 0.f ? 1.0f / lt : 0.f;
    f32x16 a0 = f32x16{}, a1 = f32x16{};
    add_scaled(a0, a1, o0, o1, inv, wsf, r32, hi);
    store_o(a0, a1, (LAS bf16*)(lds + M_OST + wid * 4096), Ob + ((size_t)b * 8192 + qmin) * 512 + h * 64, 512, lane, r32, hi);
    __syncthreads();
}

constexpr int N_KS = 0, N_VS = 16384, N_WSF = 32768, N_ACC = 34816, N_IMP = 100352, N_SEL = 133376, N_UNI = 134400, N_BL = 134464, IMPS = 129;
struct NsaT { const bf16 *Qn, *Kc, *Vc, *Ksel, *Vsel, *Kwin, *Vwin; const float* gates; bf16* Oa; };
__device__ __forceinline__ void setbit(unsigned (&w)[4], int j) { const int wi = j >> 5; const unsigned bv = 1u << (j & 31); w[0] |= wi == 0 ? bv : 0u; w[1] |= wi == 1 ? bv : 0u; w[2] |= wi == 2 ? bv : 0u; w[3] |= wi == 3 ? bv : 0u; }
__device__ __forceinline__ void nsa_unit(int b, int g, int ti, const NsaT& T, LAS char* lds, int wave_id) {
    int tid_ = wave_id * 64 + opaque_lane();
    const int tid = tid_, lane = tid & 63, r32 = lane & 31, hi = lane >> 5, wid = __builtin_amdgcn_readfirstlane(tid >> 6);
    const int hh = wid & 3, qh = wid >> 2, H = g * 4 + hh, bg = b * 2 + g;
    const int t0 = ti * 64, qrow = qh * 32 + r32, t = t0 + qrow;
    const float slope2 = __builtin_amdgcn_exp2f(-(float)(H + 1)) * LOG2E;
    bf16x8 qr[4];
    { const bf16* qp = T.Qn + ((size_t)b * 8192 + t) * 512 + H * 64 + hi * 8;
#pragma unroll
      for (int d0 = 0; d0 < 4; ++d0) qr[d0] = *(const bf16x8*)(qp + d0 * 16); }
    LAS float* wsf = (LAS float*)(lds + N_WSF) + wid * 64;
    LAS float* imp = (LAS float*)(lds + N_IMP);
    LAS unsigned* selw = (LAS unsigned*)(lds + N_SEL);
    LAS unsigned* uni = (LAS unsigned*)(lds + N_UNI);
    LAS unsigned* blist = (LAS unsigned*)(lds + N_BL);
    const int vlane = ((lane >> 4) & 1) * 32 + (lane & 3) * 8 + (4 * hi + ((lane & 15) >> 2)) * 64;
    for (int i = tid; i < 64 * IMPS; i += 512) imp[i] = 0.f;
    if (tid < 256) selw[tid] = 0u;
    if (tid < 8) uni[tid] = 0u;
    const float* gp = T.gates + ((size_t)b * 8192 + t) * 24 + H * 3;
    const float gc = gp[0], gs = gp[1], gw = gp[2];
    LAS float* accL = (LAS float*)(lds + N_ACC) + wid * 2048;
    u32x4 kr0, vr0;
    const int ntc = (4 * ti + 3 + 63) >> 6;
    const char* Kcg = (const char*)(T.Kc + (size_t)bg * 8 * 4096); const char* Vcg = (const char*)(T.Vc + (size_t)bg * 8 * 4096);
    float m = -1e30f, l = 0.f;
#ifndef NSA_SKIP_P1
    kr0 = *(const u32x4*)(Kcg + tid * 16); *(LAS u32x4*)(lds + N_KS + tid * 16) = kr0;
    __syncthreads();
    for (int kt = 0; kt < ntc; ++kt) {
        const int sl = kt & 1;
        if (kt + 1 < ntc) kr0 = *(const u32x4*)(Kcg + (size_t)(kt + 1) * 8192 + tid * 16);
        { f32x16 p0, p1; qk_tile<4>(p0, p1, (lcp)(lds + N_KS + sl * 8192), qr, r32, hi);
          const int nb = 64 * kt + 4 * hi;
#pragma unroll
          for (int r = 0; r < 16; ++r) { const int n = nb + (r & 3) + 8 * (r >> 2); const int e0 = 16 * n + 31 - t, e1 = e0 + 512;
              p0[r] = e0 <= 0 ? p0[r] + slope2 * (float)e0 : -INFINITY; p1[r] = e1 <= 0 ? p1[r] + slope2 * (float)e1 : -INFINITY; }
          const float rm = max32(p0, p1); const float mn = fmaxf(m, rm); float s = 0.f;
#pragma unroll
          for (int r = 0; r < 16; ++r) s += __builtin_amdgcn_exp2f(p0[r] - mn) + __builtin_amdgcn_exp2f(p1[r] - mn);
          l = l * __builtin_amdgcn_exp2f(m - mn) + s; m = mn; }
        if (kt + 1 < ntc) *(LAS u32x4*)(lds + N_KS + (sl ^ 1) * 8192 + tid * 16) = kr0;
        __syncthreads();
    }
    {
      auto rm_ = __builtin_amdgcn_permlane32_swap(__float_as_uint(m), __float_as_uint(m), false, false); auto rl_ = __builtin_amdgcn_permlane32_swap(__float_as_uint(l), __float_as_uint(l), false, false);
      const float mo = __uint_as_float(hi ? rm_[0] : rm_[1]), lo = __uint_as_float(hi ? rl_[0] : rl_[1]); const float mn = fmaxf(m, mo);
      l = l * __builtin_amdgcn_exp2f(m - mn) + lo * __builtin_amdgcn_exp2f(mo - mn); m = mn; }
#endif
    const float invl = l > 0.f ? 1.0f / l : 0.f;
    f32x16 o0 = f32x16{}, o1 = f32x16{};
#ifndef NSA_SKIP_P2
    kr0 = *(const u32x4*)(Kcg + tid * 16); vr0 = *(const u32x4*)(Vcg + tid * 16);
    *(LAS u32x4*)(lds + N_KS + tid * 16) = kr0; *(LAS u32x4*)(lds + N_VS + tid * 16) = vr0;
    __syncthreads();
    for (int kt = 0; kt < ntc; ++kt) {
        const int sl = kt & 1;
        if (kt + 1 < ntc) { kr0 = *(const u32x4*)(Kcg + (size_t)(kt + 1) * 8192 + tid * 16); vr0 = *(const u32x4*)(Vcg + (size_t)(kt + 1) * 8192 + tid * 16); }
        { f32x16 p0, p1; qk_tile<4>(p0, p1, (lcp)(lds + N_KS + sl * 8192), qr, r32, hi);
          const int nb = 64 * kt + 4 * hi;
#pragma unroll
          for (int r = 0; r < 16; ++r) { const int n = nb + (r & 3) + 8 * (r >> 2); const int e0 = 16 * n + 31 - t, e1 = e0 + 512;
              p0[r] = e0 <= 0 ? __builtin_amdgcn_exp2f(p0[r] + slope2 * (float)e0 - m) * invl : 0.f; p1[r] = e1 <= 0 ? __builtin_amdgcn_exp2f(p1[r] + slope2 * (float)e1 - m) * invl : 0.f; }
          LAS float* ir = imp + qrow * IMPS + 16 * kt + hi;
#pragma unroll
          for (int rg = 0; rg < 4; ++rg) {
              const float A0 = (p0[4 * rg] + p0[4 * rg + 1]) + (p0[4 * rg + 2] + p0[4 * rg + 3]), A1 = (p1[4 * rg] + p1[4 * rg + 1]) + (p1[4 * rg + 2] + p1[4 * rg + 3]);
              __hip_atomic_fetch_add(ir + 2 * rg, A0, __ATOMIC_RELAXED, __HIP_MEMORY_SCOPE_WORKGROUP); __hip_atomic_fetch_add(ir + 2 * rg + 1, p0[4 * rg + 3], __ATOMIC_RELAXED, __HIP_MEMORY_SCOPE_WORKGROUP);
              __hip_atomic_fetch_add(ir + 8 + 2 * rg, A1, __ATOMIC_RELAXED, __HIP_MEMORY_SCOPE_WORKGROUP); __hip_atomic_fetch_add(ir + 8 + 2 * rg + 1, p1[4 * rg + 3], __ATOMIC_RELAXED, __HIP_MEMORY_SCOPE_WORKGROUP); }
          u32x4 pa[4]; pack_p(pa, p0, p1);
          pv_tile(o0, o1, (lcp)(lds + N_VS + sl * 8192 + vlane), pa); }
        if (kt + 1 < ntc) { *(LAS u32x4*)(lds + N_KS + (sl ^ 1) * 8192 + tid * 16) = kr0; *(LAS u32x4*)(lds + N_VS + (sl ^ 1) * 8192 + tid * 16) = vr0; }
        __syncthreads();
    }
    acc_lds<true>(accL, o0, o1, gc, wsf, r32, hi);
#endif
#ifndef NSA_SKIP_TOPK
    {
        const int q = tid >> 3, sub = tid & 7;
        unsigned w[4] = {0u, 0u, 0u, 0u};
        if (ti <= 15) { if (sub == 0) w[0] = (2u << ti) - 1u; }
        else {
            const LAS float* row = imp + q * IMPS;
#pragma unroll 1
            for (int half = 0; half < 2; ++half) {
                float v[8]; int cnt[8];
#pragma unroll
                for (int k = 0; k < 8; ++k) { const int j = 1 + sub + 8 * (k + 8 * half); v[k] = (j <= ti - 2) ? row[j] : -1.0f; cnt[k] = 0; }
#pragma unroll 1
                for (int jp = 1; jp <= ti - 2; ++jp) { const float vp = row[jp];
#pragma unroll
                    for (int k = 0; k < 8; ++k) { const int j = 1 + sub + 8 * (k + 8 * half); cnt[k] += (vp > v[k] || (vp == v[k] && jp < j)) ? 1 : 0; } }
#pragma unroll
                for (int k = 0; k < 8; ++k) { const int j = 1 + sub + 8 * (k + 8 * half); if (j <= ti - 2 && cnt[k] < 13) setbit(w, j); }
            }
            if (sub == 0) { w[0] |= 1u; setbit(w, ti); setbit(w, ti - 1); }
        }
#pragma unroll
        for (int k = 0; k < 4; ++k) if (w[k]) { __hip_atomic_fetch_or(selw + q * 4 + k, w[k], __ATOMIC_RELAXED, __HIP_MEMORY_SCOPE_WORKGROUP); __hip_atomic_fetch_or(uni + k, w[k], __ATOMIC_RELAXED, __HIP_MEMORY_SCOPE_WORKGROUP); }
    }
#endif
    __syncthreads();
    if (tid == 0) { int nb = 0;
        for (int k = 0; k < 4; ++k) { unsigned u = uni[k]; while (u) { const int bit = __builtin_ctz(u); u &= u - 1u; blist[nb++] = (unsigned)(32 * k + bit); } }
        uni[4] = (unsigned)nb; }
    __syncthreads();
    const int nsel = (int)uni[4];
    unsigned sw[4];
#pragma unroll
    for (int k = 0; k < 4; ++k) sw[k] = selw[qrow * 4 + k];
#ifndef NSA_SKIP_SEL
    {
        const char* Kg = (const char*)(T.Ksel + (size_t)bg * 128 * 4096); const char* Vg = (const char*)(T.Vsel + (size_t)bg * 128 * 4096);
        m = -1e30f; l = 0.f; o0 = f32x16{}; o1 = f32x16{};
        int j = (int)blist[0];
        kr0 = *(const u32x4*)(Kg + (size_t)j * 8192 + tid * 16); vr0 = *(const u32x4*)(Vg + (size_t)j * 8192 + tid * 16);
        *(LAS u32x4*)(lds + N_KS + tid * 16) = kr0; *(LAS u32x4*)(lds + N_VS + tid * 16) = vr0;
        __syncthreads();
        for (int k = 0; k < nsel; ++k) {
            const int sl = k & 1; int jn = 0;
            if (k + 1 < nsel) { jn = (int)blist[k + 1]; kr0 = *(const u32x4*)(Kg + (size_t)jn * 8192 + tid * 16); vr0 = *(const u32x4*)(Vg + (size_t)jn * 8192 + tid * 16); }
            { f32x16 p0, p1; qk_tile<4>(p0, p1, (lcp)(lds + N_KS + sl * 8192), qr, r32, hi);
              const int jw = j >> 5; const unsigned swj = jw == 0 ? sw[0] : jw == 1 ? sw[1] : jw == 2 ? sw[2] : sw[3]; const bool mine = (swj >> (j & 31)) & 1u; const int pb = 64 * j + 4 * hi - t;
#pragma unroll
              for (int r = 0; r < 16; ++r) { const int e0 = pb + (r & 3) + 8 * (r >> 2), e1 = e0 + 32;
                  p0[r] = (mine && e0 <= 0) ? p0[r] + slope2 * (float)e0 : -INFINITY; p1[r] = (mine && e1 <= 0) ? p1[r] + slope2 * (float)e1 : -INFINITY; }
              softmax_pv(p0, p1, m, l, o0, o1, (lcp)(lds + N_VS + sl * 8192 + vlane), wsf, r32, hi); }
            if (k + 1 < nsel) { *(LAS u32x4*)(lds + N_KS + (sl ^ 1) * 8192 + tid * 16) = kr0; *(LAS u32x4*)(lds + N_VS + (sl ^ 1) * 8192 + tid * 16) = vr0; }
            j = jn;
            __syncthreads();
        }
        const float lt = xsum(l); acc_lds<false>(accL, o0, o1, lt > 0.f ? gs / lt : 0.f, wsf, r32, hi);
    }
#endif
#ifndef NSA_SKIP_WIN
    {
        const char* Kg = (const char*)(T.Kwin + (size_t)bg * 128 * 4096); const char* Vg = (const char*)(T.Vwin + (size_t)bg * 128 * 4096);
        m = -1e30f; l = 0.f; o0 = f32x16{}; o1 = f32x16{};
        const int j0 = ti >= 8 ? ti - 8 : 0, nw = ti - j0 + 1;
        kr0 = *(const u32x4*)(Kg + (size_t)j0 * 8192 + tid * 16); vr0 = *(const u32x4*)(Vg + (size_t)j0 * 8192 + tid * 16);
        *(LAS u32x4*)(lds + N_KS + tid * 16) = kr0; *(LAS u32x4*)(lds + N_VS + tid * 16) = vr0;
        __syncthreads();
        for (int k = 0; k < nw; ++k) {
            const int sl = k & 1, j = j0 + k;
            if (k + 1 < nw) { kr0 = *(const u32x4*)(Kg + (size_t)(j + 1) * 8192 + tid * 16); vr0 = *(const u32x4*)(Vg + (size_t)(j + 1) * 8192 + tid * 16); }
            { f32x16 p0, p1; qk_tile<4>(p0, p1, (lcp)(lds + N_KS + sl * 8192), qr, r32, hi);
              const int pb = 64 * j + 4 * hi - t;
#pragma unroll
              for (int r = 0; r < 16; ++r) { const int e0 = pb + (r & 3) + 8 * (r >> 2), e1 = e0 + 32;
                  p0[r] = (e0 <= 0 && e0 > -512) ? p0[r] + slope2 * (float)e0 : -INFINITY; p1[r] = (e1 <= 0 && e1 > -512) ? p1[r] + slope2 * (float)e1 : -INFINITY; }
              softmax_pv(p0, p1, m, l, o0, o1, (lcp)(lds + N_VS + sl * 8192 + vlane), wsf, r32, hi); }
            if (k + 1 < nw) { *(LAS u32x4*)(lds + N_KS + (sl ^ 1) * 8192 + tid * 16) = kr0; *(LAS u32x4*)(lds + N_VS + (sl ^ 1) * 8192 + tid * 16) = vr0; }
            __syncthreads();
        }
        const float lt = xsum(l); acc_lds<false>(accL, o0, o1, lt > 0.f ? gw / lt : 0.f, wsf, r32, hi);
    }
#endif
    store_acc(accL, T.Oa + ((size_t)b * 8192 + t0 + qh * 32) * 512 + H * 64, 512, lane);
    __syncthreads();
}
#endif

#ifndef ATT_V1
constexpr int M_STG = 40960, M_WSF = 81920, M_OST = 83968;
__device__ __forceinline__ void mla_unit(int b, int h, int qb, const bf16* Qm, const bf16* Km, const bf16* Vm, bf16* Ob, LAS char* lds, int wave_id) {
    int tid_ = wave_id * 64 + opaque_lane();
    const int tid = tid_, lane = tid & 63, r32 = lane & 31, hi = lane >> 5, wid = __builtin_amdgcn_readfirstlane(tid >> 6);
    const int q0 = qb * 256, NP = (q0 + 256) / 128;
    const int qmin = q0 + wid * 32, qpos = qmin + r32;
    bf16x8 qr[6];
    { const bf16* qp = Qm + ((size_t)b * 8192 + qpos) * 768 + h * 96 + hi * 8;
#pragma unroll
      for (int d0 = 0; d0 < 6; ++d0) qr[d0] = *(const bf16x8*)(qp + d0 * 16); }
    const char* Kg = (const char*)(Km + (size_t)(b * 8 + h) * 128 * 6144) + lane * 16;
    const char* Vg = (const char*)(Vm + (size_t)(b * 8 + h) * 128 * 4096) + lane * 16;
    LAS float* wsf = (LAS float*)(lds + M_WSF) + wid * 64;
    const int vlane = ((lane >> 4) & 1) * 32 + (lane & 3) * 8 + (4 * hi + ((lane & 15) >> 2)) * 64;
    float m = -1e30f, l = 0.f; f32x16 o0 = f32x16{}, o1 = f32x16{};
    const f32x16 zc = f32x16{};
#define MLA_DMA(p, stg) do { const int ja_ = 2 * (p), jb_ = ja_ + 1; _Pragma("unroll") for (int i_ = 0; i_ < 5; ++i_) { const int q_ = wid + 8 * i_; \
        const char* s_ = q_ < 12 ? Kg + (size_t)ja_ * 12288 + q_ * 1024 : q_ < 24 ? Kg + (size_t)jb_ * 12288 + (q_ - 12) * 1024 : q_ < 32 ? Vg + (size_t)ja_ * 8192 + (q_ - 24) * 1024 : Vg + (size_t)jb_ * 8192 + (q_ - 32) * 1024; \
        dma1k(s_, lds + (stg) * M_STG + q_ * 1024); } } while (0)
    MLA_DMA(0, 0);
    __syncthreads();
    for (int p = 0; p < NP; ++p) {
        const int st = p & 1;
        if (p + 1 < NP) MLA_DMA(p + 1, st ^ 1);
        const int ja = 2 * p, jb = ja + 1;
        if (64 * ja <= qmin + 31) {
            LAS char* sb = lds + st * M_STG;
            f32x16 p0, p1, p2, p3;
            qk_tile_c<6>(p0, p1, (lcp)sb, qr, zc, zc, r32, hi);
            qk_tile_c<6>(p2, p3, (lcp)(sb + 12288), qr, zc, zc, r32, hi);
            if (64 * ja + 63 > qmin) mask_causal(p0, p1, 64 * ja + 4 * hi - qpos);
            if (64 * jb + 63 > qmin) mask_causal(p2, p3, 64 * jb + 4 * hi - qpos);
            softmax_pv2(p0, p1, p2, p3, 0.f, 0.f, m, l, o0, o1, (lcp)(sb + 24576 + vlane), (lcp)(sb + 32768 + vlane), wsf, r32, hi);
        }
        __syncthreads();
    }
#undef MLA_DMA
    const float lt = xsum(l); const float inv = lt > 0.f ? 1.0f / lt : 0.f;
    f32x16 a0 = f32x16{}, a1 = f32x16{};
    add_scaled(a0, a1, o0, o1, inv, wsf, r32, hi);
    store_o(a0, a1, (LAS bf16*)(lds + M_OST + wid * 4096), Ob + ((size_t)b * 8192 + qmin) * 512 + h * 64, 512, lane, r32, hi);
    __syncthreads();
}
constexpr int N_KS = 0, N_VS = 16384, N_STG = 32768, N_IMP = 32768, N_WSF = 66048, N_ACC = 68096, N_SEL = 133632, N_UNI = 134656, N_BL = 134720, IMPS = 129;
struct NsaT { const bf16 *Qn, *Kc, *Vc, *Ksel, *Vsel, *Kwin, *Vwin; const float* gates; bf16* Oa; };
__device__ __forceinline__ void setbit(unsigned (&w)[4], int j) { const int wi = j >> 5; const unsigned bv = 1u << (j & 31); w[0] |= wi == 0 ? bv : 0u; w[1] |= wi == 1 ? bv : 0u; w[2] |= wi == 2 ? bv : 0u; w[3] |= wi == 3 ? bv : 0u; }
__device__ __forceinline__ void nsa_unit(int b, int g, int ti, const NsaT& T, LAS char* lds, int wave_id) {
    int tid_ = wave_id * 64 + opaque_lane();
    const int tid = tid_, lane = tid & 63, r32 = lane & 31, hi = lane >> 5, wid = __builtin_amdgcn_readfirstlane(tid >> 6);
    const int hh = wid & 3, qh = wid >> 2, H = g * 4 + hh, bg = b * 2 + g;
    const int t0 = ti * 64, qrow = qh * 32 + r32, t = t0 + qrow;
    const float slope2 = __builtin_amdgcn_exp2f(-(float)(H + 1)) * LOG2E;
    bf16x8 qr[4];
    { const bf16* qp = T.Qn + ((size_t)b * 8192 + t) * 512 + H * 64 + hi * 8;
#pragma unroll
      for (int d0 = 0; d0 < 4; ++d0) qr[d0] = *(const bf16x8*)(qp + d0 * 16); }
    LAS float* wsf = (LAS float*)(lds + N_WSF) + wid * 64;
    LAS float* imp = (LAS float*)(lds + N_IMP);
    LAS unsigned* selw = (LAS unsigned*)(lds + N_SEL);
    LAS unsigned* uni = (LAS unsigned*)(lds + N_UNI);
    LAS unsigned* blist = (LAS unsigned*)(lds + N_BL);
    const int vlane = ((lane >> 4) & 1) * 32 + (lane & 3) * 8 + (4 * hi + ((lane & 15) >> 2)) * 64;
    for (int i = tid; i < 64 * IMPS; i += 512) imp[i] = 0.f;
    if (tid < 256) selw[tid] = 0u;
    if (tid < 8) uni[tid] = 0u;
    const float* gp = T.gates + ((size_t)b * 8192 + t) * 24 + H * 3;
    const float gc = gp[0], gs = gp[1], gw = gp[2];
    LAS float* accL = (LAS float*)(lds + N_ACC) + wid * 2048;
    u32x4 kr0, vr0;
    const int ntc = (4 * ti + 3 + 63) >> 6;
    const char* Kcg = (const char*)(T.Kc + (size_t)bg * 8 * 4096); const char* Vcg = (const char*)(T.Vc + (size_t)bg * 8 * 4096);
    float m = -1e30f, l = 0.f;
#ifndef NSA_SKIP_P1
    kr0 = *(const u32x4*)(Kcg + tid * 16); *(LAS u32x4*)(lds + N_KS + tid * 16) = kr0;
    __syncthreads();
    for (int kt = 0; kt < ntc; ++kt) {
        const int sl = kt & 1;
        if (kt + 1 < ntc) kr0 = *(const u32x4*)(Kcg + (size_t)(kt + 1) * 8192 + tid * 16);
        { f32x16 p0, p1; qk_tile<4>(p0, p1, (lcp)(lds + N_KS + sl * 8192), qr, r32, hi);
          const int nb = 64 * kt + 4 * hi;
#pragma unroll
          for (int r = 0; r < 16; ++r) { const int n = nb + (r & 3) + 8 * (r >> 2); const int e0 = 16 * n + 31 - t, e1 = e0 + 512;
              p0[r] = e0 <= 0 ? p0[r] + slope2 * (float)e0 : -INFINITY; p1[r] = e1 <= 0 ? p1[r] + slope2 * (float)e1 : -INFINITY; }
          const float rm = max32(p0, p1); const float mn = fmaxf(m, rm); float s = 0.f;
#pragma unroll
          for (int r = 0; r < 16; ++r) s += __builtin_amdgcn_exp2f(p0[r] - mn) + __builtin_amdgcn_exp2f(p1[r] - mn);
          l = l * __builtin_amdgcn_exp2f(m - mn) + s; m = mn; }
        if (kt + 1 < ntc) *(LAS u32x4*)(lds + N_KS + (sl ^ 1) * 8192 + tid * 16) = kr0;
        __syncthreads();
    }
    {
      auto rm_ = __builtin_amdgcn_permlane32_swap(__float_as_uint(m), __float_as_uint(m), false, false); auto rl_ = __builtin_amdgcn_permlane32_swap(__float_as_uint(l), __float_as_uint(l), false, false);
      const float mo = __uint_as_float(hi ? rm_[0] : rm_[1]), lo = __uint_as_float(hi ? rl_[0] : rl_[1]); const float mn = fmaxf(m, mo);
      l = l * __builtin_amdgcn_exp2f(m - mn) + lo * __builtin_amdgcn_exp2f(mo - mn); m = mn; }
#endif
    const float invl = l > 0.f ? 1.0f / l : 0.f;
    f32x16 o0 = f32x16{}, o1 = f32x16{};
#ifndef NSA_SKIP_P2
    kr0 = *(const u32x4*)(Kcg + tid * 16); vr0 = *(const u32x4*)(Vcg + tid * 16);
    *(LAS u32x4*)(lds + N_KS + tid * 16) = kr0; *(LAS u32x4*)(lds + N_VS + tid * 16) = vr0;
    __syncthreads();
    for (int kt = 0; kt < ntc; ++kt) {
        const int sl = kt & 1;
        if (kt + 1 < ntc) { kr0 = *(const u32x4*)(Kcg + (size_t)(kt + 1) * 8192 + tid * 16); vr0 = *(const u32x4*)(Vcg + (size_t)(kt + 1) * 8192 + tid * 16); }
        { f32x16 p0, p1; qk_tile<4>(p0, p1, (lcp)(lds + N_KS + sl * 8192), qr, r32, hi);
          const int nb = 64 * kt + 4 * hi;
#pragma unroll
          for (int r = 0; r < 16; ++r) { const int n = nb + (r & 3) + 8 * (r >> 2); const int e0 = 16 * n + 31 - t, e1 = e0 + 512;
              p0[r] = e0 <= 0 ? __builtin_amdgcn_exp2f(p0[r] + slope2 * (float)e0 - m) * invl : 0.f; p1[r] = e1 <= 0 ? __builtin_amdgcn_exp2f(p1[r] + slope2 * (float)e1 - m) * invl : 0.f; }
          LAS float* ir = imp + qrow * IMPS + 16 * kt + hi;
#pragma unroll
          for (int rg = 0; rg < 4; ++rg) {
              const float A0 = (p0[4 * rg] + p0[4 * rg + 1]) + (p0[4 * rg + 2] + p0[4 * rg + 3]), A1 = (p1[4 * rg] + p1[4 * rg + 1]) + (p1[4 * rg + 2] + p1[4 * rg + 3]);
              __hip_atomic_fetch_add(ir + 2 * rg, A0, __ATOMIC_RELAXED, __HIP_MEMORY_SCOPE_WORKGROUP); __hip_atomic_fetch_add(ir + 2 * rg + 1, p0[4 * rg + 3], __ATOMIC_RELAXED, __HIP_MEMORY_SCOPE_WORKGROUP);
              __hip_atomic_fetch_add(ir + 8 + 2 * rg, A1, __ATOMIC_RELAXED, __HIP_MEMORY_SCOPE_WORKGROUP); __hip_atomic_fetch_add(ir + 8 + 2 * rg + 1, p1[4 * rg + 3], __ATOMIC_RELAXED, __HIP_MEMORY_SCOPE_WORKGROUP); }
          u32x4 pa[4]; pack_p(pa, p0, p1);
          pv_tile(o0, o1, (lcp)(lds + N_VS + sl * 8192 + vlane), pa); }
        if (kt + 1 < ntc) { *(LAS u32x4*)(lds + N_KS + (sl ^ 1) * 8192 + tid * 16) = kr0; *(LAS u32x4*)(lds + N_VS + (sl ^ 1) * 8192 + tid * 16) = vr0; }
        __syncthreads();
    }
    acc_lds<true>(accL, o0, o1, gc, wsf, r32, hi);
#endif
#ifndef NSA_SKIP_TOPK
    {
        const int q = tid >> 3, sub = tid & 7;
        unsigned w[4] = {0u, 0u, 0u, 0u};
        if (ti <= 15) { if (sub == 0) w[0] = (2u << ti) - 1u; }
        else {
            const LAS float* row = imp + q * IMPS;
#pragma unroll 1
            for (int half = 0; half < 2; ++half) {
                float v[8]; int cnt[8];
#pragma unroll
                for (int k = 0; k < 8; ++k) { const int j = 1 + sub + 8 * (k + 8 * half); v[k] = (j <= ti - 2) ? row[j] : -1.0f; cnt[k] = 0; }
#pragma unroll 1
                for (int jp = 1; jp <= ti - 2; ++jp) { const float vp = row[jp];
#pragma unroll
                    for (int k = 0; k < 8; ++k) { const int j = 1 + sub + 8 * (k + 8 * half); cnt[k] += (vp > v[k] || (vp == v[k] && jp < j)) ? 1 : 0; } }
#pragma unroll
                for (int k = 0; k < 8; ++k) { const int j = 1 + sub + 8 * (k + 8 * half); if (j <= ti - 2 && cnt[k] < 13) setbit(w, j); }
            }
            if (sub == 0) { w[0] |= 1u; setbit(w, ti); setbit(w, ti - 1); }
        }
#pragma unroll
        for (int k = 0; k < 4; ++k) if (w[k]) { __hip_atomic_fetch_or(selw + q * 4 + k, w[k], __ATOMIC_RELAXED, __HIP_MEMORY_SCOPE_WORKGROUP); __hip_atomic_fetch_or(uni + k, w[k], __ATOMIC_RELAXED, __HIP_MEMORY_SCOPE_WORKGROUP); }
    }
#endif
    __syncthreads();
    if (tid == 0) { int nb = 0;
        for (int k = 0; k < 4; ++k) { unsigned u = uni[k]; while (u) { const int bit = __builtin_ctz(u); u &= u - 1u; blist[nb++] = (unsigned)(32 * k + bit); } }
        uni[4] = (unsigned)nb; }
    __syncthreads();
    const int nsel = (int)uni[4];
    unsigned sw[4];
#pragma unroll
    for (int k = 0; k < 4; ++k) sw[k] = selw[qrow * 4 + k];
    f32x16 bias0, bias1;
#pragma unroll
    for (int r = 0; r < 16; ++r) { bias0[r] = slope2 * (float)crow(r, hi); bias1[r] = bias0[r] + 32.0f * slope2; }
#define NSA_DMA(Kg_, Vg_, ja_, jb_, stg_) do { dma1k(Kg_ + (size_t)(ja_) * 8192, lds + (stg_) * N_STG + wid * 1024); dma1k(Kg_ + (size_t)(jb_) * 8192, lds + (stg_) * N_STG + 8192 + wid * 1024); \
        dma1k(Vg_ + (size_t)(ja_) * 8192, lds + (stg_) * N_STG + 16384 + wid * 1024); dma1k(Vg_ + (size_t)(jb_) * 8192, lds + (stg_) * N_STG + 24576 + wid * 1024); } while (0)
#ifndef NSA_SKIP_SEL
    {
        const char* Kg = (const char*)(T.Ksel + (size_t)bg * 128 * 4096) + wid * 1024 + lane * 16; const char* Vg = (const char*)(T.Vsel + (size_t)bg * 128 * 4096) + wid * 1024 + lane * 16;
        m = -1e30f; l = 0.f; o0 = f32x16{}; o1 = f32x16{};
        const int npair = (nsel + 1) >> 1;
        int ja = (int)blist[0], jb = nsel > 1 ? (int)blist[1] : ja;
        NSA_DMA(Kg, Vg, ja, jb, 0);
        __syncthreads();
        for (int p = 0; p < npair; ++p) {
            const int st = p & 1; int na = 0, nb = 0;
            if (p + 1 < npair) { na = (int)blist[2 * p + 2]; nb = (2 * p + 3 < nsel) ? (int)blist[2 * p + 3] : na; NSA_DMA(Kg, Vg, na, nb, st ^ 1); }
            { LAS char* sb = lds + st * N_STG;
              f32x16 p0, p1, p2, p3;
              qk_tile_c<4>(p0, p1, (lcp)sb, qr, bias0, bias1, r32, hi);
              qk_tile_c<4>(p2, p3, (lcp)(sb + 8192), qr, bias0, bias1, r32, hi);
              const int wa = ja >> 5, wb = jb >> 5;
              const unsigned swa = wa == 0 ? sw[0] : wa == 1 ? sw[1] : wa == 2 ? sw[2] : sw[3], swb = wb == 0 ? sw[0] : wb == 1 ? sw[1] : wb == 2 ? sw[2] : sw[3];
              const bool minea = (swa >> (ja & 31)) & 1u, mineb = ((swb >> (jb & 31)) & 1u) && (2 * p + 1 < nsel);
              if (ja == ti) mask_causal(p0, p1, 64 * ja + 4 * hi - t);
              if (jb == ti) mask_causal(p2, p3, 64 * jb + 4 * hi - t);
              const float offa = minea ? slope2 * (float)(64 * ja - t) : -INFINITY, offb = mineb ? slope2 * (float)(64 * jb - t) : -INFINITY;
              softmax_pv2(p0, p1, p2, p3, offa, offb, m, l, o0, o1, (lcp)(sb + 16384 + vlane), (lcp)(sb + 24576 + vlane), wsf, r32, hi); }
            ja = na; jb = nb;
            __syncthreads();
        }
        const float lt = xsum(l); acc_lds<false>(accL, o0, o1, lt > 0.f ? gs / lt : 0.f, wsf, r32, hi);
    }
#endif
#ifndef NSA_SKIP_WIN
    {
        const char* Kg = (const char*)(T.Kwin + (size_t)bg * 128 * 4096) + wid * 1024 + lane * 16; const char* Vg = (const char*)(T.Vwin + (size_t)bg * 128 * 4096) + wid * 1024 + lane * 16;
        m = -1e30f; l = 0.f; o0 = f32x16{}; o1 = f32x16{};
        const int j0 = ti >= 8 ? ti - 8 : 0, nw = ti - j0 + 1, npair = (nw + 1) >> 1;
        NSA_DMA(Kg, Vg, j0, (nw > 1 ? j0 + 1 : j0), 0);
        __syncthreads();
        for (int p = 0; p < npair; ++p) {
            const int st = p & 1; const int ja = j0 + 2 * p; const bool hasb = (2 * p + 1 < nw); const int jb = hasb ? ja + 1 : ja;
            if (p + 1 < npair) { const int na = ja + 2, nb = (2 * p + 3 < nw) ? na + 1 : na; NSA_DMA(Kg, Vg, na, nb, st ^ 1); }
            { LAS char* sb = lds + st * N_STG;
              f32x16 p0, p1, p2, p3;
              qk_tile_c<4>(p0, p1, (lcp)sb, qr, bias0, bias1, r32, hi);
              qk_tile_c<4>(p2, p3, (lcp)(sb + 8192), qr, bias0, bias1, r32, hi);
              if (ja == ti) mask_causal(p0, p1, 64 * ja + 4 * hi - t);
              if (jb == ti) mask_causal(p2, p3, 64 * jb + 4 * hi - t);
              if (ja == ti - 8) mask_winlow(p0, p1, 64 * ja + 4 * hi - t);
              if (jb == ti - 8) mask_winlow(p2, p3, 64 * jb + 4 * hi - t);
              const float offa = slope2 * (float)(64 * ja - t), offb = hasb ? slope2 * (float)(64 * jb - t) : -INFINITY;
              softmax_pv2(p0, p1, p2, p3, offa, offb, m, l, o0, o1, (lcp)(sb + 16384 + vlane), (lcp)(sb + 24576 + vlane), wsf, r32, hi); }
            __syncthreads();
        }
        const float lt = xsum(l); acc_lds<false>(accL, o0, o1, lt > 0.f ? gw / lt : 0.f, wsf, r32, hi);
    }
#endif
#undef NSA_DMA
    store_acc(accL, T.Oa + ((size_t)b * 8192 + t0 + qh * 32) * 512 + H * 64, 512, lane);
    __syncthreads();
}

#endif

}
#define XLAS __attribute__((address_space(3)))
#define XB_TMO      128
#define XB_XCNT(j)  (256  + 64 * (j))
#define XB_XSUB(j)  (1280 + 64 * (j))
#define XB_XGEN(j)  (2304 + 64 * (j))
#define XB_TOP      3328
#define XB_TOPGEN   3392
#define XCD_BAR_WORDS 3456
#define XB_SPIN_CAP (1u << 18)

__device__ __forceinline__ unsigned xb_ld(unsigned* p)              { return __hip_atomic_load(p, __ATOMIC_RELAXED, __HIP_MEMORY_SCOPE_AGENT); }
__device__ __forceinline__ unsigned xb_add(unsigned* p, unsigned v) { return __hip_atomic_fetch_add(p, v, __ATOMIC_RELAXED, __HIP_MEMORY_SCOPE_AGENT); }
__device__ __forceinline__ unsigned xb_xcc_id() { return (unsigned)__builtin_amdgcn_s_getreg((3 << 11) | 20) & 0xFu; }
#define XB_SPIN(cond, bar) do { unsigned _sp = 0; while (cond) { __builtin_amdgcn_s_sleep(1); \
    if ((++_sp & 255u) == 0u) { if (xb_ld(&(bar)[XB_TMO])) break; if (_sp > XB_SPIN_CAP) { atomicAdd(&(bar)[XB_TMO], 1u); break; } } } } while (0)

struct XcdBarrier {
    unsigned* bar; unsigned x;
    volatile XLAS unsigned* st;
};

__device__ __forceinline__ XcdBarrier xcd_barrier_post(unsigned* bar, volatile XLAS unsigned* st) {
    XcdBarrier b; b.bar = bar; b.x = xb_xcc_id(); b.st = st;
    if (threadIdx.x == 0) (void)xb_add(&bar[XB_XCNT(b.x)], 1u);
    return b;
}
__device__ __forceinline__ void xcd_barrier_complete(unsigned* bar, unsigned x, unsigned& nloc, unsigned& nx) {
    const unsigned G = gridDim.x * gridDim.y * gridDim.z;
    unsigned sum, cnt, mine, sp = 0u;
    for (;;) {
        sum = 0u; cnt = 0u; mine = 0u;
#pragma unroll
        for (unsigned j = 0; j < 16; ++j) { const unsigned c = xb_ld(&bar[XB_XCNT(j)]); sum += c; cnt += (c > 0u) ? 1u : 0u; mine = (j == x) ? c : mine; }
        if (sum == G) break;
        __builtin_amdgcn_s_sleep(1);
        if ((++sp & 255u) == 0u) { if (xb_ld(&bar[XB_TMO])) break; if (sp > XB_SPIN_CAP) { atomicAdd(&bar[XB_TMO], 1u); break; } }
    }
    nloc = mine > 0u ? mine : 1u; nx = cnt > 0u ? cnt : 1u;
}

__device__ __forceinline__ void xcd_barrier(const XcdBarrier& b) {
    asm volatile("s_waitcnt vmcnt(0)" ::: "memory");
    __syncthreads();
    if (threadIdx.x == 0) {
        unsigned* bar = b.bar;
        __builtin_amdgcn_s_waitcnt(0);
        unsigned nloc = b.st[0], nx = b.st[1];
        if (nloc == 0u) { xcd_barrier_complete(bar, b.x, nloc, nx); b.st[0] = nloc; b.st[1] = nx; }
        const unsigned old = xb_add(&bar[XB_XSUB(b.x)], 1u);
        const unsigned gen = old / nloc;
        if (old + 1u == (gen + 1u) * nloc) {
            __builtin_amdgcn_fence(__ATOMIC_RELEASE, "agent");
            asm volatile("s_waitcnt vmcnt(0)" ::: "memory");
            const unsigned og = xb_add(&bar[XB_TOP], 1u);
            const unsigned tg = og / nx;
            if (og + 1u == (tg + 1u) * nx) xb_add(&bar[XB_TOPGEN], 1u);
            else XB_SPIN(xb_ld(&bar[XB_TOPGEN]) == tg, bar);
            __builtin_amdgcn_fence(__ATOMIC_ACQUIRE, "agent");
            xb_add(&bar[XB_XGEN(b.x)], 1u);
            asm volatile("s_waitcnt vmcnt(0)" ::: "memory");
        } else {
            XB_SPIN(xb_ld(&bar[XB_XGEN(b.x)]) == gen, bar);
            __builtin_amdgcn_fence(__ATOMIC_ACQUIRE, "agent");
            asm volatile("s_waitcnt vmcnt(0)" ::: "memory");
        }
    }
    __syncthreads();
}
#define GLAS __attribute__((address_space(3)))
typedef unsigned short bf16_t;
typedef float f32x4 __attribute__((ext_vector_type(4)));
typedef unsigned u32x4 __attribute__((ext_vector_type(4)));
constexpr int NT_TOK = 16384, SEQ = 8192, DM = 1024, DFF = 2816, NTHREADS = 512, NWAVES = 8;
struct KArgs { const float* in[26]; float* out; unsigned char* ws; };
struct ArgRef { unsigned char* ws;
    __device__ __forceinline__ const float* in_(int i) const { const __attribute__((address_space(4))) KArgs* p = (const __attribute__((address_space(4))) KArgs*)__builtin_amdgcn_kernarg_segment_ptr(); asm volatile("" : "+s"(p)); return p->in[i]; }
};

__device__ __forceinline__ unsigned f2bf_rne(float f) { unsigned u = __builtin_bit_cast(unsigned, f); return (u + 0x7fffu + ((u >> 16) & 1u)) >> 16; }
__device__ __forceinline__ unsigned pk2(float lo, float hi) { return f2bf_rne(lo) | (f2bf_rne(hi) << 16); }

struct WSrc { const float* p; int ld; };
template <class Map> __device__ __forceinline__ void conv_weight(GLAS float* scr, int lane, int gw, int ngw, int K, int N, bf16_t* WT, const float* kscale, Map map) {
    asm volatile("" : "+v"(lane));
    const int nblk = N / 64, nitems = (K / 64) * nblk;
    for (int it = gw; it < nitems; it += ngw) {
        const int kb = it / nblk, nb = it % nblk, k0 = 64 * kb, n0 = 64 * nb;
        const WSrc s0 = map(n0), s63 = map(n0 + 63), s31 = map(n0 + 31), s1 = map(n0 + 1), s33 = map(n0 + 33);
        const bool fast = s0.p != nullptr && s63.p == s0.p + 63 && s31.p == s0.p + 31 && s1.p == s0.p + 1 && s33.p == s0.p + 33 && ((((uintptr_t)s0.p) | ((uintptr_t)s0.ld * 4u)) & 15u) == 0u;
        if (fast) {
            const float* src = s0.p + (size_t)(k0 + (lane >> 4)) * s0.ld + (lane & 15) * 4;
            f32x4 v[16];
#pragma unroll
            for (int i = 0; i < 16; ++i) v[i] = *(const f32x4*)(src + (size_t)(4 * i) * s0.ld);
#pragma unroll
            for (int i = 0; i < 16; ++i) { const int kk = 4 * i + (lane >> 4); f32x4 x = v[i]; if (kscale) x = x * kscale[k0 + kk]; GLAS float* d = scr + kk * 65 + (lane & 15) * 4; d[0] = x.x; d[1] = x.y; d[2] = x.z; d[3] = x.w; }
        } else {
#pragma unroll
            for (int hb = 0; hb < 2; ++hb) { const WSrc s = map(n0 + 32 * hb + (lane & 31));
#pragma unroll 8
                for (int i = 0; i < 32; ++i) { const int kk = 2 * i + (lane >> 5); float v = s.p ? s.p[(size_t)(k0 + kk) * s.ld] : 0.f; if (kscale) v *= kscale[k0 + kk]; scr[kk * 65 + 32 * hb + (lane & 31)] = v; } }
        }
        asm volatile("s_waitcnt lgkmcnt(0)" ::: "memory");
        const int c = lane & 7;
#pragma unroll
        for (int j = 0; j < 8; ++j) { const int n = (lane >> 3) + 8 * j; const GLAS float* sp = scr + (8 * c) * 65 + n;
            u32x4 o; o.x = pk2(sp[0 * 65], sp[1 * 65]); o.y = pk2(sp[2 * 65], sp[3 * 65]); o.z = pk2(sp[4 * 65], sp[5 * 65]); o.w = pk2(sp[6 * 65], sp[7 * 65]);
            *(u32x4*)(WT + (size_t)(n0 + n) * K + k0 + 8 * c) = o; }
        asm volatile("s_waitcnt lgkmcnt(0)" ::: "memory");
    }
}
__device__ __forceinline__ void convert_layer(const ArgRef& A, int l, GLAS unsigned char* lds, int lane, int wave, int gw, int ngw) {
    GLAS float* scr = (GLAS float*)(lds + wave * 16640);
    unsigned char* ws = A.ws;
    { const float* G = A.in_(4) + (size_t)l * 1024 * 2816; const float* U = A.in_(5) + (size_t)l * 1024 * 2816;
      conv_weight(scr, lane, gw, ngw, 1024, 5632, (bf16_t*)(ws + W_GU1), nullptr, [=](int n) { const int tl = n >> 8, r = n & 255; const uintptr_t gp = (uintptr_t)G, up = (uintptr_t)U; return WSrc{(const float*)(gp + (up - gp) * (uintptr_t)(r >> 7)) + tl * 128 + (r & 127), 2816}; }); }
    { const float* Dn = A.in_(6) + (size_t)l * 2816 * 1024; conv_weight(scr, lane, gw, ngw, 2816, 1024, (bf16_t*)(ws + W_D1), nullptr, [=](int n) { return WSrc{Dn + n, 1024}; }); }
    { const float* G = A.in_(7) + (size_t)l * 1024 * 2816; const float* U = A.in_(8) + (size_t)l * 1024 * 2816;
      conv_weight(scr, lane, gw, ngw, 1024, 5632, (bf16_t*)(ws + W_GU2), nullptr, [=](int n) { const int tl = n >> 8, r = n & 255; const uintptr_t gp = (uintptr_t)G, up = (uintptr_t)U; return WSrc{(const float*)(gp + (up - gp) * (uintptr_t)(r >> 7)) + tl * 128 + (r & 127), 2816}; }); }
    { const float* Dn = A.in_(9) + (size_t)l * 2816 * 1024; conv_weight(scr, lane, gw, ngw, 2816, 1024, (bf16_t*)(ws + W_D2), nullptr, [=](int n) { return WSrc{Dn + n, 1024}; }); }
    { const float* Wi = A.in_(10) + (size_t)l * 1024 * 4024;
      conv_weight(scr, lane, gw, ngw, 1024, 4096, (bf16_t*)(ws + W_IN), nullptr, [=](int n) {
          int src;
          if (n < 1280) src = n;
          else if (n < 1536) src = 1688 + (n - 1280);
          else if (n < 1792) src = 1304 + (n - 1536);
          else if (n < 2048) { const int r = n - 1792;
              if (r < 128) src = 1304 + 256 + r;
              else if (r < 160) { const int p = r - 128; src = 1944 + ((p & 1) ? 16 + (p >> 1) : (p >> 1)); }
              else if (r < 184) src = 1280 + (r - 160);
              else src = -1; }
          else src = 1976 + (n - 2048);
          return WSrc{src >= 0 ? Wi + src : nullptr, 4024}; }); }
    { const float* Wq = A.in_(18) + (size_t)l * 384 * 768;
      conv_weight(scr, lane, gw, ngw, 384, 768, (bf16_t*)(ws + W_UQ), A.in_(17) + (size_t)l * 384, [=](int n) { const int h = n / 96, p = n % 96; int src = h * 96 + p;
          if (p >= 64) { const int pp = p - 64; src = h * 96 + 64 + ((pp & 1) ? 16 + (pp >> 1) : (pp >> 1)); }
          return WSrc{Wq + src, 768}; }); }
    { const float* Wk = A.in_(20) + (size_t)l * 256 * 512; const float* Wv = A.in_(21) + (size_t)l * 256 * 512;
      conv_weight(scr, lane, gw, ngw, 256, 1024, (bf16_t*)(ws + W_UKV), A.in_(19) + (size_t)l * 256, [=](int n) { const uintptr_t kp = (uintptr_t)Wk, vp = (uintptr_t)Wv; return WSrc{(const float*)(kp + (vp - kp) * (uintptr_t)(n >> 9)) + (n & 511), 512}; }); }
    { const float* Wa = A.in_(22) + (size_t)l * 512 * 1024; conv_weight(scr, lane, gw, ngw, 512, 1024, (bf16_t*)(ws + W_BA), nullptr, [=](int n) { return WSrc{Wa + n, 1024}; }); }
    { const float* Wb = A.in_(23) + (size_t)l * 512 * 1024; conv_weight(scr, lane, gw, ngw, 512, 1024, (bf16_t*)(ws + W_BB), nullptr, [=](int n) { return WSrc{Wb + n, 1024}; }); }
    { const float* Wo = A.in_(24) + (size_t)l * 1024 * 1024; conv_weight(scr, lane, gw, ngw, 1024, 1024, (bf16_t*)(ws + W_OUT), nullptr, [=](int n) { return WSrc{Wo + n, 1024}; }); }
    { const float* W1 = A.in_(11) + (size_t)l * 2048 * 64; conv_weight(scr, lane, gw, ngw, 2048, 64, (bf16_t*)(ws + W_1K), nullptr, [=](int n) { return WSrc{W1 + n, 64}; }); }
    { const float* W1 = A.in_(14) + (size_t)l * 2048 * 64; conv_weight(scr, lane, gw, ngw, 2048, 64, (bf16_t*)(ws + W_1V), nullptr, [=](int n) { return WSrc{W1 + n, 64}; }); }
}
__device__ __forceinline__ void norm_phase(const float* x, bf16_t* xn, const float* sh, const float* sc, int lane, int gw, int ngw) {
    asm volatile("" : "+v"(lane));
    for (int row = gw; row < NT_TOK; row += ngw) {
        const f32x4* xr = (const f32x4*)(x + (size_t)row * DM) + lane; const int b = row >> 13;
        f32x4 v[4]; float s = 0.f;
#pragma unroll
        for (int j = 0; j < 4; ++j) { v[j] = xr[64 * j]; s += (v[j].x * v[j].x + v[j].y * v[j].y) + (v[j].z * v[j].z + v[j].w * v[j].w); }
        const float rstd = 1.0f / sqrtf(wave_sum(s) * (1.0f / DM) + 1e-6f);
        unsigned long long* o8 = (unsigned long long*)(xn + (size_t)row * DM) + lane;
#pragma unroll
        for (int j = 0; j < 4; ++j) { const f32x4 a = *((const f32x4*)(sc + (size_t)b * 9216) + lane + 64 * j), c = *((const f32x4*)(sh + (size_t)b * 9216) + lane + 64 * j);
            const f32x4 y = v[j] * rstd * (a + 1.0f) + c;
            o8[64 * j] = (unsigned long long)pk2(y.x, y.y) | ((unsigned long long)pk2(y.z, y.w) << 32); }
    }
}
__device__ __forceinline__ void final_norm_phase(float* x, const float* wn, int lane, int gw, int ngw) {
    asm volatile("" : "+v"(lane));
    for (int row = gw; row < NT_TOK; row += ngw) {
        f32x4* xr = (f32x4*)(x + (size_t)row * DM) + lane;
        f32x4 v[4]; float s = 0.f;
#pragma unroll
        for (int j = 0; j < 4; ++j) { v[j] = xr[64 * j]; s += (v[j].x * v[j].x + v[j].y * v[j].y) + (v[j].z * v[j].z + v[j].w * v[j].w); }
        const float rstd = 1.0f / sqrtf(wave_sum(s) * (1.0f / DM) + 1e-6f);
#pragma unroll
        for (int j = 0; j < 4; ++j) { const f32x4 w = *((const f32x4*)wn + lane + 64 * j); xr[64 * j] = v[j] * rstd * w; }
    }
}
__device__ __forceinline__ void adaln_phase(const ArgRef& A, GLAS unsigned char* lds, int tid, int lane, int wave, int blk, int nblk) {
    asm volatile("" : "+v"(tid), "+v"(lane));
    GLAS float* ca = (GLAS float*)lds;
    GLAS float* red = (GLAS float*)(lds + 8192);
    for (int i = tid; i < 2048; i += NTHREADS) { const float c = A.in_(1)[i]; ca[i] = c / (1.0f + __expf(-c)); }
    __syncthreads();
    float* mod = (float*)(A.ws + WS_MOD);
    for (int u = blk; u < 288; u += nblk) {
        const int l = u / 144, n0 = (u % 144) * 64;
        const float* W = A.in_(2) + (size_t)l * 1024 * 9216 + n0 + lane;
        float a0 = 0.f, a1 = 0.f;
        const int kb = wave * 128;
#pragma unroll 32
        for (int k = 0; k < 128; ++k) { const float w = W[(size_t)(kb + k) * 9216]; a0 += ca[kb + k] * w; a1 += ca[1024 + kb + k] * w; }
        red[(wave * 2 + 0) * 64 + lane] = a0; red[(wave * 2 + 1) * 64 + lane] = a1;
        __syncthreads();
        if (tid < 128) { const int b = tid >> 6, n = tid & 63; float s = A.in_(3)[(size_t)l * 9216 + n0 + n];
#pragma unroll
            for (int w = 0; w < 8; ++w) s += red[(w * 2 + b) * 64 + n];
            mod[((size_t)l * 2 + b) * 9216 + n0 + n] = s; }
        __syncthreads();
    }
}
__device__ __forceinline__ void rope_table_phase(float* cs, int gtid, int ngt) {
    for (int e = gtid; e < SEQ * 16; e += ngt) { const int t = e >> 4, i = e & 15;
        const float inv = powf(10000.0f, -(float)i / 16.0f); const float ang = (float)t * inv;
        const double rev = (double)ang * 0.15915494309189535; const double fr = rev - __builtin_rint(rev);
        cs[t * 32 + i] = __builtin_amdgcn_cosf((float)fr); cs[t * 32 + 16 + i] = __builtin_amdgcn_sinf((float)fr); }
}
__device__ __forceinline__ void cbias_phase(const ArgRef& A, GLAS unsigned char* lds, int tid, int blk) {
    GLAS float* red = (GLAS float*)(lds + 16384);
    if (blk < 4) { const int l = blk >> 1, kv = blk & 1; const float* pe = A.in_(kv ? 16 : 13) + (size_t)l * 2048; const float* w1 = A.in_(kv ? 14 : 11) + (size_t)l * 2048 * 64;
        const int n = tid & 63, part = tid >> 6; float s = 0.f;
        for (int j = part * 256; j < part * 256 + 256; ++j) s += pe[j] * w1[(size_t)j * 64 + n];
        red[part * 64 + n] = s;
        __syncthreads();
        if (tid < 64) { float t = 0.f;
#pragma unroll
            for (int p = 0; p < 8; ++p) t += red[p * 64 + tid];
            ((float*)(A.ws + WS_CBIAS))[(l * 2 + kv) * 64 + tid] = t; }
        __syncthreads();
    }
}
__device__ __forceinline__ void compress_phase(const ArgRef& A, int l, GLAS unsigned char* lds, int tid, int lane, int wave, int ubeg, int ustep) {
    asm volatile("" : "+v"(tid), "+v"(lane));
    typedef short bf16x8 __attribute__((ext_vector_type(8))); typedef float f32x16 __attribute__((ext_vector_type(16)));
    GLAS float* red = (GLAS float*)lds;
    GLAS float* c1 = (GLAS float*)(lds + 65536);
    const int r32 = lane & 31, hi = lane >> 5;
    for (int u = ubeg; u < 128; u += ustep) {
        const int kv = u >> 6, bg = (u >> 4) & 3, rb = u & 15, i0 = rb * 32;
        const bf16_t* src = (const bf16_t*)(A.ws + (kv ? WS_VCF : WS_KCF)) + (size_t)bg * SEQ * 64;
        const bf16_t* w1t = (const bf16_t*)(A.ws + (kv ? W_1V : W_1K));
        const float* w2 = A.in_(kv ? 15 : 12) + (size_t)l * 4096;
        const float* cb = (const float*)(A.ws + WS_CBIAS) + (l * 2 + kv) * 64;
        f32x16 a0 = f32x16{}, a1 = f32x16{};
        const bf16_t* ap = src + (size_t)(i0 + r32) * 1024 + wave * 256 + hi * 8;
        const bf16_t* bp = w1t + (size_t)r32 * 2048 + wave * 256 + hi * 8;
#pragma unroll 4
        for (int ks = 0; ks < 16; ++ks) {
            const bf16x8 af = *(const bf16x8*)(ap + ks * 16), b0 = *(const bf16x8*)(bp + ks * 16), b1 = *(const bf16x8*)(bp + 32 * 2048 + ks * 16);
            a0 = __builtin_amdgcn_mfma_f32_32x32x16_bf16(af, b0, a0, 0, 0, 0);
            a1 = __builtin_amdgcn_mfma_f32_32x32x16_bf16(af, b1, a1, 0, 0, 0); }
#pragma unroll
        for (int r = 0; r < 16; ++r) { red[wave * 2048 + r * 64 + lane] = a0[r]; red[wave * 2048 + (16 + r) * 64 + lane] = a1[r]; }
        __syncthreads();
#pragma unroll
        for (int j = 0; j < 4; ++j) { const int e = tid + 512 * j; float s = 0.f;
#pragma unroll
            for (int w = 0; w < 8; ++w) s += red[w * 2048 + e];
            const int nt = e >> 10, r = (e >> 6) & 15, ln = e & 63; const int i = (r & 3) + 8 * (r >> 2) + 4 * (ln >> 5), n = 32 * nt + (ln & 31);
            const float xv = s + cb[n]; const float z = 0.7978845608028654f * (xv + 0.044715f * xv * xv * xv);
            const float th = 1.0f - 2.0f * __builtin_amdgcn_rcpf(__builtin_amdgcn_exp2f(2.885390081777927f * z) + 1.0f);
            c1[i * 65 + n] = 0.5f * xv * (1.0f + th); }
        __syncthreads();
        { const int i = tid >> 4, n2 = (tid & 15) * 4; f32x4 o = (f32x4){0.f, 0.f, 0.f, 0.f};
#pragma unroll 8
          for (int k = 0; k < 64; ++k) { const float c = c1[i * 65 + k]; const f32x4 w = *(const f32x4*)(w2 + k * 64 + n2); o += w * c; }
          const int nc = i0 + i; if (nc == 511) o = (f32x4){0.f, 0.f, 0.f, 0.f};
          const size_t tb = (size_t)bg * 8 + (nc >> 6); const int key = nc & 63;
          const unsigned long long pk = (unsigned long long)pk2(o.x, o.y) | ((unsigned long long)pk2(o.z, o.w) << 32);
          if (kv == 0) *(unsigned long long*)((bf16_t*)(A.ws + WS_KC) + (tb * 8 + (n2 >> 3)) * 512 + key * 8 + (n2 & 7)) = pk;
          else *(unsigned long long*)((bf16_t*)(A.ws + WS_VC) + tb * 4096 + (n2 >> 5) * 2048 + key * 32 + (n2 & 31)) = pk; }
        __syncthreads();
    }
}

template <int NC> __device__ __forceinline__ void rstd_table(const bf16_t* X, int row0, GLAS float* tab, float scale, int lane, int wave) {
    for (int r = 0; r < 32; ++r) { const int row = wave * 32 + r; float s = 0.f;
        if (lane < NC / 8) { const u32x4 v = *(const u32x4*)(X + (size_t)(row0 + row) * NC + lane * 8);
            const unsigned w4[4] = {v.x, v.y, v.z, v.w};
#pragma unroll
            for (int i = 0; i < 4; ++i) { const float a = __uint_as_float(w4[i] << 16), b = __uint_as_float(w4[i] & 0xffff0000u); s += a * a + b * b; } }
        s = wave_sum(s);
        if (lane == 0) tab[row] = scale * __builtin_amdgcn_rsqf(s * (1.0f / NC) + 1e-6f); }
}
__device__ __forceinline__ void dump_bf16(float* out, const bf16_t* src, int nslab, int gtid, int ngt) {
    for (int i = gtid; i < NT_TOK * DM; i += ngt) { float s = 0.f; for (int k = 0; k < nslab; ++k) if (k < 3 || i < 14 * 1024 * 1024) s += __uint_as_float(((unsigned)src[(size_t)k * NT_TOK * DM + i]) << 16); out[i] = s; }
}
#ifndef WIN_ALIGN
#define WIN_ALIGN true
#define WIN_SP2 true
#endif
#ifndef STOPAT
#define STOPAT 99
#endif
#ifndef PHMASK
#define PHMASK 0xffffffffu
#endif
#define PH(k) ((PHMASK >> (k)) & 1u)
#ifndef DUPMASK
#define DUPMASK 0u
#endif
#define NREP(k) (((DUPMASK >> (k)) & 1u) ? 2 : 1)
#ifdef TPROBE
#define TSTAMP(k) do { if (blockIdx.x == 0 && wave == 0 && opaque_lane() == 0) { GLAS unsigned* tw_ = (GLAS unsigned*)(lds + 131072 + 8192); const unsigned t_ = (unsigned)__builtin_amdgcn_s_memrealtime(); tw_[k] += t_ - tw_[31]; tw_[31] = t_; } } while (0)
#else
#define TSTAMP(k) do { } while (0)
#endif
#ifndef USE_CG
#define GRIDBAR() xcd_barrier(xbar)
#else
#define GRIDBAR() grid.sync()
#endif
constexpr int LDS_BYTES = 147456;
constexpr size_t WS_BAR = 384 * 1024, BAR_BYTES = 16384;
constexpr int LDS_BARST = 147456 - 64;
__global__ void __launch_bounds__(NTHREADS, 2) hybrid_fwd(KArgs KA) {
    extern __shared__ __attribute__((aligned(16))) unsigned char lds_raw[];
    GLAS unsigned char* lds = (GLAS unsigned char*)lds_raw;
    cg::grid_group grid = cg::this_grid();
    if (threadIdx.x < 8) ((GLAS unsigned*)(lds + LDS_BARST))[threadIdx.x] = 0u;
    __syncthreads();
    XcdBarrier xbar = xcd_barrier_post((unsigned*)(KA.ws + WS_BAR), (volatile GLAS unsigned*)(lds + LDS_BARST));
    const int wave = __builtin_amdgcn_readfirstlane(threadIdx.x >> 6);
#define MYTID() (wave * 64 + opaque_lane())
    int tid = MYTID(), lane = tid & 63; asm volatile("" : "+v"(tid), "+v"(lane));
    const int G = gridDim.x, blk0 = blockIdx.x; int blk = blk0;
    const int vcu = (G % 8 == 0) ? (blk % 8) * (G / 8) + blk / 8 : blk;
    const int gw = blk * NWAVES + wave, ngw = G * NWAVES;
    ArgRef A; A.ws = KA.ws; unsigned char* const ws0 = KA.ws; unsigned char* ws = ws0;
#define PHASE_BEGIN() do { ws = ws0; blk = blk0; asm volatile("" : "+s"(ws), "+s"(blk)); A.ws = ws; tid = MYTID(); lane = tid & 63; asm volatile("" : "+v"(tid), "+v"(lane)); } while (0)
    float* mod = (float*)(ws + WS_MOD);
    float* xres = KA.out;

#ifdef TPROBE
    if (threadIdx.x < 32) ((GLAS unsigned*)(lds + 131072 + 8192))[threadIdx.x] = 0u;
    __syncthreads();
    if (threadIdx.x == 0) ((GLAS unsigned*)(lds + 131072 + 8192))[31] = (unsigned)__builtin_amdgcn_s_memrealtime();
#endif
    for (int rep0 = 0; rep0 < NREP(0); ++rep0) {
    if (PH(0)) adaln_phase(A, lds, tid, lane, wave, blk, G);
    if (PH(1)) rope_table_phase((float*)(ws + WS_CS), blk * NTHREADS + tid, G * NTHREADS);
    if (PH(2)) convert_layer(A, 0, lds, lane, wave, gw, ngw);
    __syncthreads();
    if (PH(3)) cbias_phase(A, lds, tid, blk);
    __syncthreads();
    }
    grid.sync();
    TSTAMP(0);

    for (int l = 0; l < 2; ++l) {
        PHASE_BEGIN();
        const float* ml = mod + (size_t)l * 2 * 9216;
        const float* xin = (l == 0) ? A.in_(0) : xres;
        if (PH(2) && l == 1) { convert_layer(A, 1, lds, lane, wave, gw, ngw); }
        if (PH(4)) norm_phase(xin, (bf16_t*)(ws + WS_XN), ml + 0 * 1024, ml + 1 * 1024, lane, gw, ngw);
        GRIDBAR();
        TSTAMP(1);
        PHASE_BEGIN();
        for (int rep2 = 0; rep2 < NREP(2); ++rep2) {
        if (PH(5)) { pg8::Gemm g{(const bf16_t*)(ws + WS_XN), (const bf16_t*)(ws + W_GU1), NT_TOK, 5632, 1024}; pg8::StaticOrder S; S.init(NT_TOK, 5632, G, blk);
          pg8::EpiSwiGLU E{ws};
          pg8::gemm_phase<pg8::EpiSwiGLU, pg8::StaticOrder, true, true>(lds, g, S, E, wave); }
        GRIDBAR();
        TSTAMP(2);
        PHASE_BEGIN();
        }
        if (STOPAT == 2) { dump_bf16(xres, (const bf16_t*)(ws + WS_C), 4, blk * NTHREADS + tid, G * NTHREADS); return; }
        if (PH(6)) { pg8::Gemm g{(const bf16_t*)(ws + WS_C), (const bf16_t*)(ws + W_D1), NT_TOK, 1024, 2816}; pg8::StaticOrder S; S.init(NT_TOK, 1024, G, blk);
          pg8::EpiResid E{xin, xres, ml + 2 * 1024, 0.5f};
          pg8::gemm_phase<pg8::EpiResid, pg8::StaticOrder, true, true>(lds, g, S, E, wave); }
        GRIDBAR();
        TSTAMP(3);
        PHASE_BEGIN();
        if (STOPAT == 3) {  return; }
        for (int r4 = 0; r4 < NREP(4); ++r4)
        if (PH(4)) norm_phase(xres, (bf16_t*)(ws + WS_XN), ml + 3 * 1024, ml + 4 * 1024, lane, gw, ngw);
#ifdef SENTINEL
        { unsigned* gp = (unsigned*)(ws + WS_GM); for (int i = blk * NTHREADS + tid; i < 16 * 1024 * 1024; i += G * NTHREADS) gp[i] = 0x447a447au; }
#endif
        GRIDBAR();
        TSTAMP(1);
        PHASE_BEGIN();
        if (PH(7)) { pg8::Gemm g{(const bf16_t*)(ws + WS_XN), (const bf16_t*)(ws + W_IN), NT_TOK, 4096, 1024}; pg8::StaticOrder S; S.init(NT_TOK, 4096, G, blk);
          pg8::EpiWin E{ws};
          pg8::gemm_phase<pg8::EpiWin, pg8::StaticOrder, WIN_ALIGN, WIN_SP2>(lds, g, S, E, wave); }
        GRIDBAR();
        TSTAMP(4);
        PHASE_BEGIN();
#ifndef DUMP_OFF
#define DUMP_OFF 84
#define DUMP_SLABS 4
#endif
        if (STOPAT == 5) { dump_bf16(xres, (const bf16_t*)(ws + (size_t)DUMP_OFF * MiB), DUMP_SLABS, blk * NTHREADS + tid, G * NTHREADS); return; }
        if (PH(8)) { pg8::Gemm g{(const bf16_t*)(ws + WS_CQ), (const bf16_t*)(ws + W_UQ), NT_TOK, 768, 384}; pg8::StaticOrder S; S.init(NT_TOK, 768, G, blk);
          { pg8::Unit u0; if (S.next(0, u0)) rstd_table<384>((const bf16_t*)(ws + WS_CQ), u0.pm * 256, (GLAS float*)(lds + 131072), 0.10206207261596577f * 1.4426950408889634f, lane, wave); }
          __syncthreads();
          pg8::EpiQproj E{ws, (const GLAS float*)(lds + 131072)};
          pg8::gemm_phase<pg8::EpiQproj, pg8::StaticOrder, true, true>(lds, g, S, E, wave); }
        if (PH(9)) { pg8::Gemm g{(const bf16_t*)(ws + WS_CKV), (const bf16_t*)(ws + W_UKV), NT_TOK, 1024, 256}; pg8::StaticOrder S; S.init(NT_TOK, 1024, G, blk);
          PHASE_BEGIN();
          { pg8::Unit u0; if (S.next(0, u0)) rstd_table<256>((const bf16_t*)(ws + WS_CKV), u0.pm * 256, (GLAS float*)(lds + 131072 + 1024), 1.0f, lane, wave); }
          __syncthreads();
          pg8::EpiKVproj E{ws, (const GLAS float*)(lds + 131072 + 1024)};
          pg8::gemm_phase<pg8::EpiKVproj, pg8::StaticOrder, true, true>(lds, g, S, E, wave); }
        __syncthreads();
        PHASE_BEGIN();
        if (PH(10)) compress_phase(A, l, lds, tid, lane, wave, (G - 1 - blk), G);
        GRIDBAR();
        TSTAMP(5);
        PHASE_BEGIN();
        if (STOPAT == 6) { dump_bf16(xres, (const bf16_t*)(ws + WS_QM), 2, blk * NTHREADS + tid, G * NTHREADS); return; }
        for (int rep7 = 0; rep7 < NREP(7); ++rep7) {
        { att::NsaT NT{(const bf16_t*)(ws + WS_QN), (const bf16_t*)(ws + WS_KC), (const bf16_t*)(ws + WS_VC), (const bf16_t*)(ws + WS_KSEL), (const bf16_t*)(ws + WS_VSEL),
                       (const bf16_t*)(ws + WS_KWIN), (const bf16_t*)(ws + WS_VWIN), (const float*)(ws + WS_GATES), (bf16_t*)(ws + WS_OA)};
          for (int v = vcu; v < 256; v += G) {
              for (int r11 = 0; r11 < NREP(11); ++r11) if (PH(11)) { const int bh = v >> 4, s = v & 15;
                att::mla_unit(bh >> 3, bh & 7, 31 - s, (const bf16_t*)(ws + WS_QM), (const bf16_t*)(ws + WS_KM), (const bf16_t*)(ws + WS_VM), (bf16_t*)(ws + WS_OB), (GLAS char*)lds, wave);
                att::mla_unit(bh >> 3, bh & 7, s, (const bf16_t*)(ws + WS_QM), (const bf16_t*)(ws + WS_KM), (const bf16_t*)(ws + WS_VM), (bf16_t*)(ws + WS_OB), (GLAS char*)lds, wave); }
              TSTAMP(9);
              for (int r12 = 0; r12 < NREP(12); ++r12) if (PH(12)) { const int bg = v >> 6, s = v & 63;
                att::nsa_unit(bg >> 1, bg & 1, 127 - s, NT, (GLAS char*)lds, wave);
                att::nsa_unit(bg >> 1, bg & 1, s, NT, (GLAS char*)lds, wave); }
              TSTAMP(10);
          } }
        GRIDBAR();
        TSTAMP(6);
        PHASE_BEGIN();
        }
        if (STOPAT == 7) { dump_bf16(xres, (const bf16_t*)(ws + WS_OA), 1, blk * NTHREADS + tid, G * NTHREADS); return; }
        if (PH(13)) { pg8::Gemm g{(const bf16_t*)(ws + WS_OA), (const bf16_t*)(ws + W_BA), NT_TOK, 1024, 512}; pg8::StaticOrder S; S.init(NT_TOK, 1024, G, blk);
          pg8::EpiBranch<0> E{ws};
          pg8::gemm_phase<pg8::EpiBranch<0>, pg8::StaticOrder, true, true>(lds, g, S, E, wave); }
        if (PH(14)) { pg8::Gemm g{(const bf16_t*)(ws + WS_OB), (const bf16_t*)(ws + W_BB), NT_TOK, 1024, 512}; pg8::StaticOrder S; S.init(NT_TOK, 1024, G, blk);
          pg8::EpiBranch<1> E{ws};
          pg8::gemm_phase<pg8::EpiBranch<1>, pg8::StaticOrder, true, true>(lds, g, S, E, wave); }
        GRIDBAR();
        TSTAMP(7);
        PHASE_BEGIN();
        if (STOPAT == 8) { dump_bf16(xres, (const bf16_t*)(ws + WS_Y), 1, blk * NTHREADS + tid, G * NTHREADS); return; }
        if (PH(15)) { pg8::Gemm g{(const bf16_t*)(ws + WS_Y), (const bf16_t*)(ws + W_OUT), NT_TOK, 1024, 1024}; pg8::StaticOrder S; S.init(NT_TOK, 1024, G, blk);
          pg8::EpiResid E{xres, xres, ml + 5 * 1024, 1.0f};
          pg8::gemm_phase<pg8::EpiResid, pg8::StaticOrder, true, true>(lds, g, S, E, wave); }
        GRIDBAR();
        TSTAMP(8);
        PHASE_BEGIN();
        for (int r4 = 0; r4 < NREP(4); ++r4)
        if (PH(4)) norm_phase(xres, (bf16_t*)(ws + WS_XN), ml + 6 * 1024, ml + 7 * 1024, lane, gw, ngw);
        GRIDBAR();
        TSTAMP(1);
        PHASE_BEGIN();
        if (PH(16)) { pg8::Gemm g{(const bf16_t*)(ws + WS_XN), (const bf16_t*)(ws + W_GU2), NT_TOK, 5632, 1024}; pg8::StaticOrder S; S.init(NT_TOK, 5632, G, blk);
          pg8::EpiSwiGLU E{ws};
          pg8::gemm_phase<pg8::EpiSwiGLU, pg8::StaticOrder, true, true>(lds, g, S, E, wave); }
        GRIDBAR();
        TSTAMP(2);
        PHASE_BEGIN();
        if (PH(17)) { pg8::Gemm g{(const bf16_t*)(ws + WS_C), (const bf16_t*)(ws + W_D2), NT_TOK, 1024, 2816}; pg8::StaticOrder S; S.init(NT_TOK, 1024, G, blk);
          pg8::EpiResid E{xres, xres, ml + 8 * 1024, 0.5f};
          pg8::gemm_phase<pg8::EpiResid, pg8::StaticOrder, true, true>(lds, g, S, E, wave); }
        GRIDBAR();
        TSTAMP(3);
        PHASE_BEGIN();
    }
    tid = MYTID(); lane = tid & 63; asm volatile("" : "+v"(tid), "+v"(lane));
    if (PH(18)) final_norm_phase(xres, A.in_(25), lane, gw, ngw);
#ifdef TPROBE
    TSTAMP(11);
    __syncthreads();
    if (blockIdx.x == 0 && wave == 0 && opaque_lane() == 0) { const GLAS unsigned* ta = (const GLAS unsigned*)(lds + 131072 + 8192);
        asm volatile("s_waitcnt vmcnt(0)" ::: "memory");
        xres[0] = 0.01f * (float)ta[TPA]; const float vb = 0.01f * (float)ta[TPB]; for (int i = 1; i <= 100; ++i) xres[i] = vb; }
#endif
}

extern "C" void kernel_launch(void* const* d_in, const int* in_sizes, int n_in, void* d_out, int out_size, void* d_ws, size_t ws_size, hipStream_t stream) {
    static int grid_blocks = 0;
    if (grid_blocks == 0) {
        if (n_in != 26 || out_size != NT_TOK * DM || ws_size < WS_TOTAL) { fprintf(stderr, "kernel_launch: unexpected problem (n_in %d out %d ws %zu)\n", n_in, out_size, ws_size); grid_blocks = -1; return; }
        int dev = 0, cus = 0, per_cu = 0;
        hipGetDevice(&dev);
        hipDeviceGetAttribute(&cus, hipDeviceAttributeMultiprocessorCount, dev);
        hipFuncSetAttribute((const void*)hybrid_fwd, hipFuncAttributeMaxDynamicSharedMemorySize, LDS_BYTES);
        hipOccupancyMaxActiveBlocksPerMultiprocessor(&per_cu, (const void*)hybrid_fwd, NTHREADS, LDS_BYTES);
        if (per_cu < 1) { fprintf(stderr, "kernel_launch: occupancy query says %d blocks per CU\n", per_cu); per_cu = 1; }
        if (per_cu > 1) per_cu = 1;
        grid_blocks = cus * per_cu;
        (void)hipGetLastError();
    }
    if (grid_blocks < 0) return;
    if (hipMemsetAsync((char*)d_ws + WS_BAR, 0, BAR_BYTES, stream) != hipSuccess) { fprintf(stderr, "kernel_launch: memset failed\n"); return; }
    KArgs a{};
    for (int i = 0; i < 26; ++i) a.in[i] = (const float*)d_in[i];
    a.out = (float*)d_out; a.ws = (unsigned char*)d_ws;
    void* args[] = {&a};
    hipError_t e = hipLaunchCooperativeKernel((const void*)hybrid_fwd, dim3(grid_blocks), dim3(NTHREADS), args, LDS_BYTES, stream);
    if (e != hipSuccess) fprintf(stderr, "cooperative launch failed: %s (grid %d)\n", hipGetErrorString(e), grid_blocks);
}
```

```cpp
#include <hip/hip_runtime.h>
#include <hip/hip_cooperative_groups.h>
#include <cstdio>
#include <cstdint>
namespace cg = cooperative_groups;

constexpr size_t MiB = 1u << 20;
constexpr size_t WS_MOD = 0;
constexpr size_t WS_CBIAS = 256 * 1024;
constexpr size_t WS_ERR = 384 * 1024;
constexpr size_t WS_SSQQ = 512 * 1024;
constexpr size_t WS_SSQKV = 640 * 1024;
constexpr size_t WS_GATES = 1 * MiB;
constexpr size_t WS_CS = 3 * MiB;
constexpr size_t WS_W = 4 * MiB;
constexpr size_t W_GU1 = WS_W, W_D1 = W_GU1 + (size_t)5632 * 1024 * 2, W_GU2 = W_D1 + (size_t)1024 * 2816 * 2, W_D2 = W_GU2 + (size_t)5632 * 1024 * 2;
constexpr size_t W_IN = W_D2 + (size_t)1024 * 2816 * 2, W_UQ = W_IN + (size_t)4096 * 1024 * 2, W_UKV = W_UQ + (size_t)768 * 384 * 2, W_BA = W_UKV + (size_t)1024 * 256 * 2;
constexpr size_t W_BB = W_BA + (size_t)1024 * 512 * 2, W_OUT = W_BB + (size_t)1024 * 512 * 2, W_1K = W_OUT + (size_t)1024 * 1024 * 2, W_1V = W_1K + (size_t)64 * 2048 * 2, W_END = W_1V + (size_t)64 * 2048 * 2;
static_assert(W_END <= 52 * MiB, "weights region");
constexpr size_t WS_XN = 52 * MiB;
constexpr size_t WS_OA = 52 * MiB, WS_OB = 68 * MiB;
constexpr size_t WS_C = 84 * MiB;
constexpr size_t WS_QN = 84 * MiB, WS_KCF = 100 * MiB, WS_VCF = 104 * MiB, WS_KSEL = 108 * MiB, WS_VSEL = 112 * MiB, WS_KWIN = 116 * MiB, WS_VWIN = 120 * MiB;
constexpr size_t WS_CQ = 124 * MiB, WS_CKV = 136 * MiB, WS_GM = 144 * MiB, WS_KC = 208 * MiB, WS_VC = 208 * MiB + 256 * 1024;
constexpr size_t WS_QM = 212 * MiB, WS_KM = 236 * MiB, WS_VM = 260 * MiB, WS_Y = 212 * MiB, WS_TOTAL = 276 * MiB;


__device__ __forceinline__ int opaque_lane() { unsigned z; asm volatile("v_mov_b32 %0, 0" : "=v"(z)); return (int)__builtin_amdgcn_mbcnt_hi(~0u, __builtin_amdgcn_mbcnt_lo(~0u, z)); }
template <int K> __device__ __forceinline__ float swz_xor(float v) { return __int_as_float(__builtin_amdgcn_ds_swizzle(__float_as_int(v), (K << 10) | 0x1f)); }
__device__ __forceinline__ float half_sum(float v) { auto rr = __builtin_amdgcn_permlane32_swap(__float_as_uint(v), __float_as_uint(v), false, false); return __uint_as_float(rr[0]) + __uint_as_float(rr[1]); }
__device__ __forceinline__ float wave_sum(float v) { v += swz_xor<1>(v); v += swz_xor<2>(v); v += swz_xor<4>(v); v += swz_xor<8>(v); v += swz_xor<16>(v); return half_sum(v); }
namespace pg8 {
#define PG8_LAS __attribute__((address_space(3)))
typedef unsigned short bf16_t;
typedef short bf16x8 __attribute__((ext_vector_type(8)));
typedef float f32x4 __attribute__((ext_vector_type(4)));
typedef unsigned u32x4 __attribute__((ext_vector_type(4)));
constexpr int BM = 256, BK = 64, HALF = 128, HTB = HALF * BK * 2  , STAGE_BYTES = 8 * HTB, NXCD = 8, WGM = 8;

__host__ __device__ __forceinline__ int lds_byte(int r, int c) { const int st = (r >> 4) * 2 + (c >> 5), rr = r & 15, cc = c & 31, ob = rr * 64 + cc * 2; return st * 1024 + (ob ^ (((ob >> 9) & 1) << 5)); }
__host__ __device__ __forceinline__ void stage_rc(int b, int& R, int& C) { const int st = b / 1024, sb = b % 1024, swz = sb ^ (((sb >> 9) & 1) << 5); R = (st >> 1) * 16 + swz / 64; C = (st & 1) * 32 + (swz % 64) / 2; }
__host__ __device__ __forceinline__ int perm32(int rho) { const int n = rho >> 4, i = rho & 15; return 8 * (i >> 2) + 4 * n + (i & 3); }

struct Unit { int pm, pn; };
struct Gemm { const bf16_t* A; const bf16_t* Bt; int M, N, K; };

struct StaticOrder {
    int nM, nN, nwg, G, c;
    __host__ __device__ __forceinline__ void init(int M, int N, int G_, int c_) { nM = M / BM; nN = N / BM; nwg = nM * nN; G = G_; c = c_; }
    __host__ __device__ __forceinline__ bool next(int i, Unit& u) const {
        const long L = (long)i * G + c; if (L >= nwg) return false;
        int wgid = (int)L; { const int q = nwg / NXCD, r = nwg % NXCD, xcd = wgid % NXCD, off = wgid / NXCD; wgid = (xcd < r ? xcd * (q + 1) : r * (q + 1) + (xcd - r) * q) + off; }
        const int nig = WGM * nN, gid = wgid / nig, fm = gid * WGM, gsz = (nM - fm) < WGM ? (nM - fm) : WGM;
        u.pm = fm + ((wgid % nig) % gsz); u.pn = (wgid % nig) / gsz; return true;
    }
    __device__ __forceinline__ void a_ready(const Unit&) const {}
    __device__ __forceinline__ void done(const Unit&) const {}
};

typedef float cvt_f32x2_t __attribute__((ext_vector_type(2))); typedef __bf16 cvt_bf16x2_t __attribute__((ext_vector_type(2)));
__device__ __forceinline__ unsigned cvt_pk_bf16(float lo, float hi) { cvt_f32x2_t v = {lo, hi}; cvt_bf16x2_t b = __builtin_convertvector(v, cvt_bf16x2_t); return __builtin_bit_cast(unsigned, b); }
typedef float f32x2 __attribute__((ext_vector_type(2)));
constexpr int SEQL = 8192, DMODEL = 1024, DFFN = 2816;
constexpr float LOG2E = 1.4426950408889634f;
constexpr float QSC_NSA = 0.125f * LOG2E;
constexpr float QSC_MLA = 0.10206207261596577f * LOG2E;
constexpr float NEPS = 1e-6f;
__device__ __forceinline__ float sigm(float x) { return __builtin_amdgcn_rcpf(1.0f + __builtin_amdgcn_exp2f(-LOG2E * x)); }
__device__ __forceinline__ void st8(bf16_t* p, f32x4 a0, f32x4 a1) {
    u32x4 w; w.x = cvt_pk_bf16(a0[0], a0[1]); w.y = cvt_pk_bf16(a0[2], a0[3]); w.z = cvt_pk_bf16(a1[0], a1[1]); w.w = cvt_pk_bf16(a1[2], a1[3]); *(u32x4*)p = w; }
__device__ __forceinline__ float bf2f(unsigned short h) { return __uint_as_float(((unsigned)h) << 16); }

struct EpiSwiGLU { static constexpr bool PERM = true, AFTER_DRAIN = false; unsigned char* ws;
    __device__ __forceinline__ void operator()(const f32x4 (&acc)[2][2][4][2], const Unit& u, int wr, int wc, int fr, int fq) const {
        { const int ln_ = opaque_lane(); fr = ln_ & 15; fq = ln_ >> 4; }
        const int row0 = u.pm * BM + wr * 64 + fr, col0 = u.pn * 128 + wc * 32 + 8 * fq;
#pragma unroll
        for (int ai = 0; ai < 2; ++ai)
#pragma unroll
            for (int m = 0; m < 4; ++m) { bf16_t* rowp = (bf16_t*)(ws + WS_C) + (size_t)(row0 + ai * HALF + m * 16) * DFFN + col0;
                f32x4 h0, h1;
#pragma unroll
                for (int j = 0; j < 4; ++j) { const float g0 = acc[ai][0][m][0][j], g1 = acc[ai][0][m][1][j];
                    h0[j] = g0 * sigm(g0) * acc[ai][1][m][0][j]; h1[j] = g1 * sigm(g1) * acc[ai][1][m][1][j]; }
                st8(rowp, h0, h1); }
    }
};
struct EpiResid { static constexpr bool PERM = false, AFTER_DRAIN = false; const float* xin; float* xout; const float* gate; float gs;
    __device__ __forceinline__ void operator()(const f32x4 (&acc)[2][2][4][2], const Unit& u, int wr, int wc, int fr, int fq) const {
        { const int ln_ = opaque_lane(); fr = ln_ & 15; fq = ln_ >> 4; }
        const int col0 = u.pn * BM + wc * 32 + 4 * fq; const int b = (u.pm * BM) >> 13;
        f32x4 gv[2][2];
#pragma unroll
        for (int bj = 0; bj < 2; ++bj)
#pragma unroll
            for (int n = 0; n < 2; ++n) gv[bj][n] = *(const f32x4*)(gate + (size_t)b * 9216 + col0 + bj * HALF + n * 16) * gs;
#pragma unroll
        for (int ai = 0; ai < 2; ++ai)
#pragma unroll
            for (int m = 0; m < 4; ++m) { const size_t off = (size_t)(u.pm * BM + ai * HALF + wr * 64 + m * 16 + fr) * DMODEL + col0;
#pragma unroll
                for (int bj = 0; bj < 2; ++bj)
#pragma unroll
                    for (int n = 0; n < 2; ++n) { const f32x4 xv = *(const f32x4*)(xin + off + bj * HALF + n * 16);
                        *(f32x4*)(xout + off + bj * HALF + n * 16) = xv + gv[bj][n] * acc[ai][bj][m][n]; }
                if (m & 1) asm volatile("" ::: "memory"); }
    }
};
struct EpiWin { static constexpr bool PERM = true, AFTER_DRAIN = false;
    unsigned char* ws;
    __device__ __forceinline__ void operator()(const f32x4 (&acc)[2][2][4][2], const Unit& u, int wr, int wc, int fr, int fq) const {
        { const int ln_ = opaque_lane(); fr = ln_ & 15; fq = ln_ >> 4; }
        bf16_t* const Qn = (bf16_t*)(ws + WS_QN); bf16_t* const kcf = (bf16_t*)(ws + WS_KCF); bf16_t* const vcf = (bf16_t*)(ws + WS_VCF); bf16_t* const Ksel = (bf16_t*)(ws + WS_KSEL); bf16_t* const Vsel = (bf16_t*)(ws + WS_VSEL);
        bf16_t* const Kwin = (bf16_t*)(ws + WS_KWIN); bf16_t* const Vwin = (bf16_t*)(ws + WS_VWIN); bf16_t* const cq = (bf16_t*)(ws + WS_CQ); bf16_t* const ckv = (bf16_t*)(ws + WS_CKV); bf16_t* const Km = (bf16_t*)(ws + WS_KM); bf16_t* const gm = (bf16_t*)(ws + WS_GM);
        float* const gates = (float*)(ws + WS_GATES); const float* const cs = (const float*)(ws + WS_CS);
        const int pn = u.pn;
#pragma unroll
        for (int ai = 0; ai < 2; ++ai)
#pragma unroll
            for (int m = 0; m < 4; ++m) {
                const int row = u.pm * BM + ai * HALF + wr * 64 + m * 16 + fr, b = row >> 13, t = row & (SEQL - 1);
                const int d = wc * 32 + 8 * fq;
                if (pn < 2) {
#pragma unroll
                    for (int bj = 0; bj < 2; ++bj) st8(Qn + (size_t)row * 512 + pn * 256 + bj * HALF + d, acc[ai][bj][m][0] * QSC_NSA, acc[ai][bj][m][1] * QSC_NSA);
                } else if (pn == 2) {
                    const int g = d >> 6, dd = d & 63; const size_t o = ((size_t)(b * 2 + g) * SEQL + t) * 64 + dd;
                    st8(kcf + o, acc[ai][0][m][0], acc[ai][0][m][1]); st8(vcf + o, acc[ai][1][m][0], acc[ai][1][m][1]);
                } else if (pn == 3 || pn == 4) {
                    bf16_t* Kd = pn == 3 ? Ksel : Kwin; bf16_t* Vd = pn == 3 ? Vsel : Vwin;
                    const int g = d >> 6, dd = d & 63; const size_t tb = (size_t)(b * 2 + g) * 128 + (t >> 6);
                    st8(Kd + (tb * 8 + (dd >> 3)) * 512 + (t & 63) * 8, acc[ai][0][m][0], acc[ai][0][m][1]);
                    st8(Vd + tb * 4096 + (dd >> 5) * 2048 + (t & 63) * 32 + (dd & 31), acc[ai][1][m][0], acc[ai][1][m][1]);
                } else if (pn == 5 || pn == 6) {
#pragma unroll
                    for (int bj = 0; bj < 2; ++bj) { const f32x4 a0 = acc[ai][bj][m][0], a1 = acc[ai][bj][m][1];
                        if (pn == 5) st8(ckv + (size_t)row * 256 + bj * HALF + d, a0, a1); else st8(cq + (size_t)row * 384 + bj * HALF + d, a0, a1); }
                } else if (pn == 7) {
                    st8(cq + (size_t)row * 384 + 256 + d, acc[ai][0][m][0], acc[ai][0][m][1]);
                    const f32x4 a0 = acc[ai][1][m][0], a1 = acc[ai][1][m][1];
                    if (wc == 0) {
                        const f32x4 c4 = *(const f32x4*)(cs + (size_t)t * 32 + 4 * fq), s4 = *(const f32x4*)(cs + (size_t)t * 32 + 16 + 4 * fq);
                        f32x4 o0, o1;
                        o0[0] = a0[0] * c4[0] - a0[1] * s4[0]; o0[1] = a0[0] * s4[0] + a0[1] * c4[0];
                        o0[2] = a0[2] * c4[1] - a0[3] * s4[1]; o0[3] = a0[2] * s4[1] + a0[3] * c4[1];
                        o1[0] = a1[0] * c4[2] - a1[1] * s4[2]; o1[1] = a1[0] * s4[2] + a1[1] * c4[2];
                        o1[2] = a1[2] * c4[3] - a1[3] * s4[3]; o1[3] = a1[2] * s4[3] + a1[3] * c4[3];
#pragma unroll
                        for (int h = 0; h < 8; ++h) st8(Km + (((size_t)(b * 8 + h) * 128 + (t >> 6)) * 12 + 8 + fq) * 512 + (t & 63) * 8, o0, o1);
                    } else if (wc == 1 && fq < 3) {
                        float* gp = gates + (size_t)row * 24 + 8 * fq; f32x4 g0, g1;
#pragma unroll
                        for (int j = 0; j < 4; ++j) { g0[j] = sigm(a0[j]); g1[j] = sigm(a1[j]); }
                        *(f32x4*)gp = g0; *(f32x4*)(gp + 4) = g1;
                    }
                } else {
#pragma unroll
                    for (int bj = 0; bj < 2; ++bj) { f32x4 g0, g1;
#pragma unroll
                        for (int j = 0; j < 4; ++j) { g0[j] = sigm(acc[ai][bj][m][0][j]); g1[j] = sigm(acc[ai][bj][m][1][j]); }
                        st8(gm + (size_t)row * 2048 + (pn - 8) * 256 + bj * HALF + d, g0, g1); }
                }
                asm volatile("" ::: "memory");
            }
    }
};
struct EpiQproj { static constexpr bool PERM = true, AFTER_DRAIN = false; unsigned char* ws; const PG8_LAS float* tab;
    __device__ __forceinline__ void operator()(const f32x4 (&acc)[2][2][4][2], const Unit& u, int wr, int wc, int fr, int fq) const {
        { const int ln_ = opaque_lane(); fr = ln_ & 15; fq = ln_ >> 4; }
        bf16_t* const Qm = (bf16_t*)(ws + WS_QM); const float* const cs = (const float*)(ws + WS_CS);
#pragma unroll
        for (int ai = 0; ai < 2; ++ai)
#pragma unroll
            for (int m = 0; m < 4; ++m) {
                const int row = u.pm * BM + ai * HALF + wr * 64 + m * 16 + fr, t = row & (SEQL - 1);
                const float rs = tab[ai * HALF + wr * 64 + m * 16 + fr];
#pragma unroll
                for (int bj = 0; bj < 2; ++bj) { const int n = u.pn * BM + bj * HALF + wc * 32 + 8 * fq; const int p = n % 96;
                    f32x4 a0 = acc[ai][bj][m][0] * rs, a1 = acc[ai][bj][m][1] * rs;
                    if (p >= 64) { const int i0 = (p - 64) >> 1;
                        const f32x4 c4 = *(const f32x4*)(cs + (size_t)t * 32 + i0), s4 = *(const f32x4*)(cs + (size_t)t * 32 + 16 + i0);
                        f32x4 o0, o1;
                        o0[0] = a0[0] * c4[0] - a0[1] * s4[0]; o0[1] = a0[0] * s4[0] + a0[1] * c4[0];
                        o0[2] = a0[2] * c4[1] - a0[3] * s4[1]; o0[3] = a0[2] * s4[1] + a0[3] * c4[1];
                        o1[0] = a1[0] * c4[2] - a1[1] * s4[2]; o1[1] = a1[0] * s4[2] + a1[1] * c4[2];
                        o1[2] = a1[2] * c4[3] - a1[3] * s4[3]; o1[3] = a1[2] * s4[3] + a1[3] * c4[3];
                        a0 = o0; a1 = o1; }
                    st8(Qm + (size_t)row * 768 + n, a0, a1); }
                asm volatile("" ::: "memory");
            }
    }
};
struct EpiKVproj { static constexpr bool PERM = true, AFTER_DRAIN = false; unsigned char* ws; const PG8_LAS float* tab;
    __device__ __forceinline__ void operator()(const f32x4 (&acc)[2][2][4][2], const Unit& u, int wr, int wc, int fr, int fq) const {
        { const int ln_ = opaque_lane(); fr = ln_ & 15; fq = ln_ >> 4; }
        bf16_t* const Km = (bf16_t*)(ws + WS_KM); bf16_t* const Vm = (bf16_t*)(ws + WS_VM);
#pragma unroll
        for (int ai = 0; ai < 2; ++ai)
#pragma unroll
            for (int m = 0; m < 4; ++m) {
                const int row = u.pm * BM + ai * HALF + wr * 64 + m * 16 + fr, b = row >> 13, t = row & (SEQL - 1);
                const float rs = tab[ai * HALF + wr * 64 + m * 16 + fr];
#pragma unroll
                for (int bj = 0; bj < 2; ++bj) { const int n = (u.pn & 1) * BM + bj * HALF + wc * 32 + 8 * fq; const int h = n >> 6, dd = n & 63;
                    const f32x4 a0 = acc[ai][bj][m][0] * rs, a1 = acc[ai][bj][m][1] * rs; const size_t tb = (size_t)(b * 8 + h) * 128 + (t >> 6);
                    if (u.pn < 2) st8(Km + (tb * 12 + (dd >> 3)) * 512 + (t & 63) * 8, a0, a1);
                    else st8(Vm + tb * 4096 + (dd >> 5) * 2048 + (t & 63) * 32 + (dd & 31), a0, a1); }
                asm volatile("" ::: "memory");
            }
    }
};
template <int PASS> struct EpiBranch { static constexpr bool PERM = true, AFTER_DRAIN = false; unsigned char* ws;
    __device__ __forceinline__ void operator()(const f32x4 (&acc)[2][2][4][2], const Unit& u, int wr, int wc, int fr, int fq) const {
        { const int ln_ = opaque_lane(); fr = ln_ & 15; fq = ln_ >> 4; }
        bf16_t* const Y = (bf16_t*)(ws + WS_Y); const bf16_t* const gm = (const bf16_t*)(ws + WS_GM);
#pragma unroll
        for (int ai = 0; ai < 2; ++ai)
#pragma unroll
            for (int m = 0; m < 4; ++m) { const int row = u.pm * BM + ai * HALF + wr * 64 + m * 16 + fr;
#pragma unroll
                for (int bj = 0; bj < 2; ++bj) { const int n = u.pn * BM + bj * HALF + wc * 32 + 8 * fq;
                    const u32x4 gw = *(const u32x4*)(gm + (size_t)row * 2048 + PASS * 1024 + n);
                    f32x4 a0 = acc[ai][bj][m][0], a1 = acc[ai][bj][m][1];
                    a0[0] *= __uint_as_float(gw.x << 16); a0[1] *= __uint_as_float(gw.x & 0xffff0000u); a0[2] *= __uint_as_float(gw.y << 16); a0[3] *= __uint_as_float(gw.y & 0xffff0000u);
                    a1[0] *= __uint_as_float(gw.z << 16); a1[1] *= __uint_as_float(gw.z & 0xffff0000u); a1[2] *= __uint_as_float(gw.w << 16); a1[3] *= __uint_as_float(gw.w & 0xffff0000u);
                    bf16_t* yp = Y + (size_t)row * DMODEL + n;
                    if (PASS == 1) { const u32x4 yw = *(const u32x4*)yp;
                        a0[0] += __uint_as_float(yw.x << 16); a0[1] += __uint_as_float(yw.x & 0xffff0000u); a0[2] += __uint_as_float(yw.y << 16); a0[3] += __uint_as_float(yw.y & 0xffff0000u);
                        a1[0] += __uint_as_float(yw.z << 16); a1[1] += __uint_as_float(yw.z & 0xffff0000u); a1[2] += __uint_as_float(yw.w << 16); a1[3] += __uint_as_float(yw.w & 0xffff0000u); }
                    st8(yp, a0, a1); }
            }
    }
};
template <class Epi, class Sched, bool ALIGN_EPI = false, bool SP2 = false>
__device__ __forceinline__ void gemm_phase(PG8_LAS unsigned char* lds, const Gemm g, const Sched& S, const Epi& E, int wave_id) {
    int tid_ = wave_id * 64 + opaque_lane();
    const int tid = tid_, wid = __builtin_amdgcn_readfirstlane(tid >> 6), lane = tid & 63, wr = wid >> 2, wc = wid & 3, fr = lane & 15, fq = lane >> 4;
    const int K = g.K, nt = K / BK;
    unsigned voffA[2], voffB[2];
#pragma unroll
    for (int i = 0; i < 2; ++i) { int R, C; stage_rc(tid * 16 + i * 8192, R, C); const int Rb = Epi::PERM ? ((R & ~31) + perm32(R & 31)) : R;
        voffA[i] = (unsigned)(R * K + C) * 2u; voffB[i] = (unsigned)(Rb * K + C) * 2u; }
    const size_t kstep = (size_t)(BK * 2);
    const size_t hstep = (size_t)HALF * K * 2;
    const size_t tstep = 2 * hstep;
    const unsigned ldsw = (unsigned)wid * 1024u;
    const int aoff = lds_byte(wr * 64 + fr, fq * 8), boff = lds_byte(wc * 32 + fr, fq * 8);
#define PG8_SA(b, h) (((b) * 2 + (h)) * HTB)
#define PG8_SB(b, h) ((4 + (b) * 2 + (h)) * HTB)
#define PG8_STAGE(bufoff, gbase, voff) do { _Pragma("unroll") for (int _i = 0; _i < 2; ++_i) \
        __builtin_amdgcn_global_load_lds((const unsigned*)((const char*)(gbase) + (voff)[_i]), (PG8_LAS unsigned*)(lds + (bufoff) + ldsw + _i * 8192), 16, 0, 0); } while (0)
#define PG8_LDA(dst, b, h) do { _Pragma("unroll") for (int m = 0; m < 4; ++m) _Pragma("unroll") for (int k = 0; k < 2; ++k) dst[m][k] = *(const PG8_LAS bf16x8*)(lds + PG8_SA(b, h) + aoff + m * 2048 + k * 1024); } while (0)
#define PG8_LDB(dst, b, h) do { _Pragma("unroll") for (int n = 0; n < 2; ++n) _Pragma("unroll") for (int k = 0; k < 2; ++k) dst[n][k] = *(const PG8_LAS bf16x8*)(lds + PG8_SB(b, h) + boff + n * 2048 + k * 1024); } while (0)
#define PG8_MMA(ai, bj, At, Bt) do { __builtin_amdgcn_s_setprio(1); _Pragma("unroll") for (int m = 0; m < 4; ++m) _Pragma("unroll") for (int n = 0; n < 2; ++n) _Pragma("unroll") for (int k = 0; k < 2; ++k) \
        acc[ai][bj][m][n] = __builtin_amdgcn_mfma_f32_16x16x32_bf16(Bt[n][k], At[m][k], acc[ai][bj][m][n], 0, 0, 0); __builtin_amdgcn_s_setprio(0); } while (0)
#define PG8_WAIT_V(n) asm volatile("s_waitcnt vmcnt(" #n ")" ::: "memory")
#define PG8_WAIT_L(n) asm volatile("s_waitcnt lgkmcnt(" #n ")" ::: "memory")
#define PG8_BAR __builtin_amdgcn_s_barrier()
#define PG8_SCHED __builtin_amdgcn_sched_barrier(0)
    Unit cur, nxt; int ui = 0;
    if (!S.next(0, cur)) return;
    f32x4 acc[2][2][4][2];
#pragma unroll
    for (int a = 0; a < 2; ++a)
#pragma unroll
        for (int b = 0; b < 2; ++b)
#pragma unroll
            for (int m = 0; m < 4; ++m)
#pragma unroll
                for (int n = 0; n < 2; ++n) acc[a][b][m][n] = (f32x4){0.f, 0.f, 0.f, 0.f};
    bf16x8 At[4][2], B0[2][2], B1[2][2];
    const char* cA = (const char*)g.A + (size_t)cur.pm * tstep; const char* cB = (const char*)g.Bt + (size_t)cur.pn * tstep;
    S.a_ready(cur);
    if constexpr (SP2) {
        PG8_STAGE(PG8_SB(0, 0), cB, voffB); PG8_STAGE(PG8_SB(0, 1), cB + hstep, voffB); PG8_STAGE(PG8_SA(0, 0), cA, voffA); PG8_STAGE(PG8_SA(0, 1), cA + hstep, voffA);
        if (wr == 1) PG8_BAR;
        PG8_WAIT_V(2); PG8_BAR;
        PG8_STAGE(PG8_SB(1, 0), cB + kstep, voffB); PG8_STAGE(PG8_SA(1, 0), cA + kstep, voffA); PG8_STAGE(PG8_SB(1, 1), cB + hstep + kstep, voffB);
        PG8_WAIT_V(6); PG8_BAR;
    } else {
        PG8_STAGE(PG8_SB(0, 0), cB, voffB); PG8_STAGE(PG8_SA(0, 0), cA, voffA); PG8_STAGE(PG8_SB(0, 1), cB + hstep, voffB); PG8_STAGE(PG8_SA(0, 1), cA + hstep, voffA);
        if (wr == 1) PG8_BAR;
        PG8_WAIT_V(4); PG8_BAR;
        PG8_STAGE(PG8_SB(1, 0), cB + kstep, voffB); PG8_STAGE(PG8_SA(1, 0), cA + kstep, voffA); PG8_STAGE(PG8_SB(1, 1), cB + hstep + kstep, voffB);
        PG8_WAIT_V(6); PG8_BAR;
    }
    for (;;) {
        const bool has_next = S.next(ui + 1, nxt);
        const char* nA = has_next ? (const char*)g.A + (size_t)nxt.pm * tstep : cA; const char* nB = has_next ? (const char*)g.Bt + (size_t)nxt.pn * tstep : cB;
        for (int t = 0; t < nt; t += 2) {
            const bool last = (t == nt - 2);
            const char* a1 = cA + (size_t)(t + 1) * kstep;
            const char* a2 = last ? nA : cA + (size_t)(t + 2) * kstep; const char* b2 = last ? nB : cB + (size_t)(t + 2) * kstep;
            const char* a3 = a2 + kstep; const char* b3 = b2 + kstep;
            if (last && has_next) S.a_ready(nxt);
            if constexpr (SP2) {
            PG8_LDB(B0, 0, 0); PG8_LDB(B1, 0, 1); PG8_SCHED; PG8_LDA(At, 0, 0); PG8_STAGE(PG8_SA(1, 1), a1 + hstep, voffA);
            PG8_WAIT_V(8); PG8_WAIT_L(0); PG8_BAR; PG8_MMA(0, 0, At, B0); PG8_MMA(0, 1, At, B1); PG8_BAR; PG8_SCHED;
            PG8_LDA(At, 0, 1); PG8_STAGE(PG8_SB(0, 0), b2, voffB); PG8_STAGE(PG8_SB(0, 1), b2 + hstep, voffB); PG8_STAGE(PG8_SA(0, 0), a2, voffA);
            PG8_WAIT_V(8); PG8_WAIT_L(0); PG8_BAR; PG8_MMA(1, 0, At, B0); PG8_MMA(1, 1, At, B1); PG8_BAR; PG8_SCHED;
            PG8_LDB(B0, 1, 0); PG8_LDB(B1, 1, 1); PG8_SCHED; PG8_LDA(At, 1, 0); PG8_STAGE(PG8_SA(0, 1), a2 + hstep, voffA);
            PG8_WAIT_V(8); PG8_WAIT_L(0); PG8_BAR; PG8_MMA(0, 0, At, B0); PG8_MMA(0, 1, At, B1); PG8_BAR; PG8_SCHED;
            PG8_LDA(At, 1, 1); PG8_STAGE(PG8_SB(1, 0), b3, voffB); PG8_STAGE(PG8_SB(1, 1), b3 + hstep, voffB); PG8_STAGE(PG8_SA(1, 0), a3, voffA);
            PG8_WAIT_V(8); PG8_WAIT_L(0); PG8_BAR; PG8_MMA(1, 0, At, B0); PG8_MMA(1, 1, At, B1); PG8_BAR; PG8_SCHED;
            } else {
            PG8_LDB(B0, 0, 0); PG8_SCHED; PG8_LDA(At, 0, 0); PG8_STAGE(PG8_SA(1, 1), a1 + hstep, voffA);
            PG8_WAIT_L(8); PG8_BAR; PG8_WAIT_L(0); PG8_MMA(0, 0, At, B0); PG8_BAR; PG8_SCHED;
            PG8_LDB(B1, 0, 1); PG8_STAGE(PG8_SB(0, 0), b2, voffB);
            PG8_BAR; PG8_WAIT_L(0); PG8_MMA(0, 1, At, B1); PG8_BAR;
            PG8_LDA(At, 0, 1); PG8_STAGE(PG8_SA(0, 0), a2, voffA);
            PG8_BAR; PG8_WAIT_L(0); PG8_MMA(1, 0, At, B0); PG8_BAR; PG8_SCHED;
            PG8_STAGE(PG8_SB(0, 1), b2 + hstep, voffB);
            PG8_WAIT_V(6); PG8_BAR; PG8_MMA(1, 1, At, B1); PG8_BAR;
            PG8_LDB(B0, 1, 0); PG8_SCHED; PG8_LDA(At, 1, 0); PG8_STAGE(PG8_SA(0, 1), a2 + hstep, voffA);
            PG8_WAIT_L(8); PG8_BAR; PG8_WAIT_L(0); PG8_MMA(0, 0, At, B0); PG8_BAR; PG8_SCHED;
            PG8_LDB(B1, 1, 1); PG8_STAGE(PG8_SB(1, 0), b3, voffB);
            PG8_BAR; PG8_WAIT_L(0); PG8_MMA(0, 1, At, B1); PG8_BAR;
            PG8_LDA(At, 1, 1); PG8_STAGE(PG8_SA(1, 0), a3, voffA);
            PG8_BAR; PG8_WAIT_L(0); PG8_MMA(1, 0, At, B0); PG8_BAR; PG8_SCHED;
            PG8_STAGE(PG8_SB(1, 1), b3 + hstep, voffB);
            PG8_WAIT_V(6); PG8_BAR; PG8_MMA(1, 1, At, B1); PG8_BAR;
            }
        }
        if constexpr (ALIGN_EPI) { if (wr == 0) PG8_BAR; }
        if constexpr (!Epi::AFTER_DRAIN) { E(acc, cur, wr, wc, fr, fq); S.done(cur); }
        if (!has_next) break;
#pragma unroll
        for (int a = 0; a < 2; ++a)
#pragma unroll
            for (int b = 0; b < 2; ++b)
#pragma unroll
                for (int m = 0; m < 4; ++m)
#pragma unroll
                    for (int n = 0; n < 2; ++n) acc[a][b][m][n] = (f32x4){0.f, 0.f, 0.f, 0.f};
        cur = nxt; cA = nA; cB = nB; ++ui;
        if constexpr (ALIGN_EPI) { if (wr == 1) PG8_BAR; }
    }
    PG8_WAIT_V(0);
    if constexpr (!ALIGN_EPI) { if (wr == 0) PG8_BAR; }
    PG8_BAR;
    if constexpr (Epi::AFTER_DRAIN) { E.fused(acc, cur, wr, wc, fr, fq, lds, wid, lane); S.done(cur); }
#undef PG8_SA
#undef PG8_SB
#undef PG8_STAGE
#undef PG8_LDA
#undef PG8_LDB
#undef PG8_MMA
#undef PG8_WAIT_V
#undef PG8_WAIT_L
#undef PG8_BAR
#undef PG8_SCHED
}
}
namespace att {
#define LAS __attribute__((address_space(3)))
typedef unsigned short bf16;
typedef short bf16x8 __attribute__((ext_vector_type(8)));
typedef short s16x4 __attribute__((ext_vector_type(4)));
typedef float f32x16 __attribute__((ext_vector_type(16)));
typedef float f32x4 __attribute__((ext_vector_type(4)));
typedef unsigned u32x4 __attribute__((ext_vector_type(4)));
typedef unsigned u32x2 __attribute__((ext_vector_type(2)));
typedef const LAS char* lcp;
constexpr float LOG2E = 1.4426950408889634f;
__device__ __forceinline__ int crow(int r, int hi) { return (r & 3) + 8 * (r >> 2) + 4 * hi; }
typedef float f32x2_t __attribute__((ext_vector_type(2))); typedef __bf16 bf16x2_t __attribute__((ext_vector_type(2)));
__device__ __forceinline__ unsigned cvtpk(float lo, float hi) { f32x2_t v = {lo, hi}; bf16x2_t b = __builtin_convertvector(v, bf16x2_t); return __builtin_bit_cast(unsigned, b); }
__device__ __forceinline__ unsigned short f2bf(float f) { return (unsigned short)(cvtpk(f, 0.f) & 0xffffu); }
__device__ __forceinline__ float xmax(float v) { auto rr = __builtin_amdgcn_permlane32_swap(__float_as_uint(v), __float_as_uint(v), false, false); return fmaxf(__uint_as_float(rr[0]), __uint_as_float(rr[1])); }
__device__ __forceinline__ float xsum(float v) { auto rr = __builtin_amdgcn_permlane32_swap(__float_as_uint(v), __float_as_uint(v), false, false); return __uint_as_float(rr[0]) + __uint_as_float(rr[1]); }
typedef short v4i16_t __attribute__((ext_vector_type(4)));
__device__ __forceinline__ s16x4 vtr(lcp p) { return __builtin_bit_cast(s16x4, __builtin_amdgcn_ds_read_tr16_b64_v4i16((LAS v4i16_t*)p)); }

template <int ND0> __device__ __forceinline__ void qk_tile(f32x16& p0, f32x16& p1, lcp kslot, const bf16x8* qr, int r32, int hi) {
    lcp kb = kslot + hi * 1024 + r32 * 16;
    p0 = f32x16{}; p1 = f32x16{};
#pragma unroll
    for (int d0 = 0; d0 < ND0; ++d0) {
        const bf16x8 b0 = *(const LAS bf16x8*)(kb + d0 * 2048), b1 = *(const LAS bf16x8*)(kb + d0 * 2048 + 512);
        p0 = __builtin_amdgcn_mfma_f32_32x32x16_bf16(b0, qr[d0], p0, 0, 0, 0);
        p1 = __builtin_amdgcn_mfma_f32_32x32x16_bf16(b1, qr[d0], p1, 0, 0, 0); }
}
__device__ __forceinline__ void pv_tile(f32x16& o0, f32x16& o1, lcp vp, const u32x4 (&pa)[4]) {
    const unsigned vb = (unsigned)(uintptr_t)vp;
    s16x4 lo[8], hi[8];
#pragma unroll
    for (int i = 0; i < 8; ++i) {
        asm volatile("ds_read_b64_tr_b16 %0, %1 offset:%c2" : "=&v"(lo[i]) : "v"(vb), "i"((i >> 2) * 4096 + (i & 3) * 1024) : "memory");
        asm volatile("ds_read_b64_tr_b16 %0, %1 offset:%c2" : "=&v"(hi[i]) : "v"(vb), "i"((i >> 2) * 4096 + (i & 3) * 1024 + 512) : "memory"); }
    asm volatile("s_waitcnt lgkmcnt(0)" : "+v"(lo[0]), "+v"(lo[1]), "+v"(lo[2]), "+v"(lo[3]), "+v"(lo[4]), "+v"(lo[5]), "+v"(lo[6]), "+v"(lo[7]), "+v"(hi[0]), "+v"(hi[1]), "+v"(hi[2]), "+v"(hi[3]), "+v"(hi[4]), "+v"(hi[5]), "+v"(hi[6]), "+v"(hi[7]) :: "memory");
    __builtin_amdgcn_sched_barrier(0);
#pragma unroll
    for (int ks = 0; ks < 4; ++ks) {
        const bf16x8 v0 = (bf16x8){lo[ks][0], lo[ks][1], lo[ks][2], lo[ks][3], hi[ks][0], hi[ks][1], hi[ks][2], hi[ks][3]};
        const bf16x8 v1 = (bf16x8){lo[4 + ks][0], lo[4 + ks][1], lo[4 + ks][2], lo[4 + ks][3], hi[4 + ks][0], hi[4 + ks][1], hi[4 + ks][2], hi[4 + ks][3]};
        const bf16x8 a = __builtin_bit_cast(bf16x8, pa[ks]);
        o0 = __builtin_amdgcn_mfma_f32_32x32x16_bf16(a, v0, o0, 0, 0, 0);
        o1 = __builtin_amdgcn_mfma_f32_32x32x16_bf16(a, v1, o1, 0, 0, 0); }
}
__device__ __forceinline__ void pack_p(u32x4 (&pa)[4], const f32x16& p0, const f32x16& p1) {
    pa[0] = (u32x4){cvtpk(p0[0], p0[1]), cvtpk(p0[2], p0[3]), cvtpk(p0[4], p0[5]), cvtpk(p0[6], p0[7])};
    pa[1] = (u32x4){cvtpk(p0[8], p0[9]), cvtpk(p0[10], p0[11]), cvtpk(p0[12], p0[13]), cvtpk(p0[14], p0[15])};
    pa[2] = (u32x4){cvtpk(p1[0], p1[1]), cvtpk(p1[2], p1[3]), cvtpk(p1[4], p1[5]), cvtpk(p1[6], p1[7])};
    pa[3] = (u32x4){cvtpk(p1[8], p1[9]), cvtpk(p1[10], p1[11]), cvtpk(p1[12], p1[13]), cvtpk(p1[14], p1[15])};
}
__device__ __forceinline__ float max3f(float a, float b, float c) { float r; asm("v_max3_f32 %0, %1, %2, %3" : "=v"(r) : "v"(a), "v"(b), "v"(c)); return r; }
__device__ __forceinline__ void mfma_settle(f32x16& a, f32x16& b) { asm volatile("s_nop 15\n\ts_nop 7" : "+v"(a), "+v"(b)); }
__device__ __forceinline__ float max32(const f32x16& p0, const f32x16& p1) {
    float a = max3f(p0[0], p1[0], p0[1]), b = max3f(p1[1], p0[2], p1[2]);
#pragma unroll
    for (int r = 3; r < 15; r += 2) { a = max3f(a, p0[r], p1[r]); b = max3f(b, p0[r + 1], p1[r + 1]); }
    a = max3f(a, p0[15], p1[15]);
    return fmaxf(a, b);
}
__device__ __forceinline__ void softmax_pv(f32x16& p0, f32x16& p1, float& m, float& l, f32x16& o0, f32x16& o1, lcp vp, LAS float* wsf, int r32, int hi) {
    const float rm = xmax(max32(p0, p1));
    const float mn = fmaxf(m, rm); const float f = __builtin_amdgcn_exp2f(m - mn); m = mn;
    float s = 0.f;
#pragma unroll
    for (int r = 0; r < 16; ++r) { p0[r] = __builtin_amdgcn_exp2f(p0[r] - mn); p1[r] = __builtin_amdgcn_exp2f(p1[r] - mn); s += p0[r] + p1[r]; }
    l = l * f + s;
    if (__any(f != 1.0f)) {
        if (hi == 0) wsf[r32] = f;
#pragma unroll
        for (int r = 0; r < 16; ++r) { const float fr = wsf[crow(r, hi)]; o0[r] *= fr; o1[r] *= fr; }
    }
    u32x4 pa[4]; pack_p(pa, p0, p1);
    pv_tile(o0, o1, vp, pa);
}
__device__ __forceinline__ void add_scaled(f32x16& a0, f32x16& a1, const f32x16& o0, const f32x16& o1, float fac, LAS float* wsf, int r32, int hi) {
    if (hi == 0) wsf[32 + r32] = fac;
#pragma unroll
    for (int r = 0; r < 16; ++r) { const float fr = wsf[32 + crow(r, hi)]; a0[r] += fr * o0[r]; a1[r] += fr * o1[r]; }
}
template <bool FIRST> __device__ __forceinline__ void acc_lds(LAS float* accL, const f32x16& o0, const f32x16& o1, float fac, LAS float* wsf, int r32, int hi) {
    if (hi == 0) wsf[32 + r32] = fac;
#pragma unroll
    for (int r = 0; r < 16; ++r) { const int row = crow(r, hi); const float fr = wsf[32 + row]; LAS float* p = accL + row * 64 + r32;
        if (FIRST) { p[0] = fr * o0[r]; p[32] = fr * o1[r]; } else { p[0] += fr * o0[r]; p[32] += fr * o1[r]; } }
}
__device__ __forceinline__ void store_acc(const LAS float* accL, bf16* gdst, int pitch, int lane) {
#pragma unroll
    for (int i = 0; i < 4; ++i) { const int row = i * 8 + (lane >> 3), ch = lane & 7; const f32x4 a = *(const LAS f32x4*)(accL + row * 64 + ch * 8), b = *(const LAS f32x4*)(accL + row * 64 + ch * 8 + 4);
        const u32x4 v = (u32x4){cvtpk(a[0], a[1]), cvtpk(a[2], a[3]), cvtpk(b[0], b[1]), cvtpk(b[2], b[3])}; *(u32x4*)(gdst + (size_t)row * pitch + ch * 8) = v; }
}
__device__ __forceinline__ void store_o(const f32x16& o0, const f32x16& o1, LAS bf16* stg, bf16* gdst, int pitch, int lane, int r32, int hi) {
#pragma unroll
    for (int r = 0; r < 16; ++r) { const int orow = crow(r, hi); stg[orow * 64 + r32] = f2bf(o0[r]); stg[orow * 64 + 32 + r32] = f2bf(o1[r]); }
#pragma unroll
    for (int i = 0; i < 4; ++i) { const int row = i * 8 + (lane >> 3), ch = lane & 7; const u32x4 v = *(const LAS u32x4*)(stg + row * 64 + ch * 8); *(u32x4*)(gdst + (size_t)row * pitch + ch * 8) = v; }
}


template <int ND0> __device__ __forceinline__ void qk_tile_c(f32x16& p0, f32x16& p1, lcp kslot, const bf16x8* qr, const f32x16& c0, const f32x16& c1, int r32, int hi) {
    lcp kb = kslot + hi * 1024 + r32 * 16;
    bf16x8 kf0[ND0], kf1[ND0];
#pragma unroll
    for (int d0 = 0; d0 < ND0; ++d0) { kf0[d0] = *(const LAS bf16x8*)(kb + d0 * 2048); kf1[d0] = *(const LAS bf16x8*)(kb + d0 * 2048 + 512); }
    __builtin_amdgcn_sched_barrier(0);
#pragma unroll
    for (int d0 = 0; d0 < ND0; ++d0) {
        p0 = __builtin_amdgcn_mfma_f32_32x32x16_bf16(kf0[d0], qr[d0], d0 == 0 ? c0 : p0, 0, 0, 0);
        p1 = __builtin_amdgcn_mfma_f32_32x32x16_bf16(kf1[d0], qr[d0], d0 == 0 ? c1 : p1, 0, 0, 0); }
    asm volatile("s_nop 15\n\ts_nop 7" : "+v"(p0), "+v"(p1));
}
__device__ __forceinline__ void dma1k(const char* gsrc, LAS char* dst) { __builtin_amdgcn_global_load_lds((const unsigned*)gsrc, (LAS unsigned*)dst, 16, 0, 0); }
__device__ __forceinline__ void mask_causal(f32x16& p0, f32x16& p1, int e0) {
#pragma unroll
    for (int r = 0; r < 16; ++r) { const int e = e0 + (r & 3) + 8 * (r >> 2); if (e > 0) p0[r] = -INFINITY; if (e + 32 > 0) p1[r] = -INFINITY; }
}
__device__ __forceinline__ void mask_winlow(f32x16& p0, f32x16& p1, int e0) {
#pragma unroll
    for (int r = 0; r < 16; ++r) { const int e = e0 + (r & 3) + 8 * (r >> 2); if (e <= -512) p0[r] = -INFINITY; if (e + 32 <= -512) p1[r] = -INFINITY; }
}
__device__ __forceinline__ void softmax_pv2(f32x16& p0, f32x16& p1, f32x16& p2, f32x16& p3, float offa, float offb, float& m, float& l, f32x16& o0, f32x16& o1, lcp va, lcp vb, LAS float* wsf, int r32, int hi) {
    const float rm = xmax(fmaxf(max32(p0, p1) + offa, max32(p2, p3) + offb));
    const float mn = fmaxf(m, rm); const float f = __builtin_amdgcn_exp2f(m - mn); m = mn;
    const float ca = mn - offa, cb = mn - offb;
    float s = 0.f;
#pragma unroll
    for (int r = 0; r < 16; ++r) { p0[r] = __builtin_amdgcn_exp2f(p0[r] - ca); p1[r] = __builtin_amdgcn_exp2f(p1[r] - ca); s += p0[r] + p1[r]; }
#pragma unroll
    for (int r = 0; r < 16; ++r) { p2[r] = __builtin_amdgcn_exp2f(p2[r] - cb); p3[r] = __builtin_amdgcn_exp2f(p3[r] - cb); s += p2[r] + p3[r]; }
    l = l * f + s;
    if (__any(f != 1.0f)) {
        if (hi == 0) wsf[r32] = f;
#pragma unroll
        for (int r = 0; r < 16; ++r) { const float fr = wsf[crow(r, hi)]; o0[r] *= fr; o1[r] *= fr; }
    }
    { u32x4 pa[4]; pack_p(pa, p0, p1); pv_tile(o0, o1, va, pa); }
    { u32x4 pa[4]; pack_p(pa, p2, p3); pv_tile(o0, o1, vb, pa); }
}


__device__ __forceinline__ void glds16(const void* gsrc, unsigned lds_dst) { unsigned keep;
    asm volatile("s_mov_b32 %0, m0\n\ts_mov_b32 m0, %2\n\ts_nop 0\n\tglobal_load_lds_dwordx4 %1, off\n\ts_mov_b32 m0, %0" : "=&s"(keep) : "v"(gsrc), "s"(lds_dst) : "memory"); }
#define ATT_WAIT_BAR(N) asm volatile("s_waitcnt vmcnt(" #N ") lgkmcnt(0)\n\ts_barrier" ::: "memory")
__device__ __forceinline__ void softmax_pv1(f32x16& p0, f32x16& p1, float off, float& m, float& l, f32x16& o0, f32x16& o1, lcp vp, LAS float* wsf, int r32, int hi) {
    const float rm = xmax(max32(p0, p1) + off);
    const float mn = fmaxf(m, rm); const float f = __builtin_amdgcn_exp2f(m - mn); m = mn;
    const float ca = mn - off;
    p0 = p0 - ca; p1 = p1 - ca;
    float s = 0.f;
#pragma unroll
    for (int r = 0; r < 16; ++r) { p0[r] = __builtin_amdgcn_exp2f(p0[r]); p1[r] = __builtin_amdgcn_exp2f(p1[r]); }
    { const f32x16 ps = p0 + p1;
#pragma unroll
      for (int r = 0; r < 16; ++r) s += ps[r]; }
    l = l * f + s;
    if (__any(f != 1.0f)) {
        if (hi == 0) wsf[r32] = f;
#pragma unroll
        for (int r = 0; r < 16; ++r) { const float fr = wsf[crow(r, hi)]; o0[r] *= fr; o1[r] *= fr; }
    }
    u32x4 pa[4]; pack_p(pa, p0, p1);
    pv_tile(o0, o1, vp, pa);
}

__device__ __forceinline__ void softmax_part(f32x16& p0, f32x16& p1, float off, float& m, f32x16& o0, f32x16& o1, f32x16& ol, u32x4 (&pa)[4], LAS float* wsf, int r32, int hi) {
    const float rm = xmax(max32(p0, p1) + off);
    const float mn = fmaxf(m, rm); const float f = __builtin_amdgcn_exp2f(m - mn); m = mn;
    const float ca = mn - off;
#pragma unroll
    for (int r = 0; r < 16; ++r) { p0[r] = __builtin_amdgcn_exp2f(p0[r] - ca); p1[r] = __builtin_amdgcn_exp2f(p1[r] - ca); }
    if (__any(f != 1.0f)) {
        if (hi == 0) wsf[r32] = f;
#pragma unroll
        for (int r = 0; r < 16; ++r) { const float fr = wsf[crow(r, hi)]; o0[r] *= fr; o1[r] *= fr; ol[r] *= fr; }
    }
    pack_p(pa, p0, p1);
}
__device__ __forceinline__ void pv_tile_l(f32x16& o0, f32x16& o1, f32x16& ol, lcp vp, const u32x4 (&pa)[4]) {
    const unsigned vb = (unsigned)(uintptr_t)vp;
    s16x4 lo[8], hi[8];
#pragma unroll
    for (int i = 0; i < 8; ++i) {
        asm volatile("ds_read_b64_tr_b16 %0, %1 offset:%c2" : "=&v"(lo[i]) : "v"(vb), "i"((i >> 2) * 4096 + (i & 3) * 1024) : "memory");
        asm volatile("ds_read_b64_tr_b16 %0, %1 offset:%c2" : "=&v"(hi[i]) : "v"(vb), "i"((i >> 2) * 4096 + (i & 3) * 1024 + 512) : "memory"); }
    const bf16x8 ones = (bf16x8){0x3f80, 0x3f80, 0x3f80, 0x3f80, 0x3f80, 0x3f80, 0x3f80, 0x3f80};
#pragma unroll
    for (int ks = 0; ks < 4; ++ks) ol = __builtin_amdgcn_mfma_f32_32x32x16_bf16(__builtin_bit_cast(bf16x8, pa[ks]), ones, ol, 0, 0, 0);
    asm volatile("s_waitcnt lgkmcnt(0)" : "+v"(lo[0]), "+v"(lo[1]), "+v"(lo[2]), "+v"(lo[3]), "+v"(lo[4]), "+v"(lo[5]), "+v"(lo[6]), "+v"(lo[7]), "+v"(hi[0]), "+v"(hi[1]), "+v"(hi[2]), "+v"(hi[3]), "+v"(hi[4]), "+v"(hi[5]), "+v"(hi[6]), "+v"(hi[7]) :: "memory");
    __builtin_amdgcn_sched_barrier(0);
#pragma unroll
    for (int ks = 0; ks < 4; ++ks) {
        const bf16x8 v0 = (bf16x8){lo[ks][0], lo[ks][1], lo[ks][2], lo[ks][3], hi[ks][0], hi[ks][1], hi[ks][2], hi[ks][3]};
        const bf16x8 v1 = (bf16x8){lo[4 + ks][0], lo[4 + ks][1], lo[4 + ks][2], lo[4 + ks][3], hi[4 + ks][0], hi[4 + ks][1], hi[4 + ks][2], hi[4 + ks][3]};
        const bf16x8 a = __builtin_bit_cast(bf16x8, pa[ks]);
        o0 = __builtin_amdgcn_mfma_f32_32x32x16_bf16(a, v0, o0, 0, 0, 0);
        o1 = __builtin_amdgcn_mfma_f32_32x32x16_bf16(a, v1, o1, 0, 0, 0); }
}

#ifdef ATT_V1
constexpr int M_KS = 0, M_VS = 24576, M_WSF = 40960, M_OST = 43008;
__device__ __forceinline__ void mla_unit(int b, int h, int qb, const bf16* Qm, const bf16* Km, const bf16* Vm, bf16* Ob, LAS char* lds, int wave_id) {
    int tid_ = wave_id * 64 + opaque_lane();
    const int tid = tid_, lane = tid & 63, r32 = lane & 31, hi = lane >> 5, wid = __builtin_amdgcn_readfirstlane(tid >> 6);
    const int q0 = qb * 256, NT = (q0 + 256) / 64;
    const int qmin = q0 + wid * 32, qpos = qmin + r32;
    bf16x8 qr[6];
    { const bf16* qp = Qm + ((size_t)b * 8192 + qpos) * 768 + h * 96 + hi * 8;
#pragma unroll
      for (int d0 = 0; d0 < 6; ++d0) qr[d0] = *(const bf16x8*)(qp + d0 * 16); }
    const char* Kg = (const char*)(Km + (size_t)(b * 8 + h) * 128 * 6144);
    const char* Vg = (const char*)(Vm + (size_t)(b * 8 + h) * 128 * 4096);
    LAS float* wsf = (LAS float*)(lds + M_WSF) + wid * 64;
    const int vlane = ((lane >> 4) & 1) * 32 + (lane & 3) * 8 + (4 * hi + ((lane & 15) >> 2)) * 64;
    float m = -1e30f, l = 0.f; f32x16 o0 = f32x16{}, o1 = f32x16{};
    u32x4 kr0, kr1 = u32x4{}, vr0;
    kr0 = *(const u32x4*)(Kg + tid * 16); if (tid < 256) kr1 = *(const u32x4*)(Kg + 8192 + tid * 16); vr0 = *(const u32x4*)(Vg + tid * 16);
    *(LAS u32x4*)(lds + M_KS + tid * 16) = kr0; if (tid < 256) *(LAS u32x4*)(lds + M_KS + 8192 + tid * 16) = kr1; *(LAS u32x4*)(lds + M_VS + tid * 16) = vr0;
    __syncthreads();
    for (int kt = 0; kt < NT; ++kt) {
        const int sl = kt & 1;
        if (kt + 1 < NT) { const char* kg = Kg + (size_t)(kt + 1) * 12288; const char* vg = Vg + (size_t)(kt + 1) * 8192;
            kr0 = *(const u32x4*)(kg + tid * 16); if (tid < 256) kr1 = *(const u32x4*)(kg + 8192 + tid * 16); vr0 = *(const u32x4*)(vg + tid * 16); }
        if (64 * kt <= qmin + 31) {
            f32x16 p0, p1; qk_tile<6>(p0, p1, (lcp)(lds + M_KS + sl * 12288), qr, r32, hi);
            if (64 * kt + 63 > qmin) {
                const int kb = 64 * kt + 4 * hi;
#pragma unroll
                for (int r = 0; r < 16; ++r) { const int kv = kb + (r & 3) + 8 * (r >> 2); if (kv > qpos) p0[r] = -INFINITY; if (kv + 32 > qpos) p1[r] = -INFINITY; }
            }
            softmax_pv(p0, p1, m, l, o0, o1, (lcp)(lds + M_VS + sl * 8192 + vlane), wsf, r32, hi);
        }
        if (kt + 1 < NT) { const int sn = sl ^ 1;
            *(LAS u32x4*)(lds + M_KS + sn * 12288 + tid * 16) = kr0; if (tid < 256) *(LAS u32x4*)(lds + M_KS + sn * 12288 + 8192 + tid * 16) = kr1; *(LAS u32x4*)(lds + M_VS + sn * 8192 + tid * 16) = vr0; }
        __syncthreads();
    }
    const float lt = xsum(l); const float inv = lt > 0.f ? 1.0f / lt : 0.f;
    f32x16 a0 = f32x16{}, a1 = f32x16{};
    add_scaled(a0, a1, o0, o1, inv, wsf, r32, hi);
    store_o(a0, a1, (LAS bf16*)(lds + M_OST + wid * 4096), Ob + ((size_t)b * 8192 + qmin) * 512 + h * 64, 512, lane, r32, hi);
    __syncthreads();
}

constexpr int N_KS = 0, N_VS = 16384, N_WSF = 32768, N_ACC = 34816, N_IMP = 100352, N_SEL = 133376, N_UNI = 134400, N_BL = 134464, IMPS = 129;
struct NsaT { const bf16 *Qn, *Kc, *Vc, *Ksel, *Vsel, *Kwin, *Vwin; const float* gates; bf16* Oa; };
__device__ __forceinline__ void setbit(unsigned (&w)[4], int j) { const int wi = j >> 5; const unsigned bv = 1u << (j & 31); w[0] |= wi == 0 ? bv : 0u; w[1] |= wi == 1 ? bv : 0u; w[2] |= wi == 2 ? bv : 0u; w[3] |= wi == 3 ? bv : 0u; }
__device__ __forceinline__ void nsa_unit(int b, int g, int ti, const NsaT& T, LAS char* lds, int wave_id) {
    int tid_ = wave_id * 64 + opaque_lane();
    const int tid = tid_, lane = tid & 63, r32 = lane & 31, hi = lane >> 5, wid = __builtin_amdgcn_readfirstlane(tid >> 6);
    const int hh = wid & 3, qh = wid >> 2, H = g * 4 + hh, bg = b * 2 + g;
    const int t0 = ti * 64, qrow = qh * 32 + r32, t = t0 + qrow;
    const float slope2 = __builtin_amdgcn_exp2f(-(float)(H + 1)) * LOG2E;
    bf16x8 qr[4];
    { const bf16* qp = T.Qn + ((size_t)b * 8192 + t) * 512 + H * 64 + hi * 8;
#pragma unroll
      for (int d0 = 0; d0 < 4; ++d0) qr[d0] = *(const bf16x8*)(qp + d0 * 16); }
    LAS float* wsf = (LAS float*)(lds + N_WSF) + wid * 64;
    LAS float* imp = (LAS float*)(lds + N_IMP);
    LAS unsigned* selw = (LAS unsigned*)(lds + N_SEL);
    LAS unsigned* uni = (LAS unsigned*)(lds + N_UNI);
    LAS unsigned* blist = (LAS unsigned*)(lds + N_BL);
    const int vlane = ((lane >> 4) & 1) * 32 + (lane & 3) * 8 + (4 * hi + ((lane & 15) >> 2)) * 64;
    for (int i = tid; i < 64 * IMPS; i += 512) imp[i] = 0.f;
    if (tid < 256) selw[tid] = 0u;
    if (tid < 8) uni[tid] = 0u;
    const float* gp = T.gates + ((size_t)b * 8192 + t) * 24 + H * 3;
    const float gc = gp[0], gs = gp[1], gw = gp[2];
    LAS float* accL = (LAS float*)(lds + N_ACC) + wid * 2048;
    u32x4 kr0, vr0;
    const int ntc = (4 * ti + 3 + 63) >> 6;
    const char* Kcg = (const char*)(T.Kc + (size_t)bg * 8 * 4096); const char* Vcg = (const char*)(T.Vc + (size_t)bg * 8 * 4096);
    float m = -1e30f, l = 0.f;
#ifndef NSA_SKIP_P1
    kr0 = *(const u32x4*)(Kcg + tid * 16); *(LAS u32x4*)(lds + N_KS + tid * 16) = kr0;
    __syncthreads();
    for (int kt = 0; kt < ntc; ++kt) {
        const int sl = kt & 1;
        if (kt + 1 < ntc) kr0 = *(const u32x4*)(Kcg + (size_t)(kt + 1) * 8192 + tid * 16);
        { f32x16 p0, p1; qk_tile<4>(p0, p1, (lcp)(lds + N_KS + sl * 8192), qr, r32, hi);
          const int nb = 64 * kt + 4 * hi;
#pragma unroll
          for (int r = 0; r < 16; ++r) { const int n = nb + (r & 3) + 8 * (r >> 2); const int e0 = 16 * n + 31 - t, e1 = e0 + 512;
              p0[r] = e0 <= 0 ? p0[r] + slope2 * (float)e0 : -INFINITY; p1[r] = e1 <= 0 ? p1[r] + slope2 * (float)e1 : -INFINITY; }
          const float rm = max32(p0, p1); const float mn = fmaxf(m, rm); float s = 0.f;
#pragma unroll
          for (int r = 0; r < 16; ++r) s += __builtin_amdgcn_exp2f(p0[r] - mn) + __builtin_amdgcn_exp2f(p1[r] - mn);
          l = l * __builtin_amdgcn_exp2f(m - mn) + s; m = mn; }
        if (kt + 1 < ntc) *(LAS u32x4*)(lds + N_KS + (sl ^ 1) * 8192 + tid * 16) = kr0;
        __syncthreads();
    }
    {
      auto rm_ = __builtin_amdgcn_permlane32_swap(__float_as_uint(m), __float_as_uint(m), false, false); auto rl_ = __builtin_amdgcn_permlane32_swap(__float_as_uint(l), __float_as_uint(l), false, false);
      const float mo = __uint_as_float(hi ? rm_[0] : rm_[1]), lo = __uint_as_float(hi ? rl_[0] : rl_[1]); const float mn = fmaxf(m, mo);
      l = l * __builtin_amdgcn_exp2f(m - mn) + lo * __builtin_amdgcn_exp2f(mo - mn); m = mn; }
#endif
    const float invl = l > 0.f ? 1.0f / l : 0.f;
    f32x16 o0 = f32x16{}, o1 = f32x16{};
#ifndef NSA_SKIP_P2
    kr0 = *(const u32x4*)(Kcg + tid * 16); vr0 = *(const u32x4*)(Vcg + tid * 16);
    *(LAS u32x4*)(lds + N_KS + tid * 16) = kr0; *(LAS u32x4*)(lds + N_VS + tid * 16) = vr0;
    __syncthreads();
    for (int kt = 0; kt < ntc; ++kt) {
        const int sl = kt & 1;
        if (kt + 1 < ntc) { kr0 = *(const u32x4*)(Kcg + (size_t)(kt + 1) * 8192 + tid * 16); vr0 = *(const u32x4*)(Vcg + (size_t)(kt + 1) * 8192 + tid * 16); }
        { f32x16 p0, p1; qk_tile<4>(p0, p1, (lcp)(lds + N_KS + sl * 8192), qr, r32, hi);
          const int nb = 64 * kt + 4 * hi;
#pragma unroll
          for (int r = 0; r < 16; ++r) { const int n = nb + (r & 3) + 8 * (r >> 2); const int e0 = 16 * n + 31 - t, e1 = e0 + 512;
              p0[r] = e0 <= 0 ? __builtin_amdgcn_exp2f(p0[r] + slope2 * (float)e0 - m) * invl : 0.f; p1[r] = e1 <= 0 ? __builtin_amdgcn_exp2f(p1[r] + slope2 * (float)e1 - m) * invl : 0.f; }
          LAS float* ir = imp + qrow * IMPS + 16 * kt + hi;
#pragma unroll
          for (int rg = 0; rg < 4; ++rg) {
              const float A0 = (p0[4 * rg] + p0[4 * rg + 1]) + (p0[4 * rg + 2] + p0[4 * rg + 3]), A1 = (p1[4 * rg] + p1[4 * rg + 1]) + (p1[4 * rg + 2] + p1[4 * rg + 3]);
              __hip_atomic_fetch_add(ir + 2 * rg, A0, __ATOMIC_RELAXED, __HIP_MEMORY_SCOPE_WORKGROUP); __hip_atomic_fetch_add(ir + 2 * rg + 1, p0[4 * rg + 3], __ATOMIC_RELAXED, __HIP_MEMORY_SCOPE_WORKGROUP);
              __hip_atomic_fetch_add(ir + 8 + 2 * rg, A1, __ATOMIC_RELAXED, __HIP_MEMORY_SCOPE_WORKGROUP); __hip_atomic_fetch_add(ir + 8 + 2 * rg + 1, p1[4 * rg + 3], __ATOMIC_RELAXED, __HIP_MEMORY_SCOPE_WORKGROUP); }
          u32x4 pa[4]; pack_p(pa, p0, p1);
          pv_tile(o0, o1, (lcp)(lds + N_VS + sl * 8192 + vlane), pa); }
        if (kt + 1 < ntc) { *(LAS u32x4*)(lds + N_KS + (sl ^ 1) * 8192 + tid * 16) = kr0; *(LAS u32x4*)(lds + N_VS + (sl ^ 1) * 8192 + tid * 16) = vr0; }
        __syncthreads();
    }
    acc_lds<true>(accL, o0, o1, gc, wsf, r32, hi);
#endif
#ifndef NSA_SKIP_TOPK
    {
        const int q = tid >> 3, sub = tid & 7;
        unsigned w[4] = {0u, 0u, 0u, 0u};
        if (ti <= 15) { if (sub == 0) w[0] = (2u << ti) - 1u; }
        else {
            const LAS float* row = imp + q * IMPS;
#pragma unroll 1
            for (int half = 0; half < 2; ++half) {
                float v[8]; int cnt[8];
#pragma unroll
                for (int k = 0; k < 8; ++k) { const int j = 1 + sub + 8 * (k + 8 * half); v[k] = (j <= ti - 2) ? row[j] : -1.0f; cnt[k] = 0; }
#pragma unroll 1
                for (int jp = 1; jp <= ti - 2; ++jp) { const float vp = row[jp];
#pragma unroll
                    for (int k = 0; k < 8; ++k) { const int j = 1 + sub + 8 * (k + 8 * half); cnt[k] += (vp > v[k] || (vp == v[k] && jp < j)) ? 1 : 0; } }
#pragma unroll
                for (int k = 0; k < 8; ++k) { const int j = 1 + sub + 8 * (k + 8 * half); if (j <= ti - 2 && cnt[k] < 13) setbit(w, j); }
            }
            if (sub == 0) { w[0] |= 1u; setbit(w, ti); setbit(w, ti - 1); }
        }
#pragma unroll
        for (int k = 0; k < 4; ++k) if (w[k]) { __hip_atomic_fetch_or(selw + q * 4 + k, w[k], __ATOMIC_RELAXED, __HIP_MEMORY_SCOPE_WORKGROUP); __hip_atomic_fetch_or(uni + k, w[k], __ATOMIC_RELAXED, __HIP_MEMORY_SCOPE_WORKGROUP); }
    }
#endif
    __syncthreads();
    if (tid == 0) { int nb = 0;
        for (int k = 0; k < 4; ++k) { unsigned u = uni[k]; while (u) { const int bit = __builtin_ctz(u); u &= u - 1u; blist[nb++] = (unsigned)(32 * k + bit); } }
        uni[4] = (unsigned)nb; }
    __syncthreads();
    const int nsel = (int)uni[4];
    unsigned sw[4];
#pragma unroll
    for (int k = 0; k < 4; ++k) sw[k] = selw[qrow * 4 + k];
#ifndef NSA_SKIP_SEL
    {
        const char* Kg = (const char*)(T.Ksel + (size_t)bg * 128 * 4096); const char* Vg = (const char*)(T.Vsel + (size_t)bg * 128 * 4096);
        m = -1e30f; l = 0.f; o0 = f32x16{}; o1 = f32x16{};
        int j = (int)blist[0];
        kr0 = *(const u32x4*)(Kg + (size_t)j * 8192 + tid * 16); vr0 = *(const u32x4*)(Vg + (size_t)j * 8192 + tid * 16);
        *(LAS u32x4*)(lds + N_KS + tid * 16) = kr0; *(LAS u32x4*)(lds + N_VS + tid * 16) = vr0;
        __syncthreads();
        for (int k = 0; k < nsel; ++k) {
            const int sl = k & 1; int jn = 0;
            if (k + 1 < nsel) { jn = (int)blist[k + 1]; kr0 = *(const u32x4*)(Kg + (size_t)jn * 8192 + tid * 16); vr0 = *(const u32x4*)(Vg + (size_t)jn * 8192 + tid * 16); }
            { f32x16 p0, p1; qk_tile<4>(p0, p1, (lcp)(lds + N_KS + sl * 8192), qr, r32, hi);
              const int jw = j >> 5; const unsigned swj = jw == 0 ? sw[0] : jw == 1 ? sw[1] : jw == 2 ? sw[2] : sw[3]; const bool mine = (swj >> (j & 31)) & 1u; const int pb = 64 * j + 4 * hi - t;
#pragma unroll
              for (int r = 0; r < 16; ++r) { const int e0 = pb + (r & 3) + 8 * (r >> 2), e1 = e0 + 32;
                  p0[r] = (mine && e0 <= 0) ? p0[r] + slope2 * (float)e0 : -INFINITY; p1[r] = (mine && e1 <= 0) ? p1[r] + slope2 * (float)e1 : -INFINITY; }
              softmax_pv(p0, p1, m, l, o0, o1, (lcp)(lds + N_VS + sl * 8192 + vlane), wsf, r32, hi); }
            if (k + 1 < nsel) { *(LAS u32x4*)(lds + N_KS + (sl ^ 1) * 8192 + tid * 16) = kr0; *(LAS u32x4*)(lds + N_VS + (sl ^ 1) * 8192 + tid * 16) = vr0; }
            j = jn;
            __syncthreads();
        }
        const float lt = xsum(l); acc_lds<false>(accL, o0, o1, lt > 0.f ? gs / lt : 0.f, wsf, r32, hi);
    }
#endif
#ifndef NSA_SKIP_WIN
    {
        const char* Kg = (const char*)(T.Kwin + (size_t)bg * 128 * 4096); const char* Vg = (const char*)(T.Vwin + (size_t)bg * 128 * 4096);
        m = -1e30f; l = 0.f; o0 = f32x16{}; o1 = f32x16{};
        const int j0 = ti >= 8 ? ti - 8 : 0, nw = ti - j0 + 1;
        kr0 = *(const u32x4*)(Kg + (size_t)j0 * 8192 + tid * 16); vr0 = *(const u32x4*)(Vg + (size_t)j0 * 8192 + tid * 16);
        *(LAS u32x4*)(lds + N_KS + tid * 16) = kr0; *(LAS u32x4*)(lds + N_VS + tid * 16) = vr0;
        __syncthreads();
        for (int k = 0; k < nw; ++k) {
            const int sl = k & 1, j = j0 + k;
            if (k + 1 < nw) { kr0 = *(const u32x4*)(Kg + (size_t)(j + 1) * 8192 + tid * 16); vr0 = *(const u32x4*)(Vg + (size_t)(j + 1) * 8192 + tid * 16); }
            { f32x16 p0, p1; qk_tile<4>(p0, p1, (lcp)(lds + N_KS + sl * 8192), qr, r32, hi);
              const int pb = 64 * j + 4 * hi - t;
#pragma unroll
              for (int r = 0; r < 16; ++r) { const int e0 = pb + (r & 3) + 8 * (r >> 2), e1 = e0 + 32;
                  p0[r] = (e0 <= 0 && e0 > -512) ? p0[r] + slope2 * (float)e0 : -INFINITY; p1[r] = (e1 <= 0 && e1 > -512) ? p1[r] + slope2 * (float)e1 : -INFINITY; }
              softmax_pv(p0, p1, m, l, o0, o1, (lcp)(lds + N_VS + sl * 8192 + vlane), wsf, r32, hi); }
            if (k + 1 < nw) { *(LAS u32x4*)(lds + N_KS + (sl ^ 1) * 8192 + tid * 16) = kr0; *(LAS u32x4*)(lds + N_VS + (sl ^ 1) * 8192 + tid * 16) = vr0; }
            __syncthreads();
        }
        const float lt = xsum(l); acc_lds<false>(accL, o0, o1, lt > 0.f ? gw / lt : 0.f, wsf, r32, hi);
    }
#endif
    store_acc(accL, T.Oa + ((size_t)b * 8192 + t0 + qh * 32) * 512 + H * 64, 512, lane);
    __syncthreads();
}
#endif

#ifndef ATT_V1
#ifdef MLA_V2
constexpr int M_STG = 40960, M_WSF = 81920, M_OST = 83968;
__device__ __forceinline__ void mla_unit(int b, int h, int qb, const bf16* Qm, const bf16* Km, const bf16* Vm, bf16* Ob, LAS char* lds, int wave_id) {
    int tid_ = wave_id * 64 + opaque_lane();
    const int tid = tid_, lane = tid & 63, r32 = lane & 31, hi = lane >> 5, wid = __builtin_amdgcn_readfirstlane(tid >> 6);
    const int q0 = qb * 256, NP = (q0 + 256) / 128;
    const int qmin = q0 + wid * 32, qpos = qmin + r32;
    bf16x8 qr[6];
    { const bf16* qp = Qm + ((size_t)b * 8192 + qpos) * 768 + h * 96 + hi * 8;
#pragma unroll
      for (int d0 = 0; d0 < 6; ++d0) qr[d0] = *(const bf16x8*)(qp + d0 * 16); }
    const char* Kg = (const char*)(Km + (size_t)(b * 8 + h) * 128 * 6144) + lane * 16;
    const char* Vg = (const char*)(Vm + (size_t)(b * 8 + h) * 128 * 4096) + lane * 16;
    LAS float* wsf = (LAS float*)(lds + M_WSF) + wid * 64;
    const int vlane = ((lane >> 4) & 1) * 32 + (lane & 3) * 8 + (4 * hi + ((lane & 15) >> 2)) * 64;
    float m = -1e30f, l = 0.f; f32x16 o0 = f32x16{}, o1 = f32x16{};
    const f32x16 zc = f32x16{};
#define MLA_DMA(p, stg) do { const int ja_ = 2 * (p), jb_ = ja_ + 1; _Pragma("unroll") for (int i_ = 0; i_ < 5; ++i_) { const int q_ = wid + 8 * i_; \
        const char* s_ = q_ < 12 ? Kg + (size_t)ja_ * 12288 + q_ * 1024 : q_ < 24 ? Kg + (size_t)jb_ * 12288 + (q_ - 12) * 1024 : q_ < 32 ? Vg + (size_t)ja_ * 8192 + (q_ - 24) * 1024 : Vg + (size_t)jb_ * 8192 + (q_ - 32) * 1024; \
        dma1k(s_, lds + (stg) * M_STG + q_ * 1024); } } while (0)
    MLA_DMA(0, 0);
    __syncthreads();
    for (int p = 0; p < NP; ++p) {
        const int st = p & 1;
        if (p + 1 < NP) MLA_DMA(p + 1, st ^ 1);
        const int ja = 2 * p, jb = ja + 1;
        if (64 * ja <= qmin + 31) {
            LAS char* sb = lds + st * M_STG;
            f32x16 p0, p1, p2, p3;
            qk_tile_c<6>(p0, p1, (lcp)sb, qr, zc, zc, r32, hi);
            qk_tile_c<6>(p2, p3, (lcp)(sb + 12288), qr, zc, zc, r32, hi);
            if (64 * ja + 63 > qmin) mask_causal(p0, p1, 64 * ja + 4 * hi - qpos);
            if (64 * jb + 63 > qmin) mask_causal(p2, p3, 64 * jb + 4 * hi - qpos);
            softmax_pv2(p0, p1, p2, p3, 0.f, 0.f, m, l, o0, o1, (lcp)(sb + 24576 + vlane), (lcp)(sb + 32768 + vlane), wsf, r32, hi);
        }
        __syncthreads();
    }
#undef MLA_DMA
    const float lt = xsum(l); const float inv = lt > 0.f ? 1.0f / lt : 0.f;
    f32x16 a0 = f32x16{}, a1 = f32x16{};
    add_scaled(a0, a1, o0, o1, inv, wsf, r32, hi);
    store_o(a0, a1, (LAS bf16*)(lds + M_OST + wid * 4096), Ob + ((size_t)b * 8192 + qmin) * 512 + h * 64, 512, lane, r32, hi);
    __syncthreads();
}
#else
#ifdef MLA_V4
constexpr int M_SLOT = 20480, M_WSF = 81920, M_OST = 83968;
__device__ __forceinline__ void mla_unit(int b, int h, int qb, const bf16* Qm, const bf16* Km, const bf16* Vm, bf16* Ob, LAS char* lds, int wave_id) {
    int tid_ = wave_id * 64 + opaque_lane();
    const int tid = tid_, lane = tid & 63, r32 = lane & 31, hi = lane >> 5, wid = __builtin_amdgcn_readfirstlane(tid >> 6);
    const int q0 = qb * 256, NT = (q0 + 256) / 64;
    const int qmin = q0 + wid * 32, qpos = qmin + r32;
    bf16x8 qr[6];
    { const bf16* qp = Qm + ((size_t)b * 8192 + qpos) * 768 + h * 96 + hi * 8;
#pragma unroll
      for (int d0 = 0; d0 < 6; ++d0) qr[d0] = *(const bf16x8*)(qp + d0 * 16); }
    const char* Kg = (const char*)(Km + (size_t)(b * 8 + h) * 128 * 6144) + lane * 16;
    const char* Vg = (const char*)(Vm + (size_t)(b * 8 + h) * 128 * 4096) + lane * 16;
    const unsigned lds0 = (unsigned)(uintptr_t)lds;
    LAS float* wsf = (LAS float*)(lds + M_WSF) + wid * 64;
    const int vlane = ((lane >> 4) & 1) * 32 + (lane & 3) * 8 + (4 * hi + ((lane & 15) >> 2)) * 64;
    float m = -1e30f, l = 0.f; f32x16 o0 = f32x16{}, o1 = f32x16{};
    const f32x16 zc = f32x16{};
#define MLA_DMA(t_) do { const unsigned sl_ = lds0 + (unsigned)(((t_) & 3) * M_SLOT); _Pragma("unroll") for (int i_ = 0; i_ < 3; ++i_) { int q_ = wid + 8 * i_; if (q_ >= 20) q_ -= 16; \
        const char* s_ = q_ < 12 ? Kg + (size_t)(t_) * 12288 + q_ * 1024 : Vg + (size_t)(t_) * 8192 + (q_ - 12) * 1024; glds16(s_, (unsigned)__builtin_amdgcn_readfirstlane(sl_ + q_ * 1024)); } } while (0)
#define MLA_QK(P0, P1, t_) do { qk_tile_c<6>(P0, P1, (lcp)(lds + ((t_) & 3) * M_SLOT), qr, zc, zc, r32, hi); if (64 * (t_) + 63 > qmin) mask_causal(P0, P1, 64 * (t_) + 4 * hi - qpos); } while (0)
#define MLA_STEP(PC0, PC1, PN0, PN1, t_) do { \
        if ((t_) + 3 < NT) MLA_DMA((t_) + 3); \
        if ((t_) + 1 < NT && 64 * ((t_) + 1) <= qmin + 31) MLA_QK(PN0, PN1, (t_) + 1); \
        if (64 * (t_) <= qmin + 31) softmax_pv1(PC0, PC1, 0.f, m, l, o0, o1, (lcp)(lds + ((t_) & 3) * M_SLOT + 12288 + vlane), wsf, r32, hi); \
        if ((t_) + 3 < NT) ATT_WAIT_BAR(3); else ATT_WAIT_BAR(0); } while (0)
    MLA_DMA(0); MLA_DMA(1); MLA_DMA(2);
    ATT_WAIT_BAR(3);
    f32x16 pA0, pA1, pB0 = f32x16{}, pB1 = f32x16{};
    MLA_QK(pA0, pA1, 0);
    for (int t = 0; t < NT; t += 2) {
        MLA_STEP(pA0, pA1, pB0, pB1, t);
        MLA_STEP(pB0, pB1, pA0, pA1, t + 1);
    }
#undef MLA_DMA
#undef MLA_QK
#undef MLA_STEP
    const float lt = xsum(l); const float inv = lt > 0.f ? 1.0f / lt : 0.f;
    f32x16 a0 = f32x16{}, a1 = f32x16{};
    add_scaled(a0, a1, o0, o1, inv, wsf, r32, hi);
    store_o(a0, a1, (LAS bf16*)(lds + M_OST + wid * 4096), Ob + ((size_t)b * 8192 + qmin) * 512 + h * 64, 512, lane, r32, hi);
    __syncthreads();
}
#else
constexpr int M_SLOT = 20480, M_WSF = 81920, M_OST = 83968;
template <int DIAG = 0> __device__ __forceinline__ void mla_unit(int b, int h, int qb, const bf16* Qm, const bf16* Km, const bf16* Vm, bf16* Ob, LAS char* lds, int wave_id) {
    int tid_ = wave_id * 64 + opaque_lane();
    const int tid = tid_, lane = tid & 63, r32 = lane & 31, hi = lane >> 5, wid = __builtin_amdgcn_readfirstlane(tid >> 6);
    const int q0 = qb * 256, NT = (q0 + 256) / 64;
    const int qmin = q0 + wid * 32, qpos = qmin + r32;
    bf16x8 qr[6];
    { const bf16* qp = Qm + ((size_t)b * 8192 + qpos) * 768 + h * 96 + hi * 8;
#pragma unroll
      for (int d0 = 0; d0 < 6; ++d0) qr[d0] = *(const bf16x8*)(qp + d0 * 16); }
    const char* Kg = (const char*)(Km + (size_t)(b * 8 + h) * 128 * 6144) + lane * 16;
    const char* Vg = (const char*)(Vm + (size_t)(b * 8 + h) * 128 * 4096) + lane * 16;
    const unsigned lds0 = (unsigned)(uintptr_t)lds;
    LAS float* wsf = (LAS float*)(lds + M_WSF) + wid * 64;
    const int vlane = ((lane >> 4) & 1) * 32 + (lane & 3) * 8 + (4 * hi + ((lane & 15) >> 2)) * 64;
    float m = -1e30f; f32x16 o0 = f32x16{}, o1 = f32x16{}, ol = f32x16{};
    const f32x16 zc = f32x16{};
#define MLA_DMA(t_) do { const unsigned sl_ = lds0 + (unsigned)(((t_) & 3) * M_SLOT); _Pragma("unroll") for (int i_ = 0; i_ < 3; ++i_) { const int q_ = wid + 8 * i_; if (q_ < 20) { \
        const char* s_ = q_ < 12 ? Kg + (size_t)(t_) * 12288 + q_ * 1024 : Vg + (size_t)(t_) * 8192 + (q_ - 12) * 1024; glds16(s_, (unsigned)__builtin_amdgcn_readfirstlane(sl_ + q_ * 1024)); } } } while (0)
#define MLA_QK(P0, P1, t_) do { qk_tile_c<6>(P0, P1, (lcp)(lds + ((t_) & 3) * M_SLOT), qr, zc, zc, r32, hi); if (64 * (t_) + 63 > qmin) mask_causal(P0, P1, 64 * (t_) + 4 * hi - qpos); } while (0)
    MLA_DMA(0); MLA_DMA(1);
    ATT_WAIT_BAR(0);
    f32x16 p0, p1;
    MLA_QK(p0, p1, 0);
    if (wid >= 4) ATT_WAIT_BAR(0);
    for (int t = 0; t < NT; ++t) {
        const bool need = 64 * t <= qmin + 31;
        u32x4 pa[4];
        if (t + 2 < NT && !(DIAG & 1)) MLA_DMA(t + 2);
        if (need && !(DIAG & 2)) softmax_part(p0, p1, 0.f, m, o0, o1, ol, pa, wsf, r32, hi);
        if (DIAG & 2) { pa[0] = pa[1] = pa[2] = pa[3] = (u32x4){0u, 0u, 0u, 0u}; }
        ATT_WAIT_BAR(3);
        if (need && !(DIAG & 4)) pv_tile_l(o0, o1, ol, (lcp)(lds + (t & 3) * M_SLOT + 12288 + vlane), pa);
        if (t + 1 < NT && 64 * (t + 1) <= qmin + 31 && !(DIAG & 4)) MLA_QK(p0, p1, t + 1);
        if (DIAG & 8) continue;
        ATT_WAIT_BAR(0);
    }
    if (wid < 4) ATT_WAIT_BAR(0);
#undef MLA_DMA
#undef MLA_QK
    f32x16 a0, a1;
#pragma unroll
    for (int r = 0; r < 16; ++r) { const float inv = ol[r] > 0.f ? __builtin_amdgcn_rcpf(ol[r]) : 0.f; a0[r] = o0[r] * inv; a1[r] = o1[r] * inv; }
    store_o(a0, a1, (LAS bf16*)(lds + M_OST + wid * 4096), Ob + ((size_t)b * 8192 + qmin) * 512 + h * 64, 512, lane, r32, hi);
    __syncthreads();
}
#endif
#endif
constexpr int N_KS = 0, N_VS = 16384, N_STG = 32768, N_IMP = 32768, N_WSF = 66048, N_ACC = 68096, N_SEL = 133632, N_UNI = 134656, N_BL = 134720, IMPS = 129;
struct NsaT { const bf16 *Qn, *Kc, *Vc, *Ksel, *Vsel, *Kwin, *Vwin; const float* gates; bf16* Oa; };
__device__ __forceinline__ void setbit(unsigned (&w)[4], int j) { const int wi = j >> 5; const unsigned bv = 1u << (j & 31); w[0] |= wi == 0 ? bv : 0u; w[1] |= wi == 1 ? bv : 0u; w[2] |= wi == 2 ? bv : 0u; w[3] |= wi == 3 ? bv : 0u; }
template <int DIAG = 0> __device__ __forceinline__ void nsa_unit(int b, int g, int ti, const NsaT& T, LAS char* lds, int wave_id) {
    int tid_ = wave_id * 64 + opaque_lane();
    const int tid = tid_, lane = tid & 63, r32 = lane & 31, hi = lane >> 5, wid = __builtin_amdgcn_readfirstlane(tid >> 6);
    const int hh = wid & 3, qh = wid >> 2, H = g * 4 + hh, bg = b * 2 + g;
    const int t0 = ti * 64, qrow = qh * 32 + r32, t = t0 + qrow;
    const float slope2 = __builtin_amdgcn_exp2f(-(float)(H + 1)) * LOG2E;
    bf16x8 qr[4];
    { const bf16* qp = T.Qn + ((size_t)b * 8192 + t) * 512 + H * 64 + hi * 8;
#pragma unroll
      for (int d0 = 0; d0 < 4; ++d0) qr[d0] = *(const bf16x8*)(qp + d0 * 16); }
    LAS float* wsf = (LAS float*)(lds + N_WSF) + wid * 64;
    LAS float* imp = (LAS float*)(lds + N_IMP);
    LAS unsigned* selw = (LAS unsigned*)(lds + N_SEL);
    LAS unsigned* uni = (LAS unsigned*)(lds + N_UNI);
    LAS unsigned* blist = (LAS unsigned*)(lds + N_BL);
    const int vlane = ((lane >> 4) & 1) * 32 + (lane & 3) * 8 + (4 * hi + ((lane & 15) >> 2)) * 64;
    for (int i = tid; i < 64 * IMPS; i += 512) imp[i] = 0.f;
    if (tid < 256) selw[tid] = 0u;
    if (tid < 8) uni[tid] = 0u;
    const float* gp = T.gates + ((size_t)b * 8192 + t) * 24 + H * 3;
    const float gc = gp[0], gs = gp[1], gw = gp[2];
    LAS float* accL = (LAS float*)(lds + N_ACC) + wid * 2048;
    u32x4 kr0, vr0;
    const int ntc = (4 * ti + 3 + 63) >> 6;
    const char* Kcg = (const char*)(T.Kc + (size_t)bg * 8 * 4096); const char* Vcg = (const char*)(T.Vc + (size_t)bg * 8 * 4096);
    float m = -1e30f, l = 0.f;
    f32x16 cb0;
#pragma unroll
    for (int r = 0; r < 16; ++r) cb0[r] = slope2 * 16.0f * (float)crow(r, hi);
    const int nmax = (t - 31) >> 4;
    const int nmax_min = (t0 + qh * 32 - 31) >> 4;
#define CMP_QK(P0, P1, kt_, sl_) do { float s512 = 512.0f * slope2; asm volatile("" : "+v"(s512)); const f32x16 cb1 = cb0 + s512; \
        qk_tile_c<4>(P0, P1, (lcp)(lds + N_KS + (sl_) * 8192), qr, cb0, cb1, r32, hi); \
        if (64 * (kt_) + 63 > nmax_min) mask_causal(P0, P1, 64 * (kt_) + 4 * hi - nmax); } while (0)
    kr0 = *(const u32x4*)(Kcg + tid * 16); *(LAS u32x4*)(lds + N_KS + tid * 16) = kr0;
    __syncthreads();
    for (int kt = 0; kt < ((DIAG & 33) ? 0 : ntc); ++kt) {
        const int sl = kt & 1;
        if (kt + 1 < ntc) kr0 = *(const u32x4*)(Kcg + (size_t)(kt + 1) * 8192 + tid * 16);
        { f32x16 p0, p1; CMP_QK(p0, p1, kt, sl);
          const float off = slope2 * (float)(1024 * kt + 31 - t);
          const float mn = fmaxf(m, max32(p0, p1) + off); const float ca = mn - off; float s = 0.f;
#pragma unroll
          for (int r = 0; r < 16; ++r) s += __builtin_amdgcn_exp2f(p0[r] - ca) + __builtin_amdgcn_exp2f(p1[r] - ca);
          l = l * __builtin_amdgcn_exp2f(m - mn) + s; m = mn; }
        if (kt + 1 < ntc) *(LAS u32x4*)(lds + N_KS + (sl ^ 1) * 8192 + tid * 16) = kr0;
        __syncthreads();
    }
    { auto rm_ = __builtin_amdgcn_permlane32_swap(__float_as_uint(m), __float_as_uint(m), false, false); auto rl_ = __builtin_amdgcn_permlane32_swap(__float_as_uint(l), __float_as_uint(l), false, false);
      const float mo = __uint_as_float(hi ? rm_[0] : rm_[1]), lo = __uint_as_float(hi ? rl_[0] : rl_[1]); const float mn = fmaxf(m, mo);
      l = l * __builtin_amdgcn_exp2f(m - mn) + lo * __builtin_amdgcn_exp2f(mo - mn); m = mn; }
    const float mlog = l > 0.f ? m + __builtin_amdgcn_logf(l) : 1e30f;
    f32x16 o0 = f32x16{}, o1 = f32x16{};
    float carry = 0.f;
#pragma unroll
    for (int i = 0; i < 32; ++i) accL[i * 64 + lane] = 0.f;
    kr0 = *(const u32x4*)(Kcg + tid * 16); vr0 = *(const u32x4*)(Vcg + tid * 16);
    *(LAS u32x4*)(lds + N_KS + tid * 16) = kr0; *(LAS u32x4*)(lds + N_VS + tid * 16) = vr0;
    __syncthreads();
    for (int kt = 0; kt < ((DIAG & 1) ? 0 : ntc); ++kt) {
        const int sl = kt & 1;
        if (kt + 1 < ntc) { kr0 = *(const u32x4*)(Kcg + (size_t)(kt + 1) * 8192 + tid * 16); vr0 = *(const u32x4*)(Vcg + (size_t)(kt + 1) * 8192 + tid * 16); }
        { f32x16 p0, p1; CMP_QK(p0, p1, kt, sl);
          const float ca = mlog - slope2 * (float)(1024 * kt + 31 - t);
#pragma unroll
          for (int r = 0; r < 16; ++r) { p0[r] = __builtin_amdgcn_exp2f(p0[r] - ca); p1[r] = __builtin_amdgcn_exp2f(p1[r] - ca); }
          { float PL0[4], PL1[4];
#pragma unroll
            for (int rg = 0; rg < 4; ++rg) {
                auto x0 = __builtin_amdgcn_permlane32_swap(__float_as_uint(p0[4 * rg + 3]), __float_as_uint(p0[4 * rg + 3]), false, false); PL0[rg] = __uint_as_float(hi ? x0[0] : x0[1]);
                auto x1 = __builtin_amdgcn_permlane32_swap(__float_as_uint(p1[4 * rg + 3]), __float_as_uint(p1[4 * rg + 3]), false, false); PL1[rg] = __uint_as_float(hi ? x1[0] : x1[1]); }
            const int jb = 16 * (kt & 3) + hi;
#pragma unroll
            for (int rg = 0; rg < 4; ++rg) {
                const float v0 = (p0[4 * rg] + p0[4 * rg + 1]) + (p0[4 * rg + 2] + p0[4 * rg + 3]) + (hi ? PL0[rg] : (rg > 0 ? PL0[rg - 1] : carry));
                const float v1 = (p1[4 * rg] + p1[4 * rg + 1]) + (p1[4 * rg + 2] + p1[4 * rg + 3]) + (hi ? PL1[rg] : (rg > 0 ? PL1[rg - 1] : PL0[3]));
                accL[r32 * 64 + ((jb + 2 * rg + r32) & 63)] = v0; accL[r32 * 64 + ((jb + 8 + 2 * rg + r32) & 63)] = v1; }
            carry = PL1[3]; }
          u32x4 pa[4]; pack_p(pa, p0, p1);
          pv_tile(o0, o1, (lcp)(lds + N_VS + sl * 8192 + vlane), pa); }
        if (kt + 1 < ntc) { *(LAS u32x4*)(lds + N_KS + (sl ^ 1) * 8192 + tid * 16) = kr0; *(LAS u32x4*)(lds + N_VS + (sl ^ 1) * 8192 + tid * 16) = vr0; }
        __syncthreads();
        if ((kt & 3) == 3 || kt == ntc - 1) {
            { const int q = tid >> 3, jj0 = (tid & 7) * 8, row = q & 31; const LAS float* pb = (const LAS float*)(lds + N_ACC) + ((q >> 5) * 4) * 2048 + row * 64;
#pragma unroll
              for (int e = 0; e < 8; ++e) { const int ix = (jj0 + e + row) & 63; imp[q * IMPS + 64 * (kt >> 2) + jj0 + e] = (pb[ix] + pb[2048 + ix]) + (pb[4096 + ix] + pb[6144 + ix]); } }
            __syncthreads();
            if (kt != ntc - 1) {
#pragma unroll
                for (int i = 0; i < 32; ++i) accL[i * 64 + lane] = 0.f; }
        }
    }
#undef CMP_QK
    acc_lds<true>(accL, o0, o1, gc, wsf, r32, hi);
    {
        const int q = tid >> 3, sub = tid & 7;
        unsigned w[4] = {0u, 0u, 0u, 0u};
        if (ti <= 15 || (DIAG & 2)) { if (sub == 0) w[0] = (ti <= 15) ? (2u << ti) - 1u : 0xffffu; }
        else {
            const LAS float* row = imp + q * IMPS;
#pragma unroll 1
            for (int half = 0; half < 2; ++half) {
                float v[8]; int cnt[8];
#pragma unroll
                for (int k = 0; k < 8; ++k) { const int j = 1 + sub + 8 * (k + 8 * half); v[k] = (j <= ti - 2) ? row[j] : -1.0f; cnt[k] = 0; }
#pragma unroll 1
                for (int jp = 1; jp <= ti - 2; ++jp) { const float vp = row[jp];
#pragma unroll
                    for (int k = 0; k < 8; ++k) { const int j = 1 + sub + 8 * (k + 8 * half); cnt[k] += (vp > v[k] || (vp == v[k] && jp < j)) ? 1 : 0; } }
#pragma unroll
                for (int k = 0; k < 8; ++k) { const int j = 1 + sub + 8 * (k + 8 * half); if (j <= ti - 2 && cnt[k] < 13) setbit(w, j); }
            }
            if (sub == 0) { w[0] |= 1u; setbit(w, ti); setbit(w, ti - 1); }
        }
#pragma unroll
        for (int k = 0; k < 4; ++k) if (w[k]) { __hip_atomic_fetch_or(selw + q * 4 + k, w[k], __ATOMIC_RELAXED, __HIP_MEMORY_SCOPE_WORKGROUP); __hip_atomic_fetch_or(uni + k, w[k], __ATOMIC_RELAXED, __HIP_MEMORY_SCOPE_WORKGROUP); }
    }
    __syncthreads();
    if (tid == 0) { int nb = 0;
        for (int k = 0; k < 4; ++k) { unsigned u = uni[k]; while (u) { const int bit = __builtin_ctz(u); u &= u - 1u; blist[nb++] = (unsigned)(32 * k + bit); } }
        uni[4] = (unsigned)nb; }
    __syncthreads();
    const int nsel = (int)uni[4];
    unsigned sw[4];
#pragma unroll
    for (int k = 0; k < 4; ++k) sw[k] = selw[qrow * 4 + k];
    f32x16 bias0, bias1;
#pragma unroll
    for (int r = 0; r < 16; ++r) { bias0[r] = slope2 * (float)crow(r, hi); bias1[r] = bias0[r] + 32.0f * slope2; }
#define NSA_DMA(Kg_, Vg_, ja_, jb_, stg_) do { dma1k(Kg_ + (size_t)(ja_) * 8192, lds + (stg_) * N_STG + wid * 1024); dma1k(Kg_ + (size_t)(jb_) * 8192, lds + (stg_) * N_STG + 8192 + wid * 1024); \
        dma1k(Vg_ + (size_t)(ja_) * 8192, lds + (stg_) * N_STG + 16384 + wid * 1024); dma1k(Vg_ + (size_t)(jb_) * 8192, lds + (stg_) * N_STG + 24576 + wid * 1024); } while (0)
    if (!(DIAG & 4)) {
        const char* Kg = (const char*)(T.Ksel + (size_t)bg * 128 * 4096) + wid * 1024 + lane * 16; const char* Vg = (const char*)(T.Vsel + (size_t)bg * 128 * 4096) + wid * 1024 + lane * 16;
        m = -1e30f; l = 0.f; o0 = f32x16{}; o1 = f32x16{};
        const int npair = (nsel + 1) >> 1;
        int ja = (int)blist[0], jb = nsel > 1 ? (int)blist[1] : ja;
        NSA_DMA(Kg, Vg, ja, jb, 0);
        __syncthreads();
        for (int p = 0; p < npair; ++p) {
            const int st = p & 1; int na = 0, nb = 0;
            if (p + 1 < npair) { na = (int)blist[2 * p + 2]; nb = (2 * p + 3 < nsel) ? (int)blist[2 * p + 3] : na; NSA_DMA(Kg, Vg, na, nb, st ^ 1); }
            { LAS char* sb = lds + st * N_STG;
              f32x16 p0, p1, p2, p3;
              qk_tile_c<4>(p0, p1, (lcp)sb, qr, bias0, bias1, r32, hi);
              qk_tile_c<4>(p2, p3, (lcp)(sb + 8192), qr, bias0, bias1, r32, hi);
              const int wa = ja >> 5, wb = jb >> 5;
              const unsigned swa = wa == 0 ? sw[0] : wa == 1 ? sw[1] : wa == 2 ? sw[2] : sw[3], swb = wb == 0 ? sw[0] : wb == 1 ? sw[1] : wb == 2 ? sw[2] : sw[3];
              const bool minea = (swa >> (ja & 31)) & 1u, mineb = ((swb >> (jb & 31)) & 1u) && (2 * p + 1 < nsel);
              if (ja == ti) mask_causal(p0, p1, 64 * ja + 4 * hi - t);
              if (jb == ti) mask_causal(p2, p3, 64 * jb + 4 * hi - t);
              const float offa = minea ? slope2 * (float)(64 * ja - t) : -INFINITY, offb = mineb ? slope2 * (float)(64 * jb - t) : -INFINITY;
              softmax_pv2(p0, p1, p2, p3, offa, offb, m, l, o0, o1, (lcp)(sb + 16384 + vlane), (lcp)(sb + 24576 + vlane), wsf, r32, hi); }
            ja = na; jb = nb;
            __syncthreads();
        }
        const float lt = xsum(l); acc_lds<false>(accL, o0, o1, lt > 0.f ? gs / lt : 0.f, wsf, r32, hi);
    }
    if (!(DIAG & 8)) {
        const char* Kg = (const char*)(T.Kwin + (size_t)bg * 128 * 4096) + wid * 1024 + lane * 16; const char* Vg = (const char*)(T.Vwin + (size_t)bg * 128 * 4096) + wid * 1024 + lane * 16;
        m = -1e30f; l = 0.f; o0 = f32x16{}; o1 = f32x16{};
        const int j0 = ti >= 8 ? ti - 8 : 0, nw = ti - j0 + 1, npair = (nw + 1) >> 1;
        NSA_DMA(Kg, Vg, j0, (nw > 1 ? j0 + 1 : j0), 0);
        __syncthreads();
        for (int p = 0; p < npair; ++p) {
            const int st = p & 1; const int ja = j0 + 2 * p; const bool hasb = (2 * p + 1 < nw); const int jb = hasb ? ja + 1 : ja;
            if (p + 1 < npair) { const int na = ja + 2, nb = (2 * p + 3 < nw) ? na + 1 : na; NSA_DMA(Kg, Vg, na, nb, st ^ 1); }
            { LAS char* sb = lds + st * N_STG;
              f32x16 p0, p1, p2, p3;
              qk_tile_c<4>(p0, p1, (lcp)sb, qr, bias0, bias1, r32, hi);
              qk_tile_c<4>(p2, p3, (lcp)(sb + 8192), qr, bias0, bias1, r32, hi);
              if (ja == ti) mask_causal(p0, p1, 64 * ja + 4 * hi - t);
              if (jb == ti) mask_causal(p2, p3, 64 * jb + 4 * hi - t);
              if (ja == ti - 8) mask_winlow(p0, p1, 64 * ja + 4 * hi - t);
              if (jb == ti - 8) mask_winlow(p2, p3, 64 * jb + 4 * hi - t);
              const float offa = slope2 * (float)(64 * ja - t), offb = hasb ? slope2 * (float)(64 * jb - t) : -INFINITY;
              softmax_pv2(p0, p1, p2, p3, offa, offb, m, l, o0, o1, (lcp)(sb + 16384 + vlane), (lcp)(sb + 24576 + vlane), wsf, r32, hi); }
            __syncthreads();
        }
        const float lt = xsum(l); acc_lds<false>(accL, o0, o1, lt > 0.f ? gw / lt : 0.f, wsf, r32, hi);
    }
#undef NSA_DMA
    store_acc(accL, T.Oa + ((size_t)b * 8192 + t0 + qh * 32) * 512 + H * 64, 512, lane);
    __syncthreads();
}

#endif

}
#define XLAS __attribute__((address_space(3)))
#define XB_TMO      128
#define XB_XCNT(j)  (256  + 64 * (j))
#define XB_XSUB(j)  (1280 + 64 * (j))
#define XB_XGEN(j)  (2304 + 64 * (j))
#define XB_TOP      3328
#define XB_TOPGEN   3392
#define XCD_BAR_WORDS 3456
#define XB_SPIN_CAP (1u << 18)

__device__ __forceinline__ unsigned xb_ld(unsigned* p)              { return __hip_atomic_load(p, __ATOMIC_RELAXED, __HIP_MEMORY_SCOPE_AGENT); }
__device__ __forceinline__ unsigned xb_add(unsigned* p, unsigned v) { return __hip_atomic_fetch_add(p, v, __ATOMIC_RELAXED, __HIP_MEMORY_SCOPE_AGENT); }
__device__ __forceinline__ unsigned xb_xcc_id() { return (unsigned)__builtin_amdgcn_s_getreg((3 << 11) | 20) & 0xFu; }
#define XB_SPIN(cond, bar) do { unsigned _sp = 0; while (cond) { __builtin_amdgcn_s_sleep(1); \
    if ((++_sp & 255u) == 0u) { if (xb_ld(&(bar)[XB_TMO])) break; if (_sp > XB_SPIN_CAP) { atomicAdd(&(bar)[XB_TMO], 1u); break; } } } } while (0)

struct XcdBarrier {
    unsigned* bar; unsigned x;
    volatile XLAS unsigned* st;
};

__device__ __forceinline__ XcdBarrier xcd_barrier_post(unsigned* bar, volatile XLAS unsigned* st) {
    XcdBarrier b; b.bar = bar; b.x = xb_xcc_id(); b.st = st;
    if (threadIdx.x == 0) (void)xb_add(&bar[XB_XCNT(b.x)], 1u);
    return b;
}
__device__ __forceinline__ void xcd_barrier_complete(unsigned* bar, unsigned x, unsigned& nloc, unsigned& nx) {
    const unsigned G = gridDim.x * gridDim.y * gridDim.z;
    unsigned sum, cnt, mine, sp = 0u;
    for (;;) {
        sum = 0u; cnt = 0u; mine = 0u;
#pragma unroll
        for (unsigned j = 0; j < 16; ++j) { const unsigned c = xb_ld(&bar[XB_XCNT(j)]); sum += c; cnt += (c > 0u) ? 1u : 0u; mine = (j == x) ? c : mine; }
        if (sum == G) break;
        __builtin_amdgcn_s_sleep(1);
        if ((++sp & 255u) == 0u) { if (xb_ld(&bar[XB_TMO])) break; if (sp > XB_SPIN_CAP) { atomicAdd(&bar[XB_TMO], 1u); break; } }
    }
    nloc = mine > 0u ? mine : 1u; nx = cnt > 0u ? cnt : 1u;
}

__device__ __forceinline__ void xcd_barrier(const XcdBarrier& b) {
    asm volatile("s_waitcnt vmcnt(0)" ::: "memory");
    __syncthreads();
    if (threadIdx.x == 0) {
        unsigned* bar = b.bar;
        __builtin_amdgcn_s_waitcnt(0);
        unsigned nloc = b.st[0], nx = b.st[1];
        if (nloc == 0u) { xcd_barrier_complete(bar, b.x, nloc, nx); b.st[0] = nloc; b.st[1] = nx; }
        const unsigned old = xb_add(&bar[XB_XSUB(b.x)], 1u);
        const unsigned gen = old / nloc;
        if (old + 1u == (gen + 1u) * nloc) {
            __builtin_amdgcn_fence(__ATOMIC_RELEASE, "agent");
            asm volatile("s_waitcnt vmcnt(0)" ::: "memory");
            const unsigned og = xb_add(&bar[XB_TOP], 1u);
            const unsigned tg = og / nx;
            if (og + 1u == (tg + 1u) * nx) xb_add(&bar[XB_TOPGEN], 1u);
            else XB_SPIN(xb_ld(&bar[XB_TOPGEN]) == tg, bar);
            __builtin_amdgcn_fence(__ATOMIC_ACQUIRE, "agent");
            xb_add(&bar[XB_XGEN(b.x)], 1u);
            asm volatile("s_waitcnt vmcnt(0)" ::: "memory");
        } else {
            XB_SPIN(xb_ld(&bar[XB_XGEN(b.x)]) == gen, bar);
            __builtin_amdgcn_fence(__ATOMIC_ACQUIRE, "agent");
            asm volatile("s_waitcnt vmcnt(0)" ::: "memory");
        }
    }
    __syncthreads();
}
#define GLAS __attribute__((address_space(3)))
typedef unsigned short bf16_t;
typedef float f32x4 __attribute__((ext_vector_type(4)));
typedef unsigned u32x4 __attribute__((ext_vector_type(4)));
constexpr int NT_TOK = 16384, SEQ = 8192, DM = 1024, DFF = 2816, NTHREADS = 512, NWAVES = 8;
struct KArgs { const float* in[26]; float* out; unsigned char* ws; };
struct ArgRef { unsigned char* ws;
    __device__ __forceinline__ const float* in_(int i) const { const __attribute__((address_space(4))) KArgs* p = (const __attribute__((address_space(4))) KArgs*)__builtin_amdgcn_kernarg_segment_ptr(); asm volatile("" : "+s"(p)); const unsigned long long v_ = *(const __attribute__((address_space(4))) unsigned long long*)(&p->in[i]); return (const float*)(const __attribute__((address_space(1))) float*)v_; }
};

__device__ __forceinline__ unsigned f2bf_rne(float f) { unsigned u = __builtin_bit_cast(unsigned, f); return (u + 0x7fffu + ((u >> 16) & 1u)) >> 16; }
__device__ __forceinline__ unsigned pk2(float lo, float hi) { return f2bf_rne(lo) | (f2bf_rne(hi) << 16); }

struct WSrc { const float* p; int ld; };
template <class Map> __device__ __forceinline__ void conv_weight(GLAS float* scr, int lane, int gw, int ngw, int K, int N, bf16_t* WT, const float* kscale, Map map) {
    asm volatile("" : "+v"(lane));
    const int nblk = N / 64, nitems = (K / 64) * nblk;
    for (int it = gw; it < nitems; it += ngw) {
        const int kb = it / nblk, nb = it % nblk, k0 = 64 * kb, n0 = 64 * nb;
        const WSrc s0 = map(n0), s63 = map(n0 + 63), s31 = map(n0 + 31), s1 = map(n0 + 1), s33 = map(n0 + 33);
        const bool fast = s0.p != nullptr && s63.p == s0.p + 63 && s31.p == s0.p + 31 && s1.p == s0.p + 1 && s33.p == s0.p + 33 && ((((uintptr_t)s0.p) | ((uintptr_t)s0.ld * 4u)) & 15u) == 0u;
        if (fast) {
            const float* src = s0.p + (size_t)(k0 + (lane >> 4)) * s0.ld + (lane & 15) * 4;
            f32x4 v[16];
#pragma unroll
            for (int i = 0; i < 16; ++i) v[i] = *(const f32x4*)(src + (size_t)(4 * i) * s0.ld);
#pragma unroll
            for (int i = 0; i < 16; ++i) { const int kk = 4 * i + (lane >> 4); f32x4 x = v[i]; if (kscale) x = x * kscale[k0 + kk]; GLAS float* d = scr + kk * 65 + (lane & 15) * 4; d[0] = x.x; d[1] = x.y; d[2] = x.z; d[3] = x.w; }
        } else {
#pragma unroll
            for (int hb = 0; hb < 2; ++hb) { const WSrc s = map(n0 + 32 * hb + (lane & 31));
#pragma unroll 8
                for (int i = 0; i < 32; ++i) { const int kk = 2 * i + (lane >> 5); float v = s.p ? s.p[(size_t)(k0 + kk) * s.ld] : 0.f; if (kscale) v *= kscale[k0 + kk]; scr[kk * 65 + 32 * hb + (lane & 31)] = v; } }
        }
        asm volatile("s_waitcnt lgkmcnt(0)" ::: "memory");
        const int c = lane & 7;
#pragma unroll
        for (int j = 0; j < 8; ++j) { const int n = (lane >> 3) + 8 * j; const GLAS float* sp = scr + (8 * c) * 65 + n;
            u32x4 o; o.x = pk2(sp[0 * 65], sp[1 * 65]); o.y = pk2(sp[2 * 65], sp[3 * 65]); o.z = pk2(sp[4 * 65], sp[5 * 65]); o.w = pk2(sp[6 * 65], sp[7 * 65]);
            *(u32x4*)(WT + (size_t)(n0 + n) * K + k0 + 8 * c) = o; }
        asm volatile("s_waitcnt lgkmcnt(0)" ::: "memory");
    }
}
__device__ __forceinline__ void convert_layer(const ArgRef& A, int l, GLAS unsigned char* lds, int lane, int wave, int gw, int ngw) {
    GLAS float* scr = (GLAS float*)(lds + wave * 16640);
    unsigned char* ws = A.ws;
    { const float* G = A.in_(4) + (size_t)l * 1024 * 2816; const float* U = A.in_(5) + (size_t)l * 1024 * 2816;
      conv_weight(scr, lane, gw, ngw, 1024, 5632, (bf16_t*)(ws + W_GU1), nullptr, [=](int n) { const int tl = n >> 8, r = n & 255; const uintptr_t gp = (uintptr_t)G, up = (uintptr_t)U; return WSrc{(const float*)(const __attribute__((address_space(1))) float*)(gp + (up - gp) * (uintptr_t)(r >> 7)) + tl * 128 + (r & 127), 2816}; }); }
    { const float* Dn = A.in_(6) + (size_t)l * 2816 * 1024; conv_weight(scr, lane, gw, ngw, 2816, 1024, (bf16_t*)(ws + W_D1), nullptr, [=](int n) { return WSrc{Dn + n, 1024}; }); }
    { const float* G = A.in_(7) + (size_t)l * 1024 * 2816; const float* U = A.in_(8) + (size_t)l * 1024 * 2816;
      conv_weight(scr, lane, gw, ngw, 1024, 5632, (bf16_t*)(ws + W_GU2), nullptr, [=](int n) { const int tl = n >> 8, r = n & 255; const uintptr_t gp = (uintptr_t)G, up = (uintptr_t)U; return WSrc{(const float*)(const __attribute__((address_space(1))) float*)(gp + (up - gp) * (uintptr_t)(r >> 7)) + tl * 128 + (r & 127), 2816}; }); }
    { const float* Dn = A.in_(9) + (size_t)l * 2816 * 1024; conv_weight(scr, lane, gw, ngw, 2816, 1024, (bf16_t*)(ws + W_D2), nullptr, [=](int n) { return WSrc{Dn + n, 1024}; }); }
    { const float* Wi = A.in_(10) + (size_t)l * 1024 * 4024;
      conv_weight(scr, lane, gw, ngw, 1024, 4096, (bf16_t*)(ws + W_IN), nullptr, [=](int n) {
          int src;
          if (n < 1280) src = n;
          else if (n < 1536) src = 1688 + (n - 1280);
          else if (n < 1792) src = 1304 + (n - 1536);
          else if (n < 2048) { const int r = n - 1792;
              if (r < 128) src = 1304 + 256 + r;
              else if (r < 160) { const int p = r - 128; src = 1944 + ((p & 1) ? 16 + (p >> 1) : (p >> 1)); }
              else if (r < 184) src = 1280 + (r - 160);
              else src = -1; }
          else src = 1976 + (n - 2048);
          return WSrc{src >= 0 ? Wi + src : nullptr, 4024}; }); }
    { const float* Wq = A.in_(18) + (size_t)l * 384 * 768;
      conv_weight(scr, lane, gw, ngw, 384, 768, (bf16_t*)(ws + W_UQ), A.in_(17) + (size_t)l * 384, [=](int n) { const int h = n / 96, p = n % 96; int src = h * 96 + p;
          if (p >= 64) { const int pp = p - 64; src = h * 96 + 64 + ((pp & 1) ? 16 + (pp >> 1) : (pp >> 1)); }
          return WSrc{Wq + src, 768}; }); }
    { const float* Wk = A.in_(20) + (size_t)l * 256 * 512; const float* Wv = A.in_(21) + (size_t)l * 256 * 512;
      conv_weight(scr, lane, gw, ngw, 256, 1024, (bf16_t*)(ws + W_UKV), A.in_(19) + (size_t)l * 256, [=](int n) { const uintptr_t kp = (uintptr_t)Wk, vp = (uintptr_t)Wv; return WSrc{(const float*)(const __attribute__((address_space(1))) float*)(kp + (vp - kp) * (uintptr_t)(n >> 9)) + (n & 511), 512}; }); }
    { const float* Wa = A.in_(22) + (size_t)l * 512 * 1024; conv_weight(scr, lane, gw, ngw, 512, 1024, (bf16_t*)(ws + W_BA), nullptr, [=](int n) { return WSrc{Wa + n, 1024}; }); }
    { const float* Wb = A.in_(23) + (size_t)l * 512 * 1024; conv_weight(scr, lane, gw, ngw, 512, 1024, (bf16_t*)(ws + W_BB), nullptr, [=](int n) { return WSrc{Wb + n, 1024}; }); }
    { const float* Wo = A.in_(24) + (size_t)l * 1024 * 1024; conv_weight(scr, lane, gw, ngw, 1024, 1024, (bf16_t*)(ws + W_OUT), nullptr, [=](int n) { return WSrc{Wo + n, 1024}; }); }
    { const float* W1 = A.in_(11) + (size_t)l * 2048 * 64; conv_weight(scr, lane, gw, ngw, 2048, 64, (bf16_t*)(ws + W_1K), nullptr, [=](int n) { return WSrc{W1 + n, 64}; }); }
    { const float* W1 = A.in_(14) + (size_t)l * 2048 * 64; conv_weight(scr, lane, gw, ngw, 2048, 64, (bf16_t*)(ws + W_1V), nullptr, [=](int n) { return WSrc{W1 + n, 64}; }); }
}
__device__ __forceinline__ void norm_phase(const float* x, bf16_t* xn, const float* sh, const float* sc, int lane, int gw, int ngw) {
    asm volatile("" : "+v"(lane));
    for (int row = gw; row < NT_TOK; row += ngw) {
        const f32x4* xr = (const f32x4*)(x + (size_t)row * DM) + lane; const int b = row >> 13;
        f32x4 v[4]; float s = 0.f;
#pragma unroll
        for (int j = 0; j < 4; ++j) { v[j] = xr[64 * j]; s += (v[j].x * v[j].x + v[j].y * v[j].y) + (v[j].z * v[j].z + v[j].w * v[j].w); }
        const float rstd = 1.0f / sqrtf(wave_sum(s) * (1.0f / DM) + 1e-6f);
        unsigned long long* o8 = (unsigned long long*)(xn + (size_t)row * DM) + lane;
#pragma unroll
        for (int j = 0; j < 4; ++j) { const f32x4 a = *((const f32x4*)(sc + (size_t)b * 9216) + lane + 64 * j), c = *((const f32x4*)(sh + (size_t)b * 9216) + lane + 64 * j);
            const f32x4 y = v[j] * rstd * (a + 1.0f) + c;
            o8[64 * j] = (unsigned long long)pk2(y.x, y.y) | ((unsigned long long)pk2(y.z, y.w) << 32); }
    }
}
__device__ __forceinline__ void final_norm_phase(float* x, const float* wn, int lane, int gw, int ngw) {
    asm volatile("" : "+v"(lane));
    for (int row = gw; row < NT_TOK; row += ngw) {
        f32x4* xr = (f32x4*)(x + (size_t)row * DM) + lane;
        f32x4 v[4]; float s = 0.f;
#pragma unroll
        for (int j = 0; j < 4; ++j) { v[j] = xr[64 * j]; s += (v[j].x * v[j].x + v[j].y * v[j].y) + (v[j].z * v[j].z + v[j].w * v[j].w); }
        const float rstd = 1.0f / sqrtf(wave_sum(s) * (1.0f / DM) + 1e-6f);
#pragma unroll
        for (int j = 0; j < 4; ++j) { const f32x4 w = *((const f32x4*)wn + lane + 64 * j); xr[64 * j] = v[j] * rstd * w; }
    }
}
__device__ __forceinline__ void adaln_phase(const ArgRef& A, GLAS unsigned char* lds, int tid, int lane, int wave, int blk, int nblk) {
    asm volatile("" : "+v"(tid), "+v"(lane));
    GLAS float* ca = (GLAS float*)lds;
    GLAS float* red = (GLAS float*)(lds + 8192);
    for (int i = tid; i < 2048; i += NTHREADS) { const float c = A.in_(1)[i]; ca[i] = c / (1.0f + __expf(-c)); }
    __syncthreads();
    float* mod = (float*)(A.ws + WS_MOD);
    for (int u = blk; u < 288; u += nblk) {
        const int l = u / 144, n0 = (u % 144) * 64;
        const float* W = A.in_(2) + (size_t)l * 1024 * 9216 + n0 + lane;
        float a0 = 0.f, a1 = 0.f;
        const int kb = wave * 128;
#pragma unroll 32
        for (int k = 0; k < 128; ++k) { const float w = W[(size_t)(kb + k) * 9216]; a0 += ca[kb + k] * w; a1 += ca[1024 + kb + k] * w; }
        red[(wave * 2 + 0) * 64 + lane] = a0; red[(wave * 2 + 1) * 64 + lane] = a1;
        __syncthreads();
        if (tid < 128) { const int b = tid >> 6, n = tid & 63; float s = A.in_(3)[(size_t)l * 9216 + n0 + n];
#pragma unroll
            for (int w = 0; w < 8; ++w) s += red[(w * 2 + b) * 64 + n];
            mod[((size_t)l * 2 + b) * 9216 + n0 + n] = s; }
        __syncthreads();
    }
}
__device__ __forceinline__ void rope_table_phase(float* cs, int gtid, int ngt) {
    for (int e = gtid; e < SEQ * 16; e += ngt) { const int t = e >> 4, i = e & 15;
        const float inv = powf(10000.0f, -(float)i / 16.0f); const float ang = (float)t * inv;
        const double rev = (double)ang * 0.15915494309189535; const double fr = rev - __builtin_rint(rev);
        cs[t * 32 + i] = __builtin_amdgcn_cosf((float)fr); cs[t * 32 + 16 + i] = __builtin_amdgcn_sinf((float)fr); }
}
__device__ __forceinline__ void cbias_phase(const ArgRef& A, GLAS unsigned char* lds, int tid, int blk) {
    GLAS float* red = (GLAS float*)(lds + 16384);
    if (blk < 4) { const int l = blk >> 1, kv = blk & 1; const float* pe = A.in_(kv ? 16 : 13) + (size_t)l * 2048; const float* w1 = A.in_(kv ? 14 : 11) + (size_t)l * 2048 * 64;
        const int n = tid & 63, part = tid >> 6; float s = 0.f;
        for (int j = part * 256; j < part * 256 + 256; ++j) s += pe[j] * w1[(size_t)j * 64 + n];
        red[part * 64 + n] = s;
        __syncthreads();
        if (tid < 64) { float t = 0.f;
#pragma unroll
            for (int p = 0; p < 8; ++p) t += red[p * 64 + tid];
            ((float*)(A.ws + WS_CBIAS))[(l * 2 + kv) * 64 + tid] = t; }
        __syncthreads();
    }
}
__device__ __forceinline__ void compress_phase(const ArgRef& A, int l, GLAS unsigned char* lds, int tid, int lane, int wave, int ubeg, int ustep) {
    asm volatile("" : "+v"(tid), "+v"(lane));
    typedef short bf16x8 __attribute__((ext_vector_type(8))); typedef float f32x16 __attribute__((ext_vector_type(16)));
    GLAS float* red = (GLAS float*)lds;
    GLAS float* c1 = (GLAS float*)(lds + 65536);
    const int r32 = lane & 31, hi = lane >> 5;
    for (int u = ubeg; u < 128; u += ustep) {
        const int kv = u >> 6, bg = (u >> 4) & 3, rb = u & 15, i0 = rb * 32;
        const bf16_t* src = (const bf16_t*)(A.ws + (kv ? WS_VCF : WS_KCF)) + (size_t)bg * SEQ * 64;
        const bf16_t* w1t = (const bf16_t*)(A.ws + (kv ? W_1V : W_1K));
        const float* w2 = A.in_(kv ? 15 : 12) + (size_t)l * 4096;
        const float* cb = (const float*)(A.ws + WS_CBIAS) + (l * 2 + kv) * 64;
        f32x16 a0 = f32x16{}, a1 = f32x16{};
        const bf16_t* ap = src + (size_t)(i0 + r32) * 1024 + wave * 256 + hi * 8;
        const bf16_t* bp = w1t + (size_t)r32 * 2048 + wave * 256 + hi * 8;
#pragma unroll 8
        for (int ks = 0; ks < 16; ++ks) {
            const bf16x8 af = *(const bf16x8*)(ap + ks * 16), b0 = *(const bf16x8*)(bp + ks * 16), b1 = *(const bf16x8*)(bp + 32 * 2048 + ks * 16);
            a0 = __builtin_amdgcn_mfma_f32_32x32x16_bf16(af, b0, a0, 0, 0, 0);
            a1 = __builtin_amdgcn_mfma_f32_32x32x16_bf16(af, b1, a1, 0, 0, 0); }
#pragma unroll
        for (int r = 0; r < 16; ++r) { red[wave * 2048 + r * 64 + lane] = a0[r]; red[wave * 2048 + (16 + r) * 64 + lane] = a1[r]; }
        __syncthreads();
#pragma unroll
        for (int j = 0; j < 4; ++j) { const int e = tid + 512 * j; float s = 0.f;
#pragma unroll
            for (int w = 0; w < 8; ++w) s += red[w * 2048 + e];
            const int nt = e >> 10, r = (e >> 6) & 15, ln = e & 63; const int i = (r & 3) + 8 * (r >> 2) + 4 * (ln >> 5), n = 32 * nt + (ln & 31);
            const float xv = s + cb[n]; const float z = 0.7978845608028654f * (xv + 0.044715f * xv * xv * xv);
            const float th = 1.0f - 2.0f * __builtin_amdgcn_rcpf(__builtin_amdgcn_exp2f(2.885390081777927f * z) + 1.0f);
            c1[i * 65 + n] = 0.5f * xv * (1.0f + th); }
        __syncthreads();
        { const int i = tid >> 4, n2 = (tid & 15) * 4; f32x4 o = (f32x4){0.f, 0.f, 0.f, 0.f};
#pragma unroll 8
          for (int k = 0; k < 64; ++k) { const float c = c1[i * 65 + k]; const f32x4 w = *(const f32x4*)(w2 + k * 64 + n2); o += w * c; }
          const int nc = i0 + i; if (nc == 511) o = (f32x4){0.f, 0.f, 0.f, 0.f};
          const size_t tb = (size_t)bg * 8 + (nc >> 6); const int key = nc & 63;
          const unsigned long long pk = (unsigned long long)pk2(o.x, o.y) | ((unsigned long long)pk2(o.z, o.w) << 32);
          if (kv == 0) *(unsigned long long*)((bf16_t*)(A.ws + WS_KC) + (tb * 8 + (n2 >> 3)) * 512 + key * 8 + (n2 & 7)) = pk;
          else *(unsigned long long*)((bf16_t*)(A.ws + WS_VC) + tb * 4096 + (n2 >> 5) * 2048 + key * 32 + (n2 & 31)) = pk; }
        __syncthreads();
    }
}

template <int NC> __device__ __forceinline__ void rstd_table(const bf16_t* X, int row0, GLAS float* tab, float scale, int lane, int wave) {
#pragma unroll 1
    for (int rb = 0; rb < 32; rb += 16) {
        u32x4 v[16];
#pragma unroll
        for (int r = 0; r < 16; ++r) { v[r] = (u32x4){0u, 0u, 0u, 0u}; if (lane < NC / 8) v[r] = *(const u32x4*)(X + (size_t)(row0 + wave * 32 + rb + r) * NC + lane * 8); }
#pragma unroll
        for (int r = 0; r < 16; ++r) { const unsigned w4[4] = {v[r].x, v[r].y, v[r].z, v[r].w}; float s = 0.f;
#pragma unroll
            for (int i = 0; i < 4; ++i) { const float a = __uint_as_float(w4[i] << 16), b = __uint_as_float(w4[i] & 0xffff0000u); s += a * a + b * b; }
            s = wave_sum(s);
            if (lane == 0) tab[wave * 32 + rb + r] = scale * __builtin_amdgcn_rsqf(s * (1.0f / NC) + 1e-6f); }
    }
}
__device__ __forceinline__ void dump_bf16(float* out, const bf16_t* src, int nslab, int gtid, int ngt) {
    for (int i = gtid; i < NT_TOK * DM; i += ngt) { float s = 0.f; for (int k = 0; k < nslab; ++k) if (k < 3 || i < 14 * 1024 * 1024) s += __uint_as_float(((unsigned)src[(size_t)k * NT_TOK * DM + i]) << 16); out[i] = s; }
}
#ifndef WIN_ALIGN
#define WIN_ALIGN true
#define WIN_SP2 true
#endif
#ifndef STOPAT
#define STOPAT 99
#endif
#ifndef PHMASK
#define PHMASK 0xffffffffu
#endif
#define PH(k) ((PHMASK >> (k)) & 1u)
#ifndef DUPMASK
#define DUPMASK 0u
#endif
#define NREP(k) (((DUPMASK >> (k)) & 1u) ? 2 : 1)
#ifdef TPROBE
#define TSTAMP(k) do { if (blockIdx.x == 0 && wave == 0 && opaque_lane() == 0) { GLAS unsigned* tw_ = (GLAS unsigned*)(lds + 131072 + 8192); const unsigned t_ = (unsigned)__builtin_amdgcn_s_memrealtime(); tw_[k] += t_ - tw_[31]; tw_[31] = t_; } } while (0)
#else
#define TSTAMP(k) do { } while (0)
#endif
#ifndef USE_CG
#define GRIDBAR() xcd_barrier(xbar)
#else
#define GRIDBAR() grid.sync()
#endif
constexpr int LDS_BYTES = 147456;
constexpr size_t WS_BAR = 384 * 1024, BAR_BYTES = 16384;
constexpr int LDS_BARST = 147456 - 64;
__global__ void __launch_bounds__(NTHREADS, 2) hybrid_fwd(KArgs KA) {
    extern __shared__ __attribute__((aligned(16))) unsigned char lds_raw[];
    GLAS unsigned char* lds = (GLAS unsigned char*)lds_raw;
    cg::grid_group grid = cg::this_grid();
    if (threadIdx.x < 8) ((GLAS unsigned*)(lds + LDS_BARST))[threadIdx.x] = 0u;
    __syncthreads();
    XcdBarrier xbar = xcd_barrier_post((unsigned*)(KA.ws + WS_BAR), (volatile GLAS unsigned*)(lds + LDS_BARST));
    const int wave = __builtin_amdgcn_readfirstlane(threadIdx.x >> 6);
#define MYTID() (wave * 64 + opaque_lane())
    int tid = MYTID(), lane = tid & 63; asm volatile("" : "+v"(tid), "+v"(lane));
    const int G = gridDim.x, blk0 = blockIdx.x; int blk = blk0;
    const int vcu = (G % 8 == 0) ? (blk % 8) * (G / 8) + blk / 8 : blk;
    const int gw = blk * NWAVES + wave, ngw = G * NWAVES;
    ArgRef A; A.ws = KA.ws; unsigned char* const ws0 = KA.ws; unsigned char* ws = ws0;
#define PHASE_BEGIN() do { unsigned long long w_ = (unsigned long long)ws0; blk = blk0; asm volatile("" : "+s"(w_), "+s"(blk)); ws = (unsigned char*)(__attribute__((address_space(1))) unsigned char*)w_; A.ws = ws; tid = MYTID(); lane = tid & 63; asm volatile("" : "+v"(tid), "+v"(lane)); } while (0)
    float* mod = (float*)(ws + WS_MOD);
    float* xres = KA.out;

#ifdef TPROBE
    if (threadIdx.x < 32) ((GLAS unsigned*)(lds + 131072 + 8192))[threadIdx.x] = 0u;
    __syncthreads();
    if (threadIdx.x == 0) ((GLAS unsigned*)(lds + 131072 + 8192))[31] = (unsigned)__builtin_amdgcn_s_memrealtime();
#endif
    for (int rep0 = 0; rep0 < NREP(0); ++rep0) {
    if (PH(0)) adaln_phase(A, lds, tid, lane, wave, blk, G);
    if (PH(1)) rope_table_phase((float*)(ws + WS_CS), blk * NTHREADS + tid, G * NTHREADS);
    if (PH(2)) convert_layer(A, 0, lds, lane, wave, gw, ngw);
    __syncthreads();
    if (PH(3)) cbias_phase(A, lds, tid, blk);
    __syncthreads();
    }
    grid.sync();
    TSTAMP(0);

    for (int l = 0; l < 2; ++l) {
        PHASE_BEGIN();
        const float* ml = mod + (size_t)l * 2 * 9216;
        const float* xin = (l == 0) ? A.in_(0) : xres;
        if (PH(2) && l == 1) { convert_layer(A, 1, lds, lane, wave, gw, ngw); }
        if (PH(4)) norm_phase(xin, (bf16_t*)(ws + WS_XN), ml + 0 * 1024, ml + 1 * 1024, lane, gw, ngw);
        GRIDBAR();
        TSTAMP(1);
        PHASE_BEGIN();
        for (int rep2 = 0; rep2 < NREP(2); ++rep2) {
        if (PH(5)) { pg8::Gemm g{(const bf16_t*)(ws + WS_XN), (const bf16_t*)(ws + W_GU1), NT_TOK, 5632, 1024}; pg8::StaticOrder S; S.init(NT_TOK, 5632, G, blk);
          pg8::EpiSwiGLU E{ws};
          pg8::gemm_phase<pg8::EpiSwiGLU, pg8::StaticOrder, true, true>(lds, g, S, E, wave); }
        GRIDBAR();
        TSTAMP(2);
        PHASE_BEGIN();
        }
        if (STOPAT == 2) { dump_bf16(xres, (const bf16_t*)(ws + WS_C), 4, blk * NTHREADS + tid, G * NTHREADS); return; }
        if (PH(6)) { pg8::Gemm g{(const bf16_t*)(ws + WS_C), (const bf16_t*)(ws + W_D1), NT_TOK, 1024, 2816}; pg8::StaticOrder S; S.init(NT_TOK, 1024, G, blk);
          pg8::EpiResid E{xin, xres, ml + 2 * 1024, 0.5f};
          pg8::gemm_phase<pg8::EpiResid, pg8::StaticOrder, true, true>(lds, g, S, E, wave); }
        GRIDBAR();
        TSTAMP(3);
        PHASE_BEGIN();
        if (STOPAT == 3) {  return; }
        for (int r4 = 0; r4 < NREP(4); ++r4)
        if (PH(4)) norm_phase(xres, (bf16_t*)(ws + WS_XN), ml + 3 * 1024, ml + 4 * 1024, lane, gw, ngw);
#ifdef SENTINEL
        { unsigned* gp = (unsigned*)(ws + WS_GM); for (int i = blk * NTHREADS + tid; i < 16 * 1024 * 1024; i += G * NTHREADS) gp[i] = 0x447a447au; }
#endif
        GRIDBAR();
        TSTAMP(1);
        PHASE_BEGIN();
        for (int rep5 = 0; rep5 < NREP(5); ++rep5) {
        if (PH(7)) { pg8::Gemm g{(const bf16_t*)(ws + WS_XN), (const bf16_t*)(ws + W_IN), NT_TOK, 4096, 1024}; pg8::StaticOrder S; S.init(NT_TOK, 4096, G, blk);
          pg8::EpiWin E{ws};
          pg8::gemm_phase<pg8::EpiWin, pg8::StaticOrder, WIN_ALIGN, WIN_SP2>(lds, g, S, E, wave); }
        GRIDBAR();
        TSTAMP(4);
        PHASE_BEGIN();
        }
#ifndef DUMP_OFF
#define DUMP_OFF 84
#define DUMP_SLABS 4
#endif
        if (STOPAT == 5) { dump_bf16(xres, (const bf16_t*)(ws + (size_t)DUMP_OFF * MiB), DUMP_SLABS, blk * NTHREADS + tid, G * NTHREADS); return; }
        for (int rep6 = 0; rep6 < NREP(6); ++rep6) {
        for (int r13 = 0; r13 < NREP(13); ++r13)
        if (PH(8)) { pg8::Gemm g{(const bf16_t*)(ws + WS_CQ), (const bf16_t*)(ws + W_UQ), NT_TOK, 768, 384}; pg8::StaticOrder S; S.init(NT_TOK, 768, G, blk);
          { pg8::Unit u0; if (S.next(0, u0)) rstd_table<384>((const bf16_t*)(ws + WS_CQ), u0.pm * 256, (GLAS float*)(lds + 131072), 0.10206207261596577f * 1.4426950408889634f, lane, wave); }
          __syncthreads();
          pg8::EpiQproj E{ws, (const GLAS float*)(lds + 131072)};
          pg8::gemm_phase<pg8::EpiQproj, pg8::StaticOrder, true, true>(lds, g, S, E, wave); }
        for (int r14 = 0; r14 < NREP(14); ++r14)
        if (PH(9)) { pg8::Gemm g{(const bf16_t*)(ws + WS_CKV), (const bf16_t*)(ws + W_UKV), NT_TOK, 1024, 256}; pg8::StaticOrder S; S.init(NT_TOK, 1024, G, blk);
          PHASE_BEGIN();
          { pg8::Unit u0; if (S.next(0, u0)) rstd_table<256>((const bf16_t*)(ws + WS_CKV), u0.pm * 256, (GLAS float*)(lds + 131072 + 1024), 1.0f, lane, wave); }
          __syncthreads();
          pg8::EpiKVproj E{ws, (const GLAS float*)(lds + 131072 + 1024)};
          pg8::gemm_phase<pg8::EpiKVproj, pg8::StaticOrder, true, true>(lds, g, S, E, wave); }
        __syncthreads();
        PHASE_BEGIN();
        for (int r15 = 0; r15 < NREP(15); ++r15)
        if (PH(10)) compress_phase(A, l, lds, tid, lane, wave, (G - 1 - blk), G);
        GRIDBAR();
        TSTAMP(5);
        PHASE_BEGIN();
        }
        if (STOPAT == 6) { dump_bf16(xres, (const bf16_t*)(ws + WS_QM), 2, blk * NTHREADS + tid, G * NTHREADS); return; }
        for (int rep7 = 0; rep7 < NREP(7); ++rep7) {
        { att::NsaT NT{(const bf16_t*)(ws + WS_QN), (const bf16_t*)(ws + WS_KC), (const bf16_t*)(ws + WS_VC), (const bf16_t*)(ws + WS_KSEL), (const bf16_t*)(ws + WS_VSEL),
                       (const bf16_t*)(ws + WS_KWIN), (const bf16_t*)(ws + WS_VWIN), (const float*)(ws + WS_GATES), (bf16_t*)(ws + WS_OA)};
          for (int v = vcu; v < 256; v += G) {
              for (int r11 = 0; r11 < NREP(11); ++r11) if (PH(11)) { const int bh = v >> 4, s = v & 15;
                if (r11 == 0) { att::mla_unit<0>(bh >> 3, bh & 7, 31 - s, (const bf16_t*)(ws + WS_QM), (const bf16_t*)(ws + WS_KM), (const bf16_t*)(ws + WS_VM), (bf16_t*)(ws + WS_OB), (GLAS char*)lds, wave);
                  att::mla_unit<0>(bh >> 3, bh & 7, s, (const bf16_t*)(ws + WS_QM), (const bf16_t*)(ws + WS_KM), (const bf16_t*)(ws + WS_VM), (bf16_t*)(ws + WS_OB), (GLAS char*)lds, wave); }
#ifdef MLADIAG
                else { att::mla_unit<MLADIAG>(bh >> 3, bh & 7, 31 - s, (const bf16_t*)(ws + WS_QM), (const bf16_t*)(ws + WS_KM), (const bf16_t*)(ws + WS_VM), (bf16_t*)(ws + WS_CQ), (GLAS char*)lds, wave);
                  att::mla_unit<MLADIAG>(bh >> 3, bh & 7, s, (const bf16_t*)(ws + WS_QM), (const bf16_t*)(ws + WS_KM), (const bf16_t*)(ws + WS_VM), (bf16_t*)(ws + WS_CQ), (GLAS char*)lds, wave); }
#endif
              }
              TSTAMP(9);
              for (int r12 = 0; r12 < NREP(12); ++r12) if (PH(12)) { const int bg = v >> 6, s = v & 63;
                if (r12 == 0) { att::nsa_unit<0>(bg >> 1, bg & 1, 127 - s, NT, (GLAS char*)lds, wave);
                  att::nsa_unit<0>(bg >> 1, bg & 1, s, NT, (GLAS char*)lds, wave); }
#ifdef NSADIAG
                else { att::NsaT ND = NT; ND.Oa = (bf16_t*)(ws + WS_CQ);
                  att::nsa_unit<NSADIAG>(bg >> 1, bg & 1, 127 - s, ND, (GLAS char*)lds, wave);
                  att::nsa_unit<NSADIAG>(bg >> 1, bg & 1, s, ND, (GLAS char*)lds, wave); }
#endif
              }
              TSTAMP(10);
          } }
        GRIDBAR();
        TSTAMP(6);
        PHASE_BEGIN();
        }
        if (STOPAT == 7) { dump_bf16(xres, (const bf16_t*)(ws + WS_OA), 1, blk * NTHREADS + tid, G * NTHREADS); return; }
        for (int rep8 = 0; rep8 < NREP(8); ++rep8) {
        if (PH(13)) { pg8::Gemm g{(const bf16_t*)(ws + WS_OA), (const bf16_t*)(ws + W_BA), NT_TOK, 1024, 512}; pg8::StaticOrder S; S.init(NT_TOK, 1024, G, blk);
          pg8::EpiBranch<0> E{ws};
          pg8::gemm_phase<pg8::EpiBranch<0>, pg8::StaticOrder, true, true>(lds, g, S, E, wave); }
        if (PH(14)) { pg8::Gemm g{(const bf16_t*)(ws + WS_OB), (const bf16_t*)(ws + W_BB), NT_TOK, 1024, 512}; pg8::StaticOrder S; S.init(NT_TOK, 1024, G, blk);
          pg8::EpiBranch<1> E{ws};
          pg8::gemm_phase<pg8::EpiBranch<1>, pg8::StaticOrder, true, true>(lds, g, S, E, wave); }
        GRIDBAR();
        TSTAMP(7);
        PHASE_BEGIN();
        }
        if (STOPAT == 8) { dump_bf16(xres, (const bf16_t*)(ws + WS_Y), 1, blk * NTHREADS + tid, G * NTHREADS); return; }
        if (PH(15)) { pg8::Gemm g{(const bf16_t*)(ws + WS_Y), (const bf16_t*)(ws + W_OUT), NT_TOK, 1024, 1024}; pg8::StaticOrder S; S.init(NT_TOK, 1024, G, blk);
          pg8::EpiResid E{xres, xres, ml + 5 * 1024, 1.0f};
          pg8::gemm_phase<pg8::EpiResid, pg8::StaticOrder, true, true>(lds, g, S, E, wave); }
        GRIDBAR();
        TSTAMP(8);
        PHASE_BEGIN();
        for (int r4 = 0; r4 < NREP(4); ++r4)
        if (PH(4)) norm_phase(xres, (bf16_t*)(ws + WS_XN), ml + 6 * 1024, ml + 7 * 1024, lane, gw, ngw);
        GRIDBAR();
        TSTAMP(1);
        PHASE_BEGIN();
        if (PH(16)) { pg8::Gemm g{(const bf16_t*)(ws + WS_XN), (const bf16_t*)(ws + W_GU2), NT_TOK, 5632, 1024}; pg8::StaticOrder S; S.init(NT_TOK, 5632, G, blk);
          pg8::EpiSwiGLU E{ws};
          pg8::gemm_phase<pg8::EpiSwiGLU, pg8::StaticOrder, true, true>(lds, g, S, E, wave); }
        GRIDBAR();
        TSTAMP(2);
        PHASE_BEGIN();
        if (PH(17)) { pg8::Gemm g{(const bf16_t*)(ws + WS_C), (const bf16_t*)(ws + W_D2), NT_TOK, 1024, 2816}; pg8::StaticOrder S; S.init(NT_TOK, 1024, G, blk);
          pg8::EpiResid E{xres, xres, ml + 8 * 1024, 0.5f};
          pg8::gemm_phase<pg8::EpiResid, pg8::StaticOrder, true, true>(lds, g, S, E, wave); }
        GRIDBAR();
        TSTAMP(3);
        PHASE_BEGIN();
    }
    tid = MYTID(); lane = tid & 63; asm volatile("" : "+v"(tid), "+v"(lane));
    if (PH(18)) final_norm_phase(xres, A.in_(25), lane, gw, ngw);
#ifdef TPROBE
    TSTAMP(11);
    __syncthreads();
    if (blockIdx.x == 0 && wave == 0 && opaque_lane() == 0) { const GLAS unsigned* ta = (const GLAS unsigned*)(lds + 131072 + 8192);
        asm volatile("s_waitcnt vmcnt(0)" ::: "memory");
        xres[0] = 0.01f * (float)ta[TPA]; const float vb = 0.01f * (float)ta[TPB]; for (int i = 1; i <= 100; ++i) xres[i] = vb; }
#endif
}

extern "C" void kernel_launch(void* const* d_in, const int* in_sizes, int n_in, void* d_out, int out_size, void* d_ws, size_t ws_size, hipStream_t stream) {
    static int grid_blocks = 0;
    if (grid_blocks == 0) {
        if (n_in != 26 || out_size != NT_TOK * DM || ws_size < WS_TOTAL) { fprintf(stderr, "kernel_launch: unexpected problem (n_in %d out %d ws %zu)\n", n_in, out_size, ws_size); grid_blocks = -1; return; }
        int dev = 0, cus = 0, per_cu = 0;
        hipGetDevice(&dev);
        hipDeviceGetAttribute(&cus, hipDeviceAttributeMultiprocessorCount, dev);
        hipFuncSetAttribute((const void*)hybrid_fwd, hipFuncAttributeMaxDynamicSharedMemorySize, LDS_BYTES);
        hipOccupancyMaxActiveBlocksPerMultiprocessor(&per_cu, (const void*)hybrid_fwd, NTHREADS, LDS_BYTES);
        if (per_cu < 1) { fprintf(stderr, "kernel_launch: occupancy query says %d blocks per CU\n", per_cu); per_cu = 1; }
        if (per_cu > 1) per_cu = 1;
        grid_blocks = cus * per_cu;
        (void)hipGetLastError();
    }
    if (grid_blocks < 0) return;
    if (hipMemsetAsync((char*)d_ws + WS_BAR, 0, BAR_BYTES, stream) != hipSuccess) { fprintf(stderr, "kernel_launch: memset failed\n"); return; }
    KArgs a{};
    for (int i = 0; i < 26; ++i) a.in[i] = (const float*)d_in[i];
    a.out = (float*)d_out; a.ws = (unsigned char*)d_ws;
    void* args[] = {&a};
    hipError_t e = hipLaunchCooperativeKernel((const void*)hybrid_fwd, dim3(grid_blocks), dim3(NTHREADS), args, LDS_BYTES, stream);
    if (e != hipSuccess) fprintf(stderr, "cooperative launch failed: %s (grid %d)\n", hipGetErrorString(e), grid_blocks);
}
```

```cpp
#include <hip/hip_runtime.h>
#include <hip/hip_cooperative_groups.h>
#include <cstdio>
#include <cstdint>
namespace cg = cooperative_groups;

constexpr size_t MiB = 1u << 20;
constexpr size_t WS_MOD = 0;
constexpr size_t WS_CBIAS = 256 * 1024;
constexpr size_t WS_ERR = 384 * 1024;
constexpr size_t WS_SSQQ = 512 * 1024;
constexpr size_t WS_SSQKV = 640 * 1024;
constexpr size_t WS_GATES = 1 * MiB;
constexpr size_t WS_CS = 3 * MiB;
constexpr size_t WS_W = 4 * MiB;
constexpr size_t W_GU1 = WS_W, W_D1 = W_GU1 + (size_t)5632 * 1024 * 2, W_GU2 = W_D1 + (size_t)1024 * 2816 * 2, W_D2 = W_GU2 + (size_t)5632 * 1024 * 2;
constexpr size_t W_IN = W_D2 + (size_t)1024 * 2816 * 2, W_UQ = W_IN + (size_t)4096 * 1024 * 2, W_UKV = W_UQ + (size_t)768 * 384 * 2, W_BA = W_UKV + (size_t)1024 * 256 * 2;
constexpr size_t W_BB = W_BA + (size_t)1024 * 512 * 2, W_OUT = W_BB + (size_t)1024 * 512 * 2, W_1K = W_OUT + (size_t)1024 * 1024 * 2, W_1V = W_1K + (size_t)64 * 2048 * 2, W_END = W_1V + (size_t)64 * 2048 * 2;
static_assert(W_END <= 52 * MiB, "weights region");
constexpr size_t WS_XN = 52 * MiB;
constexpr size_t WS_OA = 52 * MiB, WS_OB = 68 * MiB;
constexpr size_t WS_C = 84 * MiB;
constexpr size_t WS_QN = 84 * MiB, WS_KCF = 100 * MiB, WS_VCF = 104 * MiB, WS_KSEL = 108 * MiB, WS_VSEL = 112 * MiB, WS_KWIN = 116 * MiB, WS_VWIN = 120 * MiB;
constexpr size_t WS_CQ = 124 * MiB, WS_CKV = 136 * MiB, WS_GM = 144 * MiB, WS_KC = 208 * MiB, WS_VC = 208 * MiB + 256 * 1024;
constexpr size_t WS_QM = 212 * MiB, WS_KM = 236 * MiB, WS_VM = 260 * MiB, WS_Y = 212 * MiB, WS_TOTAL = 276 * MiB;


__device__ __forceinline__ int opaque_lane() { unsigned z; asm volatile("v_mov_b32 %0, 0" : "=v"(z)); return (int)__builtin_amdgcn_mbcnt_hi(~0u, __builtin_amdgcn_mbcnt_lo(~0u, z)); }
template <int K> __device__ __forceinline__ float swz_xor(float v) { return __int_as_float(__builtin_amdgcn_ds_swizzle(__float_as_int(v), (K << 10) | 0x1f)); }
__device__ __forceinline__ float half_sum(float v) { auto rr = __builtin_amdgcn_permlane32_swap(__float_as_uint(v), __float_as_uint(v), false, false); return __uint_as_float(rr[0]) + __uint_as_float(rr[1]); }
__device__ __forceinline__ float wave_sum(float v) { v += swz_xor<1>(v); v += swz_xor<2>(v); v += swz_xor<4>(v); v += swz_xor<8>(v); v += swz_xor<16>(v); return half_sum(v); }
namespace pg8 {
#define PG8_LAS __attribute__((address_space(3)))
typedef unsigned short bf16_t;
typedef short bf16x8 __attribute__((ext_vector_type(8)));
typedef float f32x4 __attribute__((ext_vector_type(4)));
typedef unsigned u32x4 __attribute__((ext_vector_type(4)));
constexpr int BM = 256, BK = 64, HALF = 128, HTB = HALF * BK * 2  , STAGE_BYTES = 8 * HTB, NXCD = 8, WGM = 8;

__host__ __device__ __forceinline__ int lds_byte(int r, int c) { const int st = (r >> 4) * 2 + (c >> 5), rr = r & 15, cc = c & 31, ob = rr * 64 + cc * 2; return st * 1024 + (ob ^ (((ob >> 9) & 1) << 5)); }
__host__ __device__ __forceinline__ void stage_rc(int b, int& R, int& C) { const int st = b / 1024, sb = b % 1024, swz = sb ^ (((sb >> 9) & 1) << 5); R = (st >> 1) * 16 + swz / 64; C = (st & 1) * 32 + (swz % 64) / 2; }
__host__ __device__ __forceinline__ int perm32(int rho) { const int n = rho >> 4, i = rho & 15; return 8 * (i >> 2) + 4 * n + (i & 3); }

struct Unit { int pm, pn; };
struct Gemm { const bf16_t* A; const bf16_t* Bt; int M, N, K; };

struct StaticOrder {
    int nM, nN, nwg, G, c;
    __host__ __device__ __forceinline__ void init(int M, int N, int G_, int c_) { nM = M / BM; nN = N / BM; nwg = nM * nN; G = G_; c = c_; }
    __host__ __device__ __forceinline__ bool next(int i, Unit& u) const {
        const long L = (long)i * G + c; if (L >= nwg) return false;
        int wgid = (int)L; { const int q = nwg / NXCD, r = nwg % NXCD, xcd = wgid % NXCD, off = wgid / NXCD; wgid = (xcd < r ? xcd * (q + 1) : r * (q + 1) + (xcd - r) * q) + off; }
        const int nig = WGM * nN, gid = wgid / nig, fm = gid * WGM, gsz = (nM - fm) < WGM ? (nM - fm) : WGM;
        u.pm = fm + ((wgid % nig) % gsz); u.pn = (wgid % nig) / gsz; return true;
    }
    __device__ __forceinline__ void a_ready(const Unit&) const {}
    __device__ __forceinline__ void done(const Unit&) const {}
};

typedef float cvt_f32x2_t __attribute__((ext_vector_type(2))); typedef __bf16 cvt_bf16x2_t __attribute__((ext_vector_type(2)));
__device__ __forceinline__ unsigned cvt_pk_bf16(float lo, float hi) { cvt_f32x2_t v = {lo, hi}; cvt_bf16x2_t b = __builtin_convertvector(v, cvt_bf16x2_t); return __builtin_bit_cast(unsigned, b); }
typedef float f32x2 __attribute__((ext_vector_type(2)));
constexpr int SEQL = 8192, DMODEL = 1024, DFFN = 2816;
constexpr float LOG2E = 1.4426950408889634f;
constexpr float QSC_NSA = 0.125f * LOG2E;
constexpr float QSC_MLA = 0.10206207261596577f * LOG2E;
constexpr float NEPS = 1e-6f;
__device__ __forceinline__ float sigm(float x) { return __builtin_amdgcn_rcpf(1.0f + __builtin_amdgcn_exp2f(-LOG2E * x)); }
__device__ __forceinline__ void st8(bf16_t* p, f32x4 a0, f32x4 a1) {
    u32x4 w; w.x = cvt_pk_bf16(a0[0], a0[1]); w.y = cvt_pk_bf16(a0[2], a0[3]); w.z = cvt_pk_bf16(a1[0], a1[1]); w.w = cvt_pk_bf16(a1[2], a1[3]); *(u32x4*)p = w; }
__device__ __forceinline__ float bf2f(unsigned short h) { return __uint_as_float(((unsigned)h) << 16); }

struct EpiSwiGLU { static constexpr bool PERM = true, AFTER_DRAIN = false; unsigned char* ws;
    __device__ __forceinline__ void operator()(const f32x4 (&acc)[2][2][4][2], const Unit& u, int wr, int wc, int fr, int fq) const {
        { const int ln_ = opaque_lane(); fr = ln_ & 15; fq = ln_ >> 4; }
        const int row0 = u.pm * BM + wr * 64 + fr, col0 = u.pn * 128 + wc * 32 + 8 * fq;
#pragma unroll
        for (int ai = 0; ai < 2; ++ai)
#pragma unroll
            for (int m = 0; m < 4; ++m) { bf16_t* rowp = (bf16_t*)(ws + WS_C) + (size_t)(row0 + ai * HALF + m * 16) * DFFN + col0;
                f32x4 h0, h1;
#pragma unroll
                for (int j = 0; j < 4; ++j) { const float g0 = acc[ai][0][m][0][j], g1 = acc[ai][0][m][1][j];
                    h0[j] = g0 * sigm(g0) * acc[ai][1][m][0][j]; h1[j] = g1 * sigm(g1) * acc[ai][1][m][1][j]; }
                st8(rowp, h0, h1); }
    }
};
struct EpiResid { static constexpr bool PERM = false, AFTER_DRAIN = false; const float* xin; float* xout; const float* gate; float gs;
    __device__ __forceinline__ void operator()(const f32x4 (&acc)[2][2][4][2], const Unit& u, int wr, int wc, int fr, int fq) const {
        { const int ln_ = opaque_lane(); fr = ln_ & 15; fq = ln_ >> 4; }
        const int col0 = u.pn * BM + wc * 32 + 4 * fq; const int b = (u.pm * BM) >> 13;
        f32x4 gv[2][2];
#pragma unroll
        for (int bj = 0; bj < 2; ++bj)
#pragma unroll
            for (int n = 0; n < 2; ++n) gv[bj][n] = *(const f32x4*)(gate + (size_t)b * 9216 + col0 + bj * HALF + n * 16) * gs;
#pragma unroll
        for (int ai = 0; ai < 2; ++ai)
#pragma unroll
            for (int m = 0; m < 4; ++m) { const size_t off = (size_t)(u.pm * BM + ai * HALF + wr * 64 + m * 16 + fr) * DMODEL + col0;
#pragma unroll
                for (int bj = 0; bj < 2; ++bj)
#pragma unroll
                    for (int n = 0; n < 2; ++n) { const f32x4 xv = *(const f32x4*)(xin + off + bj * HALF + n * 16);
                        *(f32x4*)(xout + off + bj * HALF + n * 16) = xv + gv[bj][n] * acc[ai][bj][m][n]; }
                if (m & 1) asm volatile("" ::: "memory"); }
    }
};
struct EpiWin { static constexpr bool PERM = true, AFTER_DRAIN = false;
    unsigned char* ws;
    __device__ __forceinline__ void operator()(const f32x4 (&acc)[2][2][4][2], const Unit& u, int wr, int wc, int fr, int fq) const {
        { const int ln_ = opaque_lane(); fr = ln_ & 15; fq = ln_ >> 4; }
        bf16_t* const Qn = (bf16_t*)(ws + WS_QN); bf16_t* const kcf = (bf16_t*)(ws + WS_KCF); bf16_t* const vcf = (bf16_t*)(ws + WS_VCF); bf16_t* const Ksel = (bf16_t*)(ws + WS_KSEL); bf16_t* const Vsel = (bf16_t*)(ws + WS_VSEL);
        bf16_t* const Kwin = (bf16_t*)(ws + WS_KWIN); bf16_t* const Vwin = (bf16_t*)(ws + WS_VWIN); bf16_t* const cq = (bf16_t*)(ws + WS_CQ); bf16_t* const ckv = (bf16_t*)(ws + WS_CKV); bf16_t* const Km = (bf16_t*)(ws + WS_KM); bf16_t* const gm = (bf16_t*)(ws + WS_GM);
        float* const gates = (float*)(ws + WS_GATES); const float* const cs = (const float*)(ws + WS_CS);
        const int pn = u.pn;
#pragma unroll
        for (int ai = 0; ai < 2; ++ai)
#pragma unroll
            for (int m = 0; m < 4; ++m) {
                const int row = u.pm * BM + ai * HALF + wr * 64 + m * 16 + fr, b = row >> 13, t = row & (SEQL - 1);
                const int d = wc * 32 + 8 * fq;
                if (pn < 2) {
#pragma unroll
                    for (int bj = 0; bj < 2; ++bj) st8(Qn + (size_t)row * 512 + pn * 256 + bj * HALF + d, acc[ai][bj][m][0] * QSC_NSA, acc[ai][bj][m][1] * QSC_NSA);
                } else if (pn == 2) {
                    const int g = d >> 6, dd = d & 63; const size_t o = ((size_t)(b * 2 + g) * SEQL + t) * 64 + dd;
                    st8(kcf + o, acc[ai][0][m][0], acc[ai][0][m][1]); st8(vcf + o, acc[ai][1][m][0], acc[ai][1][m][1]);
                } else if (pn == 3 || pn == 4) {
                    bf16_t* Kd = pn == 3 ? Ksel : Kwin; bf16_t* Vd = pn == 3 ? Vsel : Vwin;
                    const int g = d >> 6, dd = d & 63; const size_t tb = (size_t)(b * 2 + g) * 128 + (t >> 6);
                    st8(Kd + (tb * 8 + (dd >> 3)) * 512 + (t & 63) * 8, acc[ai][0][m][0], acc[ai][0][m][1]);
                    st8(Vd + tb * 4096 + (dd >> 5) * 2048 + (t & 63) * 32 + (dd & 31), acc[ai][1][m][0], acc[ai][1][m][1]);
                } else if (pn == 5 || pn == 6) {
#pragma unroll
                    for (int bj = 0; bj < 2; ++bj) { const f32x4 a0 = acc[ai][bj][m][0], a1 = acc[ai][bj][m][1];
                        if (pn == 5) st8(ckv + (size_t)row * 256 + bj * HALF + d, a0, a1); else st8(cq + (size_t)row * 384 + bj * HALF + d, a0, a1); }
                } else if (pn == 7) {
                    st8(cq + (size_t)row * 384 + 256 + d, acc[ai][0][m][0], acc[ai][0][m][1]);
                    const f32x4 a0 = acc[ai][1][m][0], a1 = acc[ai][1][m][1];
                    if (wc == 0) {
                        const f32x4 c4 = *(const f32x4*)(cs + (size_t)t * 32 + 4 * fq), s4 = *(const f32x4*)(cs + (size_t)t * 32 + 16 + 4 * fq);
                        f32x4 o0, o1;
                        o0[0] = a0[0] * c4[0] - a0[1] * s4[0]; o0[1] = a0[0] * s4[0] + a0[1] * c4[0];
                        o0[2] = a0[2] * c4[1] - a0[3] * s4[1]; o0[3] = a0[2] * s4[1] + a0[3] * c4[1];
                        o1[0] = a1[0] * c4[2] - a1[1] * s4[2]; o1[1] = a1[0] * s4[2] + a1[1] * c4[2];
                        o1[2] = a1[2] * c4[3] - a1[3] * s4[3]; o1[3] = a1[2] * s4[3] + a1[3] * c4[3];
#pragma unroll
                        for (int h = 0; h < 8; ++h) st8(Km + (((size_t)(b * 8 + h) * 128 + (t >> 6)) * 12 + 8 + fq) * 512 + (t & 63) * 8, o0, o1);
                    } else if (wc == 1 && fq < 3) {
                        float* gp = gates + (size_t)row * 24 + 8 * fq; f32x4 g0, g1;
#pragma unroll
                        for (int j = 0; j < 4; ++j) { g0[j] = sigm(a0[j]); g1[j] = sigm(a1[j]); }
                        *(f32x4*)gp = g0; *(f32x4*)(gp + 4) = g1;
                    }
                } else {
#pragma unroll
                    for (int bj = 0; bj < 2; ++bj) { f32x4 g0, g1;
#pragma unroll
                        for (int j = 0; j < 4; ++j) { g0[j] = sigm(acc[ai][bj][m][0][j]); g1[j] = sigm(acc[ai][bj][m][1][j]); }
                        st8(gm + (size_t)row * 2048 + (pn - 8) * 256 + bj * HALF + d, g0, g1); }
                }
                asm volatile("" ::: "memory");
            }
    }
};
struct EpiQproj { static constexpr bool PERM = true, AFTER_DRAIN = false; unsigned char* ws; const PG8_LAS float* tab;
    __device__ __forceinline__ void operator()(const f32x4 (&acc)[2][2][4][2], const Unit& u, int wr, int wc, int fr, int fq) const {
        { const int ln_ = opaque_lane(); fr = ln_ & 15; fq = ln_ >> 4; }
        bf16_t* const Qm = (bf16_t*)(ws + WS_QM); const float* const cs = (const float*)(ws + WS_CS);
#pragma unroll
        for (int ai = 0; ai < 2; ++ai)
#pragma unroll
            for (int m = 0; m < 4; ++m) {
                const int row = u.pm * BM + ai * HALF + wr * 64 + m * 16 + fr, t = row & (SEQL - 1);
                const float rs = tab[ai * HALF + wr * 64 + m * 16 + fr];
#pragma unroll
                for (int bj = 0; bj < 2; ++bj) { const int n = u.pn * BM + bj * HALF + wc * 32 + 8 * fq; const int p = n % 96;
                    f32x4 a0 = acc[ai][bj][m][0] * rs, a1 = acc[ai][bj][m][1] * rs;
                    if (p >= 64) { const int i0 = (p - 64) >> 1;
                        const f32x4 c4 = *(const f32x4*)(cs + (size_t)t * 32 + i0), s4 = *(const f32x4*)(cs + (size_t)t * 32 + 16 + i0);
                        f32x4 o0, o1;
                        o0[0] = a0[0] * c4[0] - a0[1] * s4[0]; o0[1] = a0[0] * s4[0] + a0[1] * c4[0];
                        o0[2] = a0[2] * c4[1] - a0[3] * s4[1]; o0[3] = a0[2] * s4[1] + a0[3] * c4[1];
                        o1[0] = a1[0] * c4[2] - a1[1] * s4[2]; o1[1] = a1[0] * s4[2] + a1[1] * c4[2];
                        o1[2] = a1[2] * c4[3] - a1[3] * s4[3]; o1[3] = a1[2] * s4[3] + a1[3] * c4[3];
                        a0 = o0; a1 = o1; }
                    st8(Qm + (size_t)row * 768 + n, a0, a1); }
                asm volatile("" ::: "memory");
            }
    }
};
struct EpiKVproj { static constexpr bool PERM = true, AFTER_DRAIN = false; unsigned char* ws; const PG8_LAS float* tab;
    __device__ __forceinline__ void operator()(const f32x4 (&acc)[2][2][4][2], const Unit& u, int wr, int wc, int fr, int fq) const {
        { const int ln_ = opaque_lane(); fr = ln_ & 15; fq = ln_ >> 4; }
        bf16_t* const Km = (bf16_t*)(ws + WS_KM); bf16_t* const Vm = (bf16_t*)(ws + WS_VM);
#pragma unroll
        for (int ai = 0; ai < 2; ++ai)
#pragma unroll
            for (int m = 0; m < 4; ++m) {
                const int row = u.pm * BM + ai * HALF + wr * 64 + m * 16 + fr, b = row >> 13, t = row & (SEQL - 1);
                const float rs = tab[ai * HALF + wr * 64 + m * 16 + fr];
#pragma unroll
                for (int bj = 0; bj < 2; ++bj) { const int n = (u.pn & 1) * BM + bj * HALF + wc * 32 + 8 * fq; const int h = n >> 6, dd = n & 63;
                    const f32x4 a0 = acc[ai][bj][m][0] * rs, a1 = acc[ai][bj][m][1] * rs; const size_t tb = (size_t)(b * 8 + h) * 128 + (t >> 6);
                    if (u.pn < 2) st8(Km + (tb * 12 + (dd >> 3)) * 512 + (t & 63) * 8, a0, a1);
                    else st8(Vm + tb * 4096 + (dd >> 5) * 2048 + (t & 63) * 32 + (dd & 31), a0, a1); }
                asm volatile("" ::: "memory");
            }
    }
};
template <int PASS> struct EpiBranch { static constexpr bool PERM = true, AFTER_DRAIN = false; unsigned char* ws;
    __device__ __forceinline__ void operator()(const f32x4 (&acc)[2][2][4][2], const Unit& u, int wr, int wc, int fr, int fq) const {
        { const int ln_ = opaque_lane(); fr = ln_ & 15; fq = ln_ >> 4; }
        bf16_t* const Y = (bf16_t*)(ws + WS_Y); const bf16_t* const gm = (const bf16_t*)(ws + WS_GM);
#pragma unroll
        for (int ai = 0; ai < 2; ++ai)
#pragma unroll
            for (int m = 0; m < 4; ++m) { const int row = u.pm * BM + ai * HALF + wr * 64 + m * 16 + fr;
#pragma unroll
                for (int bj = 0; bj < 2; ++bj) { const int n = u.pn * BM + bj * HALF + wc * 32 + 8 * fq;
                    const u32x4 gw = *(const u32x4*)(gm + (size_t)row * 2048 + PASS * 1024 + n);
                    f32x4 a0 = acc[ai][bj][m][0], a1 = acc[ai][bj][m][1];
                    a0[0] *= __uint_as_float(gw.x << 16); a0[1] *= __uint_as_float(gw.x & 0xffff0000u); a0[2] *= __uint_as_float(gw.y << 16); a0[3] *= __uint_as_float(gw.y & 0xffff0000u);
                    a1[0] *= __uint_as_float(gw.z << 16); a1[1] *= __uint_as_float(gw.z & 0xffff0000u); a1[2] *= __uint_as_float(gw.w << 16); a1[3] *= __uint_as_float(gw.w & 0xffff0000u);
                    bf16_t* yp = Y + (size_t)row * DMODEL + n;
                    if (PASS == 1) { const u32x4 yw = *(const u32x4*)yp;
                        a0[0] += __uint_as_float(yw.x << 16); a0[1] += __uint_as_float(yw.x & 0xffff0000u); a0[2] += __uint_as_float(yw.y << 16); a0[3] += __uint_as_float(yw.y & 0xffff0000u);
                        a1[0] += __uint_as_float(yw.z << 16); a1[1] += __uint_as_float(yw.z & 0xffff0000u); a1[2] += __uint_as_float(yw.w << 16); a1[3] += __uint_as_float(yw.w & 0xffff0000u); }
                    st8(yp, a0, a1); }
            }
    }
};
template <class Epi, class Sched, bool ALIGN_EPI = false, bool SP2 = false>
__device__ __forceinline__ void gemm_phase(PG8_LAS unsigned char* lds, const Gemm g, const Sched& S, const Epi& E, int wave_id) {
    int tid_ = wave_id * 64 + opaque_lane();
    const int tid = tid_, wid = __builtin_amdgcn_readfirstlane(tid >> 6), lane = tid & 63, wr = wid >> 2, wc = wid & 3, fr = lane & 15, fq = lane >> 4;
    const int K = g.K, nt = K / BK;
    unsigned voffA[2], voffB[2];
#pragma unroll
    for (int i = 0; i < 2; ++i) { int R, C; stage_rc(tid * 16 + i * 8192, R, C); const int Rb = Epi::PERM ? ((R & ~31) + perm32(R & 31)) : R;
        voffA[i] = (unsigned)(R * K + C) * 2u; voffB[i] = (unsigned)(Rb * K + C) * 2u; }
    const size_t kstep = (size_t)(BK * 2);
    const size_t hstep = (size_t)HALF * K * 2;
    const size_t tstep = 2 * hstep;
    const unsigned ldsw = (unsigned)wid * 1024u;
    const int aoff = lds_byte(wr * 64 + fr, fq * 8), boff = lds_byte(wc * 32 + fr, fq * 8);
#define PG8_SA(b, h) (((b) * 2 + (h)) * HTB)
#define PG8_SB(b, h) ((4 + (b) * 2 + (h)) * HTB)
#define PG8_STAGE(bufoff, gbase, voff) do { _Pragma("unroll") for (int _i = 0; _i < 2; ++_i) \
        __builtin_amdgcn_global_load_lds((const unsigned*)((const char*)(gbase) + (voff)[_i]), (PG8_LAS unsigned*)(lds + (bufoff) + ldsw + _i * 8192), 16, 0, 0); } while (0)
#define PG8_LDA(dst, b, h) do { _Pragma("unroll") for (int m = 0; m < 4; ++m) _Pragma("unroll") for (int k = 0; k < 2; ++k) dst[m][k] = *(const PG8_LAS bf16x8*)(lds + PG8_SA(b, h) + aoff + m * 2048 + k * 1024); } while (0)
#define PG8_LDB(dst, b, h) do { _Pragma("unroll") for (int n = 0; n < 2; ++n) _Pragma("unroll") for (int k = 0; k < 2; ++k) dst[n][k] = *(const PG8_LAS bf16x8*)(lds + PG8_SB(b, h) + boff + n * 2048 + k * 1024); } while (0)
#define PG8_MMA(ai, bj, At, Bt) do { __builtin_amdgcn_s_setprio(1); _Pragma("unroll") for (int m = 0; m < 4; ++m) _Pragma("unroll") for (int n = 0; n < 2; ++n) _Pragma("unroll") for (int k = 0; k < 2; ++k) \
        acc[ai][bj][m][n] = __builtin_amdgcn_mfma_f32_16x16x32_bf16(Bt[n][k], At[m][k], acc[ai][bj][m][n], 0, 0, 0); __builtin_amdgcn_s_setprio(0); } while (0)
#define PG8_WAIT_V(n) asm volatile("s_waitcnt vmcnt(" #n ")" ::: "memory")
#define PG8_WAIT_L(n) asm volatile("s_waitcnt lgkmcnt(" #n ")" ::: "memory")
#define PG8_BAR __builtin_amdgcn_s_barrier()
#define PG8_SCHED __builtin_amdgcn_sched_barrier(0)
    Unit cur, nxt; int ui = 0;
    if (!S.next(0, cur)) return;
    f32x4 acc[2][2][4][2];
#pragma unroll
    for (int a = 0; a < 2; ++a)
#pragma unroll
        for (int b = 0; b < 2; ++b)
#pragma unroll
            for (int m = 0; m < 4; ++m)
#pragma unroll
                for (int n = 0; n < 2; ++n) acc[a][b][m][n] = (f32x4){0.f, 0.f, 0.f, 0.f};
    bf16x8 At[4][2], B0[2][2], B1[2][2];
    const char* cA = (const char*)g.A + (size_t)cur.pm * tstep; const char* cB = (const char*)g.Bt + (size_t)cur.pn * tstep;
    S.a_ready(cur);
    if constexpr (SP2) {
        PG8_STAGE(PG8_SB(0, 0), cB, voffB); PG8_STAGE(PG8_SB(0, 1), cB + hstep, voffB); PG8_STAGE(PG8_SA(0, 0), cA, voffA); PG8_STAGE(PG8_SA(0, 1), cA + hstep, voffA);
        if (wr == 1) PG8_BAR;
        PG8_WAIT_V(2); PG8_BAR;
        PG8_STAGE(PG8_SB(1, 0), cB + kstep, voffB); PG8_STAGE(PG8_SA(1, 0), cA + kstep, voffA); PG8_STAGE(PG8_SB(1, 1), cB + hstep + kstep, voffB);
        PG8_WAIT_V(6); PG8_BAR;
    } else {
        PG8_STAGE(PG8_SB(0, 0), cB, voffB); PG8_STAGE(PG8_SA(0, 0), cA, voffA); PG8_STAGE(PG8_SB(0, 1), cB + hstep, voffB); PG8_STAGE(PG8_SA(0, 1), cA + hstep, voffA);
        if (wr == 1) PG8_BAR;
        PG8_WAIT_V(4); PG8_BAR;
        PG8_STAGE(PG8_SB(1, 0), cB + kstep, voffB); PG8_STAGE(PG8_SA(1, 0), cA + kstep, voffA); PG8_STAGE(PG8_SB(1, 1), cB + hstep + kstep, voffB);
        PG8_WAIT_V(6); PG8_BAR;
    }
    for (;;) {
        const bool has_next = S.next(ui + 1, nxt);
        const char* nA = has_next ? (const char*)g.A + (size_t)nxt.pm * tstep : cA; const char* nB = has_next ? (const char*)g.Bt + (size_t)nxt.pn * tstep : cB;
        for (int t = 0; t < nt; t += 2) {
            const bool last = (t == nt - 2);
            const char* a1 = cA + (size_t)(t + 1) * kstep;
            const char* a2 = last ? nA : cA + (size_t)(t + 2) * kstep; const char* b2 = last ? nB : cB + (size_t)(t + 2) * kstep;
            const char* a3 = a2 + kstep; const char* b3 = b2 + kstep;
            if (last && has_next) S.a_ready(nxt);
            if constexpr (SP2) {
            PG8_LDB(B0, 0, 0); PG8_LDB(B1, 0, 1); PG8_SCHED; PG8_LDA(At, 0, 0); PG8_STAGE(PG8_SA(1, 1), a1 + hstep, voffA);
            PG8_WAIT_V(8); PG8_WAIT_L(0); PG8_BAR; PG8_MMA(0, 0, At, B0); PG8_MMA(0, 1, At, B1); PG8_BAR; PG8_SCHED;
            PG8_LDA(At, 0, 1); PG8_STAGE(PG8_SB(0, 0), b2, voffB); PG8_STAGE(PG8_SB(0, 1), b2 + hstep, voffB); PG8_STAGE(PG8_SA(0, 0), a2, voffA);
            PG8_WAIT_V(8); PG8_WAIT_L(0); PG8_BAR; PG8_MMA(1, 0, At, B0); PG8_MMA(1, 1, At, B1); PG8_BAR; PG8_SCHED;
            PG8_LDB(B0, 1, 0); PG8_LDB(B1, 1, 1); PG8_SCHED; PG8_LDA(At, 1, 0); PG8_STAGE(PG8_SA(0, 1), a2 + hstep, voffA);
            PG8_WAIT_V(8); PG8_WAIT_L(0); PG8_BAR; PG8_MMA(0, 0, At, B0); PG8_MMA(0, 1, At, B1); PG8_BAR; PG8_SCHED;
            PG8_LDA(At, 1, 1); PG8_STAGE(PG8_SB(1, 0), b3, voffB); PG8_STAGE(PG8_SB(1, 1), b3 + hstep, voffB); PG8_STAGE(PG8_SA(1, 0), a3, voffA);
            PG8_WAIT_V(8); PG8_WAIT_L(0); PG8_BAR; PG8_MMA(1, 0, At, B0); PG8_MMA(1, 1, At, B1); PG8_BAR; PG8_SCHED;
            } else {
            PG8_LDB(B0, 0, 0); PG8_SCHED; PG8_LDA(At, 0, 0); PG8_STAGE(PG8_SA(1, 1), a1 + hstep, voffA);
            PG8_WAIT_L(8); PG8_BAR; PG8_WAIT_L(0); PG8_MMA(0, 0, At, B0); PG8_BAR; PG8_SCHED;
            PG8_LDB(B1, 0, 1); PG8_STAGE(PG8_SB(0, 0), b2, voffB);
            PG8_BAR; PG8_WAIT_L(0); PG8_MMA(0, 1, At, B1); PG8_BAR;
            PG8_LDA(At, 0, 1); PG8_STAGE(PG8_SA(0, 0), a2, voffA);
            PG8_BAR; PG8_WAIT_L(0); PG8_MMA(1, 0, At, B0); PG8_BAR; PG8_SCHED;
            PG8_STAGE(PG8_SB(0, 1), b2 + hstep, voffB);
            PG8_WAIT_V(6); PG8_BAR; PG8_MMA(1, 1, At, B1); PG8_BAR;
            PG8_LDB(B0, 1, 0); PG8_SCHED; PG8_LDA(At, 1, 0); PG8_STAGE(PG8_SA(0, 1), a2 + hstep, voffA);
            PG8_WAIT_L(8); PG8_BAR; PG8_WAIT_L(0); PG8_MMA(0, 0, At, B0); PG8_BAR; PG8_SCHED;
            PG8_LDB(B1, 1, 1); PG8_STAGE(PG8_SB(1, 0), b3, voffB);
            PG8_BAR; PG8_WAIT_L(0); PG8_MMA(0, 1, At, B1); PG8_BAR;
            PG8_LDA(At, 1, 1); PG8_STAGE(PG8_SA(1, 0), a3, voffA);
            PG8_BAR; PG8_WAIT_L(0); PG8_MMA(1, 0, At, B0); PG8_BAR; PG8_SCHED;
            PG8_STAGE(PG8_SB(1, 1), b3 + hstep, voffB);
            PG8_WAIT_V(6); PG8_BAR; PG8_MMA(1, 1, At, B1); PG8_BAR;
            }
        }
        if constexpr (ALIGN_EPI) { if (wr == 0) PG8_BAR; }
        if constexpr (!Epi::AFTER_DRAIN) { E(acc, cur, wr, wc, fr, fq); S.done(cur); }
        if (!has_next) break;
#pragma unroll
        for (int a = 0; a < 2; ++a)
#pragma unroll
            for (int b = 0; b < 2; ++b)
#pragma unroll
                for (int m = 0; m < 4; ++m)
#pragma unroll
                    for (int n = 0; n < 2; ++n) acc[a][b][m][n] = (f32x4){0.f, 0.f, 0.f, 0.f};
        cur = nxt; cA = nA; cB = nB; ++ui;
        if constexpr (ALIGN_EPI) { if (wr == 1) PG8_BAR; }
    }
    PG8_WAIT_V(0);
    if constexpr (!ALIGN_EPI) { if (wr == 0) PG8_BAR; }
    PG8_BAR;
    if constexpr (Epi::AFTER_DRAIN) { E.fused(acc, cur, wr, wc, fr, fq, lds, wid, lane); S.done(cur); }
#undef PG8_SA
#undef PG8_SB
#undef PG8_STAGE
#undef PG8_LDA
#undef PG8_LDB
#undef PG8_MMA
#undef PG8_WAIT_V
#undef PG8_WAIT_L
#undef PG8_BAR
#undef PG8_SCHED
}
}
namespace att {
#define LAS __attribute__((address_space(3)))
typedef unsigned short bf16;
typedef short bf16x8 __attribute__((ext_vector_type(8)));
typedef short s16x4 __attribute__((ext_vector_type(4)));
typedef float f32x16 __attribute__((ext_vector_type(16)));
typedef float f32x4 __attribute__((ext_vector_type(4)));
typedef unsigned u32x4 __attribute__((ext_vector_type(4)));
typedef unsigned u32x2 __attribute__((ext_vector_type(2)));
typedef const LAS char* lcp;
constexpr float LOG2E = 1.4426950408889634f;
__device__ __forceinline__ int crow(int r, int hi) { return (r & 3) + 8 * (r >> 2) + 4 * hi; }
typedef float f32x2_t __attribute__((ext_vector_type(2))); typedef __bf16 bf16x2_t __attribute__((ext_vector_type(2)));
__device__ __forceinline__ unsigned cvtpk(float lo, float hi) { f32x2_t v = {lo, hi}; bf16x2_t b = __builtin_convertvector(v, bf16x2_t); return __builtin_bit_cast(unsigned, b); }
__device__ __forceinline__ unsigned short f2bf(float f) { return (unsigned short)(cvtpk(f, 0.f) & 0xffffu); }
__device__ __forceinline__ float xmax(float v) { auto rr = __builtin_amdgcn_permlane32_swap(__float_as_uint(v), __float_as_uint(v), false, false); return fmaxf(__uint_as_float(rr[0]), __uint_as_float(rr[1])); }
__device__ __forceinline__ float xsum(float v) { auto rr = __builtin_amdgcn_permlane32_swap(__float_as_uint(v), __float_as_uint(v), false, false); return __uint_as_float(rr[0]) + __uint_as_float(rr[1]); }
typedef short v4i16_t __attribute__((ext_vector_type(4)));
__device__ __forceinline__ s16x4 vtr(lcp p) { return __builtin_bit_cast(s16x4, __builtin_amdgcn_ds_read_tr16_b64_v4i16((LAS v4i16_t*)p)); }

template <int ND0> __device__ __forceinline__ void qk_tile(f32x16& p0, f32x16& p1, lcp kslot, const bf16x8* qr, int r32, int hi) {
    lcp kb = kslot + hi * 1024 + r32 * 16;
    p0 = f32x16{}; p1 = f32x16{};
#pragma unroll
    for (int d0 = 0; d0 < ND0; ++d0) {
        const bf16x8 b0 = *(const LAS bf16x8*)(kb + d0 * 2048), b1 = *(const LAS bf16x8*)(kb + d0 * 2048 + 512);
        p0 = __builtin_amdgcn_mfma_f32_32x32x16_bf16(b0, qr[d0], p0, 0, 0, 0);
        p1 = __builtin_amdgcn_mfma_f32_32x32x16_bf16(b1, qr[d0], p1, 0, 0, 0); }
}
__device__ __forceinline__ void pv_tile(f32x16& o0, f32x16& o1, lcp vp, const u32x4 (&pa)[4]) {
    const unsigned vb = (unsigned)(uintptr_t)vp;
    s16x4 lo[8], hi[8];
#pragma unroll
    for (int i = 0; i < 8; ++i) {
        asm volatile("ds_read_b64_tr_b16 %0, %1 offset:%c2" : "=&v"(lo[i]) : "v"(vb), "i"((i >> 2) * 4096 + (i & 3) * 1024) : "memory");
        asm volatile("ds_read_b64_tr_b16 %0, %1 offset:%c2" : "=&v"(hi[i]) : "v"(vb), "i"((i >> 2) * 4096 + (i & 3) * 1024 + 512) : "memory"); }
    asm volatile("s_waitcnt lgkmcnt(0)" : "+v"(lo[0]), "+v"(lo[1]), "+v"(lo[2]), "+v"(lo[3]), "+v"(lo[4]), "+v"(lo[5]), "+v"(lo[6]), "+v"(lo[7]), "+v"(hi[0]), "+v"(hi[1]), "+v"(hi[2]), "+v"(hi[3]), "+v"(hi[4]), "+v"(hi[5]), "+v"(hi[6]), "+v"(hi[7]) :: "memory");
    __builtin_amdgcn_sched_barrier(0);
#pragma unroll
    for (int ks = 0; ks < 4; ++ks) {
        const bf16x8 v0 = (bf16x8){lo[ks][0], lo[ks][1], lo[ks][2], lo[ks][3], hi[ks][0], hi[ks][1], hi[ks][2], hi[ks][3]};
        const bf16x8 v1 = (bf16x8){lo[4 + ks][0], lo[4 + ks][1], lo[4 + ks][2], lo[4 + ks][3], hi[4 + ks][0], hi[4 + ks][1], hi[4 + ks][2], hi[4 + ks][3]};
        const bf16x8 a = __builtin_bit_cast(bf16x8, pa[ks]);
        o0 = __builtin_amdgcn_mfma_f32_32x32x16_bf16(a, v0, o0, 0, 0, 0);
        o1 = __builtin_amdgcn_mfma_f32_32x32x16_bf16(a, v1, o1, 0, 0, 0); }
}
__device__ __forceinline__ void pack_p(u32x4 (&pa)[4], const f32x16& p0, const f32x16& p1) {
    pa[0] = (u32x4){cvtpk(p0[0], p0[1]), cvtpk(p0[2], p0[3]), cvtpk(p0[4], p0[5]), cvtpk(p0[6], p0[7])};
    pa[1] = (u32x4){cvtpk(p0[8], p0[9]), cvtpk(p0[10], p0[11]), cvtpk(p0[12], p0[13]), cvtpk(p0[14], p0[15])};
    pa[2] = (u32x4){cvtpk(p1[0], p1[1]), cvtpk(p1[2], p1[3]), cvtpk(p1[4], p1[5]), cvtpk(p1[6], p1[7])};
    pa[3] = (u32x4){cvtpk(p1[8], p1[9]), cvtpk(p1[10], p1[11]), cvtpk(p1[12], p1[13]), cvtpk(p1[14], p1[15])};
}
__device__ __forceinline__ float max3f(float a, float b, float c) { float r; asm("v_max3_f32 %0, %1, %2, %3" : "=v"(r) : "v"(a), "v"(b), "v"(c)); return r; }
__device__ __forceinline__ void mfma_settle(f32x16& a, f32x16& b) { asm volatile("s_nop 15\n\ts_nop 7" : "+v"(a), "+v"(b)); }
__device__ __forceinline__ float max32(const f32x16& p0, const f32x16& p1) {
    float a = max3f(p0[0], p1[0], p0[1]), b = max3f(p1[1], p0[2], p1[2]);
#pragma unroll
    for (int r = 3; r < 15; r += 2) { a = max3f(a, p0[r], p1[r]); b = max3f(b, p0[r + 1], p1[r + 1]); }
    a = max3f(a, p0[15], p1[15]);
    return fmaxf(a, b);
}
__device__ __forceinline__ void softmax_pv(f32x16& p0, f32x16& p1, float& m, float& l, f32x16& o0, f32x16& o1, lcp vp, LAS float* wsf, int r32, int hi) {
    const float rm = xmax(max32(p0, p1));
    const float mn = fmaxf(m, rm); const float f = __builtin_amdgcn_exp2f(m - mn); m = mn;
    float s = 0.f;
#pragma unroll
    for (int r = 0; r < 16; ++r) { p0[r] = __builtin_amdgcn_exp2f(p0[r] - mn); p1[r] = __builtin_amdgcn_exp2f(p1[r] - mn); s += p0[r] + p1[r]; }
    l = l * f + s;
    if (__any(f != 1.0f)) {
        if (hi == 0) wsf[r32] = f;
#pragma unroll
        for (int r = 0; r < 16; ++r) { const float fr = wsf[crow(r, hi)]; o0[r] *= fr; o1[r] *= fr; }
    }
    u32x4 pa[4]; pack_p(pa, p0, p1);
    pv_tile(o0, o1, vp, pa);
}
__device__ __forceinline__ void add_scaled(f32x16& a0, f32x16& a1, const f32x16& o0, const f32x16& o1, float fac, LAS float* wsf, int r32, int hi) {
    if (hi == 0) wsf[32 + r32] = fac;
#pragma unroll
    for (int r = 0; r < 16; ++r) { const float fr = wsf[32 + crow(r, hi)]; a0[r] += fr * o0[r]; a1[r] += fr * o1[r]; }
}
template <bool FIRST> __device__ __forceinline__ void acc_lds(LAS float* accL, const f32x16& o0, const f32x16& o1, float fac, LAS float* wsf, int r32, int hi) {
    if (hi == 0) wsf[32 + r32] = fac;
#pragma unroll
    for (int r = 0; r < 16; ++r) { const int row = crow(r, hi); const float fr = wsf[32 + row]; LAS float* p = accL + row * 64 + r32;
        if (FIRST) { p[0] = fr * o0[r]; p[32] = fr * o1[r]; } else { p[0] += fr * o0[r]; p[32] += fr * o1[r]; } }
}
__device__ __forceinline__ void store_acc(const LAS float* accL, bf16* gdst, int pitch, int lane) {
#pragma unroll
    for (int i = 0; i < 4; ++i) { const int row = i * 8 + (lane >> 3), ch = lane & 7; const f32x4 a = *(const LAS f32x4*)(accL + row * 64 + ch * 8), b = *(const LAS f32x4*)(accL + row * 64 + ch * 8 + 4);
        const u32x4 v = (u32x4){cvtpk(a[0], a[1]), cvtpk(a[2], a[3]), cvtpk(b[0], b[1]), cvtpk(b[2], b[3])}; *(u32x4*)(gdst + (size_t)row * pitch + ch * 8) = v; }
}
__device__ __forceinline__ void store_o(const f32x16& o0, const f32x16& o1, LAS bf16* stg, bf16* gdst, int pitch, int lane, int r32, int hi) {
#pragma unroll
    for (int r = 0; r < 16; ++r) { const int orow = crow(r, hi); stg[orow * 64 + r32] = f2bf(o0[r]); stg[orow * 64 + 32 + r32] = f2bf(o1[r]); }
#pragma unroll
    for (int i = 0; i < 4; ++i) { const int row = i * 8 + (lane >> 3), ch = lane & 7; const u32x4 v = *(const LAS u32x4*)(stg + row * 64 + ch * 8); *(u32x4*)(gdst + (size_t)row * pitch + ch * 8) = v; }
}


template <int ND0> __device__ __forceinline__ void qk_tile_c(f32x16& p0, f32x16& p1, lcp kslot, const bf16x8* qr, const f32x16& c0, const f32x16& c1, int r32, int hi) {
    lcp kb = kslot + hi * 1024 + r32 * 16;
    bf16x8 kf0[ND0], kf1[ND0];
#pragma unroll
    for (int d0 = 0; d0 < ND0; ++d0) { kf0[d0] = *(const LAS bf16x8*)(kb + d0 * 2048); kf1[d0] = *(const LAS bf16x8*)(kb + d0 * 2048 + 512); }
    __builtin_amdgcn_sched_barrier(0);
#pragma unroll
    for (int d0 = 0; d0 < ND0; ++d0) {
        p0 = __builtin_amdgcn_mfma_f32_32x32x16_bf16(kf0[d0], qr[d0], d0 == 0 ? c0 : p0, 0, 0, 0);
        p1 = __builtin_amdgcn_mfma_f32_32x32x16_bf16(kf1[d0], qr[d0], d0 == 0 ? c1 : p1, 0, 0, 0); }
    asm volatile("s_nop 15\n\ts_nop 7" : "+v"(p0), "+v"(p1));
}
__device__ __forceinline__ void dma1k(const char* gsrc, LAS char* dst) { __builtin_amdgcn_global_load_lds((const unsigned*)gsrc, (LAS unsigned*)dst, 16, 0, 0); }
__device__ __forceinline__ void mask_causal(f32x16& p0, f32x16& p1, int e0) {
#pragma unroll
    for (int r = 0; r < 16; ++r) { const int e = e0 + (r & 3) + 8 * (r >> 2); if (e > 0) p0[r] = -INFINITY; if (e + 32 > 0) p1[r] = -INFINITY; }
}
__device__ __forceinline__ void mask_winlow(f32x16& p0, f32x16& p1, int e0) {
#pragma unroll
    for (int r = 0; r < 16; ++r) { const int e = e0 + (r & 3) + 8 * (r >> 2); if (e <= -512) p0[r] = -INFINITY; if (e + 32 <= -512) p1[r] = -INFINITY; }
}
__device__ __forceinline__ void softmax_pv2(f32x16& p0, f32x16& p1, f32x16& p2, f32x16& p3, float offa, float offb, float& m, float& l, f32x16& o0, f32x16& o1, lcp va, lcp vb, LAS float* wsf, int r32, int hi) {
    const float rm = xmax(fmaxf(max32(p0, p1) + offa, max32(p2, p3) + offb));
    const float mn = fmaxf(m, rm); const float f = __builtin_amdgcn_exp2f(m - mn); m = mn;
    const float ca = mn - offa, cb = mn - offb;
    float s = 0.f;
#pragma unroll
    for (int r = 0; r < 16; ++r) { p0[r] = __builtin_amdgcn_exp2f(p0[r] - ca); p1[r] = __builtin_amdgcn_exp2f(p1[r] - ca); s += p0[r] + p1[r]; }
#pragma unroll
    for (int r = 0; r < 16; ++r) { p2[r] = __builtin_amdgcn_exp2f(p2[r] - cb); p3[r] = __builtin_amdgcn_exp2f(p3[r] - cb); s += p2[r] + p3[r]; }
    l = l * f + s;
    if (__any(f != 1.0f)) {
        if (hi == 0) wsf[r32] = f;
#pragma unroll
        for (int r = 0; r < 16; ++r) { const float fr = wsf[crow(r, hi)]; o0[r] *= fr; o1[r] *= fr; }
    }
    { u32x4 pa[4]; pack_p(pa, p0, p1); pv_tile(o0, o1, va, pa); }
    { u32x4 pa[4]; pack_p(pa, p2, p3); pv_tile(o0, o1, vb, pa); }
}


__device__ __forceinline__ void glds16(const void* gsrc, unsigned lds_dst) { unsigned keep;
    asm volatile("s_mov_b32 %0, m0\n\ts_mov_b32 m0, %2\n\ts_nop 0\n\tglobal_load_lds_dwordx4 %1, off\n\ts_mov_b32 m0, %0" : "=&s"(keep) : "v"(gsrc), "s"(lds_dst) : "memory"); }
#define ATT_WAIT_BAR(N) asm volatile("s_waitcnt vmcnt(" #N ") lgkmcnt(0)\n\ts_barrier" ::: "memory")
__device__ __forceinline__ void softmax_pv1(f32x16& p0, f32x16& p1, float off, float& m, float& l, f32x16& o0, f32x16& o1, lcp vp, LAS float* wsf, int r32, int hi) {
    const float rm = xmax(max32(p0, p1) + off);
    const float mn = fmaxf(m, rm); const float f = __builtin_amdgcn_exp2f(m - mn); m = mn;
    const float ca = mn - off;
    p0 = p0 - ca; p1 = p1 - ca;
    float s = 0.f;
#pragma unroll
    for (int r = 0; r < 16; ++r) { p0[r] = __builtin_amdgcn_exp2f(p0[r]); p1[r] = __builtin_amdgcn_exp2f(p1[r]); }
    { const f32x16 ps = p0 + p1;
#pragma unroll
      for (int r = 0; r < 16; ++r) s += ps[r]; }
    l = l * f + s;
    if (__any(f != 1.0f)) {
        if (hi == 0) wsf[r32] = f;
#pragma unroll
        for (int r = 0; r < 16; ++r) { const float fr = wsf[crow(r, hi)]; o0[r] *= fr; o1[r] *= fr; }
    }
    u32x4 pa[4]; pack_p(pa, p0, p1);
    pv_tile(o0, o1, vp, pa);
}

__device__ __forceinline__ void softmax_part(f32x16& p0, f32x16& p1, float off, float& m, f32x16& o0, f32x16& o1, f32x16& ol, u32x4 (&pa)[4], LAS float* wsf, int r32, int hi) {
    const float rm = xmax(max32(p0, p1) + off);
    const float mn = fmaxf(m, rm); const float f = __builtin_amdgcn_exp2f(m - mn); m = mn;
    const float ca = mn - off;
#pragma unroll
    for (int r = 0; r < 16; ++r) { p0[r] = __builtin_amdgcn_exp2f(p0[r] - ca); p1[r] = __builtin_amdgcn_exp2f(p1[r] - ca); }
    if (__any(f != 1.0f)) {
        if (hi == 0) wsf[r32] = f;
#pragma unroll
        for (int r = 0; r < 16; ++r) { const float fr = wsf[crow(r, hi)]; o0[r] *= fr; o1[r] *= fr; ol[r] *= fr; }
    }
    pack_p(pa, p0, p1);
}
__device__ __forceinline__ void pv_tile_l(f32x16& o0, f32x16& o1, f32x16& ol, lcp vp, const u32x4 (&pa)[4]) {
    const unsigned vb = (unsigned)(uintptr_t)vp;
    s16x4 lo[8], hi[8];
#pragma unroll
    for (int i = 0; i < 8; ++i) {
        asm volatile("ds_read_b64_tr_b16 %0, %1 offset:%c2" : "=&v"(lo[i]) : "v"(vb), "i"((i >> 2) * 4096 + (i & 3) * 1024) : "memory");
        asm volatile("ds_read_b64_tr_b16 %0, %1 offset:%c2" : "=&v"(hi[i]) : "v"(vb), "i"((i >> 2) * 4096 + (i & 3) * 1024 + 512) : "memory"); }
    const bf16x8 ones = (bf16x8){0x3f80, 0x3f80, 0x3f80, 0x3f80, 0x3f80, 0x3f80, 0x3f80, 0x3f80};
#pragma unroll
    for (int ks = 0; ks < 4; ++ks) ol = __builtin_amdgcn_mfma_f32_32x32x16_bf16(__builtin_bit_cast(bf16x8, pa[ks]), ones, ol, 0, 0, 0);
    asm volatile("s_waitcnt lgkmcnt(0)" : "+v"(lo[0]), "+v"(lo[1]), "+v"(lo[2]), "+v"(lo[3]), "+v"(lo[4]), "+v"(lo[5]), "+v"(lo[6]), "+v"(lo[7]), "+v"(hi[0]), "+v"(hi[1]), "+v"(hi[2]), "+v"(hi[3]), "+v"(hi[4]), "+v"(hi[5]), "+v"(hi[6]), "+v"(hi[7]) :: "memory");
    __builtin_amdgcn_sched_barrier(0);
#pragma unroll
    for (int ks = 0; ks < 4; ++ks) {
        const bf16x8 v0 = (bf16x8){lo[ks][0], lo[ks][1], lo[ks][2], lo[ks][3], hi[ks][0], hi[ks][1], hi[ks][2], hi[ks][3]};
        const bf16x8 v1 = (bf16x8){lo[4 + ks][0], lo[4 + ks][1], lo[4 + ks][2], lo[4 + ks][3], hi[4 + ks][0], hi[4 + ks][1], hi[4 + ks][2], hi[4 + ks][3]};
        const bf16x8 a = __builtin_bit_cast(bf16x8, pa[ks]);
        o0 = __builtin_amdgcn_mfma_f32_32x32x16_bf16(a, v0, o0, 0, 0, 0);
        o1 = __builtin_amdgcn_mfma_f32_32x32x16_bf16(a, v1, o1, 0, 0, 0); }
}

#ifdef ATT_V1
constexpr int M_KS = 0, M_VS = 24576, M_WSF = 40960, M_OST = 43008;
__device__ __forceinline__ void mla_unit(int b, int h, int qb, const bf16* Qm, const bf16* Km, const bf16* Vm, bf16* Ob, LAS char* lds, int wave_id) {
    int tid_ = wave_id * 64 + opaque_lane();
    const int tid = tid_, lane = tid & 63, r32 = lane & 31, hi = lane >> 5, wid = __builtin_amdgcn_readfirstlane(tid >> 6);
    const int q0 = qb * 256, NT = (q0 + 256) / 64;
    const int qmin = q0 + wid * 32, qpos = qmin + r32;
    bf16x8 qr[6];
    { const bf16* qp = Qm + ((size_t)b * 8192 + qpos) * 768 + h * 96 + hi * 8;
#pragma unroll
      for (int d0 = 0; d0 < 6; ++d0) qr[d0] = *(const bf16x8*)(qp + d0 * 16); }
    const char* Kg = (const char*)(Km + (size_t)(b * 8 + h) * 128 * 6144);
    const char* Vg = (const char*)(Vm + (size_t)(b * 8 + h) * 128 * 4096);
    LAS float* wsf = (LAS float*)(lds + M_WSF) + wid * 64;
    const int vlane = ((lane >> 4) & 1) * 32 + (lane & 3) * 8 + (4 * hi + ((lane & 15) >> 2)) * 64;
    float m = -1e30f, l = 0.f; f32x16 o0 = f32x16{}, o1 = f32x16{};
    u32x4 kr0, kr1 = u32x4{}, vr0;
    kr0 = *(const u32x4*)(Kg + tid * 16); if (tid < 256) kr1 = *(const u32x4*)(Kg + 8192 + tid * 16); vr0 = *(const u32x4*)(Vg + tid * 16);
    *(LAS u32x4*)(lds + M_KS + tid * 16) = kr0; if (tid < 256) *(LAS u32x4*)(lds + M_KS + 8192 + tid * 16) = kr1; *(LAS u32x4*)(lds + M_VS + tid * 16) = vr0;
    __syncthreads();
    for (int kt = 0; kt < NT; ++kt) {
        const int sl = kt & 1;
        if (kt + 1 < NT) { const char* kg = Kg + (size_t)(kt + 1) * 12288; const char* vg = Vg + (size_t)(kt + 1) * 8192;
            kr0 = *(const u32x4*)(kg + tid * 16); if (tid < 256) kr1 = *(const u32x4*)(kg + 8192 + tid * 16); vr0 = *(const u32x4*)(vg + tid * 16); }
        if (64 * kt <= qmin + 31) {
            f32x16 p0, p1; qk_tile<6>(p0, p1, (lcp)(lds + M_KS + sl * 12288), qr, r32, hi);
            if (64 * kt + 63 > qmin) {
                const int kb = 64 * kt + 4 * hi;
#pragma unroll
                for (int r = 0; r < 16; ++r) { const int kv = kb + (r & 3) + 8 * (r >> 2); if (kv > qpos) p0[r] = -INFINITY; if (kv + 32 > qpos) p1[r] = -INFINITY; }
            }
            softmax_pv(p0, p1, m, l, o0, o1, (lcp)(lds + M_VS + sl * 8192 + vlane), wsf, r32, hi);
        }
        if (kt + 1 < NT) { const int sn = sl ^ 1;
            *(LAS u32x4*)(lds + M_KS + sn * 12288 + tid * 16) = kr0; if (tid < 256) *(LAS u32x4*)(lds + M_KS + sn * 12288 + 8192 + tid * 16) = kr1; *(LAS u32x4*)(lds + M_VS + sn * 8192 + tid * 16) = vr0; }
        __syncthreads();
    }
    const float lt = xsum(l); const float inv = lt > 0.f ? 1.0f / lt : 0.f;
    f32x16 a0 = f32x16{}, a1 = f32x16{};
    add_scaled(a0, a1, o0, o1, inv, wsf, r32, hi);
    store_o(a0, a1, (LAS bf16*)(lds + M_OST + wid * 4096), Ob + ((size_t)b * 8192 + qmin) * 512 + h * 64, 512, lane, r32, hi);
    __syncthreads();
}

constexpr int N_KS = 0, N_VS = 16384, N_WSF = 32768, N_ACC = 34816, N_IMP = 100352, N_SEL = 133376, N_UNI = 134400, N_BL = 134464, IMPS = 129;
struct NsaT { const bf16 *Qn, *Kc, *Vc, *Ksel, *Vsel, *Kwin, *Vwin; const float* gates; bf16* Oa; };
__device__ __forceinline__ void setbit(unsigned (&w)[4], int j) { const int wi = j >> 5; const unsigned bv = 1u << (j & 31); w[0] |= wi == 0 ? bv : 0u; w[1] |= wi == 1 ? bv : 0u; w[2] |= wi == 2 ? bv : 0u; w[3] |= wi == 3 ? bv : 0u; }
__device__ __forceinline__ void nsa_unit(int b, int g, int ti, const NsaT& T, LAS char* lds, int wave_id) {
    int tid_ = wave_id * 64 + opaque_lane();
    const int tid = tid_, lane = tid & 63, r32 = lane & 31, hi = lane >> 5, wid = __builtin_amdgcn_readfirstlane(tid >> 6);
    const int hh = wid & 3, qh = wid >> 2, H = g * 4 + hh, bg = b * 2 + g;
    const int t0 = ti * 64, qrow = qh * 32 + r32, t = t0 + qrow;
    const float slope2 = __builtin_amdgcn_exp2f(-(float)(H + 1)) * LOG2E;
    bf16x8 qr[4];
    { const bf16* qp = T.Qn + ((size_t)b * 8192 + t) * 512 + H * 64 + hi * 8;
#pragma unroll
      for (int d0 = 0; d0 < 4; ++d0) qr[d0] = *(const bf16x8*)(qp + d0 * 16); }
    LAS float* wsf = (LAS float*)(lds + N_WSF) + wid * 64;
    LAS float* imp = (LAS float*)(lds + N_IMP);
    LAS unsigned* selw = (LAS unsigned*)(lds + N_SEL);
    LAS unsigned* uni = (LAS unsigned*)(lds + N_UNI);
    LAS unsigned* blist = (LAS unsigned*)(lds + N_BL);
    const int vlane = ((lane >> 4) & 1) * 32 + (lane & 3) * 8 + (4 * hi + ((lane & 15) >> 2)) * 64;
    for (int i = tid; i < 64 * IMPS; i += 512) imp[i] = 0.f;
    if (tid < 256) selw[tid] = 0u;
    if (tid < 8) uni[tid] = 0u;
    const float* gp = T.gates + ((size_t)b * 8192 + t) * 24 + H * 3;
    const float gc = gp[0], gs = gp[1], gw = gp[2];
    LAS float* accL = (LAS float*)(lds + N_ACC) + wid * 2048;
    u32x4 kr0, vr0;
    const int ntc = (4 * ti + 3 + 63) >> 6;
    const char* Kcg = (const char*)(T.Kc + (size_t)bg * 8 * 4096); const char* Vcg = (const char*)(T.Vc + (size_t)bg * 8 * 4096);
    float m = -1e30f, l = 0.f;
#ifndef NSA_SKIP_P1
    kr0 = *(const u32x4*)(Kcg + tid * 16); *(LAS u32x4*)(lds + N_KS + tid * 16) = kr0;
    __syncthreads();
    for (int kt = 0; kt < ntc; ++kt) {
        const int sl = kt & 1;
        if (kt + 1 < ntc) kr0 = *(const u32x4*)(Kcg + (size_t)(kt + 1) * 8192 + tid * 16);
        { f32x16 p0, p1; qk_tile<4>(p0, p1, (lcp)(lds + N_KS + sl * 8192), qr, r32, hi);
          const int nb = 64 * kt + 4 * hi;
#pragma unroll
          for (int r = 0; r < 16; ++r) { const int n = nb + (r & 3) + 8 * (r >> 2); const int e0 = 16 * n + 31 - t, e1 = e0 + 512;
              p0[r] = e0 <= 0 ? p0[r] + slope2 * (float)e0 : -INFINITY; p1[r] = e1 <= 0 ? p1[r] + slope2 * (float)e1 : -INFINITY; }
          const float rm = max32(p0, p1); const float mn = fmaxf(m, rm); float s = 0.f;
#pragma unroll
          for (int r = 0; r < 16; ++r) s += __builtin_amdgcn_exp2f(p0[r] - mn) + __builtin_amdgcn_exp2f(p1[r] - mn);
          l = l * __builtin_amdgcn_exp2f(m - mn) + s; m = mn; }
        if (kt + 1 < ntc) *(LAS u32x4*)(lds + N_KS + (sl ^ 1) * 8192 + tid * 16) = kr0;
        __syncthreads();
    }
    {
      auto rm_ = __builtin_amdgcn_permlane32_swap(__float_as_uint(m), __float_as_uint(m), false, false); auto rl_ = __builtin_amdgcn_permlane32_swap(__float_as_uint(l), __float_as_uint(l), false, false);
      const float mo = __uint_as_float(hi ? rm_[0] : rm_[1]), lo = __uint_as_float(hi ? rl_[0] : rl_[1]); const float mn = fmaxf(m, mo);
      l = l * __builtin_amdgcn_exp2f(m - mn) + lo * __builtin_amdgcn_exp2f(mo - mn); m = mn; }
#endif
    const float invl = l > 0.f ? 1.0f / l : 0.f;
    f32x16 o0 = f32x16{}, o1 = f32x16{};
#ifndef NSA_SKIP_P2
    kr0 = *(const u32x4*)(Kcg + tid * 16); vr0 = *(const u32x4*)(Vcg + tid * 16);
    *(LAS u32x4*)(lds + N_KS + tid * 16) = kr0; *(LAS u32x4*)(lds + N_VS + tid * 16) = vr0;
    __syncthreads();
    for (int kt = 0; kt < ntc; ++kt) {
        const int sl = kt & 1;
        if (kt + 1 < ntc) { kr0 = *(const u32x4*)(Kcg + (size_t)(kt + 1) * 8192 + tid * 16); vr0 = *(const u32x4*)(Vcg + (size_t)(kt + 1) * 8192 + tid * 16); }
        { f32x16 p0, p1; qk_tile<4>(p0, p1, (lcp)(lds + N_KS + sl * 8192), qr, r32, hi);
          const int nb = 64 * kt + 4 * hi;
#pragma unroll
          for (int r = 0; r < 16; ++r) { const int n = nb + (r & 3) + 8 * (r >> 2); const int e0 = 16 * n + 31 - t, e1 = e0 + 512;
              p0[r] = e0 <= 0 ? __builtin_amdgcn_exp2f(p0[r] + slope2 * (float)e0 - m) * invl : 0.f; p1[r] = e1 <= 0 ? __builtin_amdgcn_exp2f(p1[r] + slope2 * (float)e1 - m) * invl : 0.f; }
          LAS float* ir = imp + qrow * IMPS + 16 * kt + hi;
#pragma unroll
          for (int rg = 0; rg < 4; ++rg) {
              const float A0 = (p0[4 * rg] + p0[4 * rg + 1]) + (p0[4 * rg + 2] + p0[4 * rg + 3]), A1 = (p1[4 * rg] + p1[4 * rg + 1]) + (p1[4 * rg + 2] + p1[4 * rg + 3]);
              __hip_atomic_fetch_add(ir + 2 * rg, A0, __ATOMIC_RELAXED, __HIP_MEMORY_SCOPE_WORKGROUP); __hip_atomic_fetch_add(ir + 2 * rg + 1, p0[4 * rg + 3], __ATOMIC_RELAXED, __HIP_MEMORY_SCOPE_WORKGROUP);
              __hip_atomic_fetch_add(ir + 8 + 2 * rg, A1, __ATOMIC_RELAXED, __HIP_MEMORY_SCOPE_WORKGROUP); __hip_atomic_fetch_add(ir + 8 + 2 * rg + 1, p1[4 * rg + 3], __ATOMIC_RELAXED, __HIP_MEMORY_SCOPE_WORKGROUP); }
          u32x4 pa[4]; pack_p(pa, p0, p1);
          pv_tile(o0, o1, (lcp)(lds + N_VS + sl * 8192 + vlane), pa); }
        if (kt + 1 < ntc) { *(LAS u32x4*)(lds + N_KS + (sl ^ 1) * 8192 + tid * 16) = kr0; *(LAS u32x4*)(lds + N_VS + (sl ^ 1) * 8192 + tid * 16) = vr0; }
        __syncthreads();
    }
    acc_lds<true>(accL, o0, o1, gc, wsf, r32, hi);
#endif
#ifndef NSA_SKIP_TOPK
    {
        const int q = tid >> 3, sub = tid & 7;
        unsigned w[4] = {0u, 0u, 0u, 0u};
        if (ti <= 15) { if (sub == 0) w[0] = (2u << ti) - 1u; }
        else {
            const LAS float* row = imp + q * IMPS;
#pragma unroll 1
            for (int half = 0; half < 2; ++half) {
                float v[8]; int cnt[8];
#pragma unroll
                for (int k = 0; k < 8; ++k) { const int j = 1 + sub + 8 * (k + 8 * half); v[k] = (j <= ti - 2) ? row[j] : -1.0f; cnt[k] = 0; }
#pragma unroll 1
                for (int jp = 1; jp <= ti - 2; ++jp) { const float vp = row[jp];
#pragma unroll
                    for (int k = 0; k < 8; ++k) { const int j = 1 + sub + 8 * (k + 8 * half); cnt[k] += (vp > v[k] || (vp == v[k] && jp < j)) ? 1 : 0; } }
#pragma unroll
                for (int k = 0; k < 8; ++k) { const int j = 1 + sub + 8 * (k + 8 * half); if (j <= ti - 2 && cnt[k] < 13) setbit(w, j); }
            }
            if (sub == 0) { w[0] |= 1u; setbit(w, ti); setbit(w, ti - 1); }
        }
#pragma unroll
        for (int k = 0; k < 4; ++k) if (w[k]) { __hip_atomic_fetch_or(selw + q * 4 + k, w[k], __ATOMIC_RELAXED, __HIP_MEMORY_SCOPE_WORKGROUP); __hip_atomic_fetch_or(uni + k, w[k], __ATOMIC_RELAXED, __HIP_MEMORY_SCOPE_WORKGROUP); }
    }
#endif
    __syncthreads();
    if (tid == 0) { int nb = 0;
        for (int k = 0; k < 4; ++k) { unsigned u = uni[k]; while (u) { const int bit = __builtin_ctz(u); u &= u - 1u; blist[nb++] = (unsigned)(32 * k + bit); } }
        uni[4] = (unsigned)nb; }
    __syncthreads();
    const int nsel = (int)uni[4];
    unsigned sw[4];
#pragma unroll
    for (int k = 0; k < 4; ++k) sw[k] = selw[qrow * 4 + k];
#ifndef NSA_SKIP_SEL
    {
        const char* Kg = (const char*)(T.Ksel + (size_t)bg * 128 * 4096); const char* Vg = (const char*)(T.Vsel + (size_t)bg * 128 * 4096);
        m = -1e30f; l = 0.f; o0 = f32x16{}; o1 = f32x16{};
        int j = (int)blist[0];
        kr0 = *(const u32x4*)(Kg + (size_t)j * 8192 + tid * 16); vr0 = *(const u32x4*)(Vg + (size_t)j * 8192 + tid * 16);
        *(LAS u32x4*)(lds + N_KS + tid * 16) = kr0; *(LAS u32x4*)(lds + N_VS + tid * 16) = vr0;
        __syncthreads();
        for (int k = 0; k < nsel; ++k) {
            const int sl = k & 1; int jn = 0;
            if (k + 1 < nsel) { jn = (int)blist[k + 1]; kr0 = *(const u32x4*)(Kg + (size_t)jn * 8192 + tid * 16); vr0 = *(const u32x4*)(Vg + (size_t)jn * 8192 + tid * 16); }
            { f32x16 p0, p1; qk_tile<4>(p0, p1, (lcp)(lds + N_KS + sl * 8192), qr, r32, hi);
              const int jw = j >> 5; const unsigned swj = jw == 0 ? sw[0] : jw == 1 ? sw[1] : jw == 2 ? sw[2] : sw[3]; const bool mine = (swj >> (j & 31)) & 1u; const int pb = 64 * j + 4 * hi - t;
#pragma unroll
              for (int r = 0; r < 16; ++r) { const int e0 = pb + (r & 3) + 8 * (r >> 2), e1 = e0 + 32;
                  p0[r] = (mine && e0 <= 0) ? p0[r] + slope2 * (float)e0 : -INFINITY; p1[r] = (mine && e1 <= 0) ? p1[r] + slope2 * (float)e1 : -INFINITY; }
              softmax_pv(p0, p1, m, l, o0, o1, (lcp)(lds + N_VS + sl * 8192 + vlane), wsf, r32, hi); }
            if (k + 1 < nsel) { *(LAS u32x4*)(lds + N_KS + (sl ^ 1) * 8192 + tid * 16) = kr0; *(LAS u32x4*)(lds + N_VS + (sl ^ 1) * 8192 + tid * 16) = vr0; }
            j = jn;
            __syncthreads();
        }
        const float lt = xsum(l); acc_lds<false>(accL, o0, o1, lt > 0.f ? gs / lt : 0.f, wsf, r32, hi);
    }
#endif
#ifndef NSA_SKIP_WIN
    {
        const char* Kg = (const char*)(T.Kwin + (size_t)bg * 128 * 4096); const char* Vg = (const char*)(T.Vwin + (size_t)bg * 128 * 4096);
        m = -1e30f; l = 0.f; o0 = f32x16{}; o1 = f32x16{};
        const int j0 = ti >= 8 ? ti - 8 : 0, nw = ti - j0 + 1;
        kr0 = *(const u32x4*)(Kg + (size_t)j0 * 8192 + tid * 16); vr0 = *(const u32x4*)(Vg + (size_t)j0 * 8192 + tid * 16);
        *(LAS u32x4*)(lds + N_KS + tid * 16) = kr0; *(LAS u32x4*)(lds + N_VS + tid * 16) = vr0;
        __syncthreads();
        for (int k = 0; k < nw; ++k) {
            const int sl = k & 1, j = j0 + k;
            if (k + 1 < nw) { kr0 = *(const u32x4*)(Kg + (size_t)(j + 1) * 8192 + tid * 16); vr0 = *(const u32x4*)(Vg + (size_t)(j + 1) * 8192 + tid * 16); }
            { f32x16 p0, p1; qk_tile<4>(p0, p1, (lcp)(lds + N_KS + sl * 8192), qr, r32, hi);
              const int pb = 64 * j + 4 * hi - t;
#pragma unroll
              for (int r = 0; r < 16; ++r) { const int e0 = pb + (r & 3) + 8 * (r >> 2), e1 = e0 + 32;
                  p0[r] = (e0 <= 0 && e0 > -512) ? p0[r] + slope2 * (float)e0 : -INFINITY; p1[r] = (e1 <= 0 && e1 > -512) ? p1[r] + slope2 * (float)e1 : -INFINITY; }
              softmax_pv(p0, p1, m, l, o0, o1, (lcp)(lds + N_VS + sl * 8192 + vlane), wsf, r32, hi); }
            if (k + 1 < nw) { *(LAS u32x4*)(lds + N_KS + (sl ^ 1) * 8192 + tid * 16) = kr0; *(LAS u32x4*)(lds + N_VS + (sl ^ 1) * 8192 + tid * 16) = vr0; }
            __syncthreads();
        }
        const float lt = xsum(l); acc_lds<false>(accL, o0, o1, lt > 0.f ? gw / lt : 0.f, wsf, r32, hi);
    }
#endif
    store_acc(accL, T.Oa + ((size_t)b * 8192 + t0 + qh * 32) * 512 + H * 64, 512, lane);
    __syncthreads();
}
#endif

#ifndef ATT_V1
#ifdef MLA_V2
constexpr int M_STG = 40960, M_WSF = 81920, M_OST = 83968;
__device__ __forceinline__ void mla_unit(int b, int h, int qb, const bf16* Qm, const bf16* Km, const bf16* Vm, bf16* Ob, LAS char* lds, int wave_id) {
    int tid_ = wave_id * 64 + opaque_lane();
    const int tid = tid_, lane = tid & 63, r32 = lane & 31, hi = lane >> 5, wid = __builtin_amdgcn_readfirstlane(tid >> 6);
    const int q0 = qb * 256, NP = (q0 + 256) / 128;
    const int qmin = q0 + wid * 32, qpos = qmin + r32;
    bf16x8 qr[6];
    { const bf16* qp = Qm + ((size_t)b * 8192 + qpos) * 768 + h * 96 + hi * 8;
#pragma unroll
      for (int d0 = 0; d0 < 6; ++d0) qr[d0] = *(const bf16x8*)(qp + d0 * 16); }
    const char* Kg = (const char*)(Km + (size_t)(b * 8 + h) * 128 * 6144) + lane * 16;
    const char* Vg = (const char*)(Vm + (size_t)(b * 8 + h) * 128 * 4096) + lane * 16;
    LAS float* wsf = (LAS float*)(lds + M_WSF) + wid * 64;
    const int vlane = ((lane >> 4) & 1) * 32 + (lane & 3) * 8 + (4 * hi + ((lane & 15) >> 2)) * 64;
    float m = -1e30f, l = 0.f; f32x16 o0 = f32x16{}, o1 = f32x16{};
    const f32x16 zc = f32x16{};
#define MLA_DMA(p, stg) do { const int ja_ = 2 * (p), jb_ = ja_ + 1; _Pragma("unroll") for (int i_ = 0; i_ < 5; ++i_) { const int q_ = wid + 8 * i_; \
        const char* s_ = q_ < 12 ? Kg + (size_t)ja_ * 12288 + q_ * 1024 : q_ < 24 ? Kg + (size_t)jb_ * 12288 + (q_ - 12) * 1024 : q_ < 32 ? Vg + (size_t)ja_ * 8192 + (q_ - 24) * 1024 : Vg + (size_t)jb_ * 8192 + (q_ - 32) * 1024; \
        dma1k(s_, lds + (stg) * M_STG + q_ * 1024); } } while (0)
    MLA_DMA(0, 0);
    __syncthreads();
    for (int p = 0; p < NP; ++p) {
        const int st = p & 1;
        if (p + 1 < NP) MLA_DMA(p + 1, st ^ 1);
        const int ja = 2 * p, jb = ja + 1;
        if (64 * ja <= qmin + 31) {
            LAS char* sb = lds + st * M_STG;
            f32x16 p0, p1, p2, p3;
            qk_tile_c<6>(p0, p1, (lcp)sb, qr, zc, zc, r32, hi);
            qk_tile_c<6>(p2, p3, (lcp)(sb + 12288), qr, zc, zc, r32, hi);
            if (64 * ja + 63 > qmin) mask_causal(p0, p1, 64 * ja + 4 * hi - qpos);
            if (64 * jb + 63 > qmin) mask_causal(p2, p3, 64 * jb + 4 * hi - qpos);
            softmax_pv2(p0, p1, p2, p3, 0.f, 0.f, m, l, o0, o1, (lcp)(sb + 24576 + vlane), (lcp)(sb + 32768 + vlane), wsf, r32, hi);
        }
        __syncthreads();
    }
#undef MLA_DMA
    const float lt = xsum(l); const float inv = lt > 0.f ? 1.0f / lt : 0.f;
    f32x16 a0 = f32x16{}, a1 = f32x16{};
    add_scaled(a0, a1, o0, o1, inv, wsf, r32, hi);
    store_o(a0, a1, (LAS bf16*)(lds + M_OST + wid * 4096), Ob + ((size_t)b * 8192 + qmin) * 512 + h * 64, 512, lane, r32, hi);
    __syncthreads();
}
#else
#ifdef MLA_V4
constexpr int M_SLOT = 20480, M_WSF = 81920, M_OST = 83968;
__device__ __forceinline__ void mla_unit(int b, int h, int qb, const bf16* Qm, const bf16* Km, const bf16* Vm, bf16* Ob, LAS char* lds, int wave_id) {
    int tid_ = wave_id * 64 + opaque_lane();
    const int tid = tid_, lane = tid & 63, r32 = lane & 31, hi = lane >> 5, wid = __builtin_amdgcn_readfirstlane(tid >> 6);
    const int q0 = qb * 256, NT = (q0 + 256) / 64;
    const int qmin = q0 + wid * 32, qpos = qmin + r32;
    bf16x8 qr[6];
    { const bf16* qp = Qm + ((size_t)b * 8192 + qpos) * 768 + h * 96 + hi * 8;
#pragma unroll
      for (int d0 = 0; d0 < 6; ++d0) qr[d0] = *(const bf16x8*)(qp + d0 * 16); }
    const char* Kg = (const char*)(Km + (size_t)(b * 8 + h) * 128 * 6144) + lane * 16;
    const char* Vg = (const char*)(Vm + (size_t)(b * 8 + h) * 128 * 4096) + lane * 16;
    const unsigned lds0 = (unsigned)(uintptr_t)lds;
    LAS float* wsf = (LAS float*)(lds + M_WSF) + wid * 64;
    const int vlane = ((lane >> 4) & 1) * 32 + (lane & 3) * 8 + (4 * hi + ((lane & 15) >> 2)) * 64;
    float m = -1e30f, l = 0.f; f32x16 o0 = f32x16{}, o1 = f32x16{};
    const f32x16 zc = f32x16{};
#define MLA_DMA(t_) do { const unsigned sl_ = lds0 + (unsigned)(((t_) & 3) * M_SLOT); _Pragma("unroll") for (int i_ = 0; i_ < 3; ++i_) { int q_ = wid + 8 * i_; if (q_ >= 20) q_ -= 16; \
        const char* s_ = q_ < 12 ? Kg + (size_t)(t_) * 12288 + q_ * 1024 : Vg + (size_t)(t_) * 8192 + (q_ - 12) * 1024; glds16(s_, (unsigned)__builtin_amdgcn_readfirstlane(sl_ + q_ * 1024)); } } while (0)
#define MLA_QK(P0, P1, t_) do { qk_tile_c<6>(P0, P1, (lcp)(lds + ((t_) & 3) * M_SLOT), qr, zc, zc, r32, hi); if (64 * (t_) + 63 > qmin) mask_causal(P0, P1, 64 * (t_) + 4 * hi - qpos); } while (0)
#define MLA_STEP(PC0, PC1, PN0, PN1, t_) do { \
        if ((t_) + 3 < NT) MLA_DMA((t_) + 3); \
        if ((t_) + 1 < NT && 64 * ((t_) + 1) <= qmin + 31) MLA_QK(PN0, PN1, (t_) + 1); \
        if (64 * (t_) <= qmin + 31) softmax_pv1(PC0, PC1, 0.f, m, l, o0, o1, (lcp)(lds + ((t_) & 3) * M_SLOT + 12288 + vlane), wsf, r32, hi); \
        if ((t_) + 3 < NT) ATT_WAIT_BAR(3); else ATT_WAIT_BAR(0); } while (0)
    MLA_DMA(0); MLA_DMA(1); MLA_DMA(2);
    ATT_WAIT_BAR(3);
    f32x16 pA0, pA1, pB0 = f32x16{}, pB1 = f32x16{};
    MLA_QK(pA0, pA1, 0);
    for (int t = 0; t < NT; t += 2) {
        MLA_STEP(pA0, pA1, pB0, pB1, t);
        MLA_STEP(pB0, pB1, pA0, pA1, t + 1);
    }
#undef MLA_DMA
#undef MLA_QK
#undef MLA_STEP
    const float lt = xsum(l); const float inv = lt > 0.f ? 1.0f / lt : 0.f;
    f32x16 a0 = f32x16{}, a1 = f32x16{};
    add_scaled(a0, a1, o0, o1, inv, wsf, r32, hi);
    store_o(a0, a1, (LAS bf16*)(lds + M_OST + wid * 4096), Ob + ((size_t)b * 8192 + qmin) * 512 + h * 64, 512, lane, r32, hi);
    __syncthreads();
}
#else
constexpr int M_SLOT = 20480, M_WSF = 81920, M_OST = 83968;
template <int DIAG = 0> __device__ __forceinline__ void mla_unit(int b, int h, int qb, const bf16* Qm, const bf16* Km, const bf16* Vm, bf16* Ob, LAS char* lds, int wave_id) {
    int tid_ = wave_id * 64 + opaque_lane();
    const int tid = tid_, lane = tid & 63, r32 = lane & 31, hi = lane >> 5, wid = __builtin_amdgcn_readfirstlane(tid >> 6);
    const int q0 = qb * 256, NT = (q0 + 256) / 64;
    const int qmin = q0 + wid * 32, qpos = qmin + r32;
    bf16x8 qr[6];
    { const bf16* qp = Qm + ((size_t)b * 8192 + qpos) * 768 + h * 96 + hi * 8;
#pragma unroll
      for (int d0 = 0; d0 < 6; ++d0) qr[d0] = *(const bf16x8*)(qp + d0 * 16); }
    const char* Kg = (const char*)(Km + (size_t)(b * 8 + h) * 128 * 6144) + lane * 16;
    const char* Vg = (const char*)(Vm + (size_t)(b * 8 + h) * 128 * 4096) + lane * 16;
    const unsigned lds0 = (unsigned)(uintptr_t)lds;
    LAS float* wsf = (LAS float*)(lds + M_WSF) + wid * 64;
    const int vlane = ((lane >> 4) & 1) * 32 + (lane & 3) * 8 + (4 * hi + ((lane & 15) >> 2)) * 64;
    float m = -1e30f; f32x16 o0 = f32x16{}, o1 = f32x16{}, ol = f32x16{};
    const f32x16 zc = f32x16{};
#define MLA_DMA(t_) do { const unsigned sl_ = lds0 + (unsigned)(((t_) & 3) * M_SLOT); _Pragma("unroll") for (int i_ = 0; i_ < 3; ++i_) { const int q_ = wid + 8 * i_; if (q_ < 20) { \
        const char* s_ = q_ < 12 ? Kg + (size_t)(t_) * 12288 + q_ * 1024 : Vg + (size_t)(t_) * 8192 + (q_ - 12) * 1024; glds16(s_, (unsigned)__builtin_amdgcn_readfirstlane(sl_ + q_ * 1024)); } } } while (0)
#define MLA_QK(P0, P1, t_) do { qk_tile_c<6>(P0, P1, (lcp)(lds + ((t_) & 3) * M_SLOT), qr, zc, zc, r32, hi); if (64 * (t_) + 63 > qmin) mask_causal(P0, P1, 64 * (t_) + 4 * hi - qpos); } while (0)
    MLA_DMA(0); MLA_DMA(1);
    ATT_WAIT_BAR(0);
    f32x16 p0, p1;
    MLA_QK(p0, p1, 0);
    if (wid >= 4) ATT_WAIT_BAR(0);
    for (int t = 0; t < NT; ++t) {
        const bool need = 64 * t <= qmin + 31;
        u32x4 pa[4];
        if (t + 2 < NT && !(DIAG & 1)) MLA_DMA(t + 2);
        if (need && !(DIAG & 2)) softmax_part(p0, p1, 0.f, m, o0, o1, ol, pa, wsf, r32, hi);
        if (DIAG & 2) { pa[0] = pa[1] = pa[2] = pa[3] = (u32x4){0u, 0u, 0u, 0u}; }
        ATT_WAIT_BAR(3);
        if (need && !(DIAG & 4)) pv_tile_l(o0, o1, ol, (lcp)(lds + (t & 3) * M_SLOT + 12288 + vlane), pa);
        if (t + 1 < NT && 64 * (t + 1) <= qmin + 31 && !(DIAG & 4)) MLA_QK(p0, p1, t + 1);
        if (DIAG & 8) continue;
        ATT_WAIT_BAR(0);
    }
    if (wid < 4) ATT_WAIT_BAR(0);
#undef MLA_DMA
#undef MLA_QK
    f32x16 a0, a1;
#pragma unroll
    for (int r = 0; r < 16; ++r) { const float inv = ol[r] > 0.f ? __builtin_amdgcn_rcpf(ol[r]) : 0.f; a0[r] = o0[r] * inv; a1[r] = o1[r] * inv; }
    store_o(a0, a1, (LAS bf16*)(lds + M_OST + wid * 4096), Ob + ((size_t)b * 8192 + qmin) * 512 + h * 64, 512, lane, r32, hi);
    __syncthreads();
}
#endif
#endif
constexpr int N_KS = 0, N_VS = 16384, N_STG = 32768, N_IMP = 32768, N_WSF = 66048, N_ACC = 68096, N_SEL = 133632, N_UNI = 134656, N_BL = 134720, IMPS = 129;
struct NsaT { const bf16 *Qn, *Kc, *Vc, *Ksel, *Vsel, *Kwin, *Vwin; const float* gates; bf16* Oa; };
__device__ __forceinline__ void setbit(unsigned (&w)[4], int j) { const int wi = j >> 5; const unsigned bv = 1u << (j & 31); w[0] |= wi == 0 ? bv : 0u; w[1] |= wi == 1 ? bv : 0u; w[2] |= wi == 2 ? bv : 0u; w[3] |= wi == 3 ? bv : 0u; }
template <int DIAG = 0> __device__ __forceinline__ void nsa_unit(int b, int g, int ti, const NsaT& T, LAS char* lds, int wave_id) {
    int tid_ = wave_id * 64 + opaque_lane();
    const int tid = tid_, lane = tid & 63, r32 = lane & 31, hi = lane >> 5, wid = __builtin_amdgcn_readfirstlane(tid >> 6);
    const int hh = wid & 3, qh = wid >> 2, H = g * 4 + hh, bg = b * 2 + g;
    const int t0 = ti * 64, qrow = qh * 32 + r32, t = t0 + qrow;
    const float slope2 = __builtin_amdgcn_exp2f(-(float)(H + 1)) * LOG2E;
    bf16x8 qr[4];
    { const bf16* qp = T.Qn + ((size_t)b * 8192 + t) * 512 + H * 64 + hi * 8;
#pragma unroll
      for (int d0 = 0; d0 < 4; ++d0) qr[d0] = *(const bf16x8*)(qp + d0 * 16); }
    LAS float* wsf = (LAS float*)(lds + N_WSF) + wid * 64;
    LAS float* imp = (LAS float*)(lds + N_IMP);
    LAS unsigned* selw = (LAS unsigned*)(lds + N_SEL);
    LAS unsigned* uni = (LAS unsigned*)(lds + N_UNI);
    LAS unsigned* blist = (LAS unsigned*)(lds + N_BL);
    const int vlane = ((lane >> 4) & 1) * 32 + (lane & 3) * 8 + (4 * hi + ((lane & 15) >> 2)) * 64;
    for (int i = tid; i < 64 * IMPS; i += 512) imp[i] = 0.f;
    if (tid < 256) selw[tid] = 0u;
    if (tid < 8) uni[tid] = 0u;
    const float* gp = T.gates + ((size_t)b * 8192 + t) * 24 + H * 3;
    const float gc = gp[0], gs = gp[1], gw = gp[2];
    LAS float* accL = (LAS float*)(lds + N_ACC) + wid * 2048;
    u32x4 kr0, vr0;
    const int ntc = (4 * ti + 3 + 63) >> 6;
    const char* Kcg = (const char*)(T.Kc + (size_t)bg * 8 * 4096); const char* Vcg = (const char*)(T.Vc + (size_t)bg * 8 * 4096);
    float m = -1e30f, l = 0.f;
    f32x16 cb0;
#pragma unroll
    for (int r = 0; r < 16; ++r) cb0[r] = slope2 * 16.0f * (float)crow(r, hi);
    const int nmax = (t - 31) >> 4;
    const int nmax_min = (t0 + qh * 32 - 31) >> 4;
#define CMP_QK(P0, P1, kt_, sl_) do { float s512 = 512.0f * slope2; asm volatile("" : "+v"(s512)); const f32x16 cb1 = cb0 + s512; \
        qk_tile_c<4>(P0, P1, (lcp)(lds + N_KS + (sl_) * 8192), qr, cb0, cb1, r32, hi); \
        if (64 * (kt_) + 63 > nmax_min) mask_causal(P0, P1, 64 * (kt_) + 4 * hi - nmax); } while (0)
    kr0 = *(const u32x4*)(Kcg + tid * 16); *(LAS u32x4*)(lds + N_KS + tid * 16) = kr0;
    __syncthreads();
    for (int kt = 0; kt < ((DIAG & 33) ? 0 : ntc); ++kt) {
        const int sl = kt & 1;
        if (kt + 1 < ntc) kr0 = *(const u32x4*)(Kcg + (size_t)(kt + 1) * 8192 + tid * 16);
        { f32x16 p0, p1; CMP_QK(p0, p1, kt, sl);
          const float off = slope2 * (float)(1024 * kt + 31 - t);
          const float mn = fmaxf(m, max32(p0, p1) + off); const float ca = mn - off; float s = 0.f;
#pragma unroll
          for (int r = 0; r < 16; ++r) s += __builtin_amdgcn_exp2f(p0[r] - ca) + __builtin_amdgcn_exp2f(p1[r] - ca);
          l = l * __builtin_amdgcn_exp2f(m - mn) + s; m = mn; }
        if (kt + 1 < ntc) *(LAS u32x4*)(lds + N_KS + (sl ^ 1) * 8192 + tid * 16) = kr0;
        __syncthreads();
    }
    { auto rm_ = __builtin_amdgcn_permlane32_swap(__float_as_uint(m), __float_as_uint(m), false, false); auto rl_ = __builtin_amdgcn_permlane32_swap(__float_as_uint(l), __float_as_uint(l), false, false);
      const float mo = __uint_as_float(hi ? rm_[0] : rm_[1]), lo = __uint_as_float(hi ? rl_[0] : rl_[1]); const float mn = fmaxf(m, mo);
      l = l * __builtin_amdgcn_exp2f(m - mn) + lo * __builtin_amdgcn_exp2f(mo - mn); m = mn; }
    const float mlog = l > 0.f ? m + __builtin_amdgcn_logf(l) : 1e30f;
    f32x16 o0 = f32x16{}, o1 = f32x16{};
    float carry = 0.f;
#pragma unroll
    for (int i = 0; i < 32; ++i) accL[i * 64 + lane] = 0.f;
    kr0 = *(const u32x4*)(Kcg + tid * 16); vr0 = *(const u32x4*)(Vcg + tid * 16);
    *(LAS u32x4*)(lds + N_KS + tid * 16) = kr0; *(LAS u32x4*)(lds + N_VS + tid * 16) = vr0;
    __syncthreads();
    for (int kt = 0; kt < ((DIAG & 1) ? 0 : ntc); ++kt) {
        const int sl = kt & 1;
        if (kt + 1 < ntc) { kr0 = *(const u32x4*)(Kcg + (size_t)(kt + 1) * 8192 + tid * 16); vr0 = *(const u32x4*)(Vcg + (size_t)(kt + 1) * 8192 + tid * 16); }
        { f32x16 p0, p1; CMP_QK(p0, p1, kt, sl);
          const float ca = mlog - slope2 * (float)(1024 * kt + 31 - t);
#pragma unroll
          for (int r = 0; r < 16; ++r) { p0[r] = __builtin_amdgcn_exp2f(p0[r] - ca); p1[r] = __builtin_amdgcn_exp2f(p1[r] - ca); }
          { float PL0[4], PL1[4];
#pragma unroll
            for (int rg = 0; rg < 4; ++rg) {
                auto x0 = __builtin_amdgcn_permlane32_swap(__float_as_uint(p0[4 * rg + 3]), __float_as_uint(p0[4 * rg + 3]), false, false); PL0[rg] = __uint_as_float(hi ? x0[0] : x0[1]);
                auto x1 = __builtin_amdgcn_permlane32_swap(__float_as_uint(p1[4 * rg + 3]), __float_as_uint(p1[4 * rg + 3]), false, false); PL1[rg] = __uint_as_float(hi ? x1[0] : x1[1]); }
            const int jb = 16 * (kt & 3) + hi;
#pragma unroll
            for (int rg = 0; rg < 4; ++rg) {
                const float v0 = (p0[4 * rg] + p0[4 * rg + 1]) + (p0[4 * rg + 2] + p0[4 * rg + 3]) + (hi ? PL0[rg] : (rg > 0 ? PL0[rg - 1] : carry));
                const float v1 = (p1[4 * rg] + p1[4 * rg + 1]) + (p1[4 * rg + 2] + p1[4 * rg + 3]) + (hi ? PL1[rg] : (rg > 0 ? PL1[rg - 1] : PL0[3]));
                accL[r32 * 64 + ((jb + 2 * rg + r32) & 63)] = v0; accL[r32 * 64 + ((jb + 8 + 2 * rg + r32) & 63)] = v1; }
            carry = PL1[3]; }
          u32x4 pa[4]; pack_p(pa, p0, p1);
          pv_tile(o0, o1, (lcp)(lds + N_VS + sl * 8192 + vlane), pa); }
        if (kt + 1 < ntc) { *(LAS u32x4*)(lds + N_KS + (sl ^ 1) * 8192 + tid * 16) = kr0; *(LAS u32x4*)(lds + N_VS + (sl ^ 1) * 8192 + tid * 16) = vr0; }
        __syncthreads();
        if ((kt & 3) == 3 || kt == ntc - 1) {
            { const int q = tid >> 3, jj0 = (tid & 7) * 8, row = q & 31; const LAS float* pb = (const LAS float*)(lds + N_ACC) + ((q >> 5) * 4) * 2048 + row * 64;
#pragma unroll
              for (int e = 0; e < 8; ++e) { const int ix = (jj0 + e + row) & 63; imp[q * IMPS + 64 * (kt >> 2) + jj0 + e] = (pb[ix] + pb[2048 + ix]) + (pb[4096 + ix] + pb[6144 + ix]); } }
            __syncthreads();
            if (kt != ntc - 1) {
#pragma unroll
                for (int i = 0; i < 32; ++i) accL[i * 64 + lane] = 0.f; }
        }
    }
#undef CMP_QK
    acc_lds<true>(accL, o0, o1, gc, wsf, r32, hi);
    {
        const int q = tid >> 3, sub = tid & 7;
        unsigned w[4] = {0u, 0u, 0u, 0u};
        if (ti <= 15 || (DIAG & 2)) { if (sub == 0) w[0] = (ti <= 15) ? (2u << ti) - 1u : 0xffffu; }
        else {
            const LAS float* row = imp + q * IMPS;
            unsigned vb[16]; bool ok[16];
#pragma unroll
            for (int k = 0; k < 16; ++k) { const int j = 1 + sub + 8 * k; ok[k] = j <= ti - 2; vb[k] = ok[k] ? __float_as_uint(row[j]) : 0u; }
            unsigned T = 0u;
#pragma unroll 1
            for (int bit = 30; bit >= 0; --bit) { const unsigned trial = T | (1u << bit); int c = 0;
#pragma unroll
                for (int k = 0; k < 16; ++k) c += (ok[k] && vb[k] >= trial) ? 1 : 0;
                float cf = (float)c; cf += swz_xor<1>(cf); cf += swz_xor<2>(cf); cf += swz_xor<4>(cf);
                if (cf >= 12.5f) T = trial; }
            int cge = 0;
#pragma unroll
            for (int k = 0; k < 16; ++k) cge += (ok[k] && vb[k] >= T) ? 1 : 0;
            { float cf = (float)cge; cf += swz_xor<1>(cf); cf += swz_xor<2>(cf); cf += swz_xor<4>(cf); cge = (int)cf; }
            if (__any(cge != 13)) {
#pragma unroll 1
                for (int half = 0; half < 2; ++half) {
                    float vv[8]; int cnt[8];
#pragma unroll
                    for (int k = 0; k < 8; ++k) { const int j = 1 + sub + 8 * (k + 8 * half); vv[k] = (j <= ti - 2) ? row[j] : -1.0f; cnt[k] = 0; }
#pragma unroll 1
                    for (int jp = 1; jp <= ti - 2; ++jp) { const float vp = row[jp];
#pragma unroll
                        for (int k = 0; k < 8; ++k) { const int j = 1 + sub + 8 * (k + 8 * half); cnt[k] += (vp > vv[k] || (vp == vv[k] && jp < j)) ? 1 : 0; } }
#pragma unroll
                    for (int k = 0; k < 8; ++k) { const int j = 1 + sub + 8 * (k + 8 * half); if (j <= ti - 2 && cnt[k] < 13) setbit(w, j); }
                }
            } else {
#pragma unroll
                for (int k = 0; k < 16; ++k) { const int j = 1 + sub + 8 * k; if (ok[k] && vb[k] >= T) setbit(w, j); }
            }
            if (sub == 0) { w[0] |= 1u; setbit(w, ti); setbit(w, ti - 1); }
        }
#pragma unroll
        for (int k = 0; k < 4; ++k) if (w[k]) { __hip_atomic_fetch_or(selw + q * 4 + k, w[k], __ATOMIC_RELAXED, __HIP_MEMORY_SCOPE_WORKGROUP); __hip_atomic_fetch_or(uni + k, w[k], __ATOMIC_RELAXED, __HIP_MEMORY_SCOPE_WORKGROUP); }
    }
    __syncthreads();
    if (tid == 0) { int nb = 0;
        for (int k = 0; k < 4; ++k) { unsigned u = uni[k]; while (u) { const int bit = __builtin_ctz(u); u &= u - 1u; blist[nb++] = (unsigned)(32 * k + bit); } }
        uni[4] = (unsigned)nb; }
    __syncthreads();
    const int nsel = (int)uni[4];
    unsigned sw[4];
#pragma unroll
    for (int k = 0; k < 4; ++k) sw[k] = selw[qrow * 4 + k];
    f32x16 bias0, bias1;
#pragma unroll
    for (int r = 0; r < 16; ++r) { bias0[r] = slope2 * (float)crow(r, hi); bias1[r] = bias0[r] + 32.0f * slope2; }
#define NSA_DMA(Kg_, Vg_, ja_, jb_, stg_) do { dma1k(Kg_ + (size_t)(ja_) * 8192, lds + (stg_) * N_STG + wid * 1024); dma1k(Kg_ + (size_t)(jb_) * 8192, lds + (stg_) * N_STG + 8192 + wid * 1024); \
        dma1k(Vg_ + (size_t)(ja_) * 8192, lds + (stg_) * N_STG + 16384 + wid * 1024); dma1k(Vg_ + (size_t)(jb_) * 8192, lds + (stg_) * N_STG + 24576 + wid * 1024); } while (0)
    if (!(DIAG & 4)) {
        const char* Kg = (const char*)(T.Ksel + (size_t)bg * 128 * 4096) + wid * 1024 + lane * 16; const char* Vg = (const char*)(T.Vsel + (size_t)bg * 128 * 4096) + wid * 1024 + lane * 16;
        m = -1e30f; l = 0.f; o0 = f32x16{}; o1 = f32x16{};
        const int npair = (nsel + 1) >> 1;
        int ja = (int)blist[0], jb = nsel > 1 ? (int)blist[1] : ja;
        NSA_DMA(Kg, Vg, ja, jb, 0);
        __syncthreads();
        for (int p = 0; p < npair; ++p) {
            const int st = p & 1; int na = 0, nb = 0;
            if (p + 1 < npair) { na = (int)blist[2 * p + 2]; nb = (2 * p + 3 < nsel) ? (int)blist[2 * p + 3] : na; NSA_DMA(Kg, Vg, na, nb, st ^ 1); }
            { LAS char* sb = lds + st * N_STG;
              f32x16 p0, p1, p2, p3;
              qk_tile_c<4>(p0, p1, (lcp)sb, qr, bias0, bias1, r32, hi);
              qk_tile_c<4>(p2, p3, (lcp)(sb + 8192), qr, bias0, bias1, r32, hi);
              const int wa = ja >> 5, wb = jb >> 5;
              const unsigned swa = wa == 0 ? sw[0] : wa == 1 ? sw[1] : wa == 2 ? sw[2] : sw[3], swb = wb == 0 ? sw[0] : wb == 1 ? sw[1] : wb == 2 ? sw[2] : sw[3];
              const bool minea = (swa >> (ja & 31)) & 1u, mineb = ((swb >> (jb & 31)) & 1u) && (2 * p + 1 < nsel);
              if (ja == ti) mask_causal(p0, p1, 64 * ja + 4 * hi - t);
              if (jb == ti) mask_causal(p2, p3, 64 * jb + 4 * hi - t);
              const float offa = minea ? slope2 * (float)(64 * ja - t) : -INFINITY, offb = mineb ? slope2 * (float)(64 * jb - t) : -INFINITY;
              softmax_pv2(p0, p1, p2, p3, offa, offb, m, l, o0, o1, (lcp)(sb + 16384 + vlane), (lcp)(sb + 24576 + vlane), wsf, r32, hi); }
            ja = na; jb = nb;
            __syncthreads();
        }
        const float lt = xsum(l); acc_lds<false>(accL, o0, o1, lt > 0.f ? gs / lt : 0.f, wsf, r32, hi);
    }
    if (!(DIAG & 8)) {
        const char* Kg = (const char*)(T.Kwin + (size_t)bg * 128 * 4096) + wid * 1024 + lane * 16; const char* Vg = (const char*)(T.Vwin + (size_t)bg * 128 * 4096) + wid * 1024 + lane * 16;
        m = -1e30f; l = 0.f; o0 = f32x16{}; o1 = f32x16{};
        const int j0 = ti >= 8 ? ti - 8 : 0, nw = ti - j0 + 1, npair = (nw + 1) >> 1;
        NSA_DMA(Kg, Vg, j0, (nw > 1 ? j0 + 1 : j0), 0);
        __syncthreads();
        for (int p = 0; p < npair; ++p) {
            const int st = p & 1; const int ja = j0 + 2 * p; const bool hasb = (2 * p + 1 < nw); const int jb = hasb ? ja + 1 : ja;
            if (p + 1 < npair) { const int na = ja + 2, nb = (2 * p + 3 < nw) ? na + 1 : na; NSA_DMA(Kg, Vg, na, nb, st ^ 1); }
            { LAS char* sb = lds + st * N_STG;
              f32x16 p0, p1, p2, p3;
              qk_tile_c<4>(p0, p1, (lcp)sb, qr, bias0, bias1, r32, hi);
              qk_tile_c<4>(p2, p3, (lcp)(sb + 8192), qr, bias0, bias1, r32, hi);
              if (ja == ti) mask_causal(p0, p1, 64 * ja + 4 * hi - t);
              if (jb == ti) mask_causal(p2, p3, 64 * jb + 4 * hi - t);
              if (ja == ti - 8) mask_winlow(p0, p1, 64 * ja + 4 * hi - t);
              if (jb == ti - 8) mask_winlow(p2, p3, 64 * jb + 4 * hi - t);
              const float offa = slope2 * (float)(64 * ja - t), offb = hasb ? slope2 * (float)(64 * jb - t) : -INFINITY;
              softmax_pv2(p0, p1, p2, p3, offa, offb, m, l, o0, o1, (lcp)(sb + 16384 + vlane), (lcp)(sb + 24576 + vlane), wsf, r32, hi); }
            __syncthreads();
        }
        const float lt = xsum(l); acc_lds<false>(accL, o0, o1, lt > 0.f ? gw / lt : 0.f, wsf, r32, hi);
    }
#undef NSA_DMA
    store_acc(accL, T.Oa + ((size_t)b * 8192 + t0 + qh * 32) * 512 + H * 64, 512, lane);
    __syncthreads();
}

#endif

}
#define XLAS __attribute__((address_space(3)))
#define XB_TMO      128
#define XB_XCNT(j)  (256  + 64 * (j))
#define XB_XSUB(j)  (1280 + 64 * (j))
#define XB_XGEN(j)  (2304 + 64 * (j))
#define XB_TOP      3328
#define XB_TOPGEN   3392
#define XCD_BAR_WORDS 3456
#define XB_SPIN_CAP (1u << 18)

__device__ __forceinline__ unsigned xb_ld(unsigned* p)              { return __hip_atomic_load(p, __ATOMIC_RELAXED, __HIP_MEMORY_SCOPE_AGENT); }
__device__ __forceinline__ unsigned xb_add(unsigned* p, unsigned v) { return __hip_atomic_fetch_add(p, v, __ATOMIC_RELAXED, __HIP_MEMORY_SCOPE_AGENT); }
__device__ __forceinline__ unsigned xb_xcc_id() { return (unsigned)__builtin_amdgcn_s_getreg((3 << 11) | 20) & 0xFu; }
#define XB_SPIN(cond, bar) do { unsigned _sp = 0; while (cond) { __builtin_amdgcn_s_sleep(1); \
    if ((++_sp & 255u) == 0u) { if (xb_ld(&(bar)[XB_TMO])) break; if (_sp > XB_SPIN_CAP) { atomicAdd(&(bar)[XB_TMO], 1u); break; } } } } while (0)

struct XcdBarrier {
    unsigned* bar; unsigned x;
    volatile XLAS unsigned* st;
};

__device__ __forceinline__ XcdBarrier xcd_barrier_post(unsigned* bar, volatile XLAS unsigned* st) {
    XcdBarrier b; b.bar = bar; b.x = xb_xcc_id(); b.st = st;
    if (threadIdx.x == 0) (void)xb_add(&bar[XB_XCNT(b.x)], 1u);
    return b;
}
__device__ __forceinline__ void xcd_barrier_complete(unsigned* bar, unsigned x, unsigned& nloc, unsigned& nx) {
    const unsigned G = gridDim.x * gridDim.y * gridDim.z;
    unsigned sum, cnt, mine, sp = 0u;
    for (;;) {
        sum = 0u; cnt = 0u; mine = 0u;
#pragma unroll
        for (unsigned j = 0; j < 16; ++j) { const unsigned c = xb_ld(&bar[XB_XCNT(j)]); sum += c; cnt += (c > 0u) ? 1u : 0u; mine = (j == x) ? c : mine; }
        if (sum == G) break;
        __builtin_amdgcn_s_sleep(1);
        if ((++sp & 255u) == 0u) { if (xb_ld(&bar[XB_TMO])) break; if (sp > XB_SPIN_CAP) { atomicAdd(&bar[XB_TMO], 1u); break; } }
    }
    nloc = mine > 0u ? mine : 1u; nx = cnt > 0u ? cnt : 1u;
}

__device__ __forceinline__ void xcd_barrier(const XcdBarrier& b) {
    asm volatile("s_waitcnt vmcnt(0)" ::: "memory");
    __syncthreads();
    if (threadIdx.x == 0) {
        unsigned* bar = b.bar;
        __builtin_amdgcn_s_waitcnt(0);
        unsigned nloc = b.st[0], nx = b.st[1];
        if (nloc == 0u) { xcd_barrier_complete(bar, b.x, nloc, nx); b.st[0] = nloc; b.st[1] = nx; }
        const unsigned old = xb_add(&bar[XB_XSUB(b.x)], 1u);
        const unsigned gen = old / nloc;
        if (old + 1u == (gen + 1u) * nloc) {
            __builtin_amdgcn_fence(__ATOMIC_RELEASE, "agent");
            asm volatile("s_waitcnt vmcnt(0)" ::: "memory");
            const unsigned og = xb_add(&bar[XB_TOP], 1u);
            const unsigned tg = og / nx;
            if (og + 1u == (tg + 1u) * nx) xb_add(&bar[XB_TOPGEN], 1u);
            else XB_SPIN(xb_ld(&bar[XB_TOPGEN]) == tg, bar);
            __builtin_amdgcn_fence(__ATOMIC_ACQUIRE, "agent");
            xb_add(&bar[XB_XGEN(b.x)], 1u);
            asm volatile("s_waitcnt vmcnt(0)" ::: "memory");
        } else {
            XB_SPIN(xb_ld(&bar[XB_XGEN(b.x)]) == gen, bar);
            __builtin_amdgcn_fence(__ATOMIC_ACQUIRE, "agent");
            asm volatile("s_waitcnt vmcnt(0)" ::: "memory");
        }
    }
    __syncthreads();
}
#define GLAS __attribute__((address_space(3)))
typedef unsigned short bf16_t;
typedef float f32x4 __attribute__((ext_vector_type(4)));
typedef unsigned u32x4 __attribute__((ext_vector_type(4)));
constexpr int NT_TOK = 16384, SEQ = 8192, DM = 1024, DFF = 2816, NTHREADS = 512, NWAVES = 8;
struct KArgs { const float* in[26]; float* out; unsigned char* ws; };
struct ArgRef { unsigned char* ws;
    __device__ __forceinline__ const float* in_(int i) const { const __attribute__((address_space(4))) KArgs* p = (const __attribute__((address_space(4))) KArgs*)__builtin_amdgcn_kernarg_segment_ptr(); asm volatile("" : "+s"(p)); const unsigned long long v_ = *(const __attribute__((address_space(4))) unsigned long long*)(&p->in[i]); return (const float*)(const __attribute__((address_space(1))) float*)v_; }
};

__device__ __forceinline__ unsigned f2bf_rne(float f) { unsigned u = __builtin_bit_cast(unsigned, f); return (u + 0x7fffu + ((u >> 16) & 1u)) >> 16; }
typedef float pk_f32x2_t __attribute__((ext_vector_type(2))); typedef __bf16 pk_bf16x2_t __attribute__((ext_vector_type(2)));
__device__ __forceinline__ unsigned pk2(float lo, float hi) { pk_f32x2_t v = {lo, hi}; pk_bf16x2_t b = __builtin_convertvector(v, pk_bf16x2_t); return __builtin_bit_cast(unsigned, b); }

struct WSrc { const float* p; int ld; };
template <class Map> __device__ __forceinline__ void conv_weight(GLAS float* scr, int lane, int gw, int ngw, int& ioff, int K, int N, bf16_t* WT, const float* kscale, Map map) {
    asm volatile("" : "+v"(lane));
    const int nblk = N / 64, nitems = (K / 64) * nblk;
    const int first = (gw + ngw - ioff) % ngw; ioff = (ioff + nitems) % ngw;
    for (int it = first; it < nitems; it += ngw) {
        const int kb = it / nblk, nb = it % nblk, k0 = 64 * kb, n0 = 64 * nb;
        const WSrc s0 = map(n0), s63 = map(n0 + 63), s31 = map(n0 + 31), s1 = map(n0 + 1), s33 = map(n0 + 33);
        const bool fast = s0.p != nullptr && s63.p == s0.p + 63 && s31.p == s0.p + 31 && s1.p == s0.p + 1 && s33.p == s0.p + 33 && ((((uintptr_t)s0.p) | ((uintptr_t)s0.ld * 4u)) & 15u) == 0u;
        if (fast) {
            const float* src = s0.p + (size_t)(k0 + (lane >> 4)) * s0.ld + (lane & 15) * 4;
            f32x4 v[16];
#pragma unroll
            for (int i = 0; i < 16; ++i) v[i] = *(const f32x4*)(src + (size_t)(4 * i) * s0.ld);
#pragma unroll
            for (int i = 0; i < 16; ++i) { const int kk = 4 * i + (lane >> 4); f32x4 x = v[i]; if (kscale) x = x * kscale[k0 + kk]; GLAS float* d = scr + kk * 65 + (lane & 15) * 4; d[0] = x.x; d[1] = x.y; d[2] = x.z; d[3] = x.w; }
        } else {
#pragma unroll
            for (int hb = 0; hb < 2; ++hb) { const WSrc s = map(n0 + 32 * hb + (lane & 31));
#pragma unroll 8
                for (int i = 0; i < 32; ++i) { const int kk = 2 * i + (lane >> 5); float v = s.p ? s.p[(size_t)(k0 + kk) * s.ld] : 0.f; if (kscale) v *= kscale[k0 + kk]; scr[kk * 65 + 32 * hb + (lane & 31)] = v; } }
        }
        asm volatile("s_waitcnt lgkmcnt(0)" ::: "memory");
        const int c = lane & 7;
#pragma unroll
        for (int j = 0; j < 8; ++j) { const int n = (lane >> 3) + 8 * j; const GLAS float* sp = scr + (8 * c) * 65 + n;
            u32x4 o; o.x = pk2(sp[0 * 65], sp[1 * 65]); o.y = pk2(sp[2 * 65], sp[3 * 65]); o.z = pk2(sp[4 * 65], sp[5 * 65]); o.w = pk2(sp[6 * 65], sp[7 * 65]);
            *(u32x4*)(WT + (size_t)(n0 + n) * K + k0 + 8 * c) = o; }
        asm volatile("s_waitcnt lgkmcnt(0)" ::: "memory");
    }
}
__device__ __forceinline__ void convert_layer(const ArgRef& A, int l, GLAS unsigned char* lds, int lane, int wave, int gw, int ngw) {
    GLAS float* scr = (GLAS float*)(lds + wave * 16640);
    int ioff = 0;
    unsigned char* ws = A.ws;
    { const float* G = A.in_(4) + (size_t)l * 1024 * 2816; const float* U = A.in_(5) + (size_t)l * 1024 * 2816;
      conv_weight(scr, lane, gw, ngw, ioff, 1024, 5632, (bf16_t*)(ws + W_GU1), nullptr, [=](int n) { const int tl = n >> 8, r = n & 255; const uintptr_t gp = (uintptr_t)G, up = (uintptr_t)U; return WSrc{(const float*)(const __attribute__((address_space(1))) float*)(gp + (up - gp) * (uintptr_t)(r >> 7)) + tl * 128 + (r & 127), 2816}; }); }
    { const float* Dn = A.in_(6) + (size_t)l * 2816 * 1024; conv_weight(scr, lane, gw, ngw, ioff, 2816, 1024, (bf16_t*)(ws + W_D1), nullptr, [=](int n) { return WSrc{Dn + n, 1024}; }); }
    { const float* G = A.in_(7) + (size_t)l * 1024 * 2816; const float* U = A.in_(8) + (size_t)l * 1024 * 2816;
      conv_weight(scr, lane, gw, ngw, ioff, 1024, 5632, (bf16_t*)(ws + W_GU2), nullptr, [=](int n) { const int tl = n >> 8, r = n & 255; const uintptr_t gp = (uintptr_t)G, up = (uintptr_t)U; return WSrc{(const float*)(const __attribute__((address_space(1))) float*)(gp + (up - gp) * (uintptr_t)(r >> 7)) + tl * 128 + (r & 127), 2816}; }); }
    { const float* Dn = A.in_(9) + (size_t)l * 2816 * 1024; conv_weight(scr, lane, gw, ngw, ioff, 2816, 1024, (bf16_t*)(ws + W_D2), nullptr, [=](int n) { return WSrc{Dn + n, 1024}; }); }
    { const float* Wi = A.in_(10) + (size_t)l * 1024 * 4024;
      conv_weight(scr, lane, gw, ngw, ioff, 1024, 4096, (bf16_t*)(ws + W_IN), nullptr, [=](int n) {
          int src;
          if (n < 1280) src = n;
          else if (n < 1536) src = 1688 + (n - 1280);
          else if (n < 1792) src = 1304 + (n - 1536);
          else if (n < 2048) { const int r = n - 1792;
              if (r < 128) src = 1304 + 256 + r;
              else if (r < 160) { const int p = r - 128; src = 1944 + ((p & 1) ? 16 + (p >> 1) : (p >> 1)); }
              else if (r < 184) src = 1280 + (r - 160);
              else src = -1; }
          else src = 1976 + (n - 2048);
          return WSrc{src >= 0 ? Wi + src : nullptr, 4024}; }); }
    { const float* Wq = A.in_(18) + (size_t)l * 384 * 768;
      conv_weight(scr, lane, gw, ngw, ioff, 384, 768, (bf16_t*)(ws + W_UQ), A.in_(17) + (size_t)l * 384, [=](int n) { const int h = n / 96, p = n % 96; int src = h * 96 + p;
          if (p >= 64) { const int pp = p - 64; src = h * 96 + 64 + ((pp & 1) ? 16 + (pp >> 1) : (pp >> 1)); }
          return WSrc{Wq + src, 768}; }); }
    { const float* Wk = A.in_(20) + (size_t)l * 256 * 512; const float* Wv = A.in_(21) + (size_t)l * 256 * 512;
      conv_weight(scr, lane, gw, ngw, ioff, 256, 1024, (bf16_t*)(ws + W_UKV), A.in_(19) + (size_t)l * 256, [=](int n) { const uintptr_t kp = (uintptr_t)Wk, vp = (uintptr_t)Wv; return WSrc{(const float*)(const __attribute__((address_space(1))) float*)(kp + (vp - kp) * (uintptr_t)(n >> 9)) + (n & 511), 512}; }); }
    { const float* Wa = A.in_(22) + (size_t)l * 512 * 1024; conv_weight(scr, lane, gw, ngw, ioff, 512, 1024, (bf16_t*)(ws + W_BA), nullptr, [=](int n) { return WSrc{Wa + n, 1024}; }); }
    { const float* Wb = A.in_(23) + (size_t)l * 512 * 1024; conv_weight(scr, lane, gw, ngw, ioff, 512, 1024, (bf16_t*)(ws + W_BB), nullptr, [=](int n) { return WSrc{Wb + n, 1024}; }); }
    { const float* Wo = A.in_(24) + (size_t)l * 1024 * 1024; conv_weight(scr, lane, gw, ngw, ioff, 1024, 1024, (bf16_t*)(ws + W_OUT), nullptr, [=](int n) { return WSrc{Wo + n, 1024}; }); }
    { const float* W1 = A.in_(11) + (size_t)l * 2048 * 64; conv_weight(scr, lane, gw, ngw, ioff, 2048, 64, (bf16_t*)(ws + W_1K), nullptr, [=](int n) { return WSrc{W1 + n, 64}; }); }
    { const float* W1 = A.in_(14) + (size_t)l * 2048 * 64; conv_weight(scr, lane, gw, ngw, ioff, 2048, 64, (bf16_t*)(ws + W_1V), nullptr, [=](int n) { return WSrc{W1 + n, 64}; }); }
}
__device__ __forceinline__ void norm_phase(const float* x, bf16_t* xn, const float* sh, const float* sc, int lane, int gw, int ngw) {
    asm volatile("" : "+v"(lane));
    for (int row = gw; row < NT_TOK; row += ngw) {
        const f32x4* xr = (const f32x4*)(x + (size_t)row * DM) + lane; const int b = row >> 13;
        f32x4 v[4]; float s = 0.f;
#pragma unroll
        for (int j = 0; j < 4; ++j) { v[j] = xr[64 * j]; s += (v[j].x * v[j].x + v[j].y * v[j].y) + (v[j].z * v[j].z + v[j].w * v[j].w); }
        const float rstd = 1.0f / sqrtf(wave_sum(s) * (1.0f / DM) + 1e-6f);
        unsigned long long* o8 = (unsigned long long*)(xn + (size_t)row * DM) + lane;
#pragma unroll
        for (int j = 0; j < 4; ++j) { const f32x4 a = *((const f32x4*)(sc + (size_t)b * 9216) + lane + 64 * j), c = *((const f32x4*)(sh + (size_t)b * 9216) + lane + 64 * j);
            const f32x4 y = v[j] * rstd * (a + 1.0f) + c;
            o8[64 * j] = (unsigned long long)pk2(y.x, y.y) | ((unsigned long long)pk2(y.z, y.w) << 32); }
    }
}
__device__ __forceinline__ void final_norm_phase(float* x, const float* wn, int lane, int gw, int ngw) {
    asm volatile("" : "+v"(lane));
    for (int row = gw; row < NT_TOK; row += ngw) {
        f32x4* xr = (f32x4*)(x + (size_t)row * DM) + lane;
        f32x4 v[4]; float s = 0.f;
#pragma unroll
        for (int j = 0; j < 4; ++j) { v[j] = xr[64 * j]; s += (v[j].x * v[j].x + v[j].y * v[j].y) + (v[j].z * v[j].z + v[j].w * v[j].w); }
        const float rstd = 1.0f / sqrtf(wave_sum(s) * (1.0f / DM) + 1e-6f);
#pragma unroll
        for (int j = 0; j < 4; ++j) { const f32x4 w = *((const f32x4*)wn + lane + 64 * j); xr[64 * j] = v[j] * rstd * w; }
    }
}
__device__ __forceinline__ void adaln_phase(const ArgRef& A, GLAS unsigned char* lds, int tid, int lane, int wave, int blk, int nblk) {
    asm volatile("" : "+v"(tid), "+v"(lane));
    GLAS float* ca = (GLAS float*)lds;
    GLAS float* red = (GLAS float*)(lds + 8192);
    for (int i = tid; i < 2048; i += NTHREADS) { const float c = A.in_(1)[i]; ca[i] = c / (1.0f + __expf(-c)); }
    __syncthreads();
    float* mod = (float*)(A.ws + WS_MOD);
    for (int u = blk; u < 256; u += nblk) {
        const int c0 = u * 72, l = c0 / 9216, n0 = c0 % 9216;
        const float* W = A.in_(2) + (size_t)l * 1024 * 9216 + n0;
        const int l2 = lane & 7;
        float a0 = 0.f, a1 = 0.f, b0 = 0.f, b1 = 0.f;
        const int kb = wave * 128;
#pragma unroll 16
        for (int k = 0; k < 128; ++k) { const float w = W[(size_t)(kb + k) * 9216 + lane]; const float w8 = W[(size_t)(kb + k) * 9216 + 64 + l2];
            const float x0 = ca[kb + k], x1 = ca[1024 + kb + k]; a0 += x0 * w; a1 += x1 * w; b0 += x0 * w8; b1 += x1 * w8; }
        red[(wave * 2 + 0) * 72 + lane] = a0; red[(wave * 2 + 1) * 72 + lane] = a1;
        if (lane < 8) { red[(wave * 2 + 0) * 72 + 64 + lane] = b0; red[(wave * 2 + 1) * 72 + 64 + lane] = b1; }
        __syncthreads();
        if (tid < 144) { const int b = tid / 72, n = tid % 72; float s = A.in_(3)[(size_t)l * 9216 + n0 + n];
#pragma unroll
            for (int w = 0; w < 8; ++w) s += red[(w * 2 + b) * 72 + n];
            mod[((size_t)l * 2 + b) * 9216 + n0 + n] = s; }
        __syncthreads();
    }
}
__device__ __forceinline__ void rope_table_phase(float* cs, int gtid, int ngt) {
    for (int e = gtid; e < SEQ * 16; e += ngt) { const int t = e >> 4, i = e & 15;
        const float inv = powf(10000.0f, -(float)i / 16.0f); const float ang = (float)t * inv;
        const double rev = (double)ang * 0.15915494309189535; const double fr = rev - __builtin_rint(rev);
        cs[t * 32 + i] = __builtin_amdgcn_cosf((float)fr); cs[t * 32 + 16 + i] = __builtin_amdgcn_sinf((float)fr); }
}
__device__ __forceinline__ void cbias_phase(const ArgRef& A, GLAS unsigned char* lds, int tid, int blk) {
    GLAS float* red = (GLAS float*)(lds + 16384);
    if (blk < 4) { const int l = blk >> 1, kv = blk & 1; const float* pe = A.in_(kv ? 16 : 13) + (size_t)l * 2048; const float* w1 = A.in_(kv ? 14 : 11) + (size_t)l * 2048 * 64;
        const int n = tid & 63, part = tid >> 6; float s = 0.f;
        for (int j = part * 256; j < part * 256 + 256; ++j) s += pe[j] * w1[(size_t)j * 64 + n];
        red[part * 64 + n] = s;
        __syncthreads();
        if (tid < 64) { float t = 0.f;
#pragma unroll
            for (int p = 0; p < 8; ++p) t += red[p * 64 + tid];
            ((float*)(A.ws + WS_CBIAS))[(l * 2 + kv) * 64 + tid] = t; }
        __syncthreads();
    }
}
__device__ __forceinline__ void compress_phase(const ArgRef& A, int l, GLAS unsigned char* lds, int tid, int lane, int wave, int ubeg, int ustep) {
    asm volatile("" : "+v"(tid), "+v"(lane));
    typedef short bf16x8 __attribute__((ext_vector_type(8))); typedef float f32x16 __attribute__((ext_vector_type(16)));
    GLAS float* red = (GLAS float*)lds;
    GLAS float* c1 = (GLAS float*)(lds + 65536);
    GLAS float* w2s = (GLAS float*)(lds + 65536 + 8448);
    const int r32 = lane & 31, hi = lane >> 5;
    for (int u = ubeg; u < 128; u += ustep) {
        const int kv = u >> 6, bg = (u >> 4) & 3, rb = u & 15, i0 = rb * 32;
        const bf16_t* src = (const bf16_t*)(A.ws + (kv ? WS_VCF : WS_KCF)) + (size_t)bg * SEQ * 64;
        const bf16_t* w1t = (const bf16_t*)(A.ws + (kv ? W_1V : W_1K));
        const float* w2 = A.in_(kv ? 15 : 12) + (size_t)l * 4096;
        const float* cb = (const float*)(A.ws + WS_CBIAS) + (l * 2 + kv) * 64;
        { const f32x4* w2v = (const f32x4*)w2; f32x4 t0 = w2v[tid], t1 = w2v[tid + 512]; *(GLAS f32x4*)(w2s + 4 * tid) = t0; *(GLAS f32x4*)(w2s + 4 * (tid + 512)) = t1; }
        f32x16 a0 = f32x16{}, a1 = f32x16{};
        const bf16_t* ap = src + (size_t)(i0 + r32) * 1024 + wave * 256 + hi * 8;
        const bf16_t* bp = w1t + (size_t)r32 * 2048 + wave * 256 + hi * 8;
#pragma unroll 8
        for (int ks = 0; ks < 16; ++ks) {
            const bf16x8 af = *(const bf16x8*)(ap + ks * 16), b0 = *(const bf16x8*)(bp + ks * 16), b1 = *(const bf16x8*)(bp + 32 * 2048 + ks * 16);
            a0 = __builtin_amdgcn_mfma_f32_32x32x16_bf16(af, b0, a0, 0, 0, 0);
            a1 = __builtin_amdgcn_mfma_f32_32x32x16_bf16(af, b1, a1, 0, 0, 0); }
#pragma unroll
        for (int r = 0; r < 16; ++r) { red[wave * 2048 + r * 64 + lane] = a0[r]; red[wave * 2048 + (16 + r) * 64 + lane] = a1[r]; }
        __syncthreads();
#pragma unroll
        for (int j = 0; j < 4; ++j) { const int e = tid + 512 * j; float s = 0.f;
#pragma unroll
            for (int w = 0; w < 8; ++w) s += red[w * 2048 + e];
            const int nt = e >> 10, r = (e >> 6) & 15, ln = e & 63; const int i = (r & 3) + 8 * (r >> 2) + 4 * (ln >> 5), n = 32 * nt + (ln & 31);
            const float xv = s + cb[n]; const float z = 0.7978845608028654f * (xv + 0.044715f * xv * xv * xv);
            const float th = 1.0f - 2.0f * __builtin_amdgcn_rcpf(__builtin_amdgcn_exp2f(2.885390081777927f * z) + 1.0f);
            c1[i * 65 + n] = 0.5f * xv * (1.0f + th); }
        __syncthreads();
        { const int i = tid >> 4, n2 = (tid & 15) * 4; f32x4 o = (f32x4){0.f, 0.f, 0.f, 0.f};
#pragma unroll 8
          for (int k = 0; k < 64; ++k) { const float c = c1[i * 65 + k]; const f32x4 w = *(const GLAS f32x4*)(w2s + k * 64 + n2); o += w * c; }
          const int nc = i0 + i; if (nc == 511) o = (f32x4){0.f, 0.f, 0.f, 0.f};
          const size_t tb = (size_t)bg * 8 + (nc >> 6); const int key = nc & 63;
          const unsigned long long pk = (unsigned long long)pk2(o.x, o.y) | ((unsigned long long)pk2(o.z, o.w) << 32);
          if (kv == 0) *(unsigned long long*)((bf16_t*)(A.ws + WS_KC) + (tb * 8 + (n2 >> 3)) * 512 + key * 8 + (n2 & 7)) = pk;
          else *(unsigned long long*)((bf16_t*)(A.ws + WS_VC) + tb * 4096 + (n2 >> 5) * 2048 + key * 32 + (n2 & 31)) = pk; }
        __syncthreads();
    }
}

template <int NC> __device__ __forceinline__ void rstd_table(const bf16_t* X, int row0, GLAS float* tab, float scale, int lane, int wave) {
#pragma unroll 1
    for (int rb = 0; rb < 32; rb += 16) {
        u32x4 v[16];
#pragma unroll
        for (int r = 0; r < 16; ++r) { v[r] = (u32x4){0u, 0u, 0u, 0u}; if (lane < NC / 8) v[r] = *(const u32x4*)(X + (size_t)(row0 + wave * 32 + rb + r) * NC + lane * 8); }
#pragma unroll
        for (int r = 0; r < 16; ++r) { const unsigned w4[4] = {v[r].x, v[r].y, v[r].z, v[r].w}; float s = 0.f;
#pragma unroll
            for (int i = 0; i < 4; ++i) { const float a = __uint_as_float(w4[i] << 16), b = __uint_as_float(w4[i] & 0xffff0000u); s += a * a + b * b; }
            s = wave_sum(s);
            if (lane == 0) tab[wave * 32 + rb + r] = scale * __builtin_amdgcn_rsqf(s * (1.0f / NC) + 1e-6f); }
    }
}
__device__ __forceinline__ void dump_bf16(float* out, const bf16_t* src, int nslab, int gtid, int ngt) {
    for (int i = gtid; i < NT_TOK * DM; i += ngt) { float s = 0.f; for (int k = 0; k < nslab; ++k) if (k < 3 || i < 14 * 1024 * 1024) s += __uint_as_float(((unsigned)src[(size_t)k * NT_TOK * DM + i]) << 16); out[i] = s; }
}
#ifndef WIN_ALIGN
#define WIN_ALIGN true
#define WIN_SP2 true
#endif
#ifndef STOPAT
#define STOPAT 99
#endif
#ifndef PHMASK
#define PHMASK 0xffffffffu
#endif
#define PH(k) ((PHMASK >> (k)) & 1u)
#ifndef DUPMASK
#define DUPMASK 0u
#endif
#define NREP(k) (((DUPMASK >> (k)) & 1u) ? 2 : 1)
#ifdef TPROBE
#define TSTAMP(k) do { if (blockIdx.x == 0 && wave == 0 && opaque_lane() == 0) { GLAS unsigned* tw_ = (GLAS unsigned*)(lds + 131072 + 8192); const unsigned t_ = (unsigned)__builtin_amdgcn_s_memrealtime(); tw_[k] += t_ - tw_[31]; tw_[31] = t_; } } while (0)
#else
#define TSTAMP(k) do { } while (0)
#endif
#ifndef USE_CG
#define GRIDBAR() xcd_barrier(xbar)
#else
#define GRIDBAR() grid.sync()
#endif
constexpr int LDS_BYTES = 147456;
constexpr size_t WS_BAR = 384 * 1024, BAR_BYTES = 16384;
constexpr int LDS_BARST = 147456 - 64;
__global__ void __launch_bounds__(NTHREADS, 2) hybrid_fwd(KArgs KA) {
    extern __shared__ __attribute__((aligned(16))) unsigned char lds_raw[];
    GLAS unsigned char* lds = (GLAS unsigned char*)lds_raw;
    cg::grid_group grid = cg::this_grid();
    if (threadIdx.x < 8) ((GLAS unsigned*)(lds + LDS_BARST))[threadIdx.x] = 0u;
    __syncthreads();
    XcdBarrier xbar = xcd_barrier_post((unsigned*)(KA.ws + WS_BAR), (volatile GLAS unsigned*)(lds + LDS_BARST));
    const int wave = __builtin_amdgcn_readfirstlane(threadIdx.x >> 6);
#define MYTID() (wave * 64 + opaque_lane())
    int tid = MYTID(), lane = tid & 63; asm volatile("" : "+v"(tid), "+v"(lane));
    const int G = gridDim.x, blk0 = blockIdx.x; int blk = blk0;
    const int vcu = (G % 8 == 0) ? (blk % 8) * (G / 8) + blk / 8 : blk;
    const int gw = blk * NWAVES + wave, ngw = G * NWAVES;
    ArgRef A; A.ws = KA.ws; unsigned char* const ws0 = KA.ws; unsigned char* ws = ws0;
#define PHASE_BEGIN() do { unsigned long long w_ = (unsigned long long)ws0; blk = blk0; asm volatile("" : "+s"(w_), "+s"(blk)); ws = (unsigned char*)(__attribute__((address_space(1))) unsigned char*)w_; A.ws = ws; tid = MYTID(); lane = tid & 63; asm volatile("" : "+v"(tid), "+v"(lane)); } while (0)
    float* mod = (float*)(ws + WS_MOD);
    float* xres = KA.out;

#ifdef TPROBE
    if (threadIdx.x < 32) ((GLAS unsigned*)(lds + 131072 + 8192))[threadIdx.x] = 0u;
    __syncthreads();
    if (threadIdx.x == 0) ((GLAS unsigned*)(lds + 131072 + 8192))[31] = (unsigned)__builtin_amdgcn_s_memrealtime();
#endif
    for (int rep0 = 0; rep0 < NREP(0); ++rep0) {
    if (PH(0)) adaln_phase(A, lds, tid, lane, wave, blk, G);
    if (PH(1)) rope_table_phase((float*)(ws + WS_CS), blk * NTHREADS + tid, G * NTHREADS);
    if (PH(2)) convert_layer(A, 0, lds, lane, wave, gw, ngw);
    __syncthreads();
    if (PH(3)) cbias_phase(A, lds, tid, blk);
    __syncthreads();
    }
    grid.sync();
    TSTAMP(0);

    for (int l = 0; l < 2; ++l) {
        PHASE_BEGIN();
        const float* ml = mod + (size_t)l * 2 * 9216;
        const float* xin = (l == 0) ? A.in_(0) : xres;
        if (PH(2) && l == 1) { convert_layer(A, 1, lds, lane, wave, gw, ngw); }
        if (PH(4)) norm_phase(xin, (bf16_t*)(ws + WS_XN), ml + 0 * 1024, ml + 1 * 1024, lane, gw, ngw);
        GRIDBAR();
        TSTAMP(1);
        PHASE_BEGIN();
        for (int rep2 = 0; rep2 < NREP(2); ++rep2) {
        if (PH(5)) { pg8::Gemm g{(const bf16_t*)(ws + WS_XN), (const bf16_t*)(ws + W_GU1), NT_TOK, 5632, 1024}; pg8::StaticOrder S; S.init(NT_TOK, 5632, G, blk);
          pg8::EpiSwiGLU E{ws};
          pg8::gemm_phase<pg8::EpiSwiGLU, pg8::StaticOrder, true, true>(lds, g, S, E, wave); }
        GRIDBAR();
        TSTAMP(2);
        PHASE_BEGIN();
        }
        if (STOPAT == 2) { dump_bf16(xres, (const bf16_t*)(ws + WS_C), 4, blk * NTHREADS + tid, G * NTHREADS); return; }
        if (PH(6)) { pg8::Gemm g{(const bf16_t*)(ws + WS_C), (const bf16_t*)(ws + W_D1), NT_TOK, 1024, 2816}; pg8::StaticOrder S; S.init(NT_TOK, 1024, G, blk);
          pg8::EpiResid E{xin, xres, ml + 2 * 1024, 0.5f};
          pg8::gemm_phase<pg8::EpiResid, pg8::StaticOrder, true, true>(lds, g, S, E, wave); }
        GRIDBAR();
        TSTAMP(3);
        PHASE_BEGIN();
        if (STOPAT == 3) {  return; }
        for (int r4 = 0; r4 < NREP(4); ++r4)
        if (PH(4)) norm_phase(xres, (bf16_t*)(ws + WS_XN), ml + 3 * 1024, ml + 4 * 1024, lane, gw, ngw);
#ifdef SENTINEL
        { unsigned* gp = (unsigned*)(ws + WS_GM); for (int i = blk * NTHREADS + tid; i < 16 * 1024 * 1024; i += G * NTHREADS) gp[i] = 0x447a447au; }
#endif
        GRIDBAR();
        TSTAMP(1);
        PHASE_BEGIN();
        for (int rep5 = 0; rep5 < NREP(5); ++rep5) {
        if (PH(7)) { pg8::Gemm g{(const bf16_t*)(ws + WS_XN), (const bf16_t*)(ws + W_IN), NT_TOK, 4096, 1024}; pg8::StaticOrder S; S.init(NT_TOK, 4096, G, blk);
          pg8::EpiWin E{ws};
          pg8::gemm_phase<pg8::EpiWin, pg8::StaticOrder, WIN_ALIGN, WIN_SP2>(lds, g, S, E, wave); }
        GRIDBAR();
        TSTAMP(4);
        PHASE_BEGIN();
        }
#ifndef DUMP_OFF
#define DUMP_OFF 84
#define DUMP_SLABS 4
#endif
        if (STOPAT == 5) { dump_bf16(xres, (const bf16_t*)(ws + (size_t)DUMP_OFF * MiB), DUMP_SLABS, blk * NTHREADS + tid, G * NTHREADS); return; }
        for (int rep6 = 0; rep6 < NREP(6); ++rep6) {
        for (int r13 = 0; r13 < NREP(13); ++r13)
        if (PH(8)) { pg8::Gemm g{(const bf16_t*)(ws + WS_CQ), (const bf16_t*)(ws + W_UQ), NT_TOK, 768, 384}; pg8::StaticOrder S; S.init(NT_TOK, 768, G, blk);
          { pg8::Unit u0; if (S.next(0, u0)) rstd_table<384>((const bf16_t*)(ws + WS_CQ), u0.pm * 256, (GLAS float*)(lds + 131072), 0.10206207261596577f * 1.4426950408889634f, lane, wave); }
          __syncthreads();
          pg8::EpiQproj E{ws, (const GLAS float*)(lds + 131072)};
          pg8::gemm_phase<pg8::EpiQproj, pg8::StaticOrder, true, true>(lds, g, S, E, wave); }
        for (int r14 = 0; r14 < NREP(14); ++r14)
        if (PH(9)) { pg8::Gemm g{(const bf16_t*)(ws + WS_CKV), (const bf16_t*)(ws + W_UKV), NT_TOK, 1024, 256}; pg8::StaticOrder S; S.init(NT_TOK, 1024, G, blk);
          PHASE_BEGIN();
          { pg8::Unit u0; if (S.next(0, u0)) rstd_table<256>((const bf16_t*)(ws + WS_CKV), u0.pm * 256, (GLAS float*)(lds + 131072 + 1024), 1.0f, lane, wave); }
          __syncthreads();
          pg8::EpiKVproj E{ws, (const GLAS float*)(lds + 131072 + 1024)};
          pg8::gemm_phase<pg8::EpiKVproj, pg8::StaticOrder, true, true>(lds, g, S, E, wave); }
        __syncthreads();
        PHASE_BEGIN();
        for (int r15 = 0; r15 < NREP(15); ++r15)
        if (PH(10)) compress_phase(A, l, lds, tid, lane, wave, (G - 1 - blk), G);
        GRIDBAR();
        TSTAMP(5);
        PHASE_BEGIN();
        }
        if (STOPAT == 6) { dump_bf16(xres, (const bf16_t*)(ws + WS_QM), 2, blk * NTHREADS + tid, G * NTHREADS); return; }
        for (int rep7 = 0; rep7 < NREP(7); ++rep7) {
        { att::NsaT NT{(const bf16_t*)(ws + WS_QN), (const bf16_t*)(ws + WS_KC), (const bf16_t*)(ws + WS_VC), (const bf16_t*)(ws + WS_KSEL), (const bf16_t*)(ws + WS_VSEL),
                       (const bf16_t*)(ws + WS_KWIN), (const bf16_t*)(ws + WS_VWIN), (const float*)(ws + WS_GATES), (bf16_t*)(ws + WS_OA)};
          for (int v = vcu; v < 256; v += G) {
              for (int r11 = 0; r11 < NREP(11); ++r11) if (PH(11)) { const int bh = v >> 4, s = v & 15;
                if (r11 == 0) { att::mla_unit<0>(bh >> 3, bh & 7, 31 - s, (const bf16_t*)(ws + WS_QM), (const bf16_t*)(ws + WS_KM), (const bf16_t*)(ws + WS_VM), (bf16_t*)(ws + WS_OB), (GLAS char*)lds, wave);
                  att::mla_unit<0>(bh >> 3, bh & 7, s, (const bf16_t*)(ws + WS_QM), (const bf16_t*)(ws + WS_KM), (const bf16_t*)(ws + WS_VM), (bf16_t*)(ws + WS_OB), (GLAS char*)lds, wave); }
#ifdef MLADIAG
                else { att::mla_unit<MLADIAG>(bh >> 3, bh & 7, 31 - s, (const bf16_t*)(ws + WS_QM), (const bf16_t*)(ws + WS_KM), (const bf16_t*)(ws + WS_VM), (bf16_t*)(ws + WS_CQ), (GLAS char*)lds, wave);
                  att::mla_unit<MLADIAG>(bh >> 3, bh & 7, s, (const bf16_t*)(ws + WS_QM), (const bf16_t*)(ws + WS_KM), (const bf16_t*)(ws + WS_VM), (bf16_t*)(ws + WS_CQ), (GLAS char*)lds, wave); }
#endif
              }
              TSTAMP(9);
              for (int r12 = 0; r12 < NREP(12); ++r12) if (PH(12)) { const int bg = v >> 6, s = v & 63;
                if (r12 == 0) { att::nsa_unit<0>(bg >> 1, bg & 1, 127 - s, NT, (GLAS char*)lds, wave);
                  att::nsa_unit<0>(bg >> 1, bg & 1, s, NT, (GLAS char*)lds, wave); }
#ifdef NSADIAG
                else { att::NsaT ND = NT; ND.Oa = (bf16_t*)(ws + WS_CQ);
                  att::nsa_unit<NSADIAG>(bg >> 1, bg & 1, 127 - s, ND, (GLAS char*)lds, wave);
                  att::nsa_unit<NSADIAG>(bg >> 1, bg & 1, s, ND, (GLAS char*)lds, wave); }
#endif
              }
              TSTAMP(10);
          } }
        GRIDBAR();
        TSTAMP(6);
        PHASE_BEGIN();
        }
        if (STOPAT == 7) { dump_bf16(xres, (const bf16_t*)(ws + WS_OA), 1, blk * NTHREADS + tid, G * NTHREADS); return; }
        for (int rep8 = 0; rep8 < NREP(8); ++rep8) {
        if (PH(13)) { pg8::Gemm g{(const bf16_t*)(ws + WS_OA), (const bf16_t*)(ws + W_BA), NT_TOK, 1024, 512}; pg8::StaticOrder S; S.init(NT_TOK, 1024, G, blk);
          pg8::EpiBranch<0> E{ws};
          pg8::gemm_phase<pg8::EpiBranch<0>, pg8::StaticOrder, true, true>(lds, g, S, E, wave); }
        if (PH(14)) { pg8::Gemm g{(const bf16_t*)(ws + WS_OB), (const bf16_t*)(ws + W_BB), NT_TOK, 1024, 512}; pg8::StaticOrder S; S.init(NT_TOK, 1024, G, blk);
          pg8::EpiBranch<1> E{ws};
          pg8::gemm_phase<pg8::EpiBranch<1>, pg8::StaticOrder, true, true>(lds, g, S, E, wave); }
        GRIDBAR();
        TSTAMP(7);
        PHASE_BEGIN();
        }
        if (STOPAT == 8) { dump_bf16(xres, (const bf16_t*)(ws + WS_Y), 1, blk * NTHREADS + tid, G * NTHREADS); return; }
        if (PH(15)) { pg8::Gemm g{(const bf16_t*)(ws + WS_Y), (const bf16_t*)(ws + W_OUT), NT_TOK, 1024, 1024}; pg8::StaticOrder S; S.init(NT_TOK, 1024, G, blk);
          pg8::EpiResid E{xres, xres, ml + 5 * 1024, 1.0f};
          pg8::gemm_phase<pg8::EpiResid, pg8::StaticOrder, true, true>(lds, g, S, E, wave); }
        GRIDBAR();
        TSTAMP(8);
        PHASE_BEGIN();
        for (int r4 = 0; r4 < NREP(4); ++r4)
        if (PH(4)) norm_phase(xres, (bf16_t*)(ws + WS_XN), ml + 6 * 1024, ml + 7 * 1024, lane, gw, ngw);
        GRIDBAR();
        TSTAMP(1);
        PHASE_BEGIN();
        if (PH(16)) { pg8::Gemm g{(const bf16_t*)(ws + WS_XN), (const bf16_t*)(ws + W_GU2), NT_TOK, 5632, 1024}; pg8::StaticOrder S; S.init(NT_TOK, 5632, G, blk);
          pg8::EpiSwiGLU E{ws};
          pg8::gemm_phase<pg8::EpiSwiGLU, pg8::StaticOrder, true, true>(lds, g, S, E, wave); }
        GRIDBAR();
        TSTAMP(2);
        PHASE_BEGIN();
        if (PH(17)) { pg8::Gemm g{(const bf16_t*)(ws + WS_C), (const bf16_t*)(ws + W_D2), NT_TOK, 1024, 2816}; pg8::StaticOrder S; S.init(NT_TOK, 1024, G, blk);
          pg8::EpiResid E{xres, xres, ml + 8 * 1024, 0.5f};
          pg8::gemm_phase<pg8::EpiResid, pg8::StaticOrder, true, true>(lds, g, S, E, wave); }
        GRIDBAR();
        TSTAMP(3);
        PHASE_BEGIN();
    }
    tid = MYTID(); lane = tid & 63; asm volatile("" : "+v"(tid), "+v"(lane));
    if (PH(18)) final_norm_phase(xres, A.in_(25), lane, gw, ngw);
#ifdef TPROBE
    TSTAMP(11);
    __syncthreads();
    if (blockIdx.x == 0 && wave == 0 && opaque_lane() == 0) { const GLAS unsigned* ta = (const GLAS unsigned*)(lds + 131072 + 8192);
        asm volatile("s_waitcnt vmcnt(0)" ::: "memory");
        xres[0] = 0.01f * (float)ta[TPA]; const float vb = 0.01f * (float)ta[TPB]; for (int i = 1; i <= 100; ++i) xres[i] = vb; }
#endif
}

extern "C" void kernel_launch(void* const* d_in, const int* in_sizes, int n_in, void* d_out, int out_size, void* d_ws, size_t ws_size, hipStream_t stream) {
    static int grid_blocks = 0;
    if (grid_blocks == 0) {
        if (n_in != 26 || out_size != NT_TOK * DM || ws_size < WS_TOTAL) { fprintf(stderr, "kernel_launch: unexpected problem (n_in %d out %d ws %zu)\n", n_in, out_size, ws_size); grid_blocks = -1; return; }
        int dev = 0, cus = 0, per_cu = 0;
        hipGetDevice(&dev);
        hipDeviceGetAttribute(&cus, hipDeviceAttributeMultiprocessorCount, dev);
        hipFuncSetAttribute((const void*)hybrid_fwd, hipFuncAttributeMaxDynamicSharedMemorySize, LDS_BYTES);
        hipOccupancyMaxActiveBlocksPerMultiprocessor(&per_cu, (const void*)hybrid_fwd, NTHREADS, LDS_BYTES);
        if (per_cu < 1) { fprintf(stderr, "kernel_launch: occupancy query says %d blocks per CU\n", per_cu); per_cu = 1; }
        if (per_cu > 1) per_cu = 1;
        grid_blocks = cus * per_cu;
        (void)hipGetLastError();
    }
    if (grid_blocks < 0) return;
    if (hipMemsetAsync((char*)d_ws + WS_BAR, 0, BAR_BYTES, stream) != hipSuccess) { fprintf(stderr, "kernel_launch: memset failed\n"); return; }
    KArgs a{};
    for (int i = 0; i < 26; ++i) a.in[i] = (const float*)d_in[i];
    a.out = (float*)d_out; a.ws = (unsigned char*)d_ws;
    void* args[] = {&a};
    hipError_t e = hipLaunchCooperativeKernel((const void*)hybrid_fwd, dim3(grid_blocks), dim3(NTHREADS), args, LDS_BYTES, stream);
    if (e != hipSuccess) fprintf(stderr, "cooperative launch failed: %s (grid %d)\n", hipGetErrorString(e), grid_blocks);
}
```

```cpp
#define CONV_IN_GU 1
#define GUORDER StaticOrder
#include <hip/hip_runtime.h>
#include <hip/hip_cooperative_groups.h>
#include <cstdio>
#include <cstdint>
namespace cg = cooperative_groups;

constexpr size_t MiB = 1u << 20;
constexpr size_t WS_MOD = 0;
constexpr size_t WS_CBIAS = 256 * 1024;
constexpr size_t WS_ERR = 384 * 1024;
constexpr size_t WS_SSQQ = 512 * 1024;
constexpr size_t WS_SSQKV = 640 * 1024;
constexpr size_t WS_GATES = 1 * MiB;
constexpr size_t WS_CS = 3 * MiB;
constexpr size_t WS_W = 4 * MiB;
constexpr size_t W_GU1 = WS_W, W_D1 = W_GU1 + (size_t)5632 * 1024 * 2, W_GU2 = W_D1 + (size_t)1024 * 2816 * 2, W_D2 = W_GU2 + (size_t)5632 * 1024 * 2;
constexpr size_t W_IN = W_D2 + (size_t)1024 * 2816 * 2, W_UQ = W_IN + (size_t)4096 * 1024 * 2, W_UKV = W_UQ + (size_t)768 * 384 * 2, W_BA = W_UKV + (size_t)1024 * 256 * 2;
constexpr size_t W_BB = W_BA + (size_t)1024 * 512 * 2, W_OUT = W_BB + (size_t)1024 * 512 * 2, W_1K = W_OUT + (size_t)1024 * 1024 * 2, W_1V = W_1K + (size_t)64 * 2048 * 2, W_END = W_1V + (size_t)64 * 2048 * 2;
static_assert(W_END <= 52 * MiB, "weights region");
constexpr size_t WS_XN = 52 * MiB;
constexpr size_t WS_OA = 52 * MiB, WS_OB = 68 * MiB;
constexpr size_t WS_C = 84 * MiB;
constexpr size_t WS_QN = 84 * MiB, WS_KCF = 100 * MiB, WS_VCF = 104 * MiB, WS_KSEL = 108 * MiB, WS_VSEL = 112 * MiB, WS_KWIN = 116 * MiB, WS_VWIN = 120 * MiB;
constexpr size_t WS_CQ = 124 * MiB, WS_CKV = 136 * MiB, WS_GM = 144 * MiB, WS_KC = 208 * MiB, WS_VC = 208 * MiB + 256 * 1024;
constexpr size_t WS_QM = 212 * MiB, WS_KM = 236 * MiB, WS_VM = 260 * MiB, WS_Y = 212 * MiB, WS_TOTAL = 276 * MiB;


__device__ __forceinline__ int opaque_lane() { unsigned z; asm volatile("v_mov_b32 %0, 0" : "=v"(z)); return (int)__builtin_amdgcn_mbcnt_hi(~0u, __builtin_amdgcn_mbcnt_lo(~0u, z)); }
template <int K> __device__ __forceinline__ float swz_xor(float v) { return __int_as_float(__builtin_amdgcn_ds_swizzle(__float_as_int(v), (K << 10) | 0x1f)); }
__device__ __forceinline__ float half_sum(float v) { auto rr = __builtin_amdgcn_permlane32_swap(__float_as_uint(v), __float_as_uint(v), false, false); return __uint_as_float(rr[0]) + __uint_as_float(rr[1]); }
__device__ __forceinline__ float wave_sum(float v) { v += swz_xor<1>(v); v += swz_xor<2>(v); v += swz_xor<4>(v); v += swz_xor<8>(v); v += swz_xor<16>(v); return half_sum(v); }
namespace pg8 {
#define PG8_LAS __attribute__((address_space(3)))
typedef unsigned short bf16_t;
typedef short bf16x8 __attribute__((ext_vector_type(8)));
typedef float f32x4 __attribute__((ext_vector_type(4)));
typedef unsigned u32x4 __attribute__((ext_vector_type(4)));
constexpr int BM = 256, BK = 64, HALF = 128, HTB = HALF * BK * 2  , STAGE_BYTES = 8 * HTB, NXCD = 8, WGM = 8;

__host__ __device__ __forceinline__ int lds_byte(int r, int c) { const int st = (r >> 4) * 2 + (c >> 5), rr = r & 15, cc = c & 31, ob = rr * 64 + cc * 2; return st * 1024 + (ob ^ (((ob >> 9) & 1) << 5)); }
__host__ __device__ __forceinline__ void stage_rc(int b, int& R, int& C) { const int st = b / 1024, sb = b % 1024, swz = sb ^ (((sb >> 9) & 1) << 5); R = (st >> 1) * 16 + swz / 64; C = (st & 1) * 32 + (swz % 64) / 2; }
__host__ __device__ __forceinline__ int perm32(int rho) { const int n = rho >> 4, i = rho & 15; return 8 * (i >> 2) + 4 * n + (i & 3); }

struct Unit { int pm, pn; int half = 0; };
struct Gemm { const bf16_t* A; const bf16_t* Bt; int M, N, K; };

struct StaticOrder {
    int nM, nN, nwg, G, c;
    __host__ __device__ __forceinline__ void init(int M, int N, int G_, int c_) { nM = M / BM; nN = N / BM; nwg = nM * nN; G = G_; c = c_; }
    __host__ __device__ __forceinline__ bool next(int i, Unit& u) const {
        const long L = (long)i * G + c; if (L >= nwg) return false;
        int wgid = (int)L; { const int q = nwg / NXCD, r = nwg % NXCD, xcd = wgid % NXCD, off = wgid / NXCD; wgid = (xcd < r ? xcd * (q + 1) : r * (q + 1) + (xcd - r) * q) + off; }
        const int nig = WGM * nN, gid = wgid / nig, fm = gid * WGM, gsz = (nM - fm) < WGM ? (nM - fm) : WGM;
        u.pm = fm + ((wgid % nig) % gsz); u.pn = (wgid % nig) / gsz; return true;
    }
    __device__ __forceinline__ void a_ready(const Unit&) const {}
    __device__ __forceinline__ void done(const Unit&) const {}
};
struct TailOrder { StaticOrder so; int nfull;
    __host__ __device__ __forceinline__ void init(int M, int N, int G_, int c_) { so.init(M, N, G_, c_); nfull = so.nwg / G_; }
    __host__ __device__ __forceinline__ bool next(int i, Unit& u) const {
        if (i < nfull) { const bool ok = so.next(i, u); u.half = 0; return ok; }
        if (i > nfull) return false;
        StaticOrder t = so; t.c = so.c >> 1; if (!t.next(nfull, u)) return false;
        u.half = 1 + (so.c & 1); return true; }
    __device__ __forceinline__ void a_ready(const Unit&) const {}
    __device__ __forceinline__ void done(const Unit&) const {}
};

typedef float cvt_f32x2_t __attribute__((ext_vector_type(2))); typedef __bf16 cvt_bf16x2_t __attribute__((ext_vector_type(2)));
__device__ __forceinline__ unsigned cvt_pk_bf16(float lo, float hi) { cvt_f32x2_t v = {lo, hi}; cvt_bf16x2_t b = __builtin_convertvector(v, cvt_bf16x2_t); return __builtin_bit_cast(unsigned, b); }
typedef float f32x2 __attribute__((ext_vector_type(2)));
constexpr int SEQL = 8192, DMODEL = 1024, DFFN = 2816;
constexpr float LOG2E = 1.4426950408889634f;
constexpr float QSC_NSA = 0.125f * LOG2E;
constexpr float QSC_MLA = 0.10206207261596577f * LOG2E;
constexpr float NEPS = 1e-6f;
__device__ __forceinline__ float sigm(float x) { return __builtin_amdgcn_rcpf(1.0f + __builtin_amdgcn_exp2f(-LOG2E * x)); }
__device__ __forceinline__ void st8(bf16_t* p, f32x4 a0, f32x4 a1) {
    u32x4 w; w.x = cvt_pk_bf16(a0[0], a0[1]); w.y = cvt_pk_bf16(a0[2], a0[3]); w.z = cvt_pk_bf16(a1[0], a1[1]); w.w = cvt_pk_bf16(a1[2], a1[3]); *(u32x4*)p = w; }
__device__ __forceinline__ float bf2f(unsigned short h) { return __uint_as_float(((unsigned)h) << 16); }

struct EpiSwiGLU { static constexpr bool PERM = true, AFTER_DRAIN = false; unsigned char* ws;
    __device__ __forceinline__ void operator()(const f32x4 (&acc)[2][2][4][2], const Unit& u, int wr, int wc, int fr, int fq) const {
        { const int ln_ = opaque_lane(); fr = ln_ & 15; fq = ln_ >> 4; }
        const int row0 = u.pm * BM + (u.half == 2 ? HALF : 0) + wr * 64 + fr, col0 = u.pn * 128 + wc * 32 + 8 * fq;
#pragma unroll
        for (int ai = 0; ai < 2; ++ai) if (ai == 0 || u.half == 0)
#pragma unroll
            for (int m = 0; m < 4; ++m) { bf16_t* rowp = (bf16_t*)(ws + WS_C) + (size_t)(row0 + ai * HALF + m * 16) * DFFN + col0;
                f32x4 h0, h1;
#pragma unroll
                for (int j = 0; j < 4; ++j) { const float g0 = acc[ai][0][m][0][j], g1 = acc[ai][0][m][1][j];
                    h0[j] = g0 * sigm(g0) * acc[ai][1][m][0][j]; h1[j] = g1 * sigm(g1) * acc[ai][1][m][1][j]; }
                st8(rowp, h0, h1); }
    }
};
struct EpiResid { static constexpr bool PERM = false, AFTER_DRAIN = false; const float* xin; float* xout; const float* gate; float gs;
    __device__ __forceinline__ void operator()(const f32x4 (&acc)[2][2][4][2], const Unit& u, int wr, int wc, int fr, int fq) const {
        { const int ln_ = opaque_lane(); fr = ln_ & 15; fq = ln_ >> 4; }
        const int col0 = u.pn * BM + wc * 32 + 4 * fq; const int b = (u.pm * BM) >> 13;
        f32x4 gv[2][2];
#pragma unroll
        for (int bj = 0; bj < 2; ++bj)
#pragma unroll
            for (int n = 0; n < 2; ++n) gv[bj][n] = *(const f32x4*)(gate + (size_t)b * 9216 + col0 + bj * HALF + n * 16) * gs;
#pragma unroll
        for (int ai = 0; ai < 2; ++ai)
#pragma unroll
            for (int m = 0; m < 4; ++m) { const size_t off = (size_t)(u.pm * BM + ai * HALF + wr * 64 + m * 16 + fr) * DMODEL + col0;
#pragma unroll
                for (int bj = 0; bj < 2; ++bj)
#pragma unroll
                    for (int n = 0; n < 2; ++n) { const f32x4 xv = *(const f32x4*)(xin + off + bj * HALF + n * 16);
                        *(f32x4*)(xout + off + bj * HALF + n * 16) = xv + gv[bj][n] * acc[ai][bj][m][n]; }
                if (m & 1) asm volatile("" ::: "memory"); }
    }
};

#ifdef RN_NT
#define RN_STORE(p, v) __builtin_nontemporal_store((v), (p))
#else
#define RN_STORE(p, v) (*(p) = (v))
#endif
template <bool FINAL> struct EpiResidNorm {
    static constexpr bool PERM = true, AFTER_DRAIN = true;
    const void* xin; void* xout; const float* gate; int gs2;
    const float* sh; const float* sc;
    bf16_t* xn; unsigned* slots;
    int xbf = 1;
    __device__ __forceinline__ void fused(f32x4 (&acc)[2][2][4][2], const Unit& u, int wr, int wc, int fr, int fq, PG8_LAS unsigned char* lds, int wid, int lane) const {
        { const int ln_ = opaque_lane(); fr = ln_ & 15; fq = ln_ >> 4; lane = ln_; }
        PG8_LAS float* P = (PG8_LAS float*)lds;
        PG8_LAS float* S = (PG8_LAS float*)(lds + 8192);
        const int col0 = u.pn * BM + wc * 32 + 8 * fq; const int b = (u.pm * BM) >> 13;
        { f32x4 gv[2][2];
#pragma unroll
          for (int bj = 0; bj < 2; ++bj)
#pragma unroll
              for (int n = 0; n < 2; ++n) gv[bj][n] = *(const f32x4*)(gate + (size_t)b * 9216 + col0 + bj * HALF + n * 4) * (0.5f * (float)gs2);
          u32x4 xb[2][4][2];
          if (xbf) {
#pragma unroll
              for (int ai = 0; ai < 2; ++ai)
#pragma unroll
                  for (int m = 0; m < 4; ++m) { const size_t off = (size_t)(u.pm * BM + ai * HALF + wr * 64 + m * 16 + fr) * DMODEL + col0;
#pragma unroll
                      for (int bj = 0; bj < 2; ++bj) xb[ai][m][bj] = *(const u32x4*)((const bf16_t*)xin + off + bj * HALF); }
          }
#pragma unroll
          for (int ai = 0; ai < 2; ++ai) {
#pragma unroll
              for (int m = 0; m < 4; ++m) { const size_t off = (size_t)(u.pm * BM + ai * HALF + wr * 64 + m * 16 + fr) * DMODEL + col0; float s = 0.f;
#pragma unroll
                  for (int bj = 0; bj < 2; ++bj) { u32x4 wo;
#pragma unroll
                      for (int n = 0; n < 2; ++n) { f32x4 xv;
                          if (xbf) { const unsigned w0 = n ? xb[ai][m][bj].z : xb[ai][m][bj].x, w1 = n ? xb[ai][m][bj].w : xb[ai][m][bj].y; xv = (f32x4){__uint_as_float(w0 << 16), __uint_as_float(w0 & 0xffff0000u), __uint_as_float(w1 << 16), __uint_as_float(w1 & 0xffff0000u)}; }
                          else xv = *(const f32x4*)((const float*)xin + off + bj * HALF + n * 4);
                          const f32x4 x1 = xv + gv[bj][n] * acc[ai][bj][m][n]; acc[ai][bj][m][n] = x1;
                          if (n == 0) { wo.x = cvt_pk_bf16(x1[0], x1[1]); wo.y = cvt_pk_bf16(x1[2], x1[3]); } else { wo.z = cvt_pk_bf16(x1[0], x1[1]); wo.w = cvt_pk_bf16(x1[2], x1[3]); }
                          s += (x1[0] * x1[0] + x1[1] * x1[1]) + (x1[2] * x1[2] + x1[3] * x1[3]); }
                      if (!FINAL) RN_STORE((u32x4*)((bf16_t*)xout + off + bj * HALF), wo); }
                  s += swz_xor<16>(s); s = half_sum(s);
                  if (fq == 0) P[(ai * HALF + wr * 64 + m * 16 + fr) * 4 + wc] = s; }
              asm volatile("" ::: "memory"); } }
        asm volatile("s_waitcnt lgkmcnt(0)" ::: "memory"); __builtin_amdgcn_s_barrier(); asm volatile("" ::: "memory");
        f32x4 av[2][2], cv[2][2]; void* const xout_ = xout; bf16_t* const xn_ = xn;
#pragma unroll
        for (int bj = 0; bj < 2; ++bj)
#pragma unroll
            for (int n = 0; n < 2; ++n) { if (FINAL) { av[bj][n] = *(const f32x4*)(sh + col0 + bj * HALF + n * 4); cv[bj][n] = (f32x4){0.f, 0.f, 0.f, 0.f}; }
                else { av[bj][n] = *(const f32x4*)(sc + (size_t)b * 9216 + col0 + bj * HALF + n * 4) + 1.0f; cv[bj][n] = *(const f32x4*)(sh + (size_t)b * 9216 + col0 + bj * HALF + n * 4); } }
        const int row = wid * 32 + (lane & 31);
        unsigned* const wp = slots + (size_t)(u.pm * BM + row);
        if (lane < 32) { const float t = (P[row * 4 + 0] + P[row * 4 + 1]) + (P[row * 4 + 2] + P[row * 4 + 3]);
            const unsigned v = (unsigned)fminf(t * 256.0f + 0.5f, 134217727.0f);
            (void)__hip_atomic_fetch_add(wp, v | (1u << 29), __ATOMIC_RELAXED, __HIP_MEMORY_SCOPE_AGENT); }
        { unsigned w = __hip_atomic_load(wp, __ATOMIC_RELAXED, __HIP_MEMORY_SCOPE_AGENT);
          int it_ = 0;
          while (__any((w >> 29) != 4u) && ++it_ < 100000) {
              __builtin_amdgcn_s_sleep(1);
              w = __hip_atomic_load(wp, __ATOMIC_RELAXED, __HIP_MEMORY_SCOPE_AGENT); }
          if (lane < 32) S[row] = __builtin_amdgcn_rsqf((float)(w & 0x1fffffffu) * (1.0f / 256.0f) * (1.0f / DMODEL) + NEPS); }
        asm volatile("s_waitcnt vmcnt(0) lgkmcnt(0)" ::: "memory"); __builtin_amdgcn_s_barrier(); asm volatile("" ::: "memory");
        {
#pragma unroll
          for (int ai = 0; ai < 2; ++ai)
#pragma unroll
              for (int m = 0; m < 4; ++m) { const int r = ai * HALF + wr * 64 + m * 16 + fr; const float rs = S[r]; const size_t off = (size_t)(u.pm * BM + r) * DMODEL + col0;
#pragma unroll
                  for (int bj = 0; bj < 2; ++bj) { u32x4 wo;
#pragma unroll
                      for (int n = 0; n < 2; ++n) { const f32x4 y = acc[ai][bj][m][n] * rs * av[bj][n] + cv[bj][n];
                          if (FINAL) RN_STORE((f32x4*)((float*)xout_ + off + bj * HALF + n * 4), y);
                          else if (n == 0) { wo.x = cvt_pk_bf16(y[0], y[1]); wo.y = cvt_pk_bf16(y[2], y[3]); } else { wo.z = cvt_pk_bf16(y[0], y[1]); wo.w = cvt_pk_bf16(y[2], y[3]); } }
                      if (!FINAL) RN_STORE((u32x4*)(xn_ + off + bj * HALF), wo); }
                  asm volatile("" ::: "memory"); } }
    }
};
struct EpiWin { static constexpr bool PERM = true, AFTER_DRAIN = false;
    unsigned char* ws;
    __device__ __forceinline__ void operator()(const f32x4 (&acc)[2][2][4][2], const Unit& u, int wr, int wc, int fr, int fq) const {
        { const int ln_ = opaque_lane(); fr = ln_ & 15; fq = ln_ >> 4; }
        bf16_t* const Qn = (bf16_t*)(ws + WS_QN); bf16_t* const kcf = (bf16_t*)(ws + WS_KCF); bf16_t* const vcf = (bf16_t*)(ws + WS_VCF); bf16_t* const Ksel = (bf16_t*)(ws + WS_KSEL); bf16_t* const Vsel = (bf16_t*)(ws + WS_VSEL);
        bf16_t* const Kwin = (bf16_t*)(ws + WS_KWIN); bf16_t* const Vwin = (bf16_t*)(ws + WS_VWIN); bf16_t* const cq = (bf16_t*)(ws + WS_CQ); bf16_t* const ckv = (bf16_t*)(ws + WS_CKV); bf16_t* const Km = (bf16_t*)(ws + WS_KM); bf16_t* const gm = (bf16_t*)(ws + WS_GM);
        float* const gates = (float*)(ws + WS_GATES); const float* const cs = (const float*)(ws + WS_CS);
        const int pn = u.pn;
#pragma unroll
        for (int ai = 0; ai < 2; ++ai) {
        f32x4 rcs[4][2];
        if (pn == 7 && wc == 0) {
#pragma unroll
            for (int m = 0; m < 4; ++m) { const int t_ = (u.pm * BM + ai * HALF + wr * 64 + m * 16 + fr) & (SEQL - 1);
                rcs[m][0] = *(const f32x4*)(cs + (size_t)t_ * 32 + 4 * fq); rcs[m][1] = *(const f32x4*)(cs + (size_t)t_ * 32 + 16 + 4 * fq); }
        }
#pragma unroll
            for (int m = 0; m < 4; ++m) {
                const int row = u.pm * BM + ai * HALF + wr * 64 + m * 16 + fr, b = row >> 13, t = row & (SEQL - 1);
                const int d = wc * 32 + 8 * fq;
                if (pn < 2) {
#pragma unroll
                    for (int bj = 0; bj < 2; ++bj) st8(Qn + (size_t)row * 512 + pn * 256 + bj * HALF + d, acc[ai][bj][m][0] * QSC_NSA, acc[ai][bj][m][1] * QSC_NSA);
                } else if (pn == 2) {
                    const int g = d >> 6, dd = d & 63; const size_t o = ((size_t)(b * 2 + g) * SEQL + t) * 64 + dd;
                    st8(kcf + o, acc[ai][0][m][0], acc[ai][0][m][1]); st8(vcf + o, acc[ai][1][m][0], acc[ai][1][m][1]);
                } else if (pn == 3 || pn == 4) {
                    bf16_t* Kd = pn == 3 ? Ksel : Kwin; bf16_t* Vd = pn == 3 ? Vsel : Vwin;
                    const int g = d >> 6, dd = d & 63; const size_t tb = (size_t)(b * 2 + g) * 128 + (t >> 6);
                    st8(Kd + (tb * 8 + (dd >> 3)) * 512 + (t & 63) * 8, acc[ai][0][m][0], acc[ai][0][m][1]);
                    st8(Vd + tb * 4096 + (dd >> 5) * 2048 + (t & 63) * 32 + (dd & 31), acc[ai][1][m][0], acc[ai][1][m][1]);
                } else if (pn == 5 || pn == 6) {
#pragma unroll
                    for (int bj = 0; bj < 2; ++bj) { const f32x4 a0 = acc[ai][bj][m][0], a1 = acc[ai][bj][m][1];
                        if (pn == 5) st8(ckv + (size_t)row * 256 + bj * HALF + d, a0, a1); else st8(cq + (size_t)row * 384 + bj * HALF + d, a0, a1); }
                } else if (pn == 7) {
                    st8(cq + (size_t)row * 384 + 256 + d, acc[ai][0][m][0], acc[ai][0][m][1]);
                    const f32x4 a0 = acc[ai][1][m][0], a1 = acc[ai][1][m][1];
                    if (wc == 0) {
                        const f32x4 c4 = rcs[m][0], s4 = rcs[m][1];
                        f32x4 o0, o1;
                        o0[0] = a0[0] * c4[0] - a0[1] * s4[0]; o0[1] = a0[0] * s4[0] + a0[1] * c4[0];
                        o0[2] = a0[2] * c4[1] - a0[3] * s4[1]; o0[3] = a0[2] * s4[1] + a0[3] * c4[1];
                        o1[0] = a1[0] * c4[2] - a1[1] * s4[2]; o1[1] = a1[0] * s4[2] + a1[1] * c4[2];
                        o1[2] = a1[2] * c4[3] - a1[3] * s4[3]; o1[3] = a1[2] * s4[3] + a1[3] * c4[3];
#pragma unroll
                        for (int h = 0; h < 8; ++h) st8(Km + (((size_t)(b * 8 + h) * 128 + (t >> 6)) * 12 + 8 + fq) * 512 + (t & 63) * 8, o0, o1);
                    } else if (wc == 1 && fq < 3) {
                        float* gp = gates + (size_t)row * 24 + 8 * fq; f32x4 g0, g1;
#pragma unroll
                        for (int j = 0; j < 4; ++j) { g0[j] = sigm(a0[j]); g1[j] = sigm(a1[j]); }
                        *(f32x4*)gp = g0; *(f32x4*)(gp + 4) = g1;
                    }
                } else {
                    f32x4 r0, r1, b0, b1;
#pragma unroll
                    for (int j = 0; j < 4; ++j) {
                        const float ea0 = __builtin_amdgcn_exp2f(-1.4426950408889634f * acc[ai][0][m][0][j]), ea1 = __builtin_amdgcn_exp2f(-1.4426950408889634f * acc[ai][0][m][1][j]);
                        const float eb0 = fminf(__builtin_amdgcn_exp2f(-1.4426950408889634f * acc[ai][1][m][0][j]), 1e30f), eb1 = fminf(__builtin_amdgcn_exp2f(-1.4426950408889634f * acc[ai][1][m][1][j]), 1e30f);
                        r0[j] = (1.0f + eb0) * __builtin_amdgcn_rcpf(1.0f + ea0); r1[j] = (1.0f + eb1) * __builtin_amdgcn_rcpf(1.0f + ea1);
                        b0[j] = __builtin_amdgcn_rcpf(1.0f + eb0); b1[j] = __builtin_amdgcn_rcpf(1.0f + eb1); }
                    st8(gm + (size_t)row * 2048 + (pn - 8) * 128 + d, r0, r1); st8(gm + (size_t)row * 2048 + 1024 + (pn - 8) * 128 + d, b0, b1);
                }
                asm volatile("" ::: "memory");
            }
        }
    }
};
struct EpiQproj { static constexpr bool PERM = true, AFTER_DRAIN = false; unsigned char* ws; const PG8_LAS float* tab;
    __device__ __forceinline__ void operator()(const f32x4 (&acc)[2][2][4][2], const Unit& u, int wr, int wc, int fr, int fq) const {
        { const int ln_ = opaque_lane(); fr = ln_ & 15; fq = ln_ >> 4; }
        bf16_t* const Qm = (bf16_t*)(ws + WS_QM); const float* const cs = (const float*)(ws + WS_CS);
#pragma unroll
        for (int ai = 0; ai < 2; ++ai)
#pragma unroll
            for (int m = 0; m < 4; ++m) {
                const int row = u.pm * BM + ai * HALF + wr * 64 + m * 16 + fr, t = row & (SEQL - 1);
                const float rs = tab[ai * HALF + wr * 64 + m * 16 + fr];
#pragma unroll
                for (int bj = 0; bj < 2; ++bj) { const int n = u.pn * BM + bj * HALF + wc * 32 + 8 * fq; const int p = n % 96;
                    f32x4 a0 = acc[ai][bj][m][0] * rs, a1 = acc[ai][bj][m][1] * rs;
                    if (p >= 64) { const int i0 = (p - 64) >> 1;
                        const f32x4 c4 = *(const f32x4*)(cs + (size_t)t * 32 + i0), s4 = *(const f32x4*)(cs + (size_t)t * 32 + 16 + i0);
                        f32x4 o0, o1;
                        o0[0] = a0[0] * c4[0] - a0[1] * s4[0]; o0[1] = a0[0] * s4[0] + a0[1] * c4[0];
                        o0[2] = a0[2] * c4[1] - a0[3] * s4[1]; o0[3] = a0[2] * s4[1] + a0[3] * c4[1];
                        o1[0] = a1[0] * c4[2] - a1[1] * s4[2]; o1[1] = a1[0] * s4[2] + a1[1] * c4[2];
                        o1[2] = a1[2] * c4[3] - a1[3] * s4[3]; o1[3] = a1[2] * s4[3] + a1[3] * c4[3];
                        a0 = o0; a1 = o1; }
                    st8(Qm + (size_t)row * 768 + n, a0, a1); }
                if (m & 1) asm volatile("" ::: "memory");
            }
    }
};
struct EpiKVproj { static constexpr bool PERM = true, AFTER_DRAIN = false; unsigned char* ws; const PG8_LAS float* tab;
    __device__ __forceinline__ void operator()(const f32x4 (&acc)[2][2][4][2], const Unit& u, int wr, int wc, int fr, int fq) const {
        { const int ln_ = opaque_lane(); fr = ln_ & 15; fq = ln_ >> 4; }
        bf16_t* const Km = (bf16_t*)(ws + WS_KM); bf16_t* const Vm = (bf16_t*)(ws + WS_VM);
#pragma unroll
        for (int ai = 0; ai < 2; ++ai)
#pragma unroll
            for (int m = 0; m < 4; ++m) {
                const int row = u.pm * BM + ai * HALF + wr * 64 + m * 16 + fr, b = row >> 13, t = row & (SEQL - 1);
                const float rs = tab[ai * HALF + wr * 64 + m * 16 + fr];
#pragma unroll
                for (int bj = 0; bj < 2; ++bj) { const int n = (u.pn & 1) * BM + bj * HALF + wc * 32 + 8 * fq; const int h = n >> 6, dd = n & 63;
                    const f32x4 a0 = acc[ai][bj][m][0] * rs, a1 = acc[ai][bj][m][1] * rs; const size_t tb = (size_t)(b * 8 + h) * 128 + (t >> 6);
                    if (u.pn < 2) st8(Km + (tb * 12 + (dd >> 3)) * 512 + (t & 63) * 8, a0, a1);
                    else st8(Vm + tb * 4096 + (dd >> 5) * 2048 + (t & 63) * 32 + (dd & 31), a0, a1); }
                asm volatile("" ::: "memory");
            }
    }
};
template <int PASS> struct EpiBranch { static constexpr bool PERM = true, AFTER_DRAIN = false; unsigned char* ws;
    __device__ __forceinline__ void operator()(const f32x4 (&acc)[2][2][4][2], const Unit& u, int wr, int wc, int fr, int fq) const {
        { const int ln_ = opaque_lane(); fr = ln_ & 15; fq = ln_ >> 4; }
        bf16_t* const Y = (bf16_t*)(ws + WS_Y); const bf16_t* const gm = (const bf16_t*)(ws + WS_GM);
#pragma unroll
        for (int ai = 0; ai < 2; ++ai)
#pragma unroll
            for (int m = 0; m < 4; ++m) { const int row = u.pm * BM + ai * HALF + wr * 64 + m * 16 + fr;
#pragma unroll
                for (int bj = 0; bj < 2; ++bj) { const int n = u.pn * BM + bj * HALF + wc * 32 + 8 * fq;
                    const u32x4 gw = *(const u32x4*)(gm + (size_t)row * 2048 + PASS * 1024 + n);
                    f32x4 a0 = acc[ai][bj][m][0], a1 = acc[ai][bj][m][1];
                    a0[0] *= __uint_as_float(gw.x << 16); a0[1] *= __uint_as_float(gw.x & 0xffff0000u); a0[2] *= __uint_as_float(gw.y << 16); a0[3] *= __uint_as_float(gw.y & 0xffff0000u);
                    a1[0] *= __uint_as_float(gw.z << 16); a1[1] *= __uint_as_float(gw.z & 0xffff0000u); a1[2] *= __uint_as_float(gw.w << 16); a1[3] *= __uint_as_float(gw.w & 0xffff0000u);
                    bf16_t* yp = Y + (size_t)row * DMODEL + n;
                    if (PASS == 1) { const u32x4 yw = *(const u32x4*)yp;
                        a0[0] += __uint_as_float(yw.x << 16); a0[1] += __uint_as_float(yw.x & 0xffff0000u); a0[2] += __uint_as_float(yw.y << 16); a0[3] += __uint_as_float(yw.y & 0xffff0000u);
                        a1[0] += __uint_as_float(yw.z << 16); a1[1] += __uint_as_float(yw.z & 0xffff0000u); a1[2] += __uint_as_float(yw.w << 16); a1[3] += __uint_as_float(yw.w & 0xffff0000u); }
                    st8(yp, a0, a1); }
            }
    }
};

struct EpiBranchM { static constexpr bool PERM = true, AFTER_DRAIN = false, HAS_MID = true; unsigned char* ws;
    __device__ __forceinline__ void mid(f32x4 (&acc)[2][2][4][2], const Unit& u, int wr, int wc) const {
        int fr, fq; { const int ln_ = opaque_lane(); fr = ln_ & 15; fq = ln_ >> 4; }
        const bf16_t* const gm = (const bf16_t*)(ws + WS_GM) + (size_t)(u.pm * BM + wr * 64 + fr) * 2048 + u.pn * BM + wc * 32 + 8 * fq;
        u32x4 g[2][4][2];
#pragma unroll
        for (int ai = 0; ai < 2; ++ai)
#pragma unroll
            for (int m = 0; m < 4; ++m)
#pragma unroll
                for (int bj = 0; bj < 2; ++bj) g[ai][m][bj] = *(const u32x4*)(gm + (size_t)(ai * HALF + m * 16) * 2048 + bj * HALF);
#pragma unroll
        for (int ai = 0; ai < 2; ++ai)
#pragma unroll
            for (int m = 0; m < 4; ++m)
#pragma unroll
                for (int bj = 0; bj < 2; ++bj) { const u32x4 ga = g[ai][m][bj];
                    const unsigned a4[4] = {ga.x, ga.y, ga.z, ga.w};
#pragma unroll
                    for (int i = 0; i < 4; ++i) { const float r0 = __uint_as_float(a4[i] << 16), r1 = __uint_as_float(a4[i] & 0xffff0000u);
                        if (i < 2) { acc[ai][bj][m][0][2 * i] *= r0; acc[ai][bj][m][0][2 * i + 1] *= r1; } else { acc[ai][bj][m][1][2 * i - 4] *= r0; acc[ai][bj][m][1][2 * i - 3] *= r1; } } }
        asm volatile("" ::: "memory");
    }
    __device__ __forceinline__ void operator()(const f32x4 (&acc)[2][2][4][2], const Unit& u, int wr, int wc, int fr, int fq) const {
        { const int ln_ = opaque_lane(); fr = ln_ & 15; fq = ln_ >> 4; }
        bf16_t* const Y = (bf16_t*)(ws + WS_Y) + (size_t)(u.pm * BM + wr * 64 + fr) * DMODEL + u.pn * BM + wc * 32 + 8 * fq;
        const bf16_t* const gm = (const bf16_t*)(ws + WS_GM) + (size_t)(u.pm * BM + wr * 64 + fr) * 2048 + 1024 + u.pn * BM + wc * 32 + 8 * fq;
        u32x4 g[2][4][2];
#pragma unroll
        for (int ai = 0; ai < 2; ++ai)
#pragma unroll
            for (int m = 0; m < 4; ++m)
#pragma unroll
                for (int bj = 0; bj < 2; ++bj) g[ai][m][bj] = *(const u32x4*)(gm + (size_t)(ai * HALF + m * 16) * 2048 + bj * HALF);
#pragma unroll
        for (int ai = 0; ai < 2; ++ai)
#pragma unroll
            for (int m = 0; m < 4; ++m)
#pragma unroll
                for (int bj = 0; bj < 2; ++bj) { const u32x4 gw = g[ai][m][bj];
                    f32x4 a0 = acc[ai][bj][m][0], a1 = acc[ai][bj][m][1];
                    a0[0] *= __uint_as_float(gw.x << 16); a0[1] *= __uint_as_float(gw.x & 0xffff0000u); a0[2] *= __uint_as_float(gw.y << 16); a0[3] *= __uint_as_float(gw.y & 0xffff0000u);
                    a1[0] *= __uint_as_float(gw.z << 16); a1[1] *= __uint_as_float(gw.z & 0xffff0000u); a1[2] *= __uint_as_float(gw.w << 16); a1[3] *= __uint_as_float(gw.w & 0xffff0000u);
                    st8(Y + (size_t)(ai * HALF + m * 16) * DMODEL + bj * HALF, a0, a1); }
    }
};
template <class T, class = void> struct has_mid { static constexpr bool value = false; };
template <class T> struct has_mid<T, decltype((void)T::HAS_MID)> { static constexpr bool value = true; };
template <class Epi, class Sched, bool ALIGN_EPI = false, bool SP2 = false>
__device__ __forceinline__ void gemm_phase(PG8_LAS unsigned char* lds, const Gemm g, const Sched& S, const Epi& E, int wave_id) {
    int tid_ = wave_id * 64 + opaque_lane();
    const int tid = tid_, wid = __builtin_amdgcn_readfirstlane(tid >> 6), lane = tid & 63, wr = wid >> 2, wc = wid & 3, fr = lane & 15, fq = lane >> 4;
    const int K = g.K, nt = K / BK;
    unsigned voffA[2], voffB[2];
#pragma unroll
    for (int i = 0; i < 2; ++i) { int R, C; stage_rc(tid * 16 + i * 8192, R, C); const int Rb = Epi::PERM ? ((R & ~31) + perm32(R & 31)) : R;
        voffA[i] = (unsigned)(R * K + C) * 2u; voffB[i] = (unsigned)(Rb * K + C) * 2u; }
    const size_t kstep = (size_t)(BK * 2);
    const size_t hstep = (size_t)HALF * K * 2;
    const size_t tstep = 2 * hstep;
    const unsigned ldsw = (unsigned)wid * 1024u;
    const int aoff = lds_byte(wr * 64 + fr, fq * 8), boff = lds_byte(wc * 32 + fr, fq * 8);
#define PG8_SA(b, h) (((b) * 2 + (h)) * HTB)
#define PG8_SB(b, h) ((4 + (b) * 2 + (h)) * HTB)
#define PG8_STAGE(bufoff, gbase, voff) do { _Pragma("unroll") for (int _i = 0; _i < 2; ++_i) \
        __builtin_amdgcn_global_load_lds((const unsigned*)((const char*)(gbase) + (voff)[_i]), (PG8_LAS unsigned*)(lds + (bufoff) + ldsw + _i * 8192), 16, 0, 0); } while (0)
#define PG8_LDA(dst, b, h) do { _Pragma("unroll") for (int m = 0; m < 4; ++m) _Pragma("unroll") for (int k = 0; k < 2; ++k) dst[m][k] = *(const PG8_LAS bf16x8*)(lds + PG8_SA(b, h) + aoff + m * 2048 + k * 1024); } while (0)
#define PG8_LDB(dst, b, h) do { _Pragma("unroll") for (int n = 0; n < 2; ++n) _Pragma("unroll") for (int k = 0; k < 2; ++k) dst[n][k] = *(const PG8_LAS bf16x8*)(lds + PG8_SB(b, h) + boff + n * 2048 + k * 1024); } while (0)
#define PG8_MMA(ai, bj, At, Bt) do { __builtin_amdgcn_s_setprio(1); _Pragma("unroll") for (int m = 0; m < 4; ++m) _Pragma("unroll") for (int n = 0; n < 2; ++n) _Pragma("unroll") for (int k = 0; k < 2; ++k) \
        acc[ai][bj][m][n] = __builtin_amdgcn_mfma_f32_16x16x32_bf16(Bt[n][k], At[m][k], acc[ai][bj][m][n], 0, 0, 0); __builtin_amdgcn_s_setprio(0); } while (0)
#define PG8_WAIT_V(n) asm volatile("s_waitcnt vmcnt(" #n ")" ::: "memory")
#define PG8_WAIT_L(n) asm volatile("s_waitcnt lgkmcnt(" #n ")" ::: "memory")
#define PG8_BAR __builtin_amdgcn_s_barrier()
#define PG8_SCHED __builtin_amdgcn_sched_barrier(0)
    Unit cur, nxt; int ui = 0;
    if (!S.next(0, cur)) return;
    f32x4 acc[2][2][4][2];
#pragma unroll
    for (int a = 0; a < 2; ++a)
#pragma unroll
        for (int b = 0; b < 2; ++b)
#pragma unroll
            for (int m = 0; m < 4; ++m)
#pragma unroll
                for (int n = 0; n < 2; ++n) acc[a][b][m][n] = (f32x4){0.f, 0.f, 0.f, 0.f};
    bf16x8 At[4][2], B0[2][2], B1[2][2];
    const char* cA = (const char*)g.A + (size_t)cur.pm * tstep + (cur.half == 2 ? hstep : 0); const char* cB = (const char*)g.Bt + (size_t)cur.pn * tstep;
    S.a_ready(cur);
    if constexpr (SP2) {
        PG8_STAGE(PG8_SB(0, 0), cB, voffB); PG8_STAGE(PG8_SB(0, 1), cB + hstep, voffB); PG8_STAGE(PG8_SA(0, 0), cA, voffA); PG8_STAGE(PG8_SA(0, 1), cA + hstep, voffA);
        if (wr == 1) PG8_BAR;
        PG8_WAIT_V(2); PG8_BAR;
        PG8_STAGE(PG8_SB(1, 0), cB + kstep, voffB); PG8_STAGE(PG8_SA(1, 0), cA + kstep, voffA); PG8_STAGE(PG8_SB(1, 1), cB + hstep + kstep, voffB);
        PG8_WAIT_V(6); PG8_BAR;
    } else {
        PG8_STAGE(PG8_SB(0, 0), cB, voffB); PG8_STAGE(PG8_SA(0, 0), cA, voffA); PG8_STAGE(PG8_SB(0, 1), cB + hstep, voffB); PG8_STAGE(PG8_SA(0, 1), cA + hstep, voffA);
        if (wr == 1) PG8_BAR;
        PG8_WAIT_V(4); PG8_BAR;
        PG8_STAGE(PG8_SB(1, 0), cB + kstep, voffB); PG8_STAGE(PG8_SA(1, 0), cA + kstep, voffA); PG8_STAGE(PG8_SB(1, 1), cB + hstep + kstep, voffB);
        PG8_WAIT_V(6); PG8_BAR;
    }
    for (;;) {
        const bool has_next = S.next(ui + 1, nxt);
        const char* nA = has_next ? (const char*)g.A + (size_t)nxt.pm * tstep + (nxt.half == 2 ? hstep : 0) : cA; const char* nB = has_next ? (const char*)g.Bt + (size_t)nxt.pn * tstep : cB;
        for (int t = 0; t < nt; t += 2) {
            if constexpr (has_mid<Epi>::value) { if (t == nt / 2) E.mid(acc, cur, wr, wc); }
            const bool last = (t == nt - 2);
            const char* a1 = cA + (size_t)(t + 1) * kstep;
            const char* a2 = last ? nA : cA + (size_t)(t + 2) * kstep; const char* b2 = last ? nB : cB + (size_t)(t + 2) * kstep;
            const char* a3 = a2 + kstep; const char* b3 = b2 + kstep;
            if (last && has_next) S.a_ready(nxt);
            if constexpr (SP2) {
            PG8_LDB(B0, 0, 0); PG8_LDB(B1, 0, 1); PG8_SCHED; PG8_LDA(At, 0, 0); PG8_STAGE(PG8_SA(1, 1), a1 + hstep, voffA);
            PG8_WAIT_V(8); PG8_WAIT_L(0); PG8_BAR; PG8_MMA(0, 0, At, B0); PG8_MMA(0, 1, At, B1); PG8_BAR; PG8_SCHED;
            PG8_LDA(At, 0, 1); PG8_STAGE(PG8_SB(0, 0), b2, voffB); PG8_STAGE(PG8_SB(0, 1), b2 + hstep, voffB); PG8_STAGE(PG8_SA(0, 0), a2, voffA);
            PG8_WAIT_V(8); PG8_WAIT_L(0); PG8_BAR; if (cur.half == 0) { PG8_MMA(1, 0, At, B0); PG8_MMA(1, 1, At, B1); } PG8_BAR; PG8_SCHED;
            PG8_LDB(B0, 1, 0); PG8_LDB(B1, 1, 1); PG8_SCHED; PG8_LDA(At, 1, 0); PG8_STAGE(PG8_SA(0, 1), a2 + hstep, voffA);
            PG8_WAIT_V(8); PG8_WAIT_L(0); PG8_BAR; PG8_MMA(0, 0, At, B0); PG8_MMA(0, 1, At, B1); PG8_BAR; PG8_SCHED;
            PG8_LDA(At, 1, 1); PG8_STAGE(PG8_SB(1, 0), b3, voffB); PG8_STAGE(PG8_SB(1, 1), b3 + hstep, voffB); PG8_STAGE(PG8_SA(1, 0), a3, voffA);
            PG8_WAIT_V(8); PG8_WAIT_L(0); PG8_BAR; if (cur.half == 0) { PG8_MMA(1, 0, At, B0); PG8_MMA(1, 1, At, B1); } PG8_BAR; PG8_SCHED;
            } else {
            PG8_LDB(B0, 0, 0); PG8_SCHED; PG8_LDA(At, 0, 0); PG8_STAGE(PG8_SA(1, 1), a1 + hstep, voffA);
            PG8_WAIT_L(8); PG8_BAR; PG8_WAIT_L(0); PG8_MMA(0, 0, At, B0); PG8_BAR; PG8_SCHED;
            PG8_LDB(B1, 0, 1); PG8_STAGE(PG8_SB(0, 0), b2, voffB);
            PG8_BAR; PG8_WAIT_L(0); PG8_MMA(0, 1, At, B1); PG8_BAR;
            PG8_LDA(At, 0, 1); PG8_STAGE(PG8_SA(0, 0), a2, voffA);
            PG8_BAR; PG8_WAIT_L(0); PG8_MMA(1, 0, At, B0); PG8_BAR; PG8_SCHED;
            PG8_STAGE(PG8_SB(0, 1), b2 + hstep, voffB);
            PG8_WAIT_V(6); PG8_BAR; PG8_MMA(1, 1, At, B1); PG8_BAR;
            PG8_LDB(B0, 1, 0); PG8_SCHED; PG8_LDA(At, 1, 0); PG8_STAGE(PG8_SA(0, 1), a2 + hstep, voffA);
            PG8_WAIT_L(8); PG8_BAR; PG8_WAIT_L(0); PG8_MMA(0, 0, At, B0); PG8_BAR; PG8_SCHED;
            PG8_LDB(B1, 1, 1); PG8_STAGE(PG8_SB(1, 0), b3, voffB);
            PG8_BAR; PG8_WAIT_L(0); PG8_MMA(0, 1, At, B1); PG8_BAR;
            PG8_LDA(At, 1, 1); PG8_STAGE(PG8_SA(1, 0), a3, voffA);
            PG8_BAR; PG8_WAIT_L(0); PG8_MMA(1, 0, At, B0); PG8_BAR; PG8_SCHED;
            PG8_STAGE(PG8_SB(1, 1), b3 + hstep, voffB);
            PG8_WAIT_V(6); PG8_BAR; PG8_MMA(1, 1, At, B1); PG8_BAR;
            }
        }
        if constexpr (ALIGN_EPI) { if (wr == 0) PG8_BAR; }
        if constexpr (!Epi::AFTER_DRAIN) { E(acc, cur, wr, wc, fr, fq); S.done(cur); }
        if (!has_next) break;
#pragma unroll
        for (int a = 0; a < 2; ++a)
#pragma unroll
            for (int b = 0; b < 2; ++b)
#pragma unroll
                for (int m = 0; m < 4; ++m)
#pragma unroll
                    for (int n = 0; n < 2; ++n) acc[a][b][m][n] = (f32x4){0.f, 0.f, 0.f, 0.f};
        cur = nxt; cA = nA; cB = nB; ++ui;
        if constexpr (ALIGN_EPI) { if (wr == 1) PG8_BAR; }
    }
    PG8_WAIT_V(0);
    if constexpr (!ALIGN_EPI) { if (wr == 0) PG8_BAR; }
    PG8_BAR;
    if constexpr (Epi::AFTER_DRAIN) { E.fused(acc, cur, wr, wc, fr, fq, lds, wid, lane); S.done(cur); }
#undef PG8_SA
#undef PG8_SB
#undef PG8_STAGE
#undef PG8_LDA
#undef PG8_LDB
#undef PG8_MMA
#undef PG8_WAIT_V
#undef PG8_WAIT_L
#undef PG8_BAR
#undef PG8_SCHED
}
}
namespace att {
#define LAS __attribute__((address_space(3)))
typedef unsigned short bf16;
typedef short bf16x8 __attribute__((ext_vector_type(8)));
typedef short s16x4 __attribute__((ext_vector_type(4)));
typedef float f32x16 __attribute__((ext_vector_type(16)));
typedef float f32x4 __attribute__((ext_vector_type(4)));
typedef unsigned u32x4 __attribute__((ext_vector_type(4)));
typedef unsigned u32x2 __attribute__((ext_vector_type(2)));
typedef const LAS char* lcp;
constexpr float LOG2E = 1.4426950408889634f;
__device__ __forceinline__ int crow(int r, int hi) { return (r & 3) + 8 * (r >> 2) + 4 * hi; }
typedef float f32x2_t __attribute__((ext_vector_type(2))); typedef __bf16 bf16x2_t __attribute__((ext_vector_type(2)));
__device__ __forceinline__ unsigned cvtpk(float lo, float hi) { f32x2_t v = {lo, hi}; bf16x2_t b = __builtin_convertvector(v, bf16x2_t); return __builtin_bit_cast(unsigned, b); }
__device__ __forceinline__ unsigned short f2bf(float f) { return (unsigned short)(cvtpk(f, 0.f) & 0xffffu); }
__device__ __forceinline__ float xmax(float v) { auto rr = __builtin_amdgcn_permlane32_swap(__float_as_uint(v), __float_as_uint(v), false, false); return fmaxf(__uint_as_float(rr[0]), __uint_as_float(rr[1])); }
__device__ __forceinline__ float xsum(float v) { auto rr = __builtin_amdgcn_permlane32_swap(__float_as_uint(v), __float_as_uint(v), false, false); return __uint_as_float(rr[0]) + __uint_as_float(rr[1]); }
__device__ __forceinline__ int dpp_sum8(int c) {
    c += __builtin_amdgcn_update_dpp(0, c, 0xB1, 0xF, 0xF, false);
    c += __builtin_amdgcn_update_dpp(0, c, 0x4E, 0xF, 0xF, false);
    c += __builtin_amdgcn_update_dpp(0, c, 0x141, 0xF, 0xF, false);
    return c; }
typedef short v4i16_t __attribute__((ext_vector_type(4)));
__device__ __forceinline__ s16x4 vtr(lcp p) { return __builtin_bit_cast(s16x4, __builtin_amdgcn_ds_read_tr16_b64_v4i16((LAS v4i16_t*)p)); }

template <int ND0> __device__ __forceinline__ void qk_tile(f32x16& p0, f32x16& p1, lcp kslot, const bf16x8* qr, int r32, int hi) {
    lcp kb = kslot + hi * 1024 + r32 * 16;
    p0 = f32x16{}; p1 = f32x16{};
#pragma unroll
    for (int d0 = 0; d0 < ND0; ++d0) {
        const bf16x8 b0 = *(const LAS bf16x8*)(kb + d0 * 2048), b1 = *(const LAS bf16x8*)(kb + d0 * 2048 + 512);
        p0 = __builtin_amdgcn_mfma_f32_32x32x16_bf16(b0, qr[d0], p0, 0, 0, 0);
        p1 = __builtin_amdgcn_mfma_f32_32x32x16_bf16(b1, qr[d0], p1, 0, 0, 0); }
}
__device__ __forceinline__ void pv_tile(f32x16& o0, f32x16& o1, lcp vp, const u32x4 (&pa)[4]) {
    const unsigned vb = (unsigned)(uintptr_t)vp;
    s16x4 lo[8], hi[8];
#pragma unroll
    for (int i = 0; i < 8; ++i) {
        asm volatile("ds_read_b64_tr_b16 %0, %1 offset:%c2" : "=&v"(lo[i]) : "v"(vb), "i"((i >> 2) * 4096 + (i & 3) * 1024) : "memory");
        asm volatile("ds_read_b64_tr_b16 %0, %1 offset:%c2" : "=&v"(hi[i]) : "v"(vb), "i"((i >> 2) * 4096 + (i & 3) * 1024 + 512) : "memory"); }
    asm volatile("s_waitcnt lgkmcnt(0)" : "+v"(lo[0]), "+v"(lo[1]), "+v"(lo[2]), "+v"(lo[3]), "+v"(lo[4]), "+v"(lo[5]), "+v"(lo[6]), "+v"(lo[7]), "+v"(hi[0]), "+v"(hi[1]), "+v"(hi[2]), "+v"(hi[3]), "+v"(hi[4]), "+v"(hi[5]), "+v"(hi[6]), "+v"(hi[7]) :: "memory");
    __builtin_amdgcn_sched_barrier(0);
#pragma unroll
    for (int ks = 0; ks < 4; ++ks) {
        const bf16x8 v0 = (bf16x8){lo[ks][0], lo[ks][1], lo[ks][2], lo[ks][3], hi[ks][0], hi[ks][1], hi[ks][2], hi[ks][3]};
        const bf16x8 v1 = (bf16x8){lo[4 + ks][0], lo[4 + ks][1], lo[4 + ks][2], lo[4 + ks][3], hi[4 + ks][0], hi[4 + ks][1], hi[4 + ks][2], hi[4 + ks][3]};
        const bf16x8 a = __builtin_bit_cast(bf16x8, pa[ks]);
        o0 = __builtin_amdgcn_mfma_f32_32x32x16_bf16(a, v0, o0, 0, 0, 0);
        o1 = __builtin_amdgcn_mfma_f32_32x32x16_bf16(a, v1, o1, 0, 0, 0); }
}
__device__ __forceinline__ void pack_p(u32x4 (&pa)[4], const f32x16& p0, const f32x16& p1) {
    pa[0] = (u32x4){cvtpk(p0[0], p0[1]), cvtpk(p0[2], p0[3]), cvtpk(p0[4], p0[5]), cvtpk(p0[6], p0[7])};
    pa[1] = (u32x4){cvtpk(p0[8], p0[9]), cvtpk(p0[10], p0[11]), cvtpk(p0[12], p0[13]), cvtpk(p0[14], p0[15])};
    pa[2] = (u32x4){cvtpk(p1[0], p1[1]), cvtpk(p1[2], p1[3]), cvtpk(p1[4], p1[5]), cvtpk(p1[6], p1[7])};
    pa[3] = (u32x4){cvtpk(p1[8], p1[9]), cvtpk(p1[10], p1[11]), cvtpk(p1[12], p1[13]), cvtpk(p1[14], p1[15])};
}
__device__ __forceinline__ float max3f(float a, float b, float c) { float r; asm("v_max3_f32 %0, %1, %2, %3" : "=v"(r) : "v"(a), "v"(b), "v"(c)); return r; }
__device__ __forceinline__ void mfma_settle(f32x16& a, f32x16& b) { asm volatile("s_nop 15\n\ts_nop 7" : "+v"(a), "+v"(b)); }
__device__ __forceinline__ float max32(const f32x16& p0, const f32x16& p1) {
    float a = max3f(p0[0], p1[0], p0[1]), b = max3f(p1[1], p0[2], p1[2]);
#pragma unroll
    for (int r = 3; r < 15; r += 2) { a = max3f(a, p0[r], p1[r]); b = max3f(b, p0[r + 1], p1[r + 1]); }
    a = max3f(a, p0[15], p1[15]);
    return fmaxf(a, b);
}
__device__ __forceinline__ void softmax_pv(f32x16& p0, f32x16& p1, float& m, float& l, f32x16& o0, f32x16& o1, lcp vp, LAS float* wsf, int r32, int hi) {
    const float rm = xmax(max32(p0, p1));
    const float mn = fmaxf(m, rm); const float f = __builtin_amdgcn_exp2f(m - mn); m = mn;
    float s = 0.f;
#pragma unroll
    for (int r = 0; r < 16; ++r) { p0[r] = __builtin_amdgcn_exp2f(p0[r] - mn); p1[r] = __builtin_amdgcn_exp2f(p1[r] - mn); s += p0[r] + p1[r]; }
    l = l * f + s;
    if (__any(f != 1.0f)) {
        if (hi == 0) wsf[r32] = f;
#pragma unroll
        for (int r = 0; r < 16; ++r) { const float fr = wsf[crow(r, hi)]; o0[r] *= fr; o1[r] *= fr; }
    }
    u32x4 pa[4]; pack_p(pa, p0, p1);
    pv_tile(o0, o1, vp, pa);
}
__device__ __forceinline__ void add_scaled(f32x16& a0, f32x16& a1, const f32x16& o0, const f32x16& o1, float fac, LAS float* wsf, int r32, int hi) {
    if (hi == 0) wsf[32 + r32] = fac;
#pragma unroll
    for (int r = 0; r < 16; ++r) { const float fr = wsf[32 + crow(r, hi)]; a0[r] += fr * o0[r]; a1[r] += fr * o1[r]; }
}
template <bool FIRST> __device__ __forceinline__ void acc_lds(LAS float* accL, const f32x16& o0, const f32x16& o1, float fac, LAS float* wsf, int r32, int hi) {
    if (hi == 0) wsf[32 + r32] = fac;
#pragma unroll
    for (int r = 0; r < 16; ++r) { const int row = crow(r, hi); const float fr = wsf[32 + row]; LAS float* p = accL + row * 64 + r32;
        if (FIRST) { p[0] = fr * o0[r]; p[32] = fr * o1[r]; } else { p[0] += fr * o0[r]; p[32] += fr * o1[r]; } }
}
__device__ __forceinline__ void store_acc(const LAS float* accL, bf16* gdst, int pitch, int lane) {
#pragma unroll
    for (int i = 0; i < 4; ++i) { const int row = i * 8 + (lane >> 3), ch = lane & 7; const f32x4 a = *(const LAS f32x4*)(accL + row * 64 + ch * 8), b = *(const LAS f32x4*)(accL + row * 64 + ch * 8 + 4);
        const u32x4 v = (u32x4){cvtpk(a[0], a[1]), cvtpk(a[2], a[3]), cvtpk(b[0], b[1]), cvtpk(b[2], b[3])}; *(u32x4*)(gdst + (size_t)row * pitch + ch * 8) = v; }
}
__device__ __forceinline__ void store_o(const f32x16& o0, const f32x16& o1, LAS bf16* stg, bf16* gdst, int pitch, int lane, int r32, int hi) {
#pragma unroll
    for (int r = 0; r < 16; ++r) { const int orow = crow(r, hi); stg[orow * 64 + r32] = f2bf(o0[r]); stg[orow * 64 + 32 + r32] = f2bf(o1[r]); }
#pragma unroll
    for (int i = 0; i < 4; ++i) { const int row = i * 8 + (lane >> 3), ch = lane & 7; const u32x4 v = *(const LAS u32x4*)(stg + row * 64 + ch * 8); *(u32x4*)(gdst + (size_t)row * pitch + ch * 8) = v; }
}


template <int ND0> __device__ __forceinline__ void qk_tile_c(f32x16& p0, f32x16& p1, lcp kslot, const bf16x8* qr, const f32x16& c0, const f32x16& c1, int r32, int hi) {
    lcp kb = kslot + hi * 1024 + r32 * 16;
    bf16x8 kf0[ND0], kf1[ND0];
#pragma unroll
    for (int d0 = 0; d0 < ND0; ++d0) { kf0[d0] = *(const LAS bf16x8*)(kb + d0 * 2048); kf1[d0] = *(const LAS bf16x8*)(kb + d0 * 2048 + 512); }
    __builtin_amdgcn_sched_barrier(0);
#pragma unroll
    for (int d0 = 0; d0 < ND0; ++d0) {
        p0 = __builtin_amdgcn_mfma_f32_32x32x16_bf16(kf0[d0], qr[d0], d0 == 0 ? c0 : p0, 0, 0, 0);
        p1 = __builtin_amdgcn_mfma_f32_32x32x16_bf16(kf1[d0], qr[d0], d0 == 0 ? c1 : p1, 0, 0, 0); }
    asm volatile("s_nop 15\n\ts_nop 7" : "+v"(p0), "+v"(p1));
}
__device__ __forceinline__ void dma1k(const char* gsrc, LAS char* dst) { __builtin_amdgcn_global_load_lds((const unsigned*)gsrc, (LAS unsigned*)dst, 16, 0, 0); }
__device__ __forceinline__ void mask_causal(f32x16& p0, f32x16& p1, int e0) {
#pragma unroll
    for (int r = 0; r < 16; ++r) { const int e = e0 + (r & 3) + 8 * (r >> 2); if (e > 0) p0[r] = -INFINITY; if (e + 32 > 0) p1[r] = -INFINITY; }
}
__device__ __forceinline__ void mask_winlow(f32x16& p0, f32x16& p1, int e0) {
#pragma unroll
    for (int r = 0; r < 16; ++r) { const int e = e0 + (r & 3) + 8 * (r >> 2); if (e <= -512) p0[r] = -INFINITY; if (e + 32 <= -512) p1[r] = -INFINITY; }
}
__device__ __forceinline__ void softmax_pv2(f32x16& p0, f32x16& p1, f32x16& p2, f32x16& p3, float offa, float offb, float& m, float& l, f32x16& o0, f32x16& o1, lcp va, lcp vb, LAS float* wsf, int r32, int hi) {
    const float rm = xmax(fmaxf(max32(p0, p1) + offa, max32(p2, p3) + offb));
    const float mn = fmaxf(m, rm); const float f = __builtin_amdgcn_exp2f(m - mn); m = mn;
    const float ca = mn - offa, cb = mn - offb;
    float s = 0.f;
#pragma unroll
    for (int r = 0; r < 16; ++r) { p0[r] = __builtin_amdgcn_exp2f(p0[r] - ca); p1[r] = __builtin_amdgcn_exp2f(p1[r] - ca); s += p0[r] + p1[r]; }
#pragma unroll
    for (int r = 0; r < 16; ++r) { p2[r] = __builtin_amdgcn_exp2f(p2[r] - cb); p3[r] = __builtin_amdgcn_exp2f(p3[r] - cb); s += p2[r] + p3[r]; }
    l = l * f + s;
    if (__any(f != 1.0f)) {
        if (hi == 0) wsf[r32] = f;
#pragma unroll
        for (int r = 0; r < 16; ++r) { const float fr = wsf[crow(r, hi)]; o0[r] *= fr; o1[r] *= fr; }
    }
    { u32x4 pa[4]; pack_p(pa, p0, p1); pv_tile(o0, o1, va, pa); }
    { u32x4 pa[4]; pack_p(pa, p2, p3); pv_tile(o0, o1, vb, pa); }
}


__device__ __forceinline__ void glds16(const void* gsrc, unsigned lds_dst) { unsigned keep;
    asm volatile("s_mov_b32 %0, m0\n\ts_mov_b32 m0, %2\n\ts_nop 0\n\tglobal_load_lds_dwordx4 %1, off\n\ts_mov_b32 m0, %0" : "=&s"(keep) : "v"(gsrc), "s"(lds_dst) : "memory"); }
#define ATT_WAIT_BAR(N) asm volatile("s_waitcnt vmcnt(" #N ") lgkmcnt(0)\n\ts_barrier" ::: "memory")
__device__ __forceinline__ void softmax_pv1(f32x16& p0, f32x16& p1, float off, float& m, float& l, f32x16& o0, f32x16& o1, lcp vp, LAS float* wsf, int r32, int hi) {
    const float rm = xmax(max32(p0, p1) + off);
    const float mn = fmaxf(m, rm); const float f = __builtin_amdgcn_exp2f(m - mn); m = mn;
    const float ca = mn - off;
    p0 = p0 - ca; p1 = p1 - ca;
    float s = 0.f;
#pragma unroll
    for (int r = 0; r < 16; ++r) { p0[r] = __builtin_amdgcn_exp2f(p0[r]); p1[r] = __builtin_amdgcn_exp2f(p1[r]); }
    { const f32x16 ps = p0 + p1;
#pragma unroll
      for (int r = 0; r < 16; ++r) s += ps[r]; }
    l = l * f + s;
    if (__any(f != 1.0f)) {
        if (hi == 0) wsf[r32] = f;
#pragma unroll
        for (int r = 0; r < 16; ++r) { const float fr = wsf[crow(r, hi)]; o0[r] *= fr; o1[r] *= fr; }
    }
    u32x4 pa[4]; pack_p(pa, p0, p1);
    pv_tile(o0, o1, vp, pa);
}

__device__ __forceinline__ void softmax_part(f32x16& p0, f32x16& p1, float off, float& m, f32x16& o0, f32x16& o1, f32x16& ol, u32x4 (&pa)[4], LAS float* wsf, int r32, int hi) {
    const float rm = xmax(max32(p0, p1) + off);
    const float mn = fmaxf(m, rm); const float f = __builtin_amdgcn_exp2f(m - mn); m = mn;
    const float ca = mn - off;
#pragma unroll
    for (int r = 0; r < 16; ++r) { p0[r] = __builtin_amdgcn_exp2f(p0[r] - ca); p1[r] = __builtin_amdgcn_exp2f(p1[r] - ca); }
    if (__any(f != 1.0f)) {
        if (hi == 0) wsf[r32] = f;
#pragma unroll
        for (int r = 0; r < 16; ++r) { const float fr = wsf[crow(r, hi)]; o0[r] *= fr; o1[r] *= fr; ol[r] *= fr; }
    }
    pack_p(pa, p0, p1);
}
__device__ __forceinline__ void pv_tile_l(f32x16& o0, f32x16& o1, f32x16& ol, lcp vp, const u32x4 (&pa)[4]) {
    const unsigned vb = (unsigned)(uintptr_t)vp;
    s16x4 lo[8], hi[8];
#pragma unroll
    for (int i = 0; i < 8; ++i) {
        asm volatile("ds_read_b64_tr_b16 %0, %1 offset:%c2" : "=&v"(lo[i]) : "v"(vb), "i"((i >> 2) * 4096 + (i & 3) * 1024) : "memory");
        asm volatile("ds_read_b64_tr_b16 %0, %1 offset:%c2" : "=&v"(hi[i]) : "v"(vb), "i"((i >> 2) * 4096 + (i & 3) * 1024 + 512) : "memory"); }
    const bf16x8 ones = (bf16x8){0x3f80, 0x3f80, 0x3f80, 0x3f80, 0x3f80, 0x3f80, 0x3f80, 0x3f80};
#pragma unroll
    for (int ks = 0; ks < 4; ++ks) ol = __builtin_amdgcn_mfma_f32_32x32x16_bf16(__builtin_bit_cast(bf16x8, pa[ks]), ones, ol, 0, 0, 0);
    asm volatile("s_waitcnt lgkmcnt(0)" : "+v"(lo[0]), "+v"(lo[1]), "+v"(lo[2]), "+v"(lo[3]), "+v"(lo[4]), "+v"(lo[5]), "+v"(lo[6]), "+v"(lo[7]), "+v"(hi[0]), "+v"(hi[1]), "+v"(hi[2]), "+v"(hi[3]), "+v"(hi[4]), "+v"(hi[5]), "+v"(hi[6]), "+v"(hi[7]) :: "memory");
    __builtin_amdgcn_sched_barrier(0);
#pragma unroll
    for (int ks = 0; ks < 4; ++ks) {
        const bf16x8 v0 = (bf16x8){lo[ks][0], lo[ks][1], lo[ks][2], lo[ks][3], hi[ks][0], hi[ks][1], hi[ks][2], hi[ks][3]};
        const bf16x8 v1 = (bf16x8){lo[4 + ks][0], lo[4 + ks][1], lo[4 + ks][2], lo[4 + ks][3], hi[4 + ks][0], hi[4 + ks][1], hi[4 + ks][2], hi[4 + ks][3]};
        const bf16x8 a = __builtin_bit_cast(bf16x8, pa[ks]);
        o0 = __builtin_amdgcn_mfma_f32_32x32x16_bf16(a, v0, o0, 0, 0, 0);
        o1 = __builtin_amdgcn_mfma_f32_32x32x16_bf16(a, v1, o1, 0, 0, 0); }
}

template <int THRL> __device__ __forceinline__ void softmax_part_def(f32x16& p0, f32x16& p1, float& mref, f32x16& negm, f32x16& o0, f32x16& o1, f32x16& ol, u32x4 (&pa)[4], LAS float* wsf, int r32, int hi) {
    const float rm = xmax(max32(p0, p1));
    if (__any(rm > (float)THRL)) {
        const float dl = fmaxf(rm, 0.f); mref += dl;
#pragma unroll
        for (int r = 0; r < 16; ++r) { p0[r] -= dl; p1[r] -= dl; negm[r] = -mref; }
        const float f = __builtin_amdgcn_exp2f(-dl);
        if (hi == 0) wsf[r32] = f;
#pragma unroll
        for (int r = 0; r < 16; ++r) { const float fr = wsf[crow(r, hi)]; o0[r] *= fr; o1[r] *= fr; ol[r] *= fr; }
    }
#pragma unroll
    for (int r = 0; r < 16; ++r) { p0[r] = __builtin_amdgcn_exp2f(p0[r]); p1[r] = __builtin_amdgcn_exp2f(p1[r]); }
    pack_p(pa, p0, p1);
}

template <int THRL> __device__ __forceinline__ void softmax_part_def_l(f32x16& p0, f32x16& p1, float& mref, float& l, f32x16& negm, f32x16& o0, f32x16& o1, u32x4 (&pa)[4], LAS float* wsf, int r32, int hi) {
    const float rm = xmax(max32(p0, p1));
    if (__any(rm > (float)THRL)) {
        const float dl = fmaxf(rm, 0.f); mref += dl;
#pragma unroll
        for (int r = 0; r < 16; ++r) { p0[r] -= dl; p1[r] -= dl; negm[r] = -mref; }
        const float f = __builtin_amdgcn_exp2f(-dl); l *= f;
        if (hi == 0) wsf[r32] = f;
#pragma unroll
        for (int r = 0; r < 16; ++r) { const float fr = wsf[crow(r, hi)]; o0[r] *= fr; o1[r] *= fr; }
    }
    float s = 0.f;
#pragma unroll
    for (int r = 0; r < 16; ++r) { p0[r] = __builtin_amdgcn_exp2f(p0[r]); p1[r] = __builtin_amdgcn_exp2f(p1[r]); s += p0[r] + p1[r]; }
    l += s;
    pack_p(pa, p0, p1);
}

#ifdef ATT_V1
constexpr int M_KS = 0, M_VS = 24576, M_WSF = 40960, M_OST = 43008;
__device__ __forceinline__ void mla_unit(int b, int h, int qb, const bf16* Qm, const bf16* Km, const bf16* Vm, bf16* Ob, LAS char* lds, int wave_id, int opitch = 1024) {
    int tid_ = wave_id * 64 + opaque_lane();
    const int tid = tid_, lane = tid & 63, r32 = lane & 31, hi = lane >> 5, wid = __builtin_amdgcn_readfirstlane(tid >> 6);
    const int q0 = qb * 256, NT = (q0 + 256) / 64;
    const int qmin = q0 + wid * 32, qpos = qmin + r32;
    bf16x8 qr[6];
    { const bf16* qp = Qm + ((size_t)b * 8192 + qpos) * 768 + h * 96 + hi * 8;
#pragma unroll
      for (int d0 = 0; d0 < 6; ++d0) qr[d0] = *(const bf16x8*)(qp + d0 * 16); }
    const char* Kg = (const char*)(Km + (size_t)(b * 8 + h) * 128 * 6144);
    const char* Vg = (const char*)(Vm + (size_t)(b * 8 + h) * 128 * 4096);
    LAS float* wsf = (LAS float*)(lds + M_WSF) + wid * 64;
    const int vlane = ((lane >> 4) & 1) * 32 + (lane & 3) * 8 + (4 * hi + ((lane & 15) >> 2)) * 64;
    float m = -1e30f, l = 0.f; f32x16 o0 = f32x16{}, o1 = f32x16{};
    u32x4 kr0, kr1 = u32x4{}, vr0;
    kr0 = *(const u32x4*)(Kg + tid * 16); if (tid < 256) kr1 = *(const u32x4*)(Kg + 8192 + tid * 16); vr0 = *(const u32x4*)(Vg + tid * 16);
    *(LAS u32x4*)(lds + M_KS + tid * 16) = kr0; if (tid < 256) *(LAS u32x4*)(lds + M_KS + 8192 + tid * 16) = kr1; *(LAS u32x4*)(lds + M_VS + tid * 16) = vr0;
    __syncthreads();
    for (int kt = 0; kt < NT; ++kt) {
        const int sl = kt & 1;
        if (kt + 1 < NT) { const char* kg = Kg + (size_t)(kt + 1) * 12288; const char* vg = Vg + (size_t)(kt + 1) * 8192;
            kr0 = *(const u32x4*)(kg + tid * 16); if (tid < 256) kr1 = *(const u32x4*)(kg + 8192 + tid * 16); vr0 = *(const u32x4*)(vg + tid * 16); }
        if (64 * kt <= qmin + 31) {
            f32x16 p0, p1; qk_tile<6>(p0, p1, (lcp)(lds + M_KS + sl * 12288), qr, r32, hi);
            if (64 * kt + 63 > qmin) {
                const int kb = 64 * kt + 4 * hi;
#pragma unroll
                for (int r = 0; r < 16; ++r) { const int kv = kb + (r & 3) + 8 * (r >> 2); if (kv > qpos) p0[r] = -INFINITY; if (kv + 32 > qpos) p1[r] = -INFINITY; }
            }
            softmax_pv(p0, p1, m, l, o0, o1, (lcp)(lds + M_VS + sl * 8192 + vlane), wsf, r32, hi);
        }
        if (kt + 1 < NT) { const int sn = sl ^ 1;
            *(LAS u32x4*)(lds + M_KS + sn * 12288 + tid * 16) = kr0; if (tid < 256) *(LAS u32x4*)(lds + M_KS + sn * 12288 + 8192 + tid * 16) = kr1; *(LAS u32x4*)(lds + M_VS + sn * 8192 + tid * 16) = vr0; }
        __syncthreads();
    }
    const float lt = xsum(l); const float inv = lt > 0.f ? 1.0f / lt : 0.f;
    f32x16 a0 = f32x16{}, a1 = f32x16{};
    add_scaled(a0, a1, o0, o1, inv, wsf, r32, hi);
    store_o(a0, a1, (LAS bf16*)(lds + M_OST + wid * 4096), Ob + ((size_t)b * 8192 + qmin) * opitch + h * 64, opitch, lane, r32, hi);
    __syncthreads();
}

constexpr int N_KS = 0, N_VS = 16384, N_WSF = 32768, N_ACC = 34816, N_IMP = 100352, N_SEL = 133376, N_UNI = 134400, N_BL = 134464, IMPS = 129;
struct NsaT { const bf16 *Qn, *Kc, *Vc, *Ksel, *Vsel, *Kwin, *Vwin; const float* gates; bf16* Oa; int opitch; };
__device__ __forceinline__ void setbit(unsigned (&w)[4], int j) { const int wi = j >> 5; const unsigned bv = 1u << (j & 31); w[0] |= wi == 0 ? bv : 0u; w[1] |= wi == 1 ? bv : 0u; w[2] |= wi == 2 ? bv : 0u; w[3] |= wi == 3 ? bv : 0u; }
__device__ __forceinline__ void nsa_unit(int b, int g, int ti, const NsaT& T, LAS char* lds, int wave_id) {
    int tid_ = wave_id * 64 + opaque_lane();
    const int tid = tid_, lane = tid & 63, r32 = lane & 31, hi = lane >> 5, wid = __builtin_amdgcn_readfirstlane(tid >> 6);
    const int hh = wid & 3, qh = wid >> 2, H = g * 4 + hh, bg = b * 2 + g;
    const int t0 = ti * 64, qrow = qh * 32 + r32, t = t0 + qrow;
    const float slope2 = __builtin_amdgcn_exp2f(-(float)(H + 1)) * LOG2E;
    bf16x8 qr[4];
    { const bf16* qp = T.Qn + ((size_t)b * 8192 + t) * 512 + H * 64 + hi * 8;
#pragma unroll
      for (int d0 = 0; d0 < 4; ++d0) qr[d0] = *(const bf16x8*)(qp + d0 * 16); }
    LAS float* wsf = (LAS float*)(lds + N_WSF) + wid * 64;
    LAS float* imp = (LAS float*)(lds + N_IMP);
    LAS unsigned* selw = (LAS unsigned*)(lds + N_SEL);
    LAS unsigned* uni = (LAS unsigned*)(lds + N_UNI);
    LAS unsigned* blist = (LAS unsigned*)(lds + N_BL);
    const int vlane = ((lane >> 4) & 1) * 32 + (lane & 3) * 8 + (4 * hi + ((lane & 15) >> 2)) * 64;
    for (int i = tid; i < 64 * IMPS; i += 512) imp[i] = 0.f;
    if (tid < 256) selw[tid] = 0u;
    if (tid < 8) uni[tid] = 0u;
    const float* gp = T.gates + ((size_t)b * 8192 + t) * 24 + H * 3;
    const float gc = gp[0], gs = gp[1], gw = gp[2];
    LAS float* accL = (LAS float*)(lds + N_ACC) + wid * 2048;
    u32x4 kr0, vr0;
    const int ntc = (4 * ti + 3 + 63) >> 6;
    const char* Kcg = (const char*)(T.Kc + (size_t)bg * 8 * 4096); const char* Vcg = (const char*)(T.Vc + (size_t)bg * 8 * 4096);
    float m = -1e30f, l = 0.f;
#ifndef NSA_SKIP_P1
    kr0 = *(const u32x4*)(Kcg + tid * 16); *(LAS u32x4*)(lds + N_KS + tid * 16) = kr0;
    __syncthreads();
    for (int kt = 0; kt < ntc; ++kt) {
        const int sl = kt & 1;
        if (kt + 1 < ntc) kr0 = *(const u32x4*)(Kcg + (size_t)(kt + 1) * 8192 + tid * 16);
        { f32x16 p0, p1; qk_tile<4>(p0, p1, (lcp)(lds + N_KS + sl * 8192), qr, r32, hi);
          const int nb = 64 * kt + 4 * hi;
#pragma unroll
          for (int r = 0; r < 16; ++r) { const int n = nb + (r & 3) + 8 * (r >> 2); const int e0 = 16 * n + 31 - t, e1 = e0 + 512;
              p0[r] = e0 <= 0 ? p0[r] + slope2 * (float)e0 : -INFINITY; p1[r] = e1 <= 0 ? p1[r] + slope2 * (float)e1 : -INFINITY; }
          const float rm = max32(p0, p1); const float mn = fmaxf(m, rm); float s = 0.f;
#pragma unroll
          for (int r = 0; r < 16; ++r) s += __builtin_amdgcn_exp2f(p0[r] - mn) + __builtin_amdgcn_exp2f(p1[r] - mn);
          l = l * __builtin_amdgcn_exp2f(m - mn) + s; m = mn; }
        if (kt + 1 < ntc) *(LAS u32x4*)(lds + N_KS + (sl ^ 1) * 8192 + tid * 16) = kr0;
        __syncthreads();
    }
    {
      auto rm_ = __builtin_amdgcn_permlane32_swap(__float_as_uint(m), __float_as_uint(m), false, false); auto rl_ = __builtin_amdgcn_permlane32_swap(__float_as_uint(l), __float_as_uint(l), false, false);
      const float mo = __uint_as_float(hi ? rm_[0] : rm_[1]), lo = __uint_as_float(hi ? rl_[0] : rl_[1]); const float mn = fmaxf(m, mo);
      l = l * __builtin_amdgcn_exp2f(m - mn) + lo * __builtin_amdgcn_exp2f(mo - mn); m = mn; }
#endif
    const float invl = l > 0.f ? 1.0f / l : 0.f;
    f32x16 o0 = f32x16{}, o1 = f32x16{};
#ifndef NSA_SKIP_P2
    kr0 = *(const u32x4*)(Kcg + tid * 16); vr0 = *(const u32x4*)(Vcg + tid * 16);
    *(LAS u32x4*)(lds + N_KS + tid * 16) = kr0; *(LAS u32x4*)(lds + N_VS + tid * 16) = vr0;
    __syncthreads();
    for (int kt = 0; kt < ntc; ++kt) {
        const int sl = kt & 1;
        if (kt + 1 < ntc) { kr0 = *(const u32x4*)(Kcg + (size_t)(kt + 1) * 8192 + tid * 16); vr0 = *(const u32x4*)(Vcg + (size_t)(kt + 1) * 8192 + tid * 16); }
        { f32x16 p0, p1; qk_tile<4>(p0, p1, (lcp)(lds + N_KS + sl * 8192), qr, r32, hi);
          const int nb = 64 * kt + 4 * hi;
#pragma unroll
          for (int r = 0; r < 16; ++r) { const int n = nb + (r & 3) + 8 * (r >> 2); const int e0 = 16 * n + 31 - t, e1 = e0 + 512;
              p0[r] = e0 <= 0 ? __builtin_amdgcn_exp2f(p0[r] + slope2 * (float)e0 - m) * invl : 0.f; p1[r] = e1 <= 0 ? __builtin_amdgcn_exp2f(p1[r] + slope2 * (float)e1 - m) * invl : 0.f; }
          LAS float* ir = imp + qrow * IMPS + 16 * kt + hi;
#pragma unroll
          for (int rg = 0; rg < 4; ++rg) {
              const float A0 = (p0[4 * rg] + p0[4 * rg + 1]) + (p0[4 * rg + 2] + p0[4 * rg + 3]), A1 = (p1[4 * rg] + p1[4 * rg + 1]) + (p1[4 * rg + 2] + p1[4 * rg + 3]);
              __hip_atomic_fetch_add(ir + 2 * rg, A0, __ATOMIC_RELAXED, __HIP_MEMORY_SCOPE_WORKGROUP); __hip_atomic_fetch_add(ir + 2 * rg + 1, p0[4 * rg + 3], __ATOMIC_RELAXED, __HIP_MEMORY_SCOPE_WORKGROUP);
              __hip_atomic_fetch_add(ir + 8 + 2 * rg, A1, __ATOMIC_RELAXED, __HIP_MEMORY_SCOPE_WORKGROUP); __hip_atomic_fetch_add(ir + 8 + 2 * rg + 1, p1[4 * rg + 3], __ATOMIC_RELAXED, __HIP_MEMORY_SCOPE_WORKGROUP); }
          u32x4 pa[4]; pack_p(pa, p0, p1);
          pv_tile(o0, o1, (lcp)(lds + N_VS + sl * 8192 + vlane), pa); }
        if (kt + 1 < ntc) { *(LAS u32x4*)(lds + N_KS + (sl ^ 1) * 8192 + tid * 16) = kr0; *(LAS u32x4*)(lds + N_VS + (sl ^ 1) * 8192 + tid * 16) = vr0; }
        __syncthreads();
    }
    acc_lds<true>(accL, o0, o1, gc, wsf, r32, hi);
#endif
#ifndef NSA_SKIP_TOPK
    {
        const int q = tid >> 3, sub = tid & 7;
        unsigned w[4] = {0u, 0u, 0u, 0u};
        if (ti <= 15) { if (sub == 0) w[0] = (2u << ti) - 1u; }
        else {
            const LAS float* row = imp + q * IMPS;
#pragma unroll 1
            for (int half = 0; half < 2; ++half) {
                float v[8]; int cnt[8];
#pragma unroll
                for (int k = 0; k < 8; ++k) { const int j = 1 + sub + 8 * (k + 8 * half); v[k] = (j <= ti - 2) ? row[j] : -1.0f; cnt[k] = 0; }
#pragma unroll 1
                for (int jp = 1; jp <= ti - 2; ++jp) { const float vp = row[jp];
#pragma unroll
                    for (int k = 0; k < 8; ++k) { const int j = 1 + sub + 8 * (k + 8 * half); cnt[k] += (vp > v[k] || (vp == v[k] && jp < j)) ? 1 : 0; } }
#pragma unroll
                for (int k = 0; k < 8; ++k) { const int j = 1 + sub + 8 * (k + 8 * half); if (j <= ti - 2 && cnt[k] < 13) setbit(w, j); }
            }
            if (sub == 0) { w[0] |= 1u; setbit(w, ti); setbit(w, ti - 1); }
        }
#pragma unroll
        for (int k = 0; k < 4; ++k) if (w[k]) { __hip_atomic_fetch_or(selw + q * 4 + k, w[k], __ATOMIC_RELAXED, __HIP_MEMORY_SCOPE_WORKGROUP); __hip_atomic_fetch_or(uni + k, w[k], __ATOMIC_RELAXED, __HIP_MEMORY_SCOPE_WORKGROUP); }
    }
#endif
    __syncthreads();
    if (tid == 0) { int nb = 0;
        for (int k = 0; k < 4; ++k) { unsigned u = uni[k]; while (u) { const int bit = __builtin_ctz(u); u &= u - 1u; blist[nb++] = (unsigned)(32 * k + bit); } }
        uni[4] = (unsigned)nb; }
    __syncthreads();
    const int nsel = (int)uni[4];
    unsigned sw[4];
#pragma unroll
    for (int k = 0; k < 4; ++k) sw[k] = selw[qrow * 4 + k];
#ifndef NSA_SKIP_SEL
    {
        const char* Kg = (const char*)(T.Ksel + (size_t)bg * 128 * 4096); const char* Vg = (const char*)(T.Vsel + (size_t)bg * 128 * 4096);
        m = -1e30f; l = 0.f; o0 = f32x16{}; o1 = f32x16{};
        int j = (int)blist[0];
        kr0 = *(const u32x4*)(Kg + (size_t)j * 8192 + tid * 16); vr0 = *(const u32x4*)(Vg + (size_t)j * 8192 + tid * 16);
        *(LAS u32x4*)(lds + N_KS + tid * 16) = kr0; *(LAS u32x4*)(lds + N_VS + tid * 16) = vr0;
        __syncthreads();
        for (int k = 0; k < nsel; ++k) {
            const int sl = k & 1; int jn = 0;
            if (k + 1 < nsel) { jn = (int)blist[k + 1]; kr0 = *(const u32x4*)(Kg + (size_t)jn * 8192 + tid * 16); vr0 = *(const u32x4*)(Vg + (size_t)jn * 8192 + tid * 16); }
            { f32x16 p0, p1; qk_tile<4>(p0, p1, (lcp)(lds + N_KS + sl * 8192), qr, r32, hi);
              const int jw = j >> 5; const unsigned swj = jw == 0 ? sw[0] : jw == 1 ? sw[1] : jw == 2 ? sw[2] : sw[3]; const bool mine = (swj >> (j & 31)) & 1u; const int pb = 64 * j + 4 * hi - t;
#pragma unroll
              for (int r = 0; r < 16; ++r) { const int e0 = pb + (r & 3) + 8 * (r >> 2), e1 = e0 + 32;
                  p0[r] = (mine && e0 <= 0) ? p0[r] + slope2 * (float)e0 : -INFINITY; p1[r] = (mine && e1 <= 0) ? p1[r] + slope2 * (float)e1 : -INFINITY; }
              softmax_pv(p0, p1, m, l, o0, o1, (lcp)(lds + N_VS + sl * 8192 + vlane), wsf, r32, hi); }
            if (k + 1 < nsel) { *(LAS u32x4*)(lds + N_KS + (sl ^ 1) * 8192 + tid * 16) = kr0; *(LAS u32x4*)(lds + N_VS + (sl ^ 1) * 8192 + tid * 16) = vr0; }
            j = jn;
            __syncthreads();
        }
        const float lt = xsum(l); acc_lds<false>(accL, o0, o1, lt > 0.f ? gs / lt : 0.f, wsf, r32, hi);
    }
#endif
#ifndef NSA_SKIP_WIN
    {
        const char* Kg = (const char*)(T.Kwin + (size_t)bg * 128 * 4096); const char* Vg = (const char*)(T.Vwin + (size_t)bg * 128 * 4096);
        m = -1e30f; l = 0.f; o0 = f32x16{}; o1 = f32x16{};
        const int j0 = ti >= 8 ? ti - 8 : 0, nw = ti - j0 + 1;
        kr0 = *(const u32x4*)(Kg + (size_t)j0 * 8192 + tid * 16); vr0 = *(const u32x4*)(Vg + (size_t)j0 * 8192 + tid * 16);
        *(LAS u32x4*)(lds + N_KS + tid * 16) = kr0; *(LAS u32x4*)(lds + N_VS + tid * 16) = vr0;
        __syncthreads();
        for (int k = 0; k < nw; ++k) {
            const int sl = k & 1, j = j0 + k;
            if (k + 1 < nw) { kr0 = *(const u32x4*)(Kg + (size_t)(j + 1) * 8192 + tid * 16); vr0 = *(const u32x4*)(Vg + (size_t)(j + 1) * 8192 + tid * 16); }
            { f32x16 p0, p1; qk_tile<4>(p0, p1, (lcp)(lds + N_KS + sl * 8192), qr, r32, hi);
              const int pb = 64 * j + 4 * hi - t;
#pragma unroll
              for (int r = 0; r < 16; ++r) { const int e0 = pb + (r & 3) + 8 * (r >> 2), e1 = e0 + 32;
                  p0[r] = (e0 <= 0 && e0 > -512) ? p0[r] + slope2 * (float)e0 : -INFINITY; p1[r] = (e1 <= 0 && e1 > -512) ? p1[r] + slope2 * (float)e1 : -INFINITY; }
              softmax_pv(p0, p1, m, l, o0, o1, (lcp)(lds + N_VS + sl * 8192 + vlane), wsf, r32, hi); }
            if (k + 1 < nw) { *(LAS u32x4*)(lds + N_KS + (sl ^ 1) * 8192 + tid * 16) = kr0; *(LAS u32x4*)(lds + N_VS + (sl ^ 1) * 8192 + tid * 16) = vr0; }
            __syncthreads();
        }
        const float lt = xsum(l); acc_lds<false>(accL, o0, o1, lt > 0.f ? gw / lt : 0.f, wsf, r32, hi);
    }
#endif
    store_acc(accL, T.Oa + ((size_t)b * 8192 + t0 + qh * 32) * T.opitch + H * 64, T.opitch, lane);
    __syncthreads();
}
#endif

#ifndef ATT_V1
#ifdef MLA_V2
constexpr int M_STG = 40960, M_WSF = 81920, M_OST = 83968;
__device__ __forceinline__ void mla_unit(int b, int h, int qb, const bf16* Qm, const bf16* Km, const bf16* Vm, bf16* Ob, LAS char* lds, int wave_id, int opitch = 1024) {
    int tid_ = wave_id * 64 + opaque_lane();
    const int tid = tid_, lane = tid & 63, r32 = lane & 31, hi = lane >> 5, wid = __builtin_amdgcn_readfirstlane(tid >> 6);
    const int q0 = qb * 256, NP = (q0 + 256) / 128;
    const int qmin = q0 + wid * 32, qpos = qmin + r32;
    bf16x8 qr[6];
    { const bf16* qp = Qm + ((size_t)b * 8192 + qpos) * 768 + h * 96 + hi * 8;
#pragma unroll
      for (int d0 = 0; d0 < 6; ++d0) qr[d0] = *(const bf16x8*)(qp + d0 * 16); }
    const char* Kg = (const char*)(Km + (size_t)(b * 8 + h) * 128 * 6144) + lane * 16;
    const char* Vg = (const char*)(Vm + (size_t)(b * 8 + h) * 128 * 4096) + lane * 16;
    LAS float* wsf = (LAS float*)(lds + M_WSF) + wid * 64;
    const int vlane = ((lane >> 4) & 1) * 32 + (lane & 3) * 8 + (4 * hi + ((lane & 15) >> 2)) * 64;
    float m = -1e30f, l = 0.f; f32x16 o0 = f32x16{}, o1 = f32x16{};
    const f32x16 zc = f32x16{};
#define MLA_DMA(p, stg) do { const int ja_ = 2 * (p), jb_ = ja_ + 1; _Pragma("unroll") for (int i_ = 0; i_ < 5; ++i_) { const int q_ = wid + 8 * i_; \
        const char* s_ = q_ < 12 ? Kg + (size_t)ja_ * 12288 + q_ * 1024 : q_ < 24 ? Kg + (size_t)jb_ * 12288 + (q_ - 12) * 1024 : q_ < 32 ? Vg + (size_t)ja_ * 8192 + (q_ - 24) * 1024 : Vg + (size_t)jb_ * 8192 + (q_ - 32) * 1024; \
        dma1k(s_, lds + (stg) * M_STG + q_ * 1024); } } while (0)
    MLA_DMA(0, 0);
    __syncthreads();
    for (int p = 0; p < NP; ++p) {
        const int st = p & 1;
        if (p + 1 < NP) MLA_DMA(p + 1, st ^ 1);
        const int ja = 2 * p, jb = ja + 1;
        if (64 * ja <= qmin + 31) {
            LAS char* sb = lds + st * M_STG;
            f32x16 p0, p1, p2, p3;
            qk_tile_c<6>(p0, p1, (lcp)sb, qr, zc, zc, r32, hi);
            qk_tile_c<6>(p2, p3, (lcp)(sb + 12288), qr, zc, zc, r32, hi);
            if (64 * ja + 63 > qmin) mask_causal(p0, p1, 64 * ja + 4 * hi - qpos);
            if (64 * jb + 63 > qmin) mask_causal(p2, p3, 64 * jb + 4 * hi - qpos);
            softmax_pv2(p0, p1, p2, p3, 0.f, 0.f, m, l, o0, o1, (lcp)(sb + 24576 + vlane), (lcp)(sb + 32768 + vlane), wsf, r32, hi);
        }
        __syncthreads();
    }
#undef MLA_DMA
    const float lt = xsum(l); const float inv = lt > 0.f ? 1.0f / lt : 0.f;
    f32x16 a0 = f32x16{}, a1 = f32x16{};
    add_scaled(a0, a1, o0, o1, inv, wsf, r32, hi);
    store_o(a0, a1, (LAS bf16*)(lds + M_OST + wid * 4096), Ob + ((size_t)b * 8192 + qmin) * opitch + h * 64, opitch, lane, r32, hi);
    __syncthreads();
}
#else
#ifdef MLA_V4
constexpr int M_SLOT = 20480, M_WSF = 81920, M_OST = 83968;
__device__ __forceinline__ void mla_unit(int b, int h, int qb, const bf16* Qm, const bf16* Km, const bf16* Vm, bf16* Ob, LAS char* lds, int wave_id, int opitch = 1024) {
    int tid_ = wave_id * 64 + opaque_lane();
    const int tid = tid_, lane = tid & 63, r32 = lane & 31, hi = lane >> 5, wid = __builtin_amdgcn_readfirstlane(tid >> 6);
    const int q0 = qb * 256, NT = (q0 + 256) / 64;
    const int qmin = q0 + wid * 32, qpos = qmin + r32;
    bf16x8 qr[6];
    { const bf16* qp = Qm + ((size_t)b * 8192 + qpos) * 768 + h * 96 + hi * 8;
#pragma unroll
      for (int d0 = 0; d0 < 6; ++d0) qr[d0] = *(const bf16x8*)(qp + d0 * 16); }
    const char* Kg = (const char*)(Km + (size_t)(b * 8 + h) * 128 * 6144) + lane * 16;
    const char* Vg = (const char*)(Vm + (size_t)(b * 8 + h) * 128 * 4096) + lane * 16;
    const unsigned lds0 = (unsigned)(uintptr_t)lds;
    LAS float* wsf = (LAS float*)(lds + M_WSF) + wid * 64;
    const int vlane = ((lane >> 4) & 1) * 32 + (lane & 3) * 8 + (4 * hi + ((lane & 15) >> 2)) * 64;
    float m = -1e30f, l = 0.f; f32x16 o0 = f32x16{}, o1 = f32x16{};
    const f32x16 zc = f32x16{};
#define MLA_DMA(t_) do { const unsigned sl_ = lds0 + (unsigned)(((t_) & 3) * M_SLOT); _Pragma("unroll") for (int i_ = 0; i_ < 3; ++i_) { int q_ = wid + 8 * i_; if (q_ >= 20) q_ -= 16; \
        const char* s_ = q_ < 12 ? Kg + (size_t)(t_) * 12288 + q_ * 1024 : Vg + (size_t)(t_) * 8192 + (q_ - 12) * 1024; glds16(s_, (unsigned)__builtin_amdgcn_readfirstlane(sl_ + q_ * 1024)); } } while (0)
#define MLA_QK(P0, P1, t_) do { qk_tile_c<6>(P0, P1, (lcp)(lds + ((t_) & 3) * M_SLOT), qr, zc, zc, r32, hi); if (64 * (t_) + 63 > qmin) mask_causal(P0, P1, 64 * (t_) + 4 * hi - qpos); } while (0)
#define MLA_STEP(PC0, PC1, PN0, PN1, t_) do { \
        if ((t_) + 3 < NT) MLA_DMA((t_) + 3); \
        if ((t_) + 1 < NT && 64 * ((t_) + 1) <= qmin + 31) MLA_QK(PN0, PN1, (t_) + 1); \
        if (64 * (t_) <= qmin + 31) softmax_pv1(PC0, PC1, 0.f, m, l, o0, o1, (lcp)(lds + ((t_) & 3) * M_SLOT + 12288 + vlane), wsf, r32, hi); \
        if ((t_) + 3 < NT) ATT_WAIT_BAR(3); else ATT_WAIT_BAR(0); } while (0)
    MLA_DMA(0); MLA_DMA(1); MLA_DMA(2);
    ATT_WAIT_BAR(3);
    f32x16 pA0, pA1, pB0 = f32x16{}, pB1 = f32x16{};
    MLA_QK(pA0, pA1, 0);
    for (int t = 0; t < NT; t += 2) {
        MLA_STEP(pA0, pA1, pB0, pB1, t);
        MLA_STEP(pB0, pB1, pA0, pA1, t + 1);
    }
#undef MLA_DMA
#undef MLA_QK
#undef MLA_STEP
    const float lt = xsum(l); const float inv = lt > 0.f ? 1.0f / lt : 0.f;
    f32x16 a0 = f32x16{}, a1 = f32x16{};
    add_scaled(a0, a1, o0, o1, inv, wsf, r32, hi);
    store_o(a0, a1, (LAS bf16*)(lds + M_OST + wid * 4096), Ob + ((size_t)b * 8192 + qmin) * opitch + h * 64, opitch, lane, r32, hi);
    __syncthreads();
}
#else
#ifndef MLA_V5
constexpr int M_SLOT = 20480, M_WSF = 81920, M_OST = 83968;
template <int DIAG = 0> __device__ __forceinline__ void mla_unit(int b, int h, int qb, const bf16* Qm, const bf16* Km, const bf16* Vm, bf16* Ob, LAS char* lds, int wave_id, int opitch = 1024) {
    int tid_ = wave_id * 64 + opaque_lane();
    const int tid = tid_, lane = tid & 63, r32 = lane & 31, hi = lane >> 5, wid = __builtin_amdgcn_readfirstlane(tid >> 6);
    const int q0 = qb * 256, NT = (q0 + 256) / 64;
    const int qmin = q0 + wid * 32, qpos = qmin + r32;
    bf16x8 qr[6];
    { const bf16* qp = Qm + ((size_t)b * 8192 + qpos) * 768 + h * 96 + hi * 8;
#pragma unroll
      for (int d0 = 0; d0 < 6; ++d0) qr[d0] = *(const bf16x8*)(qp + d0 * 16); }
    const char* Kg = (const char*)(Km + (size_t)(b * 8 + h) * 128 * 6144) + lane * 16;
    const char* Vg = (const char*)(Vm + (size_t)(b * 8 + h) * 128 * 4096) + lane * 16;
    const unsigned lds0 = (unsigned)(uintptr_t)lds;
    LAS float* wsf = (LAS float*)(lds + M_WSF) + wid * 64;
    const int vlane = ((lane >> 4) & 1) * 32 + (lane & 3) * 8 + (4 * hi + ((lane & 15) >> 2)) * 64;
    const unsigned klane = (unsigned)(hi * 1024 + r32 * 16);
    float m = 0.f, l = 0.f; f32x16 o0 = f32x16{}, o1 = f32x16{};
    f32x16 zc = f32x16{};
    s16x4 vlo[8], vhi[8];
#define MLA_DMA(t_) do { const unsigned sl_ = lds0 + (unsigned)(((t_) & 3) * M_SLOT); _Pragma("unroll") for (int i_ = 0; i_ < 3; ++i_) { int q_ = wid + 8 * i_; if (q_ >= 20) q_ -= 16; { \
        const char* s_ = q_ < 12 ? Kg + (size_t)(t_) * 12288 + q_ * 1024 : Vg + (size_t)(t_) * 8192 + (q_ - 12) * 1024; glds16(s_, (unsigned)__builtin_amdgcn_readfirstlane(sl_ + q_ * 1024)); } } } while (0)
#define MLA_KRD(kb_, j_) do { if ((j_) & 1) asm volatile("ds_read_b128 %0, %1 offset:%c2" : "=&v"(kf1[(j_) >> 1]) : "v"(kb_), "i"(((j_) >> 1) * 2048 + 512) : "memory"); \
        else asm volatile("ds_read_b128 %0, %1 offset:%c2" : "=&v"(kf0[(j_) >> 1]) : "v"(kb_), "i"(((j_) >> 1) * 2048) : "memory"); } while (0)
#define MLA_VRD(vb_, j_) do { if ((j_) & 1) asm volatile("ds_read_b64_tr_b16 %0, %1 offset:%c2" : "=&v"(vhi[(j_) >> 1]) : "v"(vb_), "i"((((j_) >> 1) >> 2) * 4096 + (((j_) >> 1) & 3) * 1024 + 512) : "memory"); \
        else asm volatile("ds_read_b64_tr_b16 %0, %1 offset:%c2" : "=&v"(vlo[(j_) >> 1]) : "v"(vb_), "i"((((j_) >> 1) >> 2) * 4096 + (((j_) >> 1) & 3) * 1024) : "memory"); } while (0)
#define MLA_KF_READY() asm volatile("s_waitcnt lgkmcnt(0)" : "+v"(kf0[0]), "+v"(kf0[1]), "+v"(kf0[2]), "+v"(kf0[3]), "+v"(kf0[4]), "+v"(kf0[5]), "+v"(kf1[0]), "+v"(kf1[1]), "+v"(kf1[2]), "+v"(kf1[3]), "+v"(kf1[4]), "+v"(kf1[5]) :: "memory")
#define MLA_VF_READY() asm volatile("" : "+v"(vlo[0]), "+v"(vlo[1]), "+v"(vlo[2]), "+v"(vlo[3]), "+v"(vlo[4]), "+v"(vlo[5]), "+v"(vlo[6]), "+v"(vlo[7]), "+v"(vhi[0]), "+v"(vhi[1]), "+v"(vhi[2]), "+v"(vhi[3]), "+v"(vhi[4]), "+v"(vhi[5]), "+v"(vhi[6]), "+v"(vhi[7]) :: "memory")
#define SB() __builtin_amdgcn_sched_barrier(0)
#pragma unroll
    for (int i = 0; i < 8; ++i) { vlo[i] = s16x4{}; vhi[i] = s16x4{}; }
    MLA_DMA(0); MLA_DMA(1); MLA_DMA(2);
    ATT_WAIT_BAR(3);
    f32x16 p0, p1;
    { bf16x8 kf0[6], kf1[6]; const unsigned kb_ = lds0 + klane, vb_ = lds0 + 12288u + (unsigned)vlane;
#pragma unroll
      for (int j = 0; j < 12; ++j) MLA_KRD(kb_, j);
#pragma unroll
      for (int j = 0; j < 16; ++j) MLA_VRD(vb_, j);
      MLA_KF_READY();
#pragma unroll
      for (int d0 = 0; d0 < 6; ++d0) { p0 = __builtin_amdgcn_mfma_f32_32x32x16_bf16(kf0[d0], qr[d0], d0 == 0 ? zc : p0, 0, 0, 0); p1 = __builtin_amdgcn_mfma_f32_32x32x16_bf16(kf1[d0], qr[d0], d0 == 0 ? zc : p1, 0, 0, 0); }
      asm volatile("s_nop 15\n\ts_nop 7" : "+v"(p0), "+v"(p1));
      if (63 > qmin) mask_causal(p0, p1, 4 * hi - qpos); }
    if (wid >= 4) ATT_WAIT_BAR(3);
    for (int t = 0; t < NT; ++t) {
        const bool need = 64 * t <= qmin + 31, need1 = t + 1 < NT && 64 * (t + 1) <= qmin + 31;
        u32x4 pa[4];
        if (need) softmax_part_def_l<8>(p0, p1, m, l, zc, o0, o1, pa, wsf, r32, hi);
        SB();
        ATT_WAIT_BAR(3);
        MLA_VF_READY();
        if (t + 3 < NT) MLA_DMA(t + 3);
        bf16x8 kf0[6], kf1[6];
        const unsigned kb_ = lds0 + (unsigned)(((t + 1) & 3) * M_SLOT) + klane, vb_ = lds0 + (unsigned)(((t + 1) & 3) * M_SLOT + 12288 + vlane);
        if (need && need1) {
            bf16x8 v0[4], v1[4];
#pragma unroll
            for (int ks = 0; ks < 4; ++ks) { v0[ks] = (bf16x8){vlo[ks][0], vlo[ks][1], vlo[ks][2], vlo[ks][3], vhi[ks][0], vhi[ks][1], vhi[ks][2], vhi[ks][3]};
                v1[ks] = (bf16x8){vlo[4 + ks][0], vlo[4 + ks][1], vlo[4 + ks][2], vlo[4 + ks][3], vhi[4 + ks][0], vhi[4 + ks][1], vhi[4 + ks][2], vhi[4 + ks][3]}; }
            SB();
#pragma unroll
            for (int ks = 0; ks < 4; ++ks) { const bf16x8 a = __builtin_bit_cast(bf16x8, pa[ks]);
                o0 = __builtin_amdgcn_mfma_f32_32x32x16_bf16(a, v0[ks], o0, 0, 0, 0); SB(); MLA_KRD(kb_, 3 * ks); MLA_KRD(kb_, 3 * ks + 1); SB();
                o1 = __builtin_amdgcn_mfma_f32_32x32x16_bf16(a, v1[ks], o1, 0, 0, 0); SB(); MLA_KRD(kb_, 3 * ks + 2); SB(); }
            MLA_KF_READY();
            SB();
#pragma unroll
            for (int d0 = 0; d0 < 6; ++d0) {
                p0 = __builtin_amdgcn_mfma_f32_32x32x16_bf16(kf0[d0], qr[d0], d0 == 0 ? zc : p0, 0, 0, 0); SB(); MLA_VRD(vb_, 3 * d0); if (d0 < 5) MLA_VRD(vb_, 3 * d0 + 1); SB();
                p1 = __builtin_amdgcn_mfma_f32_32x32x16_bf16(kf1[d0], qr[d0], d0 == 0 ? zc : p1, 0, 0, 0); SB(); if (d0 < 5) MLA_VRD(vb_, 3 * d0 + 2); SB(); }
            asm volatile("s_nop 15\n\ts_nop 7" : "+v"(p0), "+v"(p1));
            if (64 * (t + 1) + 63 > qmin) mask_causal(p0, p1, 64 * (t + 1) + 4 * hi - qpos);
        } else if (need) {
#pragma unroll
            for (int ks = 0; ks < 4; ++ks) {
                const bf16x8 v0 = (bf16x8){vlo[ks][0], vlo[ks][1], vlo[ks][2], vlo[ks][3], vhi[ks][0], vhi[ks][1], vhi[ks][2], vhi[ks][3]};
                const bf16x8 v1 = (bf16x8){vlo[4 + ks][0], vlo[4 + ks][1], vlo[4 + ks][2], vlo[4 + ks][3], vhi[4 + ks][0], vhi[4 + ks][1], vhi[4 + ks][2], vhi[4 + ks][3]};
                const bf16x8 a = __builtin_bit_cast(bf16x8, pa[ks]);
                o0 = __builtin_amdgcn_mfma_f32_32x32x16_bf16(a, v0, o0, 0, 0, 0);
                o1 = __builtin_amdgcn_mfma_f32_32x32x16_bf16(a, v1, o1, 0, 0, 0); }
        }
        SB();
        if (t + 3 < NT) ATT_WAIT_BAR(3); else ATT_WAIT_BAR(0);
    }
    if (wid < 4) ATT_WAIT_BAR(0);
#undef MLA_DMA
#undef MLA_KRD
#undef MLA_VRD
#undef MLA_KF_READY
#undef MLA_VF_READY
#undef SB
    const float lt = xsum(l); const float inv = lt > 0.f ? 1.0f / lt : 0.f;
    f32x16 a0 = f32x16{}, a1 = f32x16{};
    add_scaled(a0, a1, o0, o1, inv, wsf, r32, hi);
    store_o(a0, a1, (LAS bf16*)(lds + M_OST + wid * 4096), Ob + ((size_t)b * 8192 + qmin) * opitch + h * 64, opitch, lane, r32, hi);
    __syncthreads();
}
#else
constexpr int M_SLOT = 20480, M_WSF = 81920, M_OST = 83968;
template <int DIAG = 0> __device__ __forceinline__ void mla_unit(int b, int h, int qb, const bf16* Qm, const bf16* Km, const bf16* Vm, bf16* Ob, LAS char* lds, int wave_id, int opitch = 1024) {
    int tid_ = wave_id * 64 + opaque_lane();
    const int tid = tid_, lane = tid & 63, r32 = lane & 31, hi = lane >> 5, wid = __builtin_amdgcn_readfirstlane(tid >> 6);
    const int q0 = qb * 256, NT = (q0 + 256) / 64;
    const int qmin = q0 + wid * 32, qpos = qmin + r32;
    bf16x8 qr[6];
    { const bf16* qp = Qm + ((size_t)b * 8192 + qpos) * 768 + h * 96 + hi * 8;
#pragma unroll
      for (int d0 = 0; d0 < 6; ++d0) qr[d0] = *(const bf16x8*)(qp + d0 * 16); }
    const char* Kg = (const char*)(Km + (size_t)(b * 8 + h) * 128 * 6144) + lane * 16;
    const char* Vg = (const char*)(Vm + (size_t)(b * 8 + h) * 128 * 4096) + lane * 16;
    const unsigned lds0 = (unsigned)(uintptr_t)lds;
    LAS float* wsf = (LAS float*)(lds + M_WSF) + wid * 64;
    const int vlane = ((lane >> 4) & 1) * 32 + (lane & 3) * 8 + (4 * hi + ((lane & 15) >> 2)) * 64;
    float m = 0.f, l = 0.f; f32x16 o0 = f32x16{}, o1 = f32x16{};
    f32x16 zc = f32x16{};
#define MLA_DMA(t_) do { const unsigned sl_ = lds0 + (unsigned)(((t_) & 3) * M_SLOT); _Pragma("unroll") for (int i_ = 0; i_ < 3; ++i_) { int q_ = wid + 8 * i_; if (q_ >= 20) q_ -= 16; { \
        const char* s_ = q_ < 12 ? Kg + (size_t)(t_) * 12288 + q_ * 1024 : Vg + (size_t)(t_) * 8192 + (q_ - 12) * 1024; glds16(s_, (unsigned)__builtin_amdgcn_readfirstlane(sl_ + q_ * 1024)); } } } while (0)
#define MLA_QK(P0, P1, t_) do { qk_tile_c<6>(P0, P1, (lcp)(lds + ((t_) & 3) * M_SLOT), qr, zc, zc, r32, hi); if (64 * (t_) + 63 > qmin) mask_causal(P0, P1, 64 * (t_) + 4 * hi - qpos); } while (0)
    MLA_DMA(0); MLA_DMA(1); MLA_DMA(2);
    ATT_WAIT_BAR(3);
    f32x16 p0, p1;
    MLA_QK(p0, p1, 0);
    if (wid >= 4) ATT_WAIT_BAR(0);
    for (int t = 0; t < NT; ++t) {
        const bool need = 64 * t <= qmin + 31;
        u32x4 pa[4];
        if (need && !(DIAG & 2)) softmax_part_def_l<8>(p0, p1, m, l, zc, o0, o1, pa, wsf, r32, hi);
        if (DIAG & 2) { pa[0] = pa[1] = pa[2] = pa[3] = (u32x4){0u, 0u, 0u, 0u}; }
        ATT_WAIT_BAR(3);
        if (t + 3 < NT && !(DIAG & 1)) MLA_DMA(t + 3);
        if (need && !(DIAG & 4)) pv_tile(o0, o1, (lcp)(lds + (t & 3) * M_SLOT + 12288 + vlane), pa);
        if (t + 1 < NT && 64 * (t + 1) <= qmin + 31 && !(DIAG & 4)) MLA_QK(p0, p1, t + 1);
        if (DIAG & 8) continue;
        if (t + 3 < NT) ATT_WAIT_BAR(3); else ATT_WAIT_BAR(0);
    }
    if (wid < 4) ATT_WAIT_BAR(0);
#undef MLA_DMA
#undef MLA_QK
    const float lt = xsum(l); const float inv = lt > 0.f ? 1.0f / lt : 0.f;
    f32x16 a0 = f32x16{}, a1 = f32x16{};
    add_scaled(a0, a1, o0, o1, inv, wsf, r32, hi);
    store_o(a0, a1, (LAS bf16*)(lds + M_OST + wid * 4096), Ob + ((size_t)b * 8192 + qmin) * opitch + h * 64, opitch, lane, r32, hi);
    __syncthreads();
}
#endif
#endif
#endif
constexpr int N_KS = 0, N_VS = 16384, N_STG = 32768, N_IMP = 32768, N_WSF = 66048, N_ACC = 68096, N_SEL = 133632, N_UNI = 134656, N_BL = 134720, IMPS = 129;
struct NsaT { const bf16 *Qn, *Kc, *Vc, *Ksel, *Vsel, *Kwin, *Vwin; const float* gates; bf16* Oa; int opitch; };
__device__ __forceinline__ void setbit(unsigned (&w)[4], int j) { const int wi = j >> 5; const unsigned bv = 1u << (j & 31); w[0] |= wi == 0 ? bv : 0u; w[1] |= wi == 1 ? bv : 0u; w[2] |= wi == 2 ? bv : 0u; w[3] |= wi == 3 ? bv : 0u; }
template <int DIAG = 0> __device__ __forceinline__ void nsa_unit(int b, int g, int ti, const NsaT& T, LAS char* lds, int wave_id) {
    int tid_ = wave_id * 64 + opaque_lane();
    const int tid = tid_, lane = tid & 63, r32 = lane & 31, hi = lane >> 5, wid = __builtin_amdgcn_readfirstlane(tid >> 6);
    const int hh = wid & 3, qh = wid >> 2, H = g * 4 + hh, bg = b * 2 + g;
    const int t0 = ti * 64, qrow = qh * 32 + r32, t = t0 + qrow;
    const float slope2 = __builtin_amdgcn_exp2f(-(float)(H + 1)) * LOG2E;
    bf16x8 qr[4];
    { const bf16* qp = T.Qn + ((size_t)b * 8192 + t) * 512 + H * 64 + hi * 8;
#pragma unroll
      for (int d0 = 0; d0 < 4; ++d0) qr[d0] = *(const bf16x8*)(qp + d0 * 16); }
    LAS float* wsf = (LAS float*)(lds + N_WSF) + wid * 64;
    LAS float* imp = (LAS float*)(lds + N_IMP);
    LAS unsigned* selw = (LAS unsigned*)(lds + N_SEL);
    LAS unsigned* uni = (LAS unsigned*)(lds + N_UNI);
    LAS unsigned* blist = (LAS unsigned*)(lds + N_BL);
    const int vlane = ((lane >> 4) & 1) * 32 + (lane & 3) * 8 + (4 * hi + ((lane & 15) >> 2)) * 64;
    for (int i = tid; i < 64 * IMPS; i += 512) imp[i] = 0.f;
    if (tid < 256) selw[tid] = 0u;
    if (tid < 8) uni[tid] = 0u;
    const float* gp = T.gates + ((size_t)b * 8192 + t) * 24 + H * 3;
    const float gc = gp[0], gs = gp[1], gw = gp[2];
    LAS float* accL = (LAS float*)(lds + N_ACC) + wid * 2048;
    u32x4 kr0, vr0;
    const int ntc = (4 * ti + 3 + 63) >> 6;
    const char* Kcg = (const char*)(T.Kc + (size_t)bg * 8 * 4096); const char* Vcg = (const char*)(T.Vc + (size_t)bg * 8 * 4096);
    float m = -1e30f, l = 0.f;
    f32x16 cb0;
#pragma unroll
    for (int r = 0; r < 16; ++r) cb0[r] = slope2 * 16.0f * (float)crow(r, hi);
    const int nmax = (t - 31) >> 4;
    const int nmax_min = (t0 + qh * 32 - 31) >> 4;
#define CMP_QK(P0, P1, kt_, sl_) do { float s512 = 512.0f * slope2; asm volatile("" : "+v"(s512)); const f32x16 cb1 = cb0 + s512; \
        qk_tile_c<4>(P0, P1, (lcp)(lds + N_KS + (sl_) * 8192), qr, cb0, cb1, r32, hi); \
        if (64 * (kt_) + 63 > nmax_min) mask_causal(P0, P1, 64 * (kt_) + 4 * hi - nmax); } while (0)
    kr0 = *(const u32x4*)(Kcg + tid * 16); *(LAS u32x4*)(lds + N_KS + tid * 16) = kr0;
    __syncthreads();
    for (int kt = 0; kt < ((DIAG & 33) ? 0 : ntc); ++kt) {
        const int sl = kt & 1;
        if (kt + 1 < ntc) kr0 = *(const u32x4*)(Kcg + (size_t)(kt + 1) * 8192 + tid * 16);
        { f32x16 p0, p1; CMP_QK(p0, p1, kt, sl);
          const float off = slope2 * (float)(1024 * kt + 31 - t);
          const float mn = fmaxf(m, max32(p0, p1) + off); const float ca = mn - off; float s = 0.f;
#pragma unroll
          for (int r = 0; r < 16; ++r) s += __builtin_amdgcn_exp2f(p0[r] - ca) + __builtin_amdgcn_exp2f(p1[r] - ca);
          l = l * __builtin_amdgcn_exp2f(m - mn) + s; m = mn; }
        if (kt + 1 < ntc) *(LAS u32x4*)(lds + N_KS + (sl ^ 1) * 8192 + tid * 16) = kr0;
        __syncthreads();
    }
    { auto rm_ = __builtin_amdgcn_permlane32_swap(__float_as_uint(m), __float_as_uint(m), false, false); auto rl_ = __builtin_amdgcn_permlane32_swap(__float_as_uint(l), __float_as_uint(l), false, false);
      const float mo = __uint_as_float(hi ? rm_[0] : rm_[1]), lo = __uint_as_float(hi ? rl_[0] : rl_[1]); const float mn = fmaxf(m, mo);
      l = l * __builtin_amdgcn_exp2f(m - mn) + lo * __builtin_amdgcn_exp2f(mo - mn); m = mn; }
    const float mlog = l > 0.f ? m + __builtin_amdgcn_logf(l) : 1e30f;
    f32x16 o0 = f32x16{}, o1 = f32x16{};
    float carry = 0.f;
#pragma unroll
    for (int i = 0; i < 32; ++i) accL[i * 64 + lane] = 0.f;
    kr0 = *(const u32x4*)(Kcg + tid * 16); vr0 = *(const u32x4*)(Vcg + tid * 16);
    *(LAS u32x4*)(lds + N_KS + tid * 16) = kr0; *(LAS u32x4*)(lds + N_VS + tid * 16) = vr0;
    __syncthreads();
    for (int kt = 0; kt < ((DIAG & 1) ? 0 : ntc); ++kt) {
        const int sl = kt & 1;
        if (kt + 1 < ntc) { kr0 = *(const u32x4*)(Kcg + (size_t)(kt + 1) * 8192 + tid * 16); vr0 = *(const u32x4*)(Vcg + (size_t)(kt + 1) * 8192 + tid * 16); }
        { f32x16 p0, p1; CMP_QK(p0, p1, kt, sl);
          const float ca = mlog - slope2 * (float)(1024 * kt + 31 - t);
#pragma unroll
          for (int r = 0; r < 16; ++r) { p0[r] = __builtin_amdgcn_exp2f(p0[r] - ca); p1[r] = __builtin_amdgcn_exp2f(p1[r] - ca); }
          { float PL0[4], PL1[4];
#pragma unroll
            for (int rg = 0; rg < 4; ++rg) {
                auto x0 = __builtin_amdgcn_permlane32_swap(__float_as_uint(p0[4 * rg + 3]), __float_as_uint(p0[4 * rg + 3]), false, false); PL0[rg] = __uint_as_float(hi ? x0[0] : x0[1]);
                auto x1 = __builtin_amdgcn_permlane32_swap(__float_as_uint(p1[4 * rg + 3]), __float_as_uint(p1[4 * rg + 3]), false, false); PL1[rg] = __uint_as_float(hi ? x1[0] : x1[1]); }
            const int jb = 16 * (kt & 3) + hi;
#pragma unroll
            for (int rg = 0; rg < 4; ++rg) {
                const float v0 = (p0[4 * rg] + p0[4 * rg + 1]) + (p0[4 * rg + 2] + p0[4 * rg + 3]) + (hi ? PL0[rg] : (rg > 0 ? PL0[rg - 1] : carry));
                const float v1 = (p1[4 * rg] + p1[4 * rg + 1]) + (p1[4 * rg + 2] + p1[4 * rg + 3]) + (hi ? PL1[rg] : (rg > 0 ? PL1[rg - 1] : PL0[3]));
                accL[r32 * 64 + ((jb + 2 * rg + r32) & 63)] = v0; accL[r32 * 64 + ((jb + 8 + 2 * rg + r32) & 63)] = v1; }
            carry = PL1[3]; }
          u32x4 pa[4]; pack_p(pa, p0, p1);
          pv_tile(o0, o1, (lcp)(lds + N_VS + sl * 8192 + vlane), pa); }
        if (kt + 1 < ntc) { *(LAS u32x4*)(lds + N_KS + (sl ^ 1) * 8192 + tid * 16) = kr0; *(LAS u32x4*)(lds + N_VS + (sl ^ 1) * 8192 + tid * 16) = vr0; }
        __syncthreads();
        if ((kt & 3) == 3 || kt == ntc - 1) {
            { const int q = tid >> 3, jj0 = (tid & 7) * 8, row = q & 31; const LAS float* pb = (const LAS float*)(lds + N_ACC) + ((q >> 5) * 4) * 2048 + row * 64;
#pragma unroll
              for (int e = 0; e < 8; ++e) { const int ix = (jj0 + e + row) & 63; imp[q * IMPS + 64 * (kt >> 2) + jj0 + e] = (pb[ix] + pb[2048 + ix]) + (pb[4096 + ix] + pb[6144 + ix]); } }
            __syncthreads();
            if (kt != ntc - 1) {
#pragma unroll
                for (int i = 0; i < 32; ++i) accL[i * 64 + lane] = 0.f; }
        }
    }
#undef CMP_QK
    acc_lds<true>(accL, o0, o1, gc, wsf, r32, hi);
    {
        const int q = tid >> 3, sub = tid & 7;
        unsigned w[4] = {0u, 0u, 0u, 0u};
        if (ti <= 15 || (DIAG & 2)) { if (sub == 0) w[0] = (ti <= 15) ? (2u << ti) - 1u : 0xffffu; }
        else {
            const LAS float* row = imp + q * IMPS;
            unsigned vb[16]; bool ok[16];
#pragma unroll
            for (int k = 0; k < 16; ++k) { const int j = 1 + sub + 8 * k; ok[k] = j <= ti - 2; vb[k] = ok[k] ? __float_as_uint(row[j]) : 0u; }
            unsigned T = 0u;
#pragma unroll 1
            for (int bit = 30; bit >= 0; --bit) { const unsigned trial = T | (1u << bit); int c = 0;
#pragma unroll
                for (int k = 0; k < 16; ++k) c += (ok[k] && vb[k] >= trial) ? 1 : 0;
                c = dpp_sum8(c);
                if (c >= 13) T = trial; }
            int cgt = 0;
#pragma unroll
            for (int k = 0; k < 16; ++k) cgt += (ok[k] && vb[k] > T) ? 1 : 0;
            cgt = dpp_sum8(cgt);
            const int need_eq = 13 - cgt; int running = 0;
            const int gsh = 8 * ((tid & 63) >> 3);
#pragma unroll
            for (int k = 0; k < 16; ++k) { const int j = 1 + sub + 8 * k; const bool eq = ok[k] && vb[k] == T, gt = ok[k] && vb[k] > T;
                const unsigned g8 = (unsigned)(__ballot(eq) >> gsh) & 0xffu;
                const int rank = running + __builtin_popcount(g8 & ((1u << sub) - 1u));
                if (gt || (eq && rank < need_eq)) setbit(w, j);
                running += __builtin_popcount(g8); }
            if (sub == 0) { w[0] |= 1u; setbit(w, ti); setbit(w, ti - 1); }
        }
#pragma unroll
        for (int k = 0; k < 4; ++k) if (w[k]) { __hip_atomic_fetch_or(selw + q * 4 + k, w[k], __ATOMIC_RELAXED, __HIP_MEMORY_SCOPE_WORKGROUP); __hip_atomic_fetch_or(uni + k, w[k], __ATOMIC_RELAXED, __HIP_MEMORY_SCOPE_WORKGROUP); }
    }
    __syncthreads();
    if (tid < 128) {
        const unsigned u0 = uni[0], u1 = uni[1], u2 = uni[2], u3 = uni[3]; const int k = tid >> 5, bb = tid & 31;
        const unsigned uk = k == 0 ? u0 : k == 1 ? u1 : k == 2 ? u2 : u3;
        const int c0 = __builtin_popcount(u0), c1 = __builtin_popcount(u1), c2 = __builtin_popcount(u2), c3 = __builtin_popcount(u3);
        if ((uk >> bb) & 1u) blist[__builtin_popcount(uk & ((1u << bb) - 1u)) + (k > 0 ? c0 : 0) + (k > 1 ? c1 : 0) + (k > 2 ? c2 : 0)] = (unsigned)tid;
        if (tid == 0) uni[4] = (unsigned)(c0 + c1 + c2 + c3); }
    __syncthreads();
    const int nsel = (int)uni[4];
    unsigned sw[4];
#pragma unroll
    for (int k = 0; k < 4; ++k) sw[k] = selw[qrow * 4 + k];
    f32x16 bias0, bias1;
#pragma unroll
    for (int r = 0; r < 16; ++r) { bias0[r] = slope2 * (float)crow(r, hi); bias1[r] = bias0[r] + 32.0f * slope2; }
#define NSA_DMA(Kg_, Vg_, ja_, jb_, stg_) do { dma1k(Kg_ + (size_t)(ja_) * 8192, lds + (stg_) * N_STG + wid * 1024); dma1k(Kg_ + (size_t)(jb_) * 8192, lds + (stg_) * N_STG + 8192 + wid * 1024); \
        dma1k(Vg_ + (size_t)(ja_) * 8192, lds + (stg_) * N_STG + 16384 + wid * 1024); dma1k(Vg_ + (size_t)(jb_) * 8192, lds + (stg_) * N_STG + 24576 + wid * 1024); } while (0)
    if (!(DIAG & 4)) {
        const char* Kg = (const char*)(T.Ksel + (size_t)bg * 128 * 4096) + wid * 1024 + lane * 16; const char* Vg = (const char*)(T.Vsel + (size_t)bg * 128 * 4096) + wid * 1024 + lane * 16;
        m = -1e30f; l = 0.f; o0 = f32x16{}; o1 = f32x16{};
        const int npair = (nsel + 1) >> 1;
        int ja = (int)blist[0], jb = nsel > 1 ? (int)blist[1] : ja;
        NSA_DMA(Kg, Vg, ja, jb, 0);
        __syncthreads();
        for (int p = 0; p < npair; ++p) {
            const int st = p & 1; int na = 0, nb = 0;
            if (p + 1 < npair) { na = (int)blist[2 * p + 2]; nb = (2 * p + 3 < nsel) ? (int)blist[2 * p + 3] : na; NSA_DMA(Kg, Vg, na, nb, st ^ 1); }
            const int wa = ja >> 5, wb = jb >> 5;
            const unsigned swa = wa == 0 ? sw[0] : wa == 1 ? sw[1] : wa == 2 ? sw[2] : sw[3], swb = wb == 0 ? sw[0] : wb == 1 ? sw[1] : wb == 2 ? sw[2] : sw[3];
            const bool minea = (swa >> (ja & 31)) & 1u, mineb = ((swb >> (jb & 31)) & 1u) && (2 * p + 1 < nsel);
            if (__any(minea || mineb))
            { LAS char* sb = lds + st * N_STG;
              f32x16 p0, p1, p2, p3;
              qk_tile_c<4>(p0, p1, (lcp)sb, qr, bias0, bias1, r32, hi);
              qk_tile_c<4>(p2, p3, (lcp)(sb + 8192), qr, bias0, bias1, r32, hi);
              if (ja == ti) mask_causal(p0, p1, 64 * ja + 4 * hi - t);
              if (jb == ti) mask_causal(p2, p3, 64 * jb + 4 * hi - t);
              const float offa = minea ? slope2 * (float)(64 * ja - t) : -INFINITY, offb = mineb ? slope2 * (float)(64 * jb - t) : -INFINITY;
              softmax_pv2(p0, p1, p2, p3, offa, offb, m, l, o0, o1, (lcp)(sb + 16384 + vlane), (lcp)(sb + 24576 + vlane), wsf, r32, hi); }
            ja = na; jb = nb;
            __syncthreads();
        }
        const float lt = xsum(l); acc_lds<false>(accL, o0, o1, lt > 0.f ? gs / lt : 0.f, wsf, r32, hi);
    }
    if (!(DIAG & 8)) {
        const char* Kg = (const char*)(T.Kwin + (size_t)bg * 128 * 4096) + wid * 1024 + lane * 16; const char* Vg = (const char*)(T.Vwin + (size_t)bg * 128 * 4096) + wid * 1024 + lane * 16;
        m = -1e30f; l = 0.f; o0 = f32x16{}; o1 = f32x16{};
        const int j0 = ti >= 8 ? ti - 8 : 0, nw = ti - j0 + 1, npair = (nw + 1) >> 1;
        NSA_DMA(Kg, Vg, j0, (nw > 1 ? j0 + 1 : j0), 0);
        __syncthreads();
        for (int p = 0; p < npair; ++p) {
            const int st = p & 1; const int ja = j0 + 2 * p; const bool hasb = (2 * p + 1 < nw); const int jb = hasb ? ja + 1 : ja;
            if (p + 1 < npair) { const int na = ja + 2, nb = (2 * p + 3 < nw) ? na + 1 : na; NSA_DMA(Kg, Vg, na, nb, st ^ 1); }
            { LAS char* sb = lds + st * N_STG;
              f32x16 p0, p1, p2, p3;
              qk_tile_c<4>(p0, p1, (lcp)sb, qr, bias0, bias1, r32, hi);
              qk_tile_c<4>(p2, p3, (lcp)(sb + 8192), qr, bias0, bias1, r32, hi);
              if (ja == ti) mask_causal(p0, p1, 64 * ja + 4 * hi - t);
              if (jb == ti) mask_causal(p2, p3, 64 * jb + 4 * hi - t);
              if (ja == ti - 8) mask_winlow(p0, p1, 64 * ja + 4 * hi - t);
              if (jb == ti - 8) mask_winlow(p2, p3, 64 * jb + 4 * hi - t);
              const float offa = slope2 * (float)(64 * ja - t), offb = hasb ? slope2 * (float)(64 * jb - t) : -INFINITY;
              softmax_pv2(p0, p1, p2, p3, offa, offb, m, l, o0, o1, (lcp)(sb + 16384 + vlane), (lcp)(sb + 24576 + vlane), wsf, r32, hi); }
            __syncthreads();
        }
        const float lt = xsum(l); acc_lds<false>(accL, o0, o1, lt > 0.f ? gw / lt : 0.f, wsf, r32, hi);
    }
#undef NSA_DMA
    store_acc(accL, T.Oa + ((size_t)b * 8192 + t0 + qh * 32) * T.opitch + H * 64, T.opitch, lane);
    __syncthreads();
}

#endif

}
#define XLAS __attribute__((address_space(3)))
#define XB_TMO      128
#define XB_XCNT(j)  (256  + 64 * (j))
#define XB_XSUB(j)  (1280 + 64 * (j))
#define XB_XGEN(j)  (2304 + 64 * (j))
#define XB_TOP      3328
#define XB_TOPGEN   3392
#define XCD_BAR_WORDS 3456
#define XB_SPIN_CAP (1u << 18)

__device__ __forceinline__ unsigned xb_ld(unsigned* p)              { return __hip_atomic_load(p, __ATOMIC_RELAXED, __HIP_MEMORY_SCOPE_AGENT); }
__device__ __forceinline__ unsigned xb_add(unsigned* p, unsigned v) { return __hip_atomic_fetch_add(p, v, __ATOMIC_RELAXED, __HIP_MEMORY_SCOPE_AGENT); }
__device__ __forceinline__ unsigned xb_xcc_id() { return (unsigned)__builtin_amdgcn_s_getreg((3 << 11) | 20) & 0xFu; }
#define XB_SPIN(cond, bar) do { unsigned _sp = 0; while (cond) { __builtin_amdgcn_s_sleep(1); \
    if ((++_sp & 255u) == 0u) { if (xb_ld(&(bar)[XB_TMO])) break; if (_sp > XB_SPIN_CAP) { atomicAdd(&(bar)[XB_TMO], 1u); break; } } } } while (0)

struct XcdBarrier {
    unsigned* bar; unsigned x;
    volatile XLAS unsigned* st;
};

__device__ __forceinline__ XcdBarrier xcd_barrier_post(unsigned* bar, volatile XLAS unsigned* st) {
    XcdBarrier b; b.bar = bar; b.x = xb_xcc_id(); b.st = st;
    if (threadIdx.x == 0) (void)xb_add(&bar[XB_XCNT(b.x)], 1u);
    return b;
}
__device__ __forceinline__ void xcd_barrier_complete(unsigned* bar, unsigned x, unsigned& nloc, unsigned& nx) {
    const unsigned G = gridDim.x * gridDim.y * gridDim.z;
    unsigned sum, cnt, mine, sp = 0u;
    for (;;) {
        sum = 0u; cnt = 0u; mine = 0u;
#pragma unroll
        for (unsigned j = 0; j < 16; ++j) { const unsigned c = xb_ld(&bar[XB_XCNT(j)]); sum += c; cnt += (c > 0u) ? 1u : 0u; mine = (j == x) ? c : mine; }
        if (sum == G) break;
        __builtin_amdgcn_s_sleep(1);
        if ((++sp & 255u) == 0u) { if (xb_ld(&bar[XB_TMO])) break; if (sp > XB_SPIN_CAP) { atomicAdd(&bar[XB_TMO], 1u); break; } }
    }
    nloc = mine > 0u ? mine : 1u; nx = cnt > 0u ? cnt : 1u;
}

__device__ __forceinline__ void xcd_barrier(const XcdBarrier& b0, int wave_id) {
    XcdBarrier b = b0; { unsigned long long bp_ = (unsigned long long)b0.bar; unsigned bx_ = b0.x; asm volatile("" : "+s"(bp_), "+s"(bx_)); b.bar = (unsigned*)(__attribute__((address_space(1))) unsigned*)bp_; b.x = bx_; }
    asm volatile("s_waitcnt vmcnt(0)" ::: "memory");
    __syncthreads();
    if (wave_id == 0 && opaque_lane() == 0) {
        unsigned* bar = b.bar;
        __builtin_amdgcn_s_waitcnt(0);
        unsigned nloc = b.st[0], nx = b.st[1];
        if (nloc == 0u) { xcd_barrier_complete(bar, b.x, nloc, nx); b.st[0] = nloc; b.st[1] = nx; }
        const unsigned old = xb_add(&bar[XB_XSUB(b.x)], 1u);
        const unsigned gen = old / nloc;
        if (old + 1u == (gen + 1u) * nloc) {
            __builtin_amdgcn_fence(__ATOMIC_RELEASE, "agent");
            asm volatile("s_waitcnt vmcnt(0)" ::: "memory");
            const unsigned og = xb_add(&bar[XB_TOP], 1u);
            const unsigned tg = og / nx;
            if (og + 1u == (tg + 1u) * nx) xb_add(&bar[XB_TOPGEN], 1u);
            else XB_SPIN(xb_ld(&bar[XB_TOPGEN]) == tg, bar);
            __builtin_amdgcn_fence(__ATOMIC_ACQUIRE, "agent");
            xb_add(&bar[XB_XGEN(b.x)], 1u);
            asm volatile("s_waitcnt vmcnt(0)" ::: "memory");
        } else {
            XB_SPIN(xb_ld(&bar[XB_XGEN(b.x)]) == gen, bar);
            __builtin_amdgcn_fence(__ATOMIC_ACQUIRE, "agent");
            asm volatile("s_waitcnt vmcnt(0)" ::: "memory");
        }
    }
    __syncthreads();
}
#define GLAS __attribute__((address_space(3)))
typedef unsigned short bf16_t;
typedef float f32x4 __attribute__((ext_vector_type(4)));
typedef unsigned u32x4 __attribute__((ext_vector_type(4)));
constexpr int NT_TOK = 16384, SEQ = 8192, DM = 1024, DFF = 2816, NTHREADS = 512, NWAVES = 8;
struct KArgs { const float* in[26]; float* out; unsigned char* ws; };
struct ArgRef { unsigned char* ws;
    __device__ __forceinline__ const float* in_(int i) const { const __attribute__((address_space(4))) KArgs* p = (const __attribute__((address_space(4))) KArgs*)__builtin_amdgcn_kernarg_segment_ptr(); asm volatile("" : "+s"(p)); const unsigned long long v_ = *(const __attribute__((address_space(4))) unsigned long long*)(&p->in[i]); return (const float*)(const __attribute__((address_space(1))) float*)v_; }
};

__device__ __forceinline__ unsigned f2bf_rne(float f) { unsigned u = __builtin_bit_cast(unsigned, f); return (u + 0x7fffu + ((u >> 16) & 1u)) >> 16; }
typedef float pk_f32x2_t __attribute__((ext_vector_type(2))); typedef __bf16 pk_bf16x2_t __attribute__((ext_vector_type(2)));
__device__ __forceinline__ unsigned pk2(float lo, float hi) { pk_f32x2_t v = {lo, hi}; pk_bf16x2_t b = __builtin_convertvector(v, pk_bf16x2_t); return __builtin_bit_cast(unsigned, b); }

struct WSrc { const float* p; int ld; };
template <class Map> __device__ __forceinline__ void conv_weight(int MODE, GLAS float* scr, int lane, int gw, int ngw, int& ioff, int K, int N, bf16_t* WT, const float* kscale, Map map, int ldw = 0, int koff = 0) {
    unsigned sink_ = 0u;
    if (ldw == 0) ldw = K;
    asm volatile("" : "+v"(lane));
    const int nblk = N / 64, nitems = (K / 64) * nblk;
    const int first = (gw + ngw - ioff) % ngw; ioff = (ioff + nitems) % ngw;
    for (int it = first; it < nitems; it += ngw) {
        const int kb = it / nblk, nb = it % nblk, k0 = 64 * kb, n0 = 64 * nb;
        const WSrc s0 = map(n0), s63 = map(n0 + 63), s31 = map(n0 + 31), s1 = map(n0 + 1), s33 = map(n0 + 33);
        const bool fast = s0.p != nullptr && s63.p == s0.p + 63 && s31.p == s0.p + 31 && s1.p == s0.p + 1 && s33.p == s0.p + 33 && ((((uintptr_t)s0.p) | ((uintptr_t)s0.ld * 4u)) & 15u) == 0u;
        if (MODE == 4 && !fast) continue;
        if (fast) {
            const float* src = s0.p + (size_t)(k0 + (lane >> 4)) * s0.ld + (lane & 15) * 4;
            f32x4 v[16];
#pragma unroll
            for (int i = 0; i < 16; ++i) v[i] = __builtin_nontemporal_load((const f32x4*)(src + (size_t)(4 * i) * s0.ld));
#pragma unroll
            for (int i = 0; i < 16; ++i) { const int kk = 4 * i + (lane >> 4); f32x4 x = v[i]; if (kscale) x = x * kscale[k0 + kk]; if (MODE == 1 || MODE == 4) { sink_ ^= __float_as_uint(x.x) ^ __float_as_uint(x.y) ^ __float_as_uint(x.z) ^ __float_as_uint(x.w); continue; } GLAS float* d = scr + kk * 65 + (lane & 15) * 4; d[0] = x.x; d[1] = x.y; d[2] = x.z; d[3] = x.w; }
        } else {
            const WSrc sa = map(n0 + (lane & 31)), sb = map(n0 + 32 + (lane & 31));
            const float* pa = (sa.p ? sa.p : (const float*)WT) + (size_t)(k0 + (lane >> 5)) * sa.ld; const float* pb = (sb.p ? sb.p : (const float*)WT) + (size_t)(k0 + (lane >> 5)) * sb.ld;
            float t[64];
#pragma unroll
            for (int i = 0; i < 32; ++i) { t[i] = pa[(size_t)(2 * i) * sa.ld]; t[32 + i] = pb[(size_t)(2 * i) * sb.ld]; }
#pragma unroll
            for (int i = 0; i < 32; ++i) { const int kk = 2 * i + (lane >> 5); float a = sa.p ? t[i] : 0.f, b = sb.p ? t[32 + i] : 0.f; if (kscale) { const float ks = kscale[k0 + kk]; a *= ks; b *= ks; }
                if (MODE == 1 || MODE == 4) { sink_ ^= __float_as_uint(a) ^ __float_as_uint(b); continue; } scr[kk * 65 + (lane & 31)] = a; scr[kk * 65 + 32 + (lane & 31)] = b; }
        }
        if (MODE == 1 || MODE == 4) continue;
        asm volatile("s_waitcnt lgkmcnt(0)" ::: "memory");
        const int c = lane & 7;
#pragma unroll
        for (int j = 0; j < 8; ++j) { const int n = (lane >> 3) + 8 * j; const GLAS float* sp = scr + (8 * c) * 65 + n;
            u32x4 o; o.x = pk2(sp[0 * 65], sp[1 * 65]); o.y = pk2(sp[2 * 65], sp[3 * 65]); o.z = pk2(sp[4 * 65], sp[5 * 65]); o.w = pk2(sp[6 * 65], sp[7 * 65]);
            if (MODE == 2) { sink_ ^= o.x ^ o.y ^ o.z ^ o.w; continue; }
            *(u32x4*)(WT + (size_t)(n0 + n) * ldw + koff + k0 + 8 * c) = o; }
        asm volatile("s_waitcnt lgkmcnt(0)" ::: "memory");
    }
    if (MODE != 0 && sink_ == 0x9e3779b9u) *(unsigned*)(WT) = sink_;
}
constexpr unsigned CONV_ALL = 0xfffu, CONV_LATE = 4u | 8u, CONV_EARLY = 1u | 2u | 16u;
__device__ __forceinline__ void convert_layer(const ArgRef& A, int l, GLAS unsigned char* lds, int lane, int wave, int gw, int ngw, int MODE = 0, unsigned parts = CONV_ALL) {
    constexpr size_t dst_off = 0;
    GLAS float* scr = (GLAS float*)(lds + wave * 16640);
    int ioff = 0;
    unsigned char* ws = A.ws + dst_off;
    if (parts & 1u) { const float* G = A.in_(4) + (size_t)l * 1024 * 2816; const float* U = A.in_(5) + (size_t)l * 1024 * 2816;
      conv_weight(MODE, scr, lane, gw, ngw, ioff, 1024, 5632, (bf16_t*)(ws + W_GU1), nullptr, [=](int n) { const int tl = n >> 8, r = n & 255; const uintptr_t gp = (uintptr_t)G, up = (uintptr_t)U; return WSrc{(const float*)(const __attribute__((address_space(1))) float*)(gp + (up - gp) * (uintptr_t)(r >> 7)) + tl * 128 + (r & 127), 2816}; }); }
    if (parts & 2u) { const float* Dn = A.in_(6) + (size_t)l * 2816 * 1024; conv_weight(MODE, scr, lane, gw, ngw, ioff, 2816, 1024, (bf16_t*)(ws + W_D1), nullptr, [=](int n) { return WSrc{Dn + n, 1024}; }); }
    if (parts & 4u) { const float* G = A.in_(7) + (size_t)l * 1024 * 2816; const float* U = A.in_(8) + (size_t)l * 1024 * 2816;
      conv_weight(MODE, scr, lane, gw, ngw, ioff, 1024, 5632, (bf16_t*)(ws + W_GU2), nullptr, [=](int n) { const int tl = n >> 8, r = n & 255; const uintptr_t gp = (uintptr_t)G, up = (uintptr_t)U; return WSrc{(const float*)(const __attribute__((address_space(1))) float*)(gp + (up - gp) * (uintptr_t)(r >> 7)) + tl * 128 + (r & 127), 2816}; }); }
    if (parts & 8u) { const float* Dn = A.in_(9) + (size_t)l * 2816 * 1024; conv_weight(MODE, scr, lane, gw, ngw, ioff, 2816, 1024, (bf16_t*)(ws + W_D2), nullptr, [=](int n) { return WSrc{Dn + n, 1024}; }); }
    if (parts & 16u) { const float* Wi = A.in_(10) + (size_t)l * 1024 * 4024;
      conv_weight(MODE, scr, lane, gw, ngw, ioff, 1024, 4096, (bf16_t*)(ws + W_IN), nullptr, [=](int n) {
          int src;
          if (n < 1280) src = n;
          else if (n < 1536) src = 1688 + (n - 1280);
          else if (n < 1792) src = 1304 + (n - 1536);
          else if (n < 2048) { const int r = n - 1792;
              if (r < 128) src = 1304 + 256 + r;
              else if (r < 160) { const int p = r - 128; src = 1944 + ((p & 1) ? 16 + (p >> 1) : (p >> 1)); }
              else if (r < 184) src = 1280 + (r - 160);
              else src = -1; }
          else { const int q = n - 2048, j = q >> 8, r = q & 255; src = 1976 + (r >> 7) * 1024 + j * 128 + (r & 127); }
          return WSrc{src >= 0 ? Wi + src : nullptr, 4024}; }); }
    if (parts & 32u) { const float* Wq = A.in_(18) + (size_t)l * 384 * 768;
      conv_weight(MODE, scr, lane, gw, ngw, ioff, 384, 768, (bf16_t*)(ws + W_UQ), A.in_(17) + (size_t)l * 384, [=](int n) { const int h = n / 96, p = n % 96; int src = h * 96 + p;
          if (p >= 64) { const int pp = p - 64; src = h * 96 + 64 + ((pp & 1) ? 16 + (pp >> 1) : (pp >> 1)); }
          return WSrc{Wq + src, 768}; }); }
    if (parts & 64u) { const float* Wk = A.in_(20) + (size_t)l * 256 * 512; const float* Wv = A.in_(21) + (size_t)l * 256 * 512;
      conv_weight(MODE, scr, lane, gw, ngw, ioff, 256, 1024, (bf16_t*)(ws + W_UKV), A.in_(19) + (size_t)l * 256, [=](int n) { const uintptr_t kp = (uintptr_t)Wk, vp = (uintptr_t)Wv; return WSrc{(const float*)(const __attribute__((address_space(1))) float*)(kp + (vp - kp) * (uintptr_t)(n >> 9)) + (n & 511), 512}; }); }
    if (parts & 128u) { const float* Wa = A.in_(22) + (size_t)l * 512 * 1024; conv_weight(MODE, scr, lane, gw, ngw, ioff, 512, 1024, (bf16_t*)(ws + W_BA), nullptr, [=](int n) { return WSrc{Wa + n, 1024}; }, 1024, 0); }
    if (parts & 256u) { const float* Wb = A.in_(23) + (size_t)l * 512 * 1024; conv_weight(MODE, scr, lane, gw, ngw, ioff, 512, 1024, (bf16_t*)(ws + W_BA), nullptr, [=](int n) { return WSrc{Wb + n, 1024}; }, 1024, 512); }
    if (parts & 512u) { const float* Wo = A.in_(24) + (size_t)l * 1024 * 1024; conv_weight(MODE, scr, lane, gw, ngw, ioff, 1024, 1024, (bf16_t*)(ws + W_OUT), nullptr, [=](int n) { return WSrc{Wo + n, 1024}; }); }
    if (parts & 1024u) { const float* W1 = A.in_(11) + (size_t)l * 2048 * 64; conv_weight(MODE, scr, lane, gw, ngw, ioff, 2048, 64, (bf16_t*)(ws + W_1K), nullptr, [=](int n) { return WSrc{W1 + n, 64}; }); }
    if (parts & 2048u) { const float* W1 = A.in_(14) + (size_t)l * 2048 * 64; conv_weight(MODE, scr, lane, gw, ngw, ioff, 2048, 64, (bf16_t*)(ws + W_1V), nullptr, [=](int n) { return WSrc{W1 + n, 64}; }); }
}
__device__ __forceinline__ void norm_phase(const float* x, bf16_t* xn, const float* sh, const float* sc, int lane, int gw, int ngw) {
    asm volatile("" : "+v"(lane));
    for (int row = gw; row < NT_TOK; row += ngw) {
        const f32x4* xr = (const f32x4*)(x + (size_t)row * DM) + lane; const int b = row >> 13;
        f32x4 v[4]; float s = 0.f;
#pragma unroll
        for (int j = 0; j < 4; ++j) { v[j] = xr[64 * j]; s += (v[j].x * v[j].x + v[j].y * v[j].y) + (v[j].z * v[j].z + v[j].w * v[j].w); }
        const float rstd = 1.0f / sqrtf(wave_sum(s) * (1.0f / DM) + 1e-6f);
        unsigned long long* o8 = (unsigned long long*)(xn + (size_t)row * DM) + lane;
#pragma unroll
        for (int j = 0; j < 4; ++j) { const f32x4 a = *((const f32x4*)(sc + (size_t)b * 9216) + lane + 64 * j), c = *((const f32x4*)(sh + (size_t)b * 9216) + lane + 64 * j);
            const f32x4 y = v[j] * rstd * (a + 1.0f) + c;
            o8[64 * j] = (unsigned long long)pk2(y.x, y.y) | ((unsigned long long)pk2(y.z, y.w) << 32); }
    }
}
__device__ __forceinline__ void final_norm_phase(float* x, const float* wn, int lane, int gw, int ngw) {
    asm volatile("" : "+v"(lane));
    for (int row = gw; row < NT_TOK; row += ngw) {
        f32x4* xr = (f32x4*)(x + (size_t)row * DM) + lane;
        f32x4 v[4]; float s = 0.f;
#pragma unroll
        for (int j = 0; j < 4; ++j) { v[j] = xr[64 * j]; s += (v[j].x * v[j].x + v[j].y * v[j].y) + (v[j].z * v[j].z + v[j].w * v[j].w); }
        const float rstd = 1.0f / sqrtf(wave_sum(s) * (1.0f / DM) + 1e-6f);
#pragma unroll
        for (int j = 0; j < 4; ++j) { const f32x4 w = *((const f32x4*)wn + lane + 64 * j); xr[64 * j] = v[j] * rstd * w; }
    }
}
__device__ __forceinline__ void adaln_phase(const ArgRef& A, GLAS unsigned char* lds, int tid, int lane, int wave, int blk, int nblk) {
    asm volatile("" : "+v"(tid), "+v"(lane));
    GLAS float* ca = (GLAS float*)lds;
    GLAS float* red = (GLAS float*)(lds + 8192);
    for (int i = tid; i < 2048; i += NTHREADS) { const float c = A.in_(1)[i]; ca[i] = c / (1.0f + __expf(-c)); }
    __syncthreads();
    float* mod = (float*)(A.ws + WS_MOD);
    for (int u = blk; u < 256; u += nblk) {
        const int c0 = u * 72, l = c0 / 9216, n0 = c0 % 9216;
        const float* W = A.in_(2) + (size_t)l * 1024 * 9216 + n0;
        const int l2 = lane & 7;
        float a0 = 0.f, a1 = 0.f, b0 = 0.f, b1 = 0.f;
        const int kb = wave * 128;
#pragma unroll 16
        for (int k = 0; k < 128; ++k) { const float w = __builtin_nontemporal_load(W + (size_t)(kb + k) * 9216 + lane); const float w8 = __builtin_nontemporal_load(W + (size_t)(kb + k) * 9216 + 64 + l2);
            const float x0 = ca[kb + k], x1 = ca[1024 + kb + k]; a0 += x0 * w; a1 += x1 * w; b0 += x0 * w8; b1 += x1 * w8; }
        red[(wave * 2 + 0) * 72 + lane] = a0; red[(wave * 2 + 1) * 72 + lane] = a1;
        if (lane < 8) { red[(wave * 2 + 0) * 72 + 64 + lane] = b0; red[(wave * 2 + 1) * 72 + 64 + lane] = b1; }
        __syncthreads();
        if (tid < 144) { const int b = tid / 72, n = tid % 72; float s = A.in_(3)[(size_t)l * 9216 + n0 + n];
#pragma unroll
            for (int w = 0; w < 8; ++w) s += red[(w * 2 + b) * 72 + n];
            mod[((size_t)l * 2 + b) * 9216 + n0 + n] = s; }
        __syncthreads();
    }
}
__device__ __forceinline__ void rope_table_phase(float* cs, int gtid, int ngt) {
    for (int e = gtid; e < SEQ * 16; e += ngt) { const int t = e >> 4, i = e & 15;
        const float inv = powf(10000.0f, -(float)i / 16.0f); const float ang = (float)t * inv;
        const double rev = (double)ang * 0.15915494309189535; const double fr = rev - __builtin_rint(rev);
        cs[t * 32 + i] = __builtin_amdgcn_cosf((float)fr); cs[t * 32 + 16 + i] = __builtin_amdgcn_sinf((float)fr); }
}
__device__ __forceinline__ void cbias_phase(const ArgRef& A, GLAS unsigned char* lds, int tid, int blk) {
    GLAS float* red = (GLAS float*)(lds + 16384);
    if (blk < 4) { const int l = blk >> 1, kv = blk & 1; const float* pe = A.in_(kv ? 16 : 13) + (size_t)l * 2048; const float* w1 = A.in_(kv ? 14 : 11) + (size_t)l * 2048 * 64;
        const int n4 = tid & 15, part = tid >> 4; f32x4 s = (f32x4){0.f, 0.f, 0.f, 0.f};
        const f32x4* w1v = (const f32x4*)w1 + (size_t)part * 64 * 16 + n4; const float* pep = pe + part * 64;
#pragma unroll 16
        for (int jj = 0; jj < 64; ++jj) s += w1v[(size_t)jj * 16] * pep[jj];
        *(GLAS f32x4*)(red + part * 64 + 4 * n4) = s;
        __syncthreads();
        if (tid < 64) { float t = 0.f;
#pragma unroll
            for (int p = 0; p < 32; ++p) t += red[p * 64 + tid];
            ((float*)(A.ws + WS_CBIAS))[(l * 2 + kv) * 64 + tid] = t; }
        __syncthreads();
    }
}
__device__ __forceinline__ void compress_phase(const ArgRef& A, int l, GLAS unsigned char* lds, int tid, int lane, int wave, int ubeg, int ustep) {
    asm volatile("" : "+v"(tid), "+v"(lane));
    typedef short bf16x8 __attribute__((ext_vector_type(8))); typedef float f32x16 __attribute__((ext_vector_type(16)));
    GLAS float* red = (GLAS float*)lds;
    GLAS float* c1 = (GLAS float*)(lds + 65536);
    GLAS float* w2s = (GLAS float*)(lds + 65536 + 8448);
    const int r32 = lane & 31, hi = lane >> 5;
    for (int u = ubeg; u < 64; u += ustep) {
        const int kv = u >> 5, bg = (u >> 3) & 3, rb = u & 7, i00 = rb * 64;
        const bf16_t* src = (const bf16_t*)(A.ws + (kv ? WS_VCF : WS_KCF)) + (size_t)bg * SEQ * 64;
        const bf16_t* w1t = (const bf16_t*)(A.ws + (kv ? W_1V : W_1K));
        const float* w2 = A.in_(kv ? 15 : 12) + (size_t)l * 4096;
        const float* cb = (const float*)(A.ws + WS_CBIAS) + (l * 2 + kv) * 64;
        { const f32x4* w2v = (const f32x4*)w2; f32x4 t0 = w2v[tid], t1 = w2v[tid + 512]; *(GLAS f32x4*)(w2s + 4 * tid) = t0; *(GLAS f32x4*)(w2s + 4 * (tid + 512)) = t1; }
        f32x16 a00 = f32x16{}, a01 = f32x16{}, a10 = f32x16{}, a11 = f32x16{};
        const bf16_t* ap = src + (size_t)(i00 + r32) * 1024 + wave * 256 + hi * 8;
        const bf16_t* bp = w1t + (size_t)r32 * 2048 + wave * 256 + hi * 8;
#pragma unroll 8
        for (int ks = 0; ks < 16; ++ks) {
            const bf16x8 af0 = *(const bf16x8*)(ap + ks * 16), af1 = *(const bf16x8*)(ap + 32 * 1024 + ks * 16), b0 = *(const bf16x8*)(bp + ks * 16), b1 = *(const bf16x8*)(bp + 32 * 2048 + ks * 16);
            a00 = __builtin_amdgcn_mfma_f32_32x32x16_bf16(af0, b0, a00, 0, 0, 0);
            a01 = __builtin_amdgcn_mfma_f32_32x32x16_bf16(af0, b1, a01, 0, 0, 0);
            a10 = __builtin_amdgcn_mfma_f32_32x32x16_bf16(af1, b0, a10, 0, 0, 0);
            a11 = __builtin_amdgcn_mfma_f32_32x32x16_bf16(af1, b1, a11, 0, 0, 0); }
#pragma unroll
        for (int rbk = 0; rbk < 2; ++rbk) { const int i0 = i00 + 32 * rbk;
#pragma unroll
            for (int r = 0; r < 16; ++r) { red[wave * 2048 + r * 64 + lane] = rbk ? a10[r] : a00[r]; red[wave * 2048 + (16 + r) * 64 + lane] = rbk ? a11[r] : a01[r]; }
            __syncthreads();
#pragma unroll
            for (int j = 0; j < 4; ++j) { const int e = tid + 512 * j; float s = 0.f;
#pragma unroll
                for (int w = 0; w < 8; ++w) s += red[w * 2048 + e];
                const int nt = e >> 10, r = (e >> 6) & 15, ln = e & 63; const int i = (r & 3) + 8 * (r >> 2) + 4 * (ln >> 5), n = 32 * nt + (ln & 31);
                const float xv = s + cb[n]; const float z = 0.7978845608028654f * (xv + 0.044715f * xv * xv * xv);
                const float th = 1.0f - 2.0f * __builtin_amdgcn_rcpf(__builtin_amdgcn_exp2f(2.885390081777927f * z) + 1.0f);
                c1[i * 65 + n] = 0.5f * xv * (1.0f + th); }
            __syncthreads();
            { const int i = tid >> 4, n2 = (tid & 15) * 4; f32x4 o = (f32x4){0.f, 0.f, 0.f, 0.f};
#pragma unroll 8
              for (int k = 0; k < 64; ++k) { const float c = c1[i * 65 + k]; const f32x4 w = *(const GLAS f32x4*)(w2s + k * 64 + n2); o += w * c; }
              const int nc = i0 + i; if (nc == 511) o = (f32x4){0.f, 0.f, 0.f, 0.f};
              const size_t tb = (size_t)bg * 8 + (nc >> 6); const int key = nc & 63;
              const unsigned long long pk = (unsigned long long)pk2(o.x, o.y) | ((unsigned long long)pk2(o.z, o.w) << 32);
              if (kv == 0) *(unsigned long long*)((bf16_t*)(A.ws + WS_KC) + (tb * 8 + (n2 >> 3)) * 512 + key * 8 + (n2 & 7)) = pk;
              else *(unsigned long long*)((bf16_t*)(A.ws + WS_VC) + tb * 4096 + (n2 >> 5) * 2048 + key * 32 + (n2 & 31)) = pk; }
            __syncthreads();
        }
    }
}

template <int NC> __device__ __forceinline__ void rstd_table(const bf16_t* X, int row0, GLAS float* tab, float scale, int lane, int wave) {
#pragma unroll 1
    for (int rb = 0; rb < 32; rb += 16) {
        u32x4 v[16];
#pragma unroll
        for (int r = 0; r < 16; ++r) { v[r] = (u32x4){0u, 0u, 0u, 0u}; if (lane < NC / 8) v[r] = *(const u32x4*)(X + (size_t)(row0 + wave * 32 + rb + r) * NC + lane * 8); }
#pragma unroll
        for (int r = 0; r < 16; ++r) { const unsigned w4[4] = {v[r].x, v[r].y, v[r].z, v[r].w}; float s = 0.f;
#pragma unroll
            for (int i = 0; i < 4; ++i) { const float a = __uint_as_float(w4[i] << 16), b = __uint_as_float(w4[i] & 0xffff0000u); s += a * a + b * b; }
            s = wave_sum(s);
            if (lane == 0) tab[wave * 32 + rb + r] = scale * __builtin_amdgcn_rsqf(s * (1.0f / NC) + 1e-6f); }
    }
}
__device__ __forceinline__ void dump_bf16(float* out, const bf16_t* src, int nslab, int gtid, int ngt) {
    for (int i = gtid; i < NT_TOK * DM; i += ngt) { float s = 0.f; for (int k = 0; k < nslab; ++k) if (k < 3 || i < 14 * 1024 * 1024) s += __uint_as_float(((unsigned)src[(size_t)k * NT_TOK * DM + i]) << 16); out[i] = s; }
}
#ifndef WIN_ALIGN
#define WIN_ALIGN true
#define WIN_SP2 true
#endif
#ifndef GUORDER
#define GUORDER TailOrder
#endif
#ifndef STOPAT
#define STOPAT 99
#endif
#ifndef PHMASK
#define PHMASK 0xffffffffu
#endif
#define PH(k) ((PHMASK >> (k)) & 1u)
#ifndef FUSE_NORM
#define FUSE_NORM 1
#endif
#define XCNT(bank) ((unsigned*)(ws + WS_BAR + 16384 * (1 + (bank))))
#define XSLOT(bank) ((unsigned*)(ws + WS_RSQ + (size_t)65536 * (bank)))
#ifndef DUPMASK
#define DUPMASK 0u
#endif
#define NREP(k) (((DUPMASK >> (k)) & 1u) ? 2 : 1)
#ifdef TPROBE
#define TSTAMP(k) do { if (blockIdx.x == 0 && wave == 0 && opaque_lane() == 0) { GLAS unsigned* tw_ = (GLAS unsigned*)(lds + 131072 + 8192); const unsigned t_ = (unsigned)__builtin_amdgcn_s_memrealtime(); tw_[k] += t_ - tw_[31]; tw_[31] = t_; } } while (0)
#else
#define TSTAMP(k) do { } while (0)
#endif
#ifndef USE_CG
#define GRIDBAR() xcd_barrier(xbar, wave)
#else
#define GRIDBAR() grid.sync()
#endif
constexpr int LDS_BYTES = 147456;
constexpr size_t WS_RSQ = 512 * 1024;
constexpr size_t WS_BAR = 384 * 1024, BAR_BYTES = 524288;
constexpr size_t WS_XRES = 278 * MiB;
constexpr size_t WS_XCH = 276 * MiB;
constexpr int LDS_BARST = 147456 - 64;
__global__ void __launch_bounds__(NTHREADS, 2) hybrid_fwd(KArgs KA) {
    extern __shared__ __attribute__((aligned(16))) unsigned char lds_raw[];
    GLAS unsigned char* lds = (GLAS unsigned char*)lds_raw;
    cg::grid_group grid = cg::this_grid();
    if (threadIdx.x < 8) ((GLAS unsigned*)(lds + LDS_BARST))[threadIdx.x] = 0u;
    __syncthreads();
    XcdBarrier xbar = xcd_barrier_post((unsigned*)(KA.ws + WS_BAR), (volatile GLAS unsigned*)(lds + LDS_BARST));
    const int wave = __builtin_amdgcn_readfirstlane(threadIdx.x >> 6);
#define MYTID() (wave * 64 + opaque_lane())
    int tid = MYTID(), lane = tid & 63; asm volatile("" : "+v"(tid), "+v"(lane));
    const int G = gridDim.x, blk0 = blockIdx.x; int blk = blk0;
    const int vcu = (G % 8 == 0) ? (blk % 8) * (G / 8) + blk / 8 : blk;
    const int gw = blk * NWAVES + wave, ngw = G * NWAVES;
    ArgRef A; A.ws = KA.ws; unsigned char* const ws0 = KA.ws; unsigned char* ws = ws0;
#define PHASE_BEGIN() do { unsigned long long w_ = (unsigned long long)ws0; blk = blk0; asm volatile("" : "+s"(w_), "+s"(blk)); ws = (unsigned char*)(__attribute__((address_space(1))) unsigned char*)w_; A.ws = ws; tid = MYTID(); lane = tid & 63; asm volatile("" : "+v"(tid), "+v"(lane)); } while (0)
    float* mod = (float*)(ws + WS_MOD);
    float* xres = KA.out;

#ifdef TPROBE
    if (threadIdx.x < 32) ((GLAS unsigned*)(lds + 131072 + 8192))[threadIdx.x] = 0u;
    __syncthreads();
    if (threadIdx.x == 0) ((GLAS unsigned*)(lds + 131072 + 8192))[31] = (unsigned)__builtin_amdgcn_s_memrealtime();
#endif
    for (int rep0 = 0; rep0 < NREP(0); ++rep0) {
    if (PH(0)) adaln_phase(A, lds, tid, lane, wave, blk, G);
    if (PH(1)) rope_table_phase((float*)(ws + WS_CS), blk * NTHREADS + tid, G * NTHREADS);
#ifdef CONV_IN_GU
    if (PH(2)) convert_layer(A, 0, lds, lane, wave, gw, ngw, 0, G == 256 ? (CONV_ALL & ~CONV_LATE) : CONV_ALL);
#else
    if (PH(2)) convert_layer(A, 0, lds, lane, wave, gw, ngw);
#endif
    __syncthreads();
    if (PH(3)) cbias_phase(A, lds, tid, blk);
#ifdef CBDUP
    for (int r_ = 0; r_ < CBDUP; ++r_) { __syncthreads(); cbias_phase(A, lds, tid, blk); }
#endif
    __syncthreads();
    }
#ifndef USE_CG_FIRST
    GRIDBAR();
#else
    grid.sync();
#endif
    TSTAMP(0);

    for (int l = 0; l < 2; ++l) {
#ifdef XTRA_BARS
        for (int xb_ = 0; xb_ < XTRA_BARS; ++xb_) GRIDBAR();
#endif
        PHASE_BEGIN();
        const float* ml = mod + (size_t)l * 2 * 9216;
        const float* xin = (l == 0) ? A.in_(0) : xres;
#if defined(CONVPROBE)
        if (PH(2) && l == 1) { for (int r_ = 0; r_ < 2; ++r_) { int md_ = r_ ? (CONVPROBE == 3 ? 0 : CONVPROBE) : 0; asm volatile("" : "+s"(md_)); convert_layer(A, 1, lds, lane, wave, gw, ngw, md_); __syncthreads(); PHASE_BEGIN(); } }
#else
#ifndef CONV_IN_GU
        if (PH(2) && l == 1) { convert_layer(A, 1, lds, lane, wave, gw, ngw); }
#endif
#endif
        if (PH(4) && (!FUSE_NORM || l == 0)) norm_phase(xin, (bf16_t*)(ws + WS_XN), ml + 0 * 1024, ml + 1 * 1024, lane, gw, ngw);
#ifdef CONV_IN_GU
        if (l == 1 && G != 256) convert_layer(A, 1, lds, lane, wave, gw, ngw);
        if (l == 0 || G != 256 || !FUSE_NORM) { GRIDBAR(); TSTAMP(1); PHASE_BEGIN(); }
#else
        GRIDBAR();
        TSTAMP(1);
        PHASE_BEGIN();
#endif
        for (int rep2 = 0; rep2 < NREP(2); ++rep2) {
        if (PH(5)) { pg8::Gemm g{(const bf16_t*)(ws + WS_XN), (const bf16_t*)(ws + W_GU1), NT_TOK, 5632, 1024}; pg8::GUORDER S; S.init(NT_TOK, 5632, G, blk);
          pg8::EpiSwiGLU E{ws};
          pg8::gemm_phase<pg8::EpiSwiGLU, pg8::GUORDER, true, true>(lds, g, S, E, wave); }
#ifdef CONV_IN_GU
        if (G == 256 && blk >= 128) { __syncthreads(); PHASE_BEGIN(); convert_layer(A, l, lds, lane, wave, (blk - 128) * NWAVES + wave, 128 * NWAVES, 0, l == 0 ? CONV_LATE : (CONV_ALL & ~CONV_EARLY)); }
#endif
        GRIDBAR();
        TSTAMP(2);
        PHASE_BEGIN();
        }
        if (STOPAT == 2) { dump_bf16(xres, (const bf16_t*)(ws + WS_C), 4, blk * NTHREADS + tid, G * NTHREADS); return; }
        if (PH(6)) { pg8::Gemm g{(const bf16_t*)(ws + WS_C), (const bf16_t*)(ws + W_D1), NT_TOK, 1024, 2816}; pg8::StaticOrder S; S.init(NT_TOK, 1024, G, blk);
#if FUSE_NORM
          const unsigned long long xa_ = (l == 0) ? (unsigned long long)A.in_(0) : (unsigned long long)(ws + WS_XRES);
          pg8::EpiResidNorm<false> E{(const void*)(const __attribute__((address_space(1))) void*)xa_, (void*)(ws + WS_XRES), ml + 2 * 1024, 1, ml + 3 * 1024, ml + 4 * 1024, (bf16_t*)(ws + WS_XN), XSLOT(l * 3 + 0), (l == 0) ? 0 : 1};
          pg8::gemm_phase<pg8::EpiResidNorm<false>, pg8::StaticOrder, false, true>(lds, g, S, E, wave); }
#else
          pg8::EpiResid E{xin, xres, ml + 2 * 1024, 0.5f};
          pg8::gemm_phase<pg8::EpiResid, pg8::StaticOrder, true, true>(lds, g, S, E, wave); }
#endif
        GRIDBAR();
        TSTAMP(3);
        PHASE_BEGIN();
        if (STOPAT == 3) {  return; }
#if !FUSE_NORM
        for (int r4 = 0; r4 < NREP(4); ++r4)
        if (PH(4)) norm_phase(xres, (bf16_t*)(ws + WS_XN), ml + 3 * 1024, ml + 4 * 1024, lane, gw, ngw);
#ifdef SENTINEL
        { unsigned* gp = (unsigned*)(ws + WS_GM); for (int i = blk * NTHREADS + tid; i < 16 * 1024 * 1024; i += G * NTHREADS) gp[i] = 0x447a447au; }
#endif
        GRIDBAR();
        TSTAMP(1);
        PHASE_BEGIN();
#endif
        for (int rep5 = 0; rep5 < NREP(5); ++rep5) {
        if (PH(7)) { pg8::Gemm g{(const bf16_t*)(ws + WS_XN), (const bf16_t*)(ws + W_IN), NT_TOK, 4096, 1024}; pg8::StaticOrder S; S.init(NT_TOK, 4096, G, blk);
          pg8::EpiWin E{ws};
          pg8::gemm_phase<pg8::EpiWin, pg8::StaticOrder, WIN_ALIGN, WIN_SP2>(lds, g, S, E, wave); }
        GRIDBAR();
        TSTAMP(4);
        PHASE_BEGIN();
        }
#ifndef DUMP_OFF
#define DUMP_OFF 84
#define DUMP_SLABS 4
#endif
        if (STOPAT == 5) { dump_bf16(xres, (const bf16_t*)(ws + (size_t)DUMP_OFF * MiB), DUMP_SLABS, blk * NTHREADS + tid, G * NTHREADS); return; }
        for (int rep6 = 0; rep6 < NREP(6); ++rep6) {
        for (int r13 = 0; r13 < NREP(13); ++r13)
        if (PH(8)) { pg8::Gemm g{(const bf16_t*)(ws + WS_CQ), (const bf16_t*)(ws + W_UQ), NT_TOK, 768, 384}; pg8::StaticOrder S; S.init(NT_TOK, 768, G, blk);
          { pg8::Unit u0; if (S.next(0, u0)) rstd_table<384>((const bf16_t*)(ws + WS_CQ), u0.pm * 256, (GLAS float*)(lds + 131072), 0.10206207261596577f * 1.4426950408889634f, lane, wave); }
          __syncthreads();
          pg8::EpiQproj E{ws, (const GLAS float*)(lds + 131072)};
          pg8::gemm_phase<pg8::EpiQproj, pg8::StaticOrder, true, true>(lds, g, S, E, wave); }
        for (int r14 = 0; r14 < NREP(14); ++r14)
        if (PH(9)) { pg8::Gemm g{(const bf16_t*)(ws + WS_CKV), (const bf16_t*)(ws + W_UKV), NT_TOK, 1024, 256}; pg8::StaticOrder S; S.init(NT_TOK, 1024, G, blk);
          PHASE_BEGIN();
          { pg8::Unit u0; if (S.next(0, u0)) rstd_table<256>((const bf16_t*)(ws + WS_CKV), u0.pm * 256, (GLAS float*)(lds + 131072 + 1024), 1.0f, lane, wave); }
          __syncthreads();
          pg8::EpiKVproj E{ws, (const GLAS float*)(lds + 131072 + 1024)};
          pg8::gemm_phase<pg8::EpiKVproj, pg8::StaticOrder, true, true>(lds, g, S, E, wave); }
        __syncthreads();
        PHASE_BEGIN();
        for (int r15 = 0; r15 < NREP(15); ++r15)
        if (PH(10)) compress_phase(A, l, lds, tid, lane, wave, (G == 256 ? (blk >= 192 ? blk - 192 : 64) : (G - 1 - blk)), (G == 256 ? 64 : G));
        GRIDBAR();
        TSTAMP(5);
        PHASE_BEGIN();
        }
        if (STOPAT == 6) { dump_bf16(xres, (const bf16_t*)(ws + WS_QM), 2, blk * NTHREADS + tid, G * NTHREADS); return; }
        for (int rep7 = 0; rep7 < NREP(7); ++rep7) {
        { att::NsaT NT{(const bf16_t*)(ws + WS_QN), (const bf16_t*)(ws + WS_KC), (const bf16_t*)(ws + WS_VC), (const bf16_t*)(ws + WS_KSEL), (const bf16_t*)(ws + WS_VSEL),
                       (const bf16_t*)(ws + WS_KWIN), (const bf16_t*)(ws + WS_VWIN), (const float*)(ws + WS_GATES), (bf16_t*)(ws + WS_OA), 1024};
          for (int v = vcu; v < 256; v += G) {
              for (int r11 = 0; r11 < NREP(11); ++r11) if (PH(11)) { const int bh = v >> 4, s = v & 15;
                if (r11 == 0) { att::mla_unit<0>(bh >> 3, bh & 7, 31 - s, (const bf16_t*)(ws + WS_QM), (const bf16_t*)(ws + WS_KM), (const bf16_t*)(ws + WS_VM), (bf16_t*)(ws + WS_OA) + 512, (GLAS char*)lds, wave);
                  att::mla_unit<0>(bh >> 3, bh & 7, s, (const bf16_t*)(ws + WS_QM), (const bf16_t*)(ws + WS_KM), (const bf16_t*)(ws + WS_VM), (bf16_t*)(ws + WS_OA) + 512, (GLAS char*)lds, wave); }
#ifdef MLADIAG
                else { att::mla_unit<MLADIAG>(bh >> 3, bh & 7, 31 - s, (const bf16_t*)(ws + WS_QM), (const bf16_t*)(ws + WS_KM), (const bf16_t*)(ws + WS_VM), (bf16_t*)(ws + WS_CQ), (GLAS char*)lds, wave, 512);
                  att::mla_unit<MLADIAG>(bh >> 3, bh & 7, s, (const bf16_t*)(ws + WS_QM), (const bf16_t*)(ws + WS_KM), (const bf16_t*)(ws + WS_VM), (bf16_t*)(ws + WS_CQ), (GLAS char*)lds, wave, 512); }
#endif
              }
              TSTAMP(9);
              for (int r12 = 0; r12 < NREP(12); ++r12) if (PH(12)) { const int bg = v >> 6, s = v & 63;
                if (r12 == 0) { att::nsa_unit<0>(bg >> 1, bg & 1, 127 - s, NT, (GLAS char*)lds, wave);
                  att::nsa_unit<0>(bg >> 1, bg & 1, s, NT, (GLAS char*)lds, wave); }
#ifdef NSADIAG
                else { att::NsaT ND = NT; ND.Oa = (bf16_t*)(ws + WS_CQ); ND.opitch = 512;
                  att::nsa_unit<NSADIAG>(bg >> 1, bg & 1, 127 - s, ND, (GLAS char*)lds, wave);
                  att::nsa_unit<NSADIAG>(bg >> 1, bg & 1, s, ND, (GLAS char*)lds, wave); }
#endif
              }
              TSTAMP(10);
          } }
        GRIDBAR();
        TSTAMP(6);
        PHASE_BEGIN();
        }
        if (STOPAT == 7) { dump_bf16(xres, (const bf16_t*)(ws + WS_OA), 1, blk * NTHREADS + tid, G * NTHREADS); return; }
        for (int rep8 = 0; rep8 < NREP(8); ++rep8) {
        if (PH(13)) { pg8::Gemm g{(const bf16_t*)(ws + WS_OA), (const bf16_t*)(ws + W_BA), NT_TOK, 1024, 1024}; pg8::StaticOrder S; S.init(NT_TOK, 1024, G, blk);
          pg8::EpiBranchM E{ws};
          pg8::gemm_phase<pg8::EpiBranchM, pg8::StaticOrder, true, true>(lds, g, S, E, wave); }
        GRIDBAR();
        TSTAMP(7);
        PHASE_BEGIN();
        }
        if (STOPAT == 8) { dump_bf16(xres, (const bf16_t*)(ws + WS_Y), 1, blk * NTHREADS + tid, G * NTHREADS); return; }
        if (PH(15)) { pg8::Gemm g{(const bf16_t*)(ws + WS_Y), (const bf16_t*)(ws + W_OUT), NT_TOK, 1024, 1024}; pg8::StaticOrder S; S.init(NT_TOK, 1024, G, blk);
#if FUSE_NORM
          pg8::EpiResidNorm<false> E{(const void*)(ws + WS_XRES), (void*)(ws + WS_XRES), ml + 5 * 1024, 2, ml + 6 * 1024, ml + 7 * 1024, (bf16_t*)(ws + WS_XN), XSLOT(l * 3 + 1)};
          pg8::gemm_phase<pg8::EpiResidNorm<false>, pg8::StaticOrder, false, true>(lds, g, S, E, wave); }
#else
          pg8::EpiResid E{xres, xres, ml + 5 * 1024, 1.0f};
          pg8::gemm_phase<pg8::EpiResid, pg8::StaticOrder, true, true>(lds, g, S, E, wave); }
#endif
        GRIDBAR();
        TSTAMP(8);
        PHASE_BEGIN();
#if !FUSE_NORM
        for (int r4 = 0; r4 < NREP(4); ++r4)
        if (PH(4)) norm_phase(xres, (bf16_t*)(ws + WS_XN), ml + 6 * 1024, ml + 7 * 1024, lane, gw, ngw);
        GRIDBAR();
        TSTAMP(1);
        PHASE_BEGIN();
#endif
        if (PH(16)) { pg8::Gemm g{(const bf16_t*)(ws + WS_XN), (const bf16_t*)(ws + W_GU2), NT_TOK, 5632, 1024}; pg8::GUORDER S; S.init(NT_TOK, 5632, G, blk);
          pg8::EpiSwiGLU E{ws};
          pg8::gemm_phase<pg8::EpiSwiGLU, pg8::GUORDER, true, true>(lds, g, S, E, wave); }
#ifdef CONV_IN_GU
        if (l == 0 && G == 256 && blk >= 128) { __syncthreads(); PHASE_BEGIN(); convert_layer(A, 1, lds, lane, wave, (blk - 128) * NWAVES + wave, 128 * NWAVES, 0, CONV_EARLY); }
#endif
        GRIDBAR();
        TSTAMP(2);
        PHASE_BEGIN();
        if (PH(17)) { pg8::Gemm g{(const bf16_t*)(ws + WS_C), (const bf16_t*)(ws + W_D2), NT_TOK, 1024, 2816}; pg8::StaticOrder S; S.init(NT_TOK, 1024, G, blk);
#if FUSE_NORM
          if (l == 0) { pg8::EpiResidNorm<false> E{(const void*)(ws + WS_XRES), (void*)(ws + WS_XRES), ml + 8 * 1024, 1, ml + 2 * 9216 + 0 * 1024, ml + 2 * 9216 + 1 * 1024, (bf16_t*)(ws + WS_XN), XSLOT(2)};
              pg8::gemm_phase<pg8::EpiResidNorm<false>, pg8::StaticOrder, false, true>(lds, g, S, E, wave); }
          else { pg8::EpiResidNorm<true> E{(const void*)(ws + WS_XRES), (void*)xres, ml + 8 * 1024, 1, A.in_(25), nullptr, nullptr, XSLOT(5)};
              pg8::gemm_phase<pg8::EpiResidNorm<true>, pg8::StaticOrder, false, true>(lds, g, S, E, wave); } }
        if (l == 0) { GRIDBAR(); TSTAMP(3); PHASE_BEGIN(); }
#else
          pg8::EpiResid E{xres, xres, ml + 8 * 1024, 0.5f};
          pg8::gemm_phase<pg8::EpiResid, pg8::StaticOrder, true, true>(lds, g, S, E, wave); }
        GRIDBAR();
        TSTAMP(3);
        PHASE_BEGIN();
#endif
    }
#if !FUSE_NORM
    tid = MYTID(); lane = tid & 63; asm volatile("" : "+v"(tid), "+v"(lane));
    if (PH(18)) final_norm_phase(xres, A.in_(25), lane, gw, ngw);
#endif
#ifdef TPROBE
    TSTAMP(11);
    __syncthreads();
    if (blockIdx.x == 0 && wave == 0 && opaque_lane() == 0) { const GLAS unsigned* ta = (const GLAS unsigned*)(lds + 131072 + 8192);
        asm volatile("s_waitcnt vmcnt(0)" ::: "memory");
        xres[0] = 0.01f * (float)ta[TPA]; const float vb = 0.01f * (float)ta[TPB]; for (int i = 1; i <= 100; ++i) xres[i] = vb; }
#endif
}

extern "C" void kernel_launch(void* const* d_in, const int* in_sizes, int n_in, void* d_out, int out_size, void* d_ws, size_t ws_size, hipStream_t stream) {
    static int grid_blocks = 0;
    if (grid_blocks == 0) {
        if (n_in != 26 || out_size != NT_TOK * DM || ws_size < WS_XRES + 32 * MiB) { fprintf(stderr, "kernel_launch: unexpected problem (n_in %d out %d ws %zu)\n", n_in, out_size, ws_size); grid_blocks = -1; return; }
        int dev = 0, cus = 0, per_cu = 0;
        hipGetDevice(&dev);
        hipDeviceGetAttribute(&cus, hipDeviceAttributeMultiprocessorCount, dev);
        hipFuncSetAttribute((const void*)hybrid_fwd, hipFuncAttributeMaxDynamicSharedMemorySize, LDS_BYTES);
        hipOccupancyMaxActiveBlocksPerMultiprocessor(&per_cu, (const void*)hybrid_fwd, NTHREADS, LDS_BYTES);
        if (per_cu < 1) { fprintf(stderr, "kernel_launch: occupancy query says %d blocks per CU\n", per_cu); per_cu = 1; }
        if (per_cu > 1) per_cu = 1;
        grid_blocks = cus * per_cu;
        (void)hipGetLastError();
    }
    if (grid_blocks < 0) return;
    if (hipMemsetAsync((char*)d_ws + WS_BAR, 0, BAR_BYTES, stream) != hipSuccess) { fprintf(stderr, "kernel_launch: memset failed\n"); return; }
    KArgs a{};
    for (int i = 0; i < 26; ++i) a.in[i] = (const float*)d_in[i];
    a.out = (float*)d_out; a.ws = (unsigned char*)d_ws;
    void* args[] = {&a};
    hipError_t e = hipLaunchCooperativeKernel((const void*)hybrid_fwd, dim3(grid_blocks), dim3(NTHREADS), args, LDS_BYTES, stream);
    if (e != hipSuccess) fprintf(stderr, "cooperative launch failed: %s (grid %d)\n", hipGetErrorString(e), grid_blocks);
}
```
